# Optimizing an MI355X kernel written in HIP

```python
import math
import jax, jax.numpy as jnp
from jax import lax
import numpy as np

D_MODEL = 1024
BATCH = 4
SEQ = 8192
DEPTH = 2

CTX_LEN = 256
GRID_W = 64
EPS = 1e-6
ROPE_THETA = 10000.0
NEG_INF = -1e30
Q_BLOCK = 128

MLA_HEADS = 8
MLA_NOPE = 64
MLA_ROPE = 32
MLA_V = 64
KV_RANK = 256
MLA_SCALE = (MLA_NOPE + MLA_ROPE) ** -0.5
SWA_HEADS = 8
SWA_KV_HEADS = 2
SWA_HEAD_DIM = 64
WINDOW = 128
BLOCK = 128
SWA_SCALE = SWA_HEAD_DIM ** -0.5
HYENA_WIDTH = 512
HYENA_ORDER = 2
HYENA_BANDS = 16
HYENA_EMB = 2 * HYENA_BANDS + 1
HYENA_HIDDEN = 64
HYENA_TARGET = 1e-2
HYENA_FAST_PCT = 0.3
HYENA_SLOW_PCT = 1.5
N_BRANCH = 3
BRANCH_WIDTH = 512
D_FF = 2816

COLS = (
    MLA_HEADS * (MLA_NOPE + MLA_ROPE),
    KV_RANK,
    MLA_ROPE,
    SWA_HEADS * SWA_HEAD_DIM,
    SWA_KV_HEADS * SWA_HEAD_DIM,
    SWA_KV_HEADS * SWA_HEAD_DIM,
    (HYENA_ORDER + 1) * HYENA_WIDTH,
    N_BRANCH * D_MODEL,
)
IN_WIDTH = sum(COLS)

kernel_name = "hybrid_mla_swa_hyena_dit_block"


def split_cols(p):
    outs, start = [], 0
    for w in COLS:
        outs.append(p[..., start:start + w])
        start += w
    return outs


def rms_norm(x, g):
    xf = x.astype(jnp.float32)
    y = xf * lax.rsqrt(jnp.mean(jnp.square(xf), axis=-1, keepdims=True) + EPS)
    return (y * g.astype(jnp.float32)).astype(x.dtype)


def modulate(x, g, shift, scale):
    return rms_norm(x, g) * (1 + scale) + shift


def axial_rope_tables(rows, rot_dim):
    row = jnp.repeat(jnp.arange(rows, dtype=jnp.float32), GRID_W)
    col = jnp.tile(jnp.arange(GRID_W, dtype=jnp.float32), rows)
    n_freq = rot_dim // 4
    inv_freq = ROPE_THETA ** (-jnp.arange(n_freq, dtype=jnp.float32) / n_freq)
    ang = jnp.concatenate([row[:, None] * inv_freq, col[:, None] * inv_freq], axis=-1)
    return jnp.cos(ang), jnp.sin(ang)


def apply_rope(x, cos, sin):
    x1, x2 = jnp.split(x, 2, axis=-1)
    return jnp.concatenate([x1 * cos - x2 * sin, x2 * cos + x1 * sin], axis=-1).astype(x.dtype)


def dwconv3(x, w, b):
    xp = jnp.pad(x, ((0, 0), (1, 1), (0, 0)))
    return xp[:, :-2] * w[0] + xp[:, 1:-1] * w[1] + xp[:, 2:] * w[2] + b


def sweep_query_blocks(fn, *qs):
    B, S = qs[0].shape[:2]
    nb = S // Q_BLOCK
    blocks = tuple(jnp.moveaxis(t.reshape(B, nb, Q_BLOCK, *t.shape[2:]), 1, 0) for t in qs)
    out = lax.map(lambda args: fn(*args), blocks)
    return jnp.moveaxis(out, 0, 1).reshape(B, S, -1)


def mla_kv(ckv, kv_norm_g, w_kv_up):
    B, L, _ = ckv.shape
    kv = (rms_norm(ckv, kv_norm_g) @ w_kv_up).reshape(B, L, MLA_HEADS, MLA_NOPE + MLA_V)
    return kv[..., :MLA_NOPE], kv[..., MLA_NOPE:]


def mla_attend(q_nope, q_rope, k_nope, k_rope, v):
    s = (jnp.einsum('bqhd,bkhd->bhqk', q_nope, k_nope, preferred_element_type=jnp.float32)
         + jnp.einsum('bqhr,bkr->bhqk', q_rope, k_rope, preferred_element_type=jnp.float32))
    p = jax.nn.softmax(s * MLA_SCALE, axis=-1).astype(v.dtype)
    return jnp.einsum('bhqk,bkhd->bqhd', p, v)


def swa_latent_attend(q, k, v, k_ctx, v_ctx, sink):
    B, S = q.shape[:2]
    C = k_ctx.shape[1]
    nb = S // BLOCK
    grp = SWA_HEADS // SWA_KV_HEADS
    qb = q.reshape(B, nb, BLOCK, SWA_KV_HEADS, grp, SWA_HEAD_DIM)

    def band(t):
        tp = jnp.pad(t, ((0, 0), (BLOCK, BLOCK), (0, 0), (0, 0))).reshape(B, nb + 2, BLOCK, SWA_KV_HEADS, SWA_HEAD_DIM)
        return jnp.concatenate([tp[:, :-2], tp[:, 1:-1], tp[:, 2:]], axis=2)

    kw, vw = band(k), band(v)
    s_loc = jnp.einsum('bnqhgd,bnkhd->bnhgqk', qb, kw, preferred_element_type=jnp.float32)
    s_ctx = jnp.einsum('bnqhgd,bchd->bnhgqc', qb, k_ctx, preferred_element_type=jnp.float32)
    q_pos = jnp.arange(nb)[:, None, None] * BLOCK + jnp.arange(BLOCK)[None, :, None]
    k_pos = (jnp.arange(nb)[:, None, None] - 1) * BLOCK + jnp.arange(3 * BLOCK)[None, None, :]
    valid = (jnp.abs(q_pos - k_pos) <= WINDOW) & (k_pos >= 0) & (k_pos < S)
    s_loc = jnp.where(valid[None, :, None, None], s_loc * SWA_SCALE, NEG_INF)
    sink_l = jnp.broadcast_to(sink.astype(jnp.float32).reshape(1, 1, SWA_KV_HEADS, grp, 1, 1), s_ctx.shape[:-1] + (1,))
    p = jax.nn.softmax(jnp.concatenate([s_ctx * SWA_SCALE, s_loc, sink_l], axis=-1), axis=-1).astype(v.dtype)
    out = (jnp.einsum('bnhgqc,bchd->bnqhgd', p[..., :C], v_ctx)
           + jnp.einsum('bnhgqk,bnkhd->bnqhgd', p[..., C:C + 3 * BLOCK], vw))
    return out.reshape(B, S, SWA_HEADS * SWA_HEAD_DIM)


def swa_context_attend(q, k, v, sink):
    B, C = q.shape[:2]
    grp = SWA_HEADS // SWA_KV_HEADS
    qg = q.reshape(B, C, SWA_KV_HEADS, grp, SWA_HEAD_DIM)
    s = jnp.einsum('bqhgd,bkhd->bhgqk', qg, k, preferred_element_type=jnp.float32) * SWA_SCALE
    sink_l = jnp.broadcast_to(sink.astype(jnp.float32).reshape(1, SWA_KV_HEADS, grp, 1, 1), s.shape[:-1] + (1,))
    p = jax.nn.softmax(jnp.concatenate([s, sink_l], axis=-1), axis=-1)[..., :-1].astype(v.dtype)
    return jnp.einsum('bhgqk,bkhd->bqhgd', p, v).reshape(B, C, SWA_HEADS * SWA_HEAD_DIM)


def hyena_filters(n_tokens, w1, b1, w2, b2, freq, w3):
    L = n_tokens
    t_idx = jnp.arange(L, dtype=jnp.float32)
    t = t_idx / max(L - 1, 1)
    bands = jnp.linspace(1e-4, HYENA_BANDS - 1, HYENA_BANDS, dtype=jnp.float32)
    ang = (2.0 * math.pi / L) * t_idx[:, None] * bands
    feats = jnp.concatenate([t[:, None], jnp.cos(ang), -jnp.sin(ang)], axis=-1)
    hid = jnp.sin(freq[0] * (feats @ w1 + b1))
    hid = jnp.sin(freq[1] * (hid @ w2 + b2))
    h = (hid @ w3).astype(jnp.float32).reshape(L, 2, HYENA_ORDER, HYENA_WIDTH)
    deltas = jnp.abs(jnp.linspace(math.log(HYENA_TARGET) / HYENA_SLOW_PCT, math.log(HYENA_TARGET) / HYENA_FAST_PCT,
                                  HYENA_WIDTH, dtype=jnp.float32))
    h = h * jnp.exp(-t[:, None] * deltas)[:, None, None, :]
    kern = jnp.concatenate([h[:, 0], jnp.zeros((1, HYENA_ORDER, HYENA_WIDTH), jnp.float32), h[:0:-1, 1]], axis=0)
    kern = kern / jnp.sum(jnp.abs(kern), axis=0, keepdims=True)
    return jnp.fft.rfft(kern, axis=0)


def hyena_branch(proj, conv_w, conv_b, filt_f, skip):
    L = proj.shape[1]
    u = dwconv3(proj, conv_w, conv_b)
    z, *gates = jnp.split(u, HYENA_ORDER + 1, axis=-1)
    z = z.astype(jnp.float32)
    for o in range(HYENA_ORDER):
        conv = jnp.fft.irfft(jnp.fft.rfft(z, n=2 * L, axis=1) * filt_f[:, o], n=2 * L, axis=1)[:, :L]
        z = gates[o] * (conv + z * skip[o])
    return z.astype(proj.dtype)


def merge_branches(y_a, y_b, y_c, gate_logits, w_branch, w_out):
    g_a, g_b, g_c = jnp.split(jax.nn.sigmoid(gate_logits), N_BRANCH, axis=-1)
    merged = g_a * (y_a @ w_branch[0]) + g_b * (y_b @ w_branch[1]) + g_c * (y_c @ w_branch[2])
    return merged @ w_out


def token_mixer(h, hc, with_ctx, rope_mla, rope_swa, w_in, kv_norm_g, w_kv_up, swa_sink,
                hy_conv_w, hy_conv_b, hy_w1, hy_b1, hy_w2, hy_b2, hy_freq, hy_w3, hy_skip, w_branch, w_out):
    B, S, _ = h.shape
    C = hc.shape[1]
    mq, mckv, mkr, sq, sk, sv, hy, gt = split_cols(h @ w_in)
    mq_c, mckv_c, mkr_c, sq_c, sk_c, sv_c, hy_c, gt_c = split_cols(hc @ w_in)
    cos_m, sin_m = rope_mla
    cos_s, sin_s = rope_swa

    q = mq.reshape(B, S, MLA_HEADS, MLA_NOPE + MLA_ROPE)
    q_nope = q[..., :MLA_NOPE]
    q_rope = apply_rope(q[..., MLA_NOPE:], cos_m[:, None], sin_m[:, None])
    k_nope, v = mla_kv(mckv, kv_norm_g, w_kv_up)
    kc_nope, vc = mla_kv(mckv_c, kv_norm_g, w_kv_up)
    keys_nope = jnp.concatenate([kc_nope, k_nope], axis=1)
    keys_rope = jnp.concatenate([mkr_c, apply_rope(mkr, cos_m, sin_m)], axis=1)
    vals = jnp.concatenate([vc, v], axis=1)
    y_a = sweep_query_blocks(lambda qn, qr: mla_attend(qn, qr, keys_nope, keys_rope, vals), q_nope, q_rope)

    q_s = apply_rope(sq.reshape(B, S, SWA_HEADS, SWA_HEAD_DIM), cos_s[:, None], sin_s[:, None])
    k_s = apply_rope(sk.reshape(B, S, SWA_KV_HEADS, SWA_HEAD_DIM), cos_s[:, None], sin_s[:, None])
    v_s = sv.reshape(B, S, SWA_KV_HEADS, SWA_HEAD_DIM)
    k_sc = sk_c.reshape(B, C, SWA_KV_HEADS, SWA_HEAD_DIM)
    v_sc = sv_c.reshape(B, C, SWA_KV_HEADS, SWA_HEAD_DIM)
    y_b = swa_latent_attend(q_s, k_s, v_s, k_sc, v_sc, swa_sink)

    y_c = hyena_branch(hy, hy_conv_w, hy_conv_b, hyena_filters(S, hy_w1, hy_b1, hy_w2, hy_b2, hy_freq, hy_w3), hy_skip)

    y = merge_branches(y_a, y_b, y_c, gt, w_branch, w_out)
    if not with_ctx:
        return y, None

    q_c = mq_c.reshape(B, C, MLA_HEADS, MLA_NOPE + MLA_ROPE)
    yc_a = mla_attend(q_c[..., :MLA_NOPE], q_c[..., MLA_NOPE:], kc_nope, mkr_c, vc).reshape(B, C, -1)
    yc_b = swa_context_attend(sq_c.reshape(B, C, SWA_HEADS, SWA_HEAD_DIM), k_sc, v_sc, swa_sink)
    yc_c = hyena_branch(hy_c, hy_conv_w, hy_conv_b, hyena_filters(C, hy_w1, hy_b1, hy_w2, hy_b2, hy_freq, hy_w3), hy_skip)
    y_ctx = merge_branches(yc_a, yc_b, yc_c, gt_c, w_branch, w_out)
    return y, y_ctx


def conv_ffn(h, w_up, conv_w, conv_b, w_down):
    u = dwconv3(h @ w_up, conv_w, conv_b)
    a, b = jnp.split(u, 2, axis=-1)
    return (jax.nn.silu(a) * b) @ w_down


def setup_inputs(seed: int = 0) -> dict:
    key = jax.random.key(seed)
    ks = iter(jax.random.split(key, 32))

    def nrm(shape, scale):
        return jax.random.normal(next(ks), shape, jnp.float32) * scale

    D = D_MODEL
    return {
        "x": nrm((BATCH, SEQ, D), 1.0),
        "c": nrm((BATCH, D), 1.0),
        "ctx": nrm((BATCH, CTX_LEN, D), 1.0),
        "c_ctx": nrm((D,), 1.0),
        "w_mod": nrm((DEPTH, D, 6 * D), D ** -0.5),
        "b_mod": nrm((DEPTH, 6 * D), 0.02),
        "norm_g": 1.0 + nrm((DEPTH, 4, D), 0.05),
        "w_in": nrm((DEPTH, D, IN_WIDTH), D ** -0.5),
        "kv_norm_g": 1.0 + nrm((DEPTH, KV_RANK), 0.05),
        "w_kv_up": nrm((DEPTH, KV_RANK, MLA_HEADS * (MLA_NOPE + MLA_V)), KV_RANK ** -0.5),
        "swa_sink": nrm((DEPTH, SWA_HEADS), 0.5),
        "hy_conv_w": nrm((DEPTH, 3, (HYENA_ORDER + 1) * HYENA_WIDTH), 3 ** -0.5),
        "hy_conv_b": nrm((DEPTH, (HYENA_ORDER + 1) * HYENA_WIDTH), 0.02),
        "hy_w1": nrm((DEPTH, HYENA_EMB, HYENA_HIDDEN), HYENA_EMB ** -0.5),
        "hy_b1": nrm((DEPTH, HYENA_HIDDEN), 0.02),
        "hy_w2": nrm((DEPTH, HYENA_HIDDEN, HYENA_HIDDEN), HYENA_HIDDEN ** -0.5),
        "hy_b2": nrm((DEPTH, HYENA_HIDDEN), 0.02),
        "hy_freq": 1.0 + nrm((DEPTH, 2, HYENA_HIDDEN), 0.05),
        "hy_w3": nrm((DEPTH, HYENA_HIDDEN, 2 * HYENA_ORDER * HYENA_WIDTH), HYENA_HIDDEN ** -0.5),
        "hy_skip": nrm((DEPTH, HYENA_ORDER, HYENA_WIDTH), 0.5),
        "w_branch": nrm((DEPTH, N_BRANCH, BRANCH_WIDTH, D), BRANCH_WIDTH ** -0.5),
        "w_out": nrm((DEPTH, D, D), D ** -0.5),
        "w_up": nrm((DEPTH, D, 2 * D_FF), D ** -0.5),
        "ffn_conv_w": nrm((DEPTH, 3, 2 * D_FF), 3 ** -0.5),
        "ffn_conv_b": nrm((DEPTH, 2 * D_FF), 0.02),
        "w_down": nrm((DEPTH, D_FF, D), D_FF ** -0.5),
    }


def reference(x, c, ctx, c_ctx, w_mod, b_mod, norm_g, w_in, kv_norm_g, w_kv_up, swa_sink,
              hy_conv_w, hy_conv_b, hy_w1, hy_b1, hy_w2, hy_b2, hy_freq, hy_w3, hy_skip,
              w_branch, w_out, w_up, ffn_conv_w, ffn_conv_b, w_down):
    S = x.shape[1]
    rows = S // GRID_W
    rope_mla = axial_rope_tables(rows, MLA_ROPE)
    rope_swa = axial_rope_tables(rows, SWA_HEAD_DIM)
    x_lat, x_ctx = x, ctx
    for l in range(DEPTH):
        with_ctx = l < DEPTH - 1
        mod = (jax.nn.silu(c) @ w_mod[l] + b_mod[l])[:, None, :]
        mod_c = (jax.nn.silu(c_ctx) @ w_mod[l] + b_mod[l])[None, None, :]
        sh1, sc1, g1, sh2, sc2, g2 = jnp.split(mod, 6, axis=-1)
        csh1, csc1, cg1, csh2, csc2, cg2 = jnp.split(mod_c, 6, axis=-1)

        y, y_ctx = token_mixer(
            modulate(x_lat, norm_g[l, 0], sh1, sc1), modulate(x_ctx, norm_g[l, 0], csh1, csc1), with_ctx,
            rope_mla, rope_swa, w_in[l], kv_norm_g[l], w_kv_up[l], swa_sink[l],
            hy_conv_w[l], hy_conv_b[l], hy_w1[l], hy_b1[l], hy_w2[l], hy_b2[l], hy_freq[l], hy_w3[l], hy_skip[l],
            w_branch[l], w_out[l])
        x_lat = x_lat + g1 * rms_norm(y, norm_g[l, 1])

        f = conv_ffn(modulate(x_lat, norm_g[l, 2], sh2, sc2), w_up[l], ffn_conv_w[l], ffn_conv_b[l], w_down[l])
        x_lat = x_lat + g2 * rms_norm(f, norm_g[l, 3])

        if with_ctx:
            x_ctx = x_ctx + cg1 * rms_norm(y_ctx, norm_g[l, 1])
            fc = conv_ffn(modulate(x_ctx, norm_g[l, 2], csh2, csc2), w_up[l], ffn_conv_w[l], ffn_conv_b[l], w_down[l])
            x_ctx = x_ctx + cg2 * rms_norm(fc, norm_g[l, 3])
    return x_lat
```

```cpp
#include <hip/hip_runtime.h>
#include <hip/hip_cooperative_groups.h>
#include <cstdio>
namespace cg = cooperative_groups;
#define DI __device__ __forceinline__
typedef unsigned short u16;
typedef __attribute__((ext_vector_type(8))) short bf16x8;
typedef __attribute__((ext_vector_type(4))) short s16x4;
typedef __attribute__((ext_vector_type(16))) float f32x16;
typedef __attribute__((ext_vector_type(4))) unsigned u32x4;
typedef __attribute__((ext_vector_type(2))) unsigned u32x2;
typedef __attribute__((ext_vector_type(2))) __bf16 bf2_t;
typedef __attribute__((ext_vector_type(2))) float f2_t;
typedef __attribute__((ext_vector_type(2))) _Float16 h2_t;
#define MFMA(a, b, c) __builtin_amdgcn_mfma_f32_32x32x16_bf16((a), (b), (c), 0, 0, 0)

constexpr int DM = 1024, NBATCH = 4, SEQ = 8192, CTX = 256, TPB = 8448, MTOK = 33792;
constexpr int DFF = 2816;
#ifndef DBG_ZERO_HCTX
#define DBG_ZERO_HCTX 0
#endif
#ifndef DBG_DUMP
#define DBG_DUMP 0
#endif
#ifndef DBG_NOFFT
#define DBG_NOFFT 0
#endif
#ifndef DBG_SPLITC
#define DBG_SPLITC 0
#endif
#ifndef DBG_REP_GEMM
#define DBG_REP_GEMM 1
#endif
#ifndef DBG_REP_MLA
#define DBG_REP_MLA 1
#endif
#ifndef DBG_HEAVY_SYNC
#define DBG_HEAVY_SYNC 0
#endif
#ifndef DBG_REP_FFT
#define DBG_REP_FFT 1
#endif
#ifndef DBG_REP_PLAIN
#define DBG_REP_PLAIN 1
#endif
#ifndef DBG_EXTRA_SYNCS
#define DBG_EXTRA_SYNCS 0
#endif
#ifndef DBG_CG_SYNC
#define DBG_CG_SYNC 0
#endif
#ifndef DBG_SKIP_BR
#define DBG_SKIP_BR 0
#endif
#define DBG_FIRST_BR ((DBG_SKIP_BR & 1) ? ((DBG_SKIP_BR & 2) ? 2 : 1) : 0)
constexpr float LOG2E = 1.4426950408889634f;
constexpr float EPS = 1e-6f;

struct Params {
  const float *x, *c, *ctx, *c_ctx, *w_mod, *b_mod, *norm_g, *w_in, *kv_norm_g, *w_kv_up, *swa_sink, *hy_conv_w, *hy_conv_b,
      *hy_w1, *hy_b1, *hy_w2, *hy_b2, *hy_freq, *hy_w3, *hy_skip, *w_branch, *w_out, *w_up, *ffn_conv_w, *ffn_conv_b, *w_down;
  float* out;
  char* ws;
};

constexpr size_t OFF_WT_IN = 0;
constexpr size_t OFF_WT_GATE = OFF_WT_IN + (size_t)3456 * 1024 * 2;
constexpr size_t OFF_WT_KV = OFF_WT_GATE + (size_t)3072 * 1024 * 2;
constexpr size_t OFF_WT_BR = OFF_WT_KV + (size_t)1024 * 256 * 2;
constexpr size_t OFF_WT_OUT = OFF_WT_BR + (size_t)3 * 1024 * 512 * 2;
constexpr size_t OFF_WT_UP = OFF_WT_OUT + (size_t)1024 * 1024 * 2;
constexpr size_t OFF_WT_DOWN = OFF_WT_UP + (size_t)5632 * 1024 * 2;
constexpr size_t OFF_RH = OFF_WT_DOWN + (size_t)1024 * 2816 * 2;
constexpr size_t OFF_KN = OFF_RH + (size_t)MTOK * 1024 * 2;
constexpr size_t OFF_VT = OFF_KN + (size_t)MTOK * 512 * 2;
constexpr size_t OFF_KR = OFF_VT + (size_t)MTOK * 512 * 2;
constexpr size_t OFF_Q = OFF_KR + (size_t)MTOK * 32 * 2;
constexpr size_t OFF_SQ = OFF_Q + (size_t)MTOK * 768 * 2;
constexpr size_t OFF_CKV = OFF_SQ + (size_t)MTOK * 512 * 2;
constexpr size_t OFF_SK = OFF_CKV + (size_t)MTOK * 256 * 2;
constexpr size_t OFF_SVT = OFF_SK + (size_t)MTOK * 128 * 2;
constexpr size_t OFF_HYT = OFF_SVT + (size_t)MTOK * 128 * 2;
constexpr size_t OFF_SPEC = OFF_HYT + (size_t)MTOK * 1536 * 2;
constexpr size_t OFF_XCTX = OFF_SPEC + (size_t)1024 * 2 * 8192 * 4;
constexpr size_t OFF_MOD = OFF_XCTX + (size_t)1024 * 1024 * 4;
constexpr size_t OFF_ROPE = OFF_MOD + (size_t)2 * 5 * 6144 * 4;
constexpr size_t OFF_HID = OFF_ROPE + (size_t)8192 * 96 * 4;
constexpr size_t HID_LAYER = (size_t)64 * (8192 + 256) * 4;
constexpr size_t OFF_ESCR = OFF_HID + 2 * HID_LAYER;
constexpr size_t OFF_BAR = OFF_ESCR + (size_t)512 * 65536;
constexpr size_t BAR_BYTES = 3456 * 4;
constexpr size_t WS_NEED = OFF_BAR + BAR_BYTES;
constexpr size_t OFF_A = OFF_Q;
constexpr size_t OFF_MERGED = OFF_HYT;
constexpr size_t OFF_HP = OFF_KN;
constexpr size_t OFF_YCT = OFF_RH;
constexpr size_t OFF_YA = OFF_RH + (size_t)MTOK * 512 * 2;
static_assert(OFF_A + (size_t)MTOK * 2816 * 2 <= OFF_SPEC, "A overlay");
static_assert(WS_NEED <= (size_t)512 * 1024 * 1024, "ws");

DI int opq(int x) { asm volatile("" : "+v"(x)); return x; }
DI float ldsc1(const float* p) { return __hip_atomic_load(p, __ATOMIC_RELAXED, __HIP_MEMORY_SCOPE_AGENT); }
DI float bf2f(u16 v) { return __uint_as_float(((unsigned)v) << 16); }
DI unsigned pack2(float a, float b) { f2_t v = {a, b}; return __builtin_bit_cast(unsigned, __builtin_convertvector(v, bf2_t)); }
DI u16 f2bf(float a) { return (u16)(pack2(a, 0.f) & 0xffffu); }
DI float lo_bf(unsigned u) { return __uint_as_float(u << 16); }
DI float hi_bf(unsigned u) { return __uint_as_float(u & 0xffff0000u); }
DI int crow(int i, int h) { return (i & 3) + 8 * (i >> 2) + 4 * h; }
DI float wave_sum(float v) {
#pragma unroll
  for (int o = 32; o > 0; o >>= 1) v += __shfl_xor(v, o);
  return v;
}
DI float sinrev(float r) { return __builtin_amdgcn_sinf(r - floorf(r)); }
DI float cosrev(float r) { return __builtin_amdgcn_cosf(r - floorf(r)); }
#if DBG_TRIVTW
#define COSREV(f) (1.0f)
#define SINREV(f) (0.0f * (f))
#else
#define COSREV(f) cosrev(f)
#define SINREV(f) sinrev(f)
#endif
#define SYNC() __syncthreads()
DI float2 cmul(float2 a, float2 b) { return make_float2(a.x * b.x - a.y * b.y, a.x * b.y + a.y * b.x); }
DI float2 cmulc(float2 a, float2 b) { return make_float2(a.x * b.x + a.y * b.y, a.y * b.x - a.x * b.y); }
#ifndef DBG_NOSWZ
#define DBG_NOSWZ 0
#endif
DI int fphys(int i) { return DBG_NOSWZ ? i : (i ^ ((i >> 4) & 15)); }
DI float2 twid_rev(float fr) { return make_float2(COSREV(fr), -SINREV(fr)); }

DI float2 root16(int e) {
  const float C1 = 0.92387953251128674f, S1 = 0.38268343236508977f, R = 0.70710678118654752f;
  switch (e) {
    case 0: return make_float2(1.f, 0.f);
    case 1: return make_float2(C1, -S1);
    case 2: return make_float2(R, -R);
    case 3: return make_float2(S1, -C1);
    case 4: return make_float2(0.f, -1.f);
    case 5: return make_float2(-S1, -C1);
    case 6: return make_float2(-R, -R);
    default: return make_float2(-C1, -S1);
  }
}
template <int R, int HALF, int S, bool INV, bool HASW>
DI void fft_stage(float2 (&v)[R], const float2 (&wp)[4]) {
#pragma unroll
  for (int idx = 0; idx < R / 2; ++idx) {
    const int blk = idx / HALF, jj = idx % HALF;
    const int j0 = blk * 2 * HALF + jj, j1 = j0 + HALF;
    const int e = jj * (8 / HALF);
    float2 tw = root16(e);
    if (HASW) { if (e == 0) tw = wp[S]; else tw = cmul(wp[S], tw); }
    const bool triv = (!HASW) && (e == 0);
    if (!INV) {
      float2 a = v[j0], b = v[j1];
      v[j0] = make_float2(a.x + b.x, a.y + b.y);
      float2 d = make_float2(a.x - b.x, a.y - b.y);
      v[j1] = triv ? d : cmul(d, tw);
    } else {
      float2 t = triv ? v[j1] : cmulc(v[j1], tw);
      float2 a = v[j0];
      v[j0] = make_float2(a.x + t.x, a.y + t.y);
      v[j1] = make_float2(a.x - t.x, a.y - t.y);
    }
  }
}
template <bool INV> DI void fft_local8(float2 (&v)[8], const float2 (&wp)[4]) {
  if (!INV) { fft_stage<8, 4, 0, false, true>(v, wp); fft_stage<8, 2, 1, false, true>(v, wp); fft_stage<8, 1, 2, false, true>(v, wp); }
  else      { fft_stage<8, 1, 2, true, true>(v, wp); fft_stage<8, 2, 1, true, true>(v, wp); fft_stage<8, 4, 0, true, true>(v, wp); }
}
template <bool INV> DI void fft_local16(float2 (&v)[16], const float2 (&wp)[4]) {
  if (!INV) { fft_stage<16, 8, 0, false, false>(v, wp); fft_stage<16, 4, 1, false, false>(v, wp); fft_stage<16, 2, 2, false, false>(v, wp); fft_stage<16, 1, 3, false, false>(v, wp); }
  else      { fft_stage<16, 1, 3, true, false>(v, wp); fft_stage<16, 2, 2, true, false>(v, wp); fft_stage<16, 4, 1, true, false>(v, wp); fft_stage<16, 8, 0, true, false>(v, wp); }
}

template <int LQ, bool INV> DI void fft_pass8(float2* lds, int tid) {
  constexpr int q = 1 << LQ;
#pragma unroll 1
  for (int it = 0; it < 4; ++it) {
    const int task = tid + 256 * it;
    const int p = task & (q - 1);
    const int g = task >> LQ;
    const int base = g * 8 * q + p;
    float2 v[8];
#pragma unroll
    for (int j = 0; j < 8; ++j) v[j] = lds[fphys(base + j * q)];
    float2 wp[4];
    wp[0] = twid_rev((float)p * (1.0f / (float)(8 * q)));
    wp[1] = cmul(wp[0], wp[0]);
    wp[2] = cmul(wp[1], wp[1]);
    wp[3] = wp[2];
    fft_local8<INV>(v, wp);
#pragma unroll
    for (int j = 0; j < 8; ++j) lds[fphys(base + j * q)] = v[j];
  }
}
template <bool INV> DI void fft_pass16(float2* lds, int tid) {
#pragma unroll 1
  for (int it = 0; it < 2; ++it) {
    const int g = tid + 256 * it;
    float2 v[16];
    const int sw = DBG_NOSWZ ? 0 : (g & 15);
#pragma unroll
    for (int j = 0; j < 16; ++j) v[j] = lds[g * 16 + (j ^ sw)];
    float2 wp[4] = {make_float2(1.f, 0.f), make_float2(1.f, 0.f), make_float2(1.f, 0.f), make_float2(1.f, 0.f)};
    fft_local16<INV>(v, wp);
#pragma unroll
    for (int j = 0; j < 16; ++j) lds[g * 16 + (j ^ sw)] = v[j];
  }
}
#ifndef DBG_FFTPASSES
#define DBG_FFTPASSES 15
#endif
DI void fft8192_fwd(float2* lds, int tid) {
  if (DBG_FFTPASSES & 1) { fft_pass8<10, false>(lds, tid); SYNC(); }
  if (DBG_FFTPASSES & 2) { fft_pass8<7, false>(lds, tid); SYNC(); }
  if (DBG_FFTPASSES & 4) { fft_pass8<4, false>(lds, tid); SYNC(); }
  if (DBG_FFTPASSES & 8) { fft_pass16<false>(lds, tid); SYNC(); }
}
DI void fft8192_inv(float2* lds, int tid) {
  fft_pass16<true>(lds, tid); SYNC();
  fft_pass8<4, true>(lds, tid); SYNC();
  fft_pass8<7, true>(lds, tid); SYNC();
  fft_pass8<10, true>(lds, tid); SYNC();
}

template <bool SWAP, bool ATR = false, int MTW = 2>
DI void gemm_main(const u16* __restrict__ A, int lda, int a_row0, int a_lo, int a_hi, int a_kstep,
                  const u16* __restrict__ B, int ldb, int nk, f32x16 (&acc)[MTW][2], char* smem) {
  constexpr int ROWS = MTW * 64, NA = MTW * 2;
  const int tid = opq(threadIdx.x), lane = tid & 63, wave = tid >> 6, wm = wave >> 1, wn = wave & 1, r = lane & 31, h = lane >> 5;
  char* sA = smem;
  char* sB = smem + ROWS * 144;
  const u16* ap[NA];
  const u16* bp[4];
  int loa[NA], lob[4];
#pragma unroll
  for (int i = 0; i < NA; ++i) {
    const int idx = tid + 256 * i, row = idx >> 3, ch = idx & 7;
    if (ATR) {
      ap[i] = A + (size_t)(idx & 63) * lda + a_row0 + (idx >> 6) * 8;
    } else {
      const int gr = min(max(a_row0 + row, a_lo), a_hi);
      ap[i] = A + (size_t)gr * lda + ch * 8;
    }
    loa[i] = row * 144 + ch * 16;
  }
#pragma unroll
  for (int i = 0; i < 4; ++i) {
    const int idx = tid + 256 * i, row = idx >> 3, ch = idx & 7;
    bp[i] = B + (size_t)row * ldb + ch * 8;
    lob[i] = row * 144 + ch * 16;
  }
  u32x4 ra0[NA], rb0[4];
#define GEMM_LOAD(RA, RB, KT)                                                                                         \
  _Pragma("unroll") for (int i = 0; i < NA; ++i)                                                                      \
    RA[i] = *(const u32x4*)(ap[i] + (ATR ? (size_t)(KT) * 64 * lda : (size_t)(KT) * a_kstep));                        \
  _Pragma("unroll") for (int i = 0; i < 4; ++i) RB[i] = *(const u32x4*)(bp[i] + (KT) * 64);
#define GEMM_STASH(RA, RB)                                                                                            \
  _Pragma("unroll") for (int i = 0; i < NA; ++i) {                                                                    \
    if (ATR) {                                                                                                        \
      const int idx = tid + 256 * i, krow = idx & 63, mch = idx >> 6;                                                 \
      _Pragma("unroll") for (int e = 0; e < 4; ++e) {                                                                 \
        *(u16*)(sA + (mch * 8 + 2 * e) * 144 + krow * 2) = (u16)(RA[i][e] & 0xffffu);                                 \
        *(u16*)(sA + (mch * 8 + 2 * e + 1) * 144 + krow * 2) = (u16)(RA[i][e] >> 16);                                 \
      }                                                                                                               \
    } else {                                                                                                          \
      *(u32x4*)(sA + loa[i]) = RA[i];                                                                                 \
    }                                                                                                                 \
  }                                                                                                                   \
  _Pragma("unroll") for (int i = 0; i < 4; ++i) *(u32x4*)(sB + lob[i]) = RB[i];
#define GEMM_COMPUTE()                                                                                                \
  _Pragma("unroll") for (int ks = 0; ks < 4; ++ks) {                                                                  \
    bf16x8 af[MTW], bfr[2];                                                                                           \
    _Pragma("unroll") for (int t = 0; t < MTW; ++t) af[t] = *(const bf16x8*)(pa + t * 32 * 144 + ks * 32);            \
    _Pragma("unroll") for (int t = 0; t < 2; ++t) bfr[t] = *(const bf16x8*)(pb + t * 32 * 144 + ks * 32);             \
    _Pragma("unroll") for (int mt = 0; mt < MTW; ++mt)                                                                \
      _Pragma("unroll") for (int nt = 0; nt < 2; ++nt)                                                                \
        acc[mt][nt] = SWAP ? MFMA(bfr[nt], af[mt], acc[mt][nt]) : MFMA(af[mt], bfr[nt], acc[mt][nt]);                 \
  }
  GEMM_LOAD(ra0, rb0, 0)
#pragma unroll
  for (int mt = 0; mt < MTW; ++mt)
#pragma unroll
    for (int nt = 0; nt < 2; ++nt)
#pragma unroll
      for (int i = 0; i < 16; ++i) acc[mt][nt][i] = 0.f;
  const char* pa = sA + (wm * (MTW * 32) + r) * 144 + h * 16;
  const char* pb = sB + (wn * 64 + r) * 144 + h * 16;
#pragma unroll 1
  for (int kk = 0; kk < nk; ++kk) {
    __syncthreads();
    GEMM_STASH(ra0, rb0)
    __syncthreads();
    if (kk + 1 < nk) { GEMM_LOAD(ra0, rb0, kk + 1) }
    GEMM_COMPUTE()
  }
#undef GEMM_LOAD
#undef GEMM_STASH
#undef GEMM_COMPUTE
}
template <int MTW>
DI void store_rowmajor(const f32x16 (&acc)[MTW][2], u16* C, int ldc, int m0, int ncol0, float scale) {
  const int tid = opq(threadIdx.x), lane = tid & 63, wave = tid >> 6, wm = wave >> 1, wn = wave & 1, r = lane & 31, h = lane >> 5;
#pragma unroll
  for (int mt = 0; mt < MTW; ++mt)
#pragma unroll
    for (int nt = 0; nt < 2; ++nt)
#pragma unroll
      for (int g = 0; g < 4; ++g) {
        const int m = m0 + wm * (MTW * 32) + mt * 32 + r, n = ncol0 + wn * 64 + nt * 32 + 8 * g + 4 * h;
        u32x2 pk;
        pk.x = pack2(acc[mt][nt][4 * g] * scale, acc[mt][nt][4 * g + 1] * scale);
        pk.y = pack2(acc[mt][nt][4 * g + 2] * scale, acc[mt][nt][4 * g + 3] * scale);
        *(u32x2*)(C + (size_t)m * ldc + n) = pk;
      }
}
template <int MTW>
DI void store_transposed(const f32x16 (&acc)[MTW][2], u16* T, int ldt, int trow0, int j0) {
  const int tid = opq(threadIdx.x), lane = tid & 63, wave = tid >> 6, wm = wave >> 1, wn = wave & 1, r = lane & 31, h = lane >> 5;
#pragma unroll
  for (int mt = 0; mt < MTW; ++mt)
#pragma unroll
    for (int nt = 0; nt < 2; ++nt)
#pragma unroll
      for (int g = 0; g < 4; ++g) {
        const int n = trow0 + wn * 64 + nt * 32 + r, m = j0 + wm * (MTW * 32) + mt * 32 + 8 * g + 4 * h;
        u32x2 pk;
        pk.x = pack2(acc[mt][nt][4 * g], acc[mt][nt][4 * g + 1]);
        pk.y = pack2(acc[mt][nt][4 * g + 2], acc[mt][nt][4 * g + 3]);
        *(u32x2*)(T + (size_t)n * ldt + m) = pk;
      }
}

constexpr int NCONV_TILES = 864 + 768 + 64 + 384 + 256 + 1408 + 704;
DI void conv_tile(const Params& p, int l, int tile, char* smem) {
  float* t = (float*)smem;
  const int tid = opq(threadIdx.x);
  int mat, tn, tk;
  if (tile < 864) { mat = 0; tn = tile / 16; tk = tile % 16; }
  else if (tile < 1632) { tile -= 864; mat = 1; tn = tile / 16; tk = tile % 16; }
  else if (tile < 1696) { tile -= 1632; mat = 2; tn = tile / 4; tk = tile % 4; }
  else if (tile < 2080) { tile -= 1696; mat = 3; tn = tile / 8; tk = tile % 8; }
  else if (tile < 2336) { tile -= 2080; mat = 4; tn = tile / 16; tk = tile % 16; }
  else if (tile < 3744) { tile -= 2336; mat = 5; tn = tile / 16; tk = tile % 16; }
  else { tile -= 3744; mat = 6; tn = tile / 44; tk = tile % 44; }
  const int k0 = tk * 64;
  const int nn = tid & 63;
  int np = tn * 64 + nn;
  const float* src; int ld; int col;
  if (mat == 0) { src = p.w_in + (size_t)l * 1024 * 6432; ld = 6432; col = np < 1024 ? np : (np < 3328 ? np + 32 : (np < 3360 ? np - 3328 + 1024 : -1)); }
  else if (mat == 1) { src = p.w_in + (size_t)l * 1024 * 6432; ld = 6432; col = 3360 + np; }
  else if (mat == 2) { src = p.w_kv_up + (size_t)l * 256 * 1024; ld = 1024; col = np < 512 ? (np >> 6) * 128 + (np & 63) : ((np - 512) >> 6) * 128 + 64 + (np & 63); }
  else if (mat == 3) { const int br = tn / 16; np = (tn % 16) * 64 + nn; src = p.w_branch + (size_t)(l * 3 + br) * 512 * 1024; ld = 1024; col = np; }
  else if (mat == 4) { src = p.w_out + (size_t)l * 1024 * 1024; ld = 1024; col = np; }
  else if (mat == 5) { src = p.w_up + (size_t)l * 1024 * 5632; ld = 5632; const int blk = np >> 7, rr = np & 127; col = rr < 64 ? blk * 64 + rr : 2816 + blk * 64 + rr - 64; }
  else { src = p.w_down + (size_t)l * 2816 * 1024; ld = 1024; col = np; }
#pragma unroll 4
  for (int i = 0; i < 16; ++i) {
    const int kk = (tid >> 6) + 4 * i;
    float v = 0.f;
    if (col >= 0) v = src[(size_t)(k0 + kk) * ld + col];
    if (mat == 2) v *= p.kv_norm_g[l * 256 + k0 + kk];
    t[kk * 65 + nn] = v;
  }
  __syncthreads();
  {
    const int n2 = tid >> 2, kq = (tid & 3) * 16;
    const int drow = tn * 64 + n2;
    u16* dst;
    if (mat == 0) dst = (u16*)(p.ws + OFF_WT_IN) + (size_t)drow * 1024;
    else if (mat == 1) dst = (u16*)(p.ws + OFF_WT_GATE) + (size_t)drow * 1024;
    else if (mat == 2) dst = (u16*)(p.ws + OFF_WT_KV) + (size_t)drow * 256;
    else if (mat == 3) dst = (u16*)(p.ws + OFF_WT_BR) + (size_t)drow * 512;
    else if (mat == 4) dst = (u16*)(p.ws + OFF_WT_OUT) + (size_t)drow * 1024;
    else if (mat == 5) dst = (u16*)(p.ws + OFF_WT_UP) + (size_t)drow * 1024;
    else dst = (u16*)(p.ws + OFF_WT_DOWN) + (size_t)drow * 2816;
    unsigned pk[8];
#pragma unroll
    for (int j = 0; j < 8; ++j) pk[j] = pack2(t[(kq + 2 * j) * 65 + n2], t[(kq + 2 * j + 1) * 65 + n2]);
    u32x4* d4 = (u32x4*)(dst + k0 + kq);
    d4[0] = u32x4{pk[0], pk[1], pk[2], pk[3]};
    d4[1] = u32x4{pk[4], pk[5], pk[6], pk[7]};
  }
  __syncthreads();
}

DI void mod_item(const Params& p, int item, char* smem) {
  float* sv = (float*)smem;
  float* red = sv + 5 * 1024;
  const int tid = opq(threadIdx.x);
  const int l = item / 96, cg0 = (item % 96) * 64;
  for (int i = tid; i < 5 * 1024; i += 256) {
    const int v = i >> 10, k = i & 1023;
    const float c = v < 4 ? p.c[v * 1024 + k] : p.c_ctx[k];
    sv[i] = c / (1.f + __expf(-c));
  }
  __syncthreads();
  const int kq = tid >> 6, cc = tid & 63, col = cg0 + cc;
  float a[5] = {0.f, 0.f, 0.f, 0.f, 0.f};
  const float* w = p.w_mod + (size_t)l * 1024 * 6144 + col;
#pragma unroll 8
  for (int k = kq * 256; k < kq * 256 + 256; ++k) {
    const float wv = w[(size_t)k * 6144];
#pragma unroll
    for (int v = 0; v < 5; ++v) a[v] += sv[v * 1024 + k] * wv;
  }
#pragma unroll
  for (int v = 0; v < 5; ++v) red[(kq * 5 + v) * 64 + cc] = a[v];
  __syncthreads();
  for (int i = tid; i < 5 * 64; i += 256) {
    const int v = i >> 6, c2 = i & 63;
    float s = p.b_mod[l * 6144 + cg0 + c2];
#pragma unroll
    for (int q = 0; q < 4; ++q) s += red[(q * 5 + v) * 64 + c2];
    ((float*)(p.ws + OFF_MOD))[(l * 5 + v) * 6144 + cg0 + c2] = s;
  }
  __syncthreads();
}

DI void rope_item(const Params& p, int item) {
  const int e = item * 256 + opq(threadIdx.x);
  const int pos = e / 48, f = e % 48;
  const int row = pos >> 6, colp = pos & 63;
  float* base = (float*)(p.ws + OFF_ROPE);
  float ang; float *cd, *sd;
  if (f < 16) {
    const int fi = f & 7;
    const float inv = exp2f(-(float)fi * (13.287712379549449f / 8.f));
    ang = (f < 8 ? (float)row : (float)colp) * inv;
    cd = base + pos * 16 + f; sd = base + 8192 * 16 + pos * 16 + f;
  } else {
    const int f2 = f - 16, fi = f2 & 15;
    const float inv = exp2f(-(float)fi * (13.287712379549449f / 16.f));
    ang = (f2 < 16 ? (float)row : (float)colp) * inv;
    cd = base + 2 * 8192 * 16 + pos * 32 + f2; sd = base + 2 * 8192 * 16 + 8192 * 32 + pos * 32 + f2;
  }
  const float rev = ang * 0.15915494309189535f;
  *cd = cosrev(rev);
  *sd = sinrev(rev);
}

DI void hid_item(const Params& p, int item, char* smem) {
  float* feat = (float*)smem;
  float* h1 = feat + 4 * 36;
  const int tid = opq(threadIdx.x);
  const int l = item / 264; const int it = item % 264;
  int L, pos00; float* dst;
  if (it < 256) { L = 8192; pos00 = it * 32; dst = (float*)(p.ws + OFF_HID + l * HID_LAYER); }
  else { L = 256; pos00 = (it - 256) * 32; dst = (float*)(p.ws + OFF_HID + l * HID_LAYER) + 64 * 8192; }
  const int pp = tid >> 6, j = tid & 63;
#pragma unroll 1
  for (int sub = 0; sub < 8; ++sub) {
    const int pos = pos00 + sub * 4 + pp;
    if (j < 33) {
      float fv;
      if (j == 0) fv = (float)pos / (float)(L - 1);
      else {
        const int bi = (j - 1) & 15;
        const float band = 1e-4f + (float)bi * ((15.f - 1e-4f) / 15.f);
        const float rev = (float)pos * band / (float)L;
        fv = (j <= 16) ? cosrev(rev) : -sinrev(rev);
      }
      feat[pp * 36 + j] = fv;
    }
    __syncthreads();
    {
      float s = p.hy_b1[l * 64 + j];
      const float* w1 = p.hy_w1 + (size_t)l * 33 * 64;
#pragma unroll
      for (int f = 0; f < 33; ++f) s += feat[pp * 36 + f] * w1[f * 64 + j];
      s *= p.hy_freq[l * 128 + j];
      h1[pp * 64 + j] = sinrev(s * 0.15915494309189535f);
    }
    __syncthreads();
    {
      float s = p.hy_b2[l * 64 + j];
      const float* w2 = p.hy_w2 + (size_t)l * 64 * 64;
#pragma unroll 8
      for (int i = 0; i < 64; ++i) s += h1[pp * 64 + i] * w2[i * 64 + j];
      s *= p.hy_freq[l * 128 + 64 + j];
      dst[(size_t)j * L + pos] = sinrev(s * 0.15915494309189535f);
    }
    __syncthreads();
  }
}

DI const float* xrow_src(const float* xl, const float* xc, int m) {
  const int b = m / TPB, j = m - b * TPB;
  return j < CTX ? xc + (size_t)(b * CTX + j) * DM : xl + (size_t)(b * SEQ + j - CTX) * DM;
}
DI void row_pass(const Params& p, int mode, const float* xl_src, const float* xc_src, float* xl_dst, float* xc_dst,
                 const u16* ybuf, const float* gy, int gate_off, int modl_gate,
                 bool has_next, const float* gn, int modl_next, int sh_off, int sc_off, u16* hdst, bool skip_ctx_rows) {
  const int tid0 = opq(threadIdx.x);
  const int lane = tid0 & 63;
  const int gw = blockIdx.x * 4 + (tid0 >> 6), nw = gridDim.x * 4;
  const float* modb = (const float*)(p.ws + OFF_MOD);
  const int per = (MTOK + nw - 1) / nw;
  const int m_beg = gw * per, m_end = min(m_beg + per, MTOK);
  int cur_v = -1;
  float4 gg[4], gs[4], shv[4];
#pragma unroll
  for (int i = 0; i < 4; ++i) { gg[i] = make_float4(0.f, 0.f, 0.f, 0.f); gs[i] = gg[i]; shv[i] = gg[i]; }
  const bool do_h = (mode == 0) || has_next;
  float4 xv_n[4];
  u32x2 yr_n[4];
#pragma unroll
  for (int i = 0; i < 4; ++i) { xv_n[i] = make_float4(0.f, 0.f, 0.f, 0.f); yr_n[i] = u32x2{0u, 0u}; }
  if (m_beg < m_end) {
    const float* xs0 = xrow_src(xl_src, xc_src, m_beg);
#pragma unroll
    for (int i = 0; i < 4; ++i) {
      xv_n[i] = *(const float4*)(xs0 + lane * 4 + 256 * i);
      if (mode == 1) yr_n[i] = *(const u32x2*)(ybuf + (size_t)m_beg * DM + lane * 4 + 256 * i);
    }
  }
  for (int m = m_beg; m < m_end; ++m) {
    const int b = m / TPB, j = m - b * TPB;
    float4 xv[4];
    u32x2 yr[4];
#pragma unroll
    for (int i = 0; i < 4; ++i) { xv[i] = xv_n[i]; yr[i] = yr_n[i]; }
    if (m + 1 < m_end) {
      const float* xs1 = xrow_src(xl_src, xc_src, m + 1);
#pragma unroll
      for (int i = 0; i < 4; ++i) {
        xv_n[i] = *(const float4*)(xs1 + lane * 4 + 256 * i);
        if (mode == 1) yr_n[i] = *(const u32x2*)(ybuf + (size_t)(m + 1) * DM + lane * 4 + 256 * i);
      }
    }
    if (skip_ctx_rows && j < CTX) continue;
    const int v = j < CTX ? 4 : b;
    if (v != cur_v) {
      cur_v = v;
#pragma unroll
      for (int i = 0; i < 4; ++i) {
        const int c = lane * 4 + 256 * i;
        if (mode == 1) {
          const float4 g4 = *(const float4*)(gy + c);
          const float4 t4 = *(const float4*)(modb + (size_t)(modl_gate * 5 + v) * 6144 + gate_off + c);
          gg[i] = make_float4(g4.x * t4.x, g4.y * t4.y, g4.z * t4.z, g4.w * t4.w);
        }
        if (do_h) {
          const float* mb = modb + (size_t)(modl_next * 5 + v) * 6144;
          const float4 g4 = *(const float4*)(gn + c);
          const float4 sc = *(const float4*)(mb + sc_off + c);
          shv[i] = *(const float4*)(mb + sh_off + c);
          gs[i] = make_float4(g4.x * (1.f + sc.x), g4.y * (1.f + sc.y), g4.z * (1.f + sc.z), g4.w * (1.f + sc.w));
        }
      }
    }
    if (mode == 1) {
      float yv[4][4];
      float ss = 0.f;
#pragma unroll
      for (int i = 0; i < 4; ++i) {
        const u32x2 u = yr[i];
        yv[i][0] = lo_bf(u.x); yv[i][1] = hi_bf(u.x); yv[i][2] = lo_bf(u.y); yv[i][3] = hi_bf(u.y);
#pragma unroll
        for (int e = 0; e < 4; ++e) ss += yv[i][e] * yv[i][e];
      }
      ss = wave_sum(ss);
      const float rstd = rsqrtf(ss * (1.f / DM) + EPS);
#pragma unroll
      for (int i = 0; i < 4; ++i) {
        xv[i].x += gg[i].x * (yv[i][0] * rstd);
        xv[i].y += gg[i].y * (yv[i][1] * rstd);
        xv[i].z += gg[i].z * (yv[i][2] * rstd);
        xv[i].w += gg[i].w * (yv[i][3] * rstd);
      }
      float* xd = (j < CTX) ? xc_dst + (size_t)(b * CTX + j) * DM : xl_dst + (size_t)(b * SEQ + j - CTX) * DM;
#pragma unroll
      for (int i = 0; i < 4; ++i) *(float4*)(xd + lane * 4 + 256 * i) = xv[i];
    }
    if (do_h) {
      float ss = 0.f;
#pragma unroll
      for (int i = 0; i < 4; ++i) ss += xv[i].x * xv[i].x + xv[i].y * xv[i].y + xv[i].z * xv[i].z + xv[i].w * xv[i].w;
      ss = wave_sum(ss);
      const float rstd = rsqrtf(ss * (1.f / DM) + EPS);
#pragma unroll
      for (int i = 0; i < 4; ++i) {
        const int c = lane * 4 + 256 * i;
        u32x2 pk;
        pk.x = pack2(xv[i].x * rstd * gs[i].x + shv[i].x, xv[i].y * rstd * gs[i].y + shv[i].y);
        pk.y = pack2(xv[i].z * rstd * gs[i].z + shv[i].z, xv[i].w * rstd * gs[i].w + shv[i].w);
        *(u32x2*)(hdst + (size_t)m * DM + c) = pk;
      }
    }
  }
}

constexpr float QS_MLA = 0.10206207261596577f * LOG2E;
constexpr float QS_SWA = 0.125f * LOG2E;

DI void rope32(f32x16& a, const float* cm, const float* sm, int pos, int h) {
#pragma unroll
  for (int i = 0; i < 8; ++i) {
    const int f = crow(i, h);
    const float c = cm[pos * 16 + f], s = sm[pos * 16 + f];
    const float x1 = a[i], x2 = a[i + 8];
    a[i] = x1 * c - x2 * s;
    a[i + 8] = x2 * c + x1 * s;
    if ((i & 3) == 3) __builtin_amdgcn_sched_barrier(0);
  }
}
DI void rope64(f32x16& a0, f32x16& a1, const float* cs, const float* ss, int pos, int h) {
#pragma unroll
  for (int i = 0; i < 16; ++i) {
    const int f = crow(i, h);
    const float c = cs[pos * 32 + f], s = ss[pos * 32 + f];
    const float x1 = a0[i], x2 = a1[i];
    a0[i] = x1 * c - x2 * s;
    a1[i] = x2 * c + x1 * s;
    if ((i & 3) == 3) __builtin_amdgcn_sched_barrier(0);
  }
}

DI void inproj_tile(const Params& p, int tile, char* smem) {
  const int mt_i = tile / 27, nt_i = tile % 27;
  const int m0 = mt_i * 192;
  const int tid = opq(threadIdx.x), lane = tid & 63, wave = tid >> 6, wm = wave >> 1, wn = wave & 1, r = lane & 31, h = lane >> 5;
  const u16* hbuf = (const u16*)(p.ws + OFF_RH);
  const u16* wt = (const u16*)(p.ws + OFF_WT_IN) + (size_t)nt_i * 128 * 1024;
  const int b = m0 / TPB, j0 = m0 - b * TPB;
  const float* cm = (const float*)(p.ws + OFF_ROPE);
  const float* sm = cm + 8192 * 16;
  const float* cs = sm + 8192 * 16;
  const float* ss = cs + 8192 * 32;
  f32x16 acc[3][2];
  if (nt_i >= 13 && nt_i <= 25) {
    gemm_main<false>(hbuf, 1024, m0, 0, MTOK - 1, 64, wt, 1024, 16, acc, smem);
    if (nt_i == 13) store_transposed(acc, (u16*)(p.ws + OFF_SVT), TPB, b * 128, j0);
    else store_transposed(acc, (u16*)(p.ws + OFF_HYT), TPB, b * 1536 + (nt_i - 14) * 128, j0);
    return;
  }
  gemm_main<true>(hbuf, 1024, m0, 0, MTOK - 1, 64, wt, 1024, 16, acc, smem);
  if (nt_i < 6) {
#pragma unroll
    for (int ntl = 0; ntl < 2; ++ntl) {
      const int s32 = nt_i * 4 + wn * 2 + ntl;
      if (s32 % 3 == 2) {
#pragma unroll
        for (int mt = 0; mt < 3; ++mt) {
          const int jr = j0 + wm * 96 + mt * 32 + r;
          if (jr >= CTX) rope32(acc[mt][ntl], cm, sm, jr - CTX, h);
        }
      }
    }
    store_rowmajor(acc, (u16*)(p.ws + OFF_Q), 768, m0, nt_i * 128, QS_MLA);
  } else if (nt_i < 8) {
    store_rowmajor(acc, (u16*)(p.ws + OFF_CKV), 256, m0, (nt_i - 6) * 128, 1.f);
  } else if (nt_i < 12) {
#pragma unroll
    for (int mt = 0; mt < 3; ++mt) {
      const int jr = j0 + wm * 96 + mt * 32 + r;
      if (jr >= CTX) rope64(acc[mt][0], acc[mt][1], cs, ss, jr - CTX, h);
    }
    store_rowmajor(acc, (u16*)(p.ws + OFF_SQ), 512, m0, (nt_i - 8) * 128, QS_SWA);
  } else if (nt_i == 12) {
#pragma unroll
    for (int mt = 0; mt < 3; ++mt) {
      const int jr = j0 + wm * 96 + mt * 32 + r;
      if (jr >= CTX) rope64(acc[mt][0], acc[mt][1], cs, ss, jr - CTX, h);
    }
    store_rowmajor(acc, (u16*)(p.ws + OFF_SK), 128, m0, 0, 1.f);
  } else {
    if (wn == 0) {
      u16* kr = (u16*)(p.ws + OFF_KR);
#pragma unroll
      for (int mt = 0; mt < 3; ++mt) {
        const int ml = wm * 96 + mt * 32 + r;
        if (j0 + ml >= CTX) rope32(acc[mt][0], cm, sm, j0 + ml - CTX, h);
#pragma unroll
        for (int g = 0; g < 4; ++g) {
          u32x2 pk;
          pk.x = pack2(acc[mt][0][4 * g], acc[mt][0][4 * g + 1]);
          pk.y = pack2(acc[mt][0][4 * g + 2], acc[mt][0][4 * g + 3]);
          *(u32x2*)(kr + (size_t)(m0 + ml) * 32 + 8 * g + 4 * h) = pk;
        }
      }
    }
  }
}

DI void kvup_tile(const Params& p, int tile, char* smem) {
  const int mt_i = tile >> 3, nt_i = tile & 7;
  const int m0 = mt_i * 192;
  const int tid = opq(threadIdx.x), lane = tid & 63, wave = tid >> 6, wm = wave >> 1, r = lane & 31, h = lane >> 5;
  const u16* ckv = (const u16*)(p.ws + OFF_CKV);
  float* rs = (float*)(smem + (192 + 128) * 144);
#pragma unroll
  for (int pass = 0; pass < 2; ++pass) {
    const int row = pass * 128 + (tid >> 1), half = tid & 1;
    const int rowc = min(row, 191);
    const u32x4* src = (const u32x4*)(ckv + (size_t)(m0 + rowc) * 256 + half * 128);
    float ss = 0.f;
#pragma unroll
    for (int i = 0; i < 16; ++i) {
      const u32x4 u = src[i];
      const unsigned w[4] = {u.x, u.y, u.z, u.w};
#pragma unroll
      for (int e = 0; e < 4; ++e) { const float a = lo_bf(w[e]), c = hi_bf(w[e]); ss += a * a + c * c; }
    }
    ss += __shfl_xor(ss, 1);
    if (half == 0 && row < 192) rs[row] = rsqrtf(ss * (1.f / 256.f) + EPS);
  }
  const u16* wt = (const u16*)(p.ws + OFF_WT_KV) + (size_t)nt_i * 128 * 256;
  const int b = m0 / TPB, j0 = m0 - b * TPB;
  f32x16 acc[3][2];
  if (nt_i < 4) {
    gemm_main<true>(ckv, 256, m0, 0, MTOK - 1, 64, wt, 256, 4, acc, smem);
#pragma unroll
    for (int mt = 0; mt < 3; ++mt) {
      const float sc = rs[wm * 96 + mt * 32 + r];
#pragma unroll
      for (int nt = 0; nt < 2; ++nt)
#pragma unroll
        for (int i = 0; i < 16; ++i) acc[mt][nt][i] *= sc;
    }
    store_rowmajor(acc, (u16*)(p.ws + OFF_KN), 512, m0, nt_i * 128, 1.f);
  } else {
    gemm_main<false>(ckv, 256, m0, 0, MTOK - 1, 64, wt, 256, 4, acc, smem);
#pragma unroll
    for (int mt = 0; mt < 3; ++mt)
#pragma unroll
      for (int i = 0; i < 16; ++i) {
        const float sc = rs[wm * 96 + mt * 32 + crow(i, h)];
        acc[mt][0][i] *= sc;
        acc[mt][1][i] *= sc;
      }
    store_transposed(acc, (u16*)(p.ws + OFF_VT), TPB, b * 512 + (nt_i - 4) * 128, j0);
  }
  __syncthreads();
}

DI void merge_tile(const Params& p, int tile, char* smem) {
  const int mt_i = tile >> 3, nt_i = tile & 7;
  const int m0 = mt_i * 192;
  const u16* hp = (const u16*)(p.ws + OFF_HP);
  const int tid = opq(threadIdx.x), lane = tid & 63, wave = tid >> 6, wm = wave >> 1, wn = wave & 1, r = lane & 31, h = lane >> 5;
  u16* C = (u16*)(p.ws + OFF_MERGED);
#pragma unroll 1
  for (int br = 0; br < 3; ++br) {
    if ((DBG_SKIP_BR >> br) & 1) continue;
    f32x16 acc[3][2];
    gemm_main<true>(hp, 1024, m0, 0, MTOK - 1, 64, (const u16*)(p.ws + OFF_WT_GATE) + (size_t)(br * 1024 + nt_i * 128) * 1024, 1024, 16, acc, smem);
    u32x2* sgp = (u32x2*)(p.ws + OFF_ESCR + (size_t)blockIdx.x * 65536) + tid * 24;
#pragma unroll
    for (int a = 0; a < 3; ++a)
#pragma unroll
      for (int b2 = 0; b2 < 2; ++b2)
#pragma unroll
        for (int g = 0; g < 4; ++g) {
          u32x2 v;
          v.x = pack2(1.f / (1.f + __expf(-acc[a][b2][4 * g])), 1.f / (1.f + __expf(-acc[a][b2][4 * g + 1])));
          v.y = pack2(1.f / (1.f + __expf(-acc[a][b2][4 * g + 2])), 1.f / (1.f + __expf(-acc[a][b2][4 * g + 3])));
          sgp[(a * 2 + b2) * 4 + g] = v;
        }
    const u16* wbr = (const u16*)(p.ws + OFF_WT_BR) + (size_t)(br * 1024 + nt_i * 128) * 512;
    if (br == 0) gemm_main<true>((const u16*)(p.ws + OFF_YA), 512, m0, 0, MTOK - 1, 64, wbr, 512, 8, acc, smem);
    else if (br == 1) gemm_main<true>((const u16*)(p.ws + OFF_SQ), 512, m0, 0, MTOK - 1, 64, wbr, 512, 8, acc, smem);
    else {
      const int b = m0 / TPB, j0 = m0 - b * TPB;
      gemm_main<true, true>((const u16*)(p.ws + OFF_YCT) + (size_t)(b * 512) * TPB, TPB, j0, 0, 0, 64, wbr, 512, 8, acc, smem);
    }
#pragma unroll
    for (int mt = 0; mt < 3; ++mt)
#pragma unroll
      for (int nt = 0; nt < 2; ++nt)
#pragma unroll
        for (int g = 0; g < 4; ++g) {
          const int m = m0 + wm * 96 + mt * 32 + r, n = nt_i * 128 + wn * 64 + nt * 32 + 8 * g + 4 * h;
          u32x2* dst = (u32x2*)(C + (size_t)m * 1024 + n);
          u32x2 prev = {0u, 0u};
          if (br > DBG_FIRST_BR) prev = *dst;
          const u32x2 sv = sgp[(mt * 2 + nt) * 4 + g];
          const unsigned s0 = sv.x, s1 = sv.y;
          u32x2 nv;
          nv.x = pack2(lo_bf(prev.x) + lo_bf(s0) * acc[mt][nt][4 * g], hi_bf(prev.x) + hi_bf(s0) * acc[mt][nt][4 * g + 1]);
          nv.y = pack2(lo_bf(prev.y) + lo_bf(s1) * acc[mt][nt][4 * g + 2], hi_bf(prev.y) + hi_bf(s1) * acc[mt][nt][4 * g + 3]);
          *dst = nv;
          __builtin_amdgcn_sched_barrier(0);
        }
  }
}

DI void plain_tile(const Params& p, int tile, const u16* A, int lda, int nk, const u16* W, u16* C, char* smem) {
  const int mt_i = tile >> 3, nt_i = tile & 7;
  f32x16 acc[3][2];
  gemm_main<true>(A, lda, mt_i * 192, 0, MTOK - 1, 64, W + (size_t)nt_i * 128 * lda, lda, nk, acc, smem);
  store_rowmajor(acc, C, 1024, mt_i * 192, nt_i * 128, 1.f);
}

DI void ffnup_tile(const Params& p, int l, int tile, char* smem) {
  const int mt_i = tile / 44, nt_i = tile % 44;
  const int b = mt_i / 46, ti = mt_i % 46;
  int seq_base, len, r0;
  if (ti < 2) { seq_base = b * TPB; len = CTX; r0 = 190 * ti; }
  else { seq_base = b * TPB + CTX; len = SEQ; r0 = 190 * (ti - 2); }
  const int tid = opq(threadIdx.x), lane = tid & 63, wave = tid >> 6, wm = wave >> 1, wn = wave & 1, r = lane & 31, h = lane >> 5;
  f32x16 acc[3][2];
  gemm_main<true>((const u16*)(p.ws + OFF_RH), 1024, seq_base + r0 - 1, seq_base, seq_base + len - 1, 64,
                  (const u16*)(p.ws + OFF_WT_UP) + (size_t)nt_i * 128 * 1024, 1024, 16, acc, smem);
  __syncthreads();
#pragma unroll
  for (int mt = 0; mt < 3; ++mt) {
    const int ml = wm * 96 + mt * 32 + r;
    const int pos = r0 - 1 + ml;
    const bool valid = pos >= 0 && pos < len;
#pragma unroll
    for (int nt = 0; nt < 2; ++nt)
#pragma unroll
      for (int g = 0; g < 4; ++g) {
        u32x2 pk = u32x2{0u, 0u};
        if (valid) {
          pk.x = pack2(acc[mt][nt][4 * g], acc[mt][nt][4 * g + 1]);
          pk.y = pack2(acc[mt][nt][4 * g + 2], acc[mt][nt][4 * g + 3]);
        }
        *(u32x2*)(smem + ml * 272 + (wn * 64 + nt * 32 + 8 * g + 4 * h) * 2) = pk;
      }
  }
  __syncthreads();
  {
    const int j4 = (tid & 15) * 4, tr = tid >> 4;
    const float* cw = p.ffn_conv_w + (size_t)l * 3 * 5632;
    const float* cb = p.ffn_conv_b + (size_t)l * 5632;
    const int cha = nt_i * 64 + j4, chb = DFF + cha;
    float wa[3][4], wb[3][4], ba[4], bb[4];
#pragma unroll
    for (int e = 0; e < 4; ++e) {
#pragma unroll
      for (int d = 0; d < 3; ++d) { wa[d][e] = cw[d * 5632 + cha + e]; wb[d][e] = cw[d * 5632 + chb + e]; }
      ba[e] = cb[cha + e]; bb[e] = cb[chb + e];
    }
    u16* Aout = (u16*)(p.ws + OFF_A);
#pragma unroll 1
    for (int i = 0; i < 12; ++i) {
      const int t = 1 + tr + 16 * i;
      const int pos = r0 - 1 + t;
      if (t <= 190 && pos < len) {
        float ca[4], cbv[4];
#pragma unroll
        for (int e = 0; e < 4; ++e) { ca[e] = ba[e]; cbv[e] = bb[e]; }
#pragma unroll
        for (int d = 0; d < 3; ++d) {
          const u32x2 ua = *(const u32x2*)(smem + (t - 1 + d) * 272 + j4 * 2);
          const u32x2 ub = *(const u32x2*)(smem + (t - 1 + d) * 272 + (64 + j4) * 2);
          ca[0] += lo_bf(ua.x) * wa[d][0]; ca[1] += hi_bf(ua.x) * wa[d][1]; ca[2] += lo_bf(ua.y) * wa[d][2]; ca[3] += hi_bf(ua.y) * wa[d][3];
          cbv[0] += lo_bf(ub.x) * wb[d][0]; cbv[1] += hi_bf(ub.x) * wb[d][1]; cbv[2] += lo_bf(ub.y) * wb[d][2]; cbv[3] += hi_bf(ub.y) * wb[d][3];
        }
        float o[4];
#pragma unroll
        for (int e = 0; e < 4; ++e) o[e] = ca[e] / (1.f + __expf(-ca[e])) * cbv[e];
        *(u32x2*)(Aout + (size_t)(seq_base + pos) * DFF + cha) = u32x2{pack2(o[0], o[1]), pack2(o[2], o[3])};
      }
    }
  }
}

template <int DQK, bool SWA>
DI void attn_item(const Params& p, int l, int b, int hq, int jq0  , int nct, int nband, int kp_start, char* smem) {
  constexpr int KS = DQK * 2 + 16;
  constexpr int KCH = DQK / 8;
  constexpr int NKC = 64 * KCH / 256;
  constexpr int NKS = DQK / 16;
  constexpr int BUFSZ = 22016;
  const int tid = opq(threadIdx.x), lane = tid & 63, wave = tid >> 6, r = lane & 31, h = lane >> 5;
  const int brow = b * TPB;
  const int ntiles = nct + nband;
  const u16* K1; int ldk1, koff; const u16* KR = (const u16*)(p.ws + OFF_KR);
  const u16* Vb; u16* outp; int ldo, ooff; const u16* Qb; int ldq;
  if (!SWA) {
    K1 = (const u16*)(p.ws + OFF_KN); ldk1 = 512; koff = hq * 64;
    Vb = (const u16*)(p.ws + OFF_VT) + (size_t)((b * 8 + hq) * 64) * TPB;
    Qb = (const u16*)(p.ws + OFF_Q); ldq = 768;
    outp = (u16*)(p.ws + OFF_YA); ldo = 512; ooff = hq * 64;
  } else {
    const int kvh = hq >> 2;
    K1 = (const u16*)(p.ws + OFF_SK); ldk1 = 128; koff = kvh * 64;
    Vb = (const u16*)(p.ws + OFF_SVT) + (size_t)((b * 2 + kvh) * 64) * TPB;
    Qb = (const u16*)(p.ws + OFF_SQ); ldq = 512;
    outp = (u16*)(p.ws + OFF_SQ); ldo = 512; ooff = hq * 64;
  }
  const int qrow = brow + jq0 + wave * 32 + r;
  bf16x8 qf[NKS];
#pragma unroll
  for (int ks = 0; ks < NKS; ++ks) qf[ks] = *(const bf16x8*)(Qb + (size_t)qrow * ldq + hq * DQK + ks * 16 + h * 8);
  f32x16 o[2];
#pragma unroll
  for (int dt = 0; dt < 2; ++dt)
#pragma unroll
    for (int i = 0; i < 16; ++i) o[dt][i] = 0.f;
  float mrun = -INFINITY, lsum = 0.f;
  u32x4 kreg[NKC], vreg[2];
  auto tile_j = [&](int it) { return it < nct ? it * 64 : CTX + kp_start + 64 * (it - nct); };
  auto issue = [&](int it) {
    const int jr = tile_j(it);
#pragma unroll
    for (int i = 0; i < NKC; ++i) {
      const int c = tid + 256 * i, key = c / KCH, part = c % KCH;
      const u16* src = (part < 8) ? K1 + (size_t)(brow + jr + key) * ldk1 + koff + part * 8
                                  : KR + (size_t)(brow + jr + key) * 32 + (part - 8) * 8;
      kreg[i] = *(const u32x4*)src;
    }
#pragma unroll
    for (int i = 0; i < 2; ++i) {
      const int c = tid + 256 * i, d = c >> 3, part = c & 7;
      vreg[i] = *(const u32x4*)(Vb + (size_t)d * TPB + jr + part * 8);
    }
  };
  auto stash = [&](int buf) {
    char* kb = smem + buf * BUFSZ;
    char* vb = kb + 13312;
#pragma unroll
    for (int i = 0; i < NKC; ++i) {
      const int c = tid + 256 * i, key = c / KCH, part = c % KCH;
      *(u32x4*)(kb + key * KS + part * 16) = kreg[i];
    }
#pragma unroll
    for (int i = 0; i < 2; ++i) {
      const int c = tid + 256 * i, d = c >> 3, part = c & 7;
      *(u32x2*)(vb + d * 136 + part * 16) = u32x2{vreg[i].x, vreg[i].y};
      *(u32x2*)(vb + d * 136 + part * 16 + 8) = u32x2{vreg[i].z, vreg[i].w};
    }
  };
  __syncthreads();
  issue(0);
  stash(0);
  __syncthreads();
  const int qpos = jq0 - CTX + wave * 32 + r;
#pragma unroll 1
  for (int it = 0; it < ntiles; ++it) {
    const int buf = it & 1;
    const char* kb = smem + buf * BUFSZ;
    const char* vb = kb + 13312;
    if (it + 1 < ntiles) issue(it + 1);
    f32x16 s[2];
#pragma unroll
    for (int kt = 0; kt < 2; ++kt) {
#pragma unroll
      for (int i = 0; i < 16; ++i) s[kt][i] = 0.f;
#pragma unroll
      for (int ks = 0; ks < NKS; ++ks) {
        const bf16x8 kf = *(const bf16x8*)(kb + (kt * 32 + r) * KS + ks * 32 + h * 16);
        s[kt] = MFMA(kf, qf[ks], s[kt]);
      }
    }
    if (SWA && it >= nct) {
      const int kpos0 = kp_start + 64 * (it - nct);
#pragma unroll
      for (int kt = 0; kt < 2; ++kt)
#pragma unroll
        for (int i = 0; i < 16; ++i) {
          const int diff = qpos - (kpos0 + kt * 32 + crow(i, h));
          if (diff > 128 || diff < -128) s[kt][i] = -1e30f;
        }
    }
    float mx = s[0][0];
#pragma unroll
    for (int kt = 0; kt < 2; ++kt)
#pragma unroll
      for (int i = 0; i < 16; ++i) mx = fmaxf(mx, s[kt][i]);
    mx = fmaxf(mx, __shfl_xor(mx, 32));
    const float mnew = fmaxf(mrun, mx);
    const float alpha = __builtin_amdgcn_exp2f(mrun - mnew);
    float ps = 0.f;
#pragma unroll
    for (int kt = 0; kt < 2; ++kt)
#pragma unroll
      for (int i = 0; i < 16; ++i) { const float e = __builtin_amdgcn_exp2f(s[kt][i] - mnew); s[kt][i] = e; ps += e; }
    if (__builtin_amdgcn_ballot_w64(mnew != mrun) != 0ull) {
      lsum *= alpha;
#pragma unroll
      for (int dt = 0; dt < 2; ++dt)
#pragma unroll
        for (int i = 0; i < 16; ++i) o[dt][i] *= alpha;
    }
    lsum += ps;
    mrun = mnew;
#pragma unroll
    for (int kt = 0; kt < 2; ++kt)
#pragma unroll
      for (int s2 = 0; s2 < 2; ++s2) {
        unsigned pk[4];
#pragma unroll
        for (int j = 0; j < 4; ++j) pk[j] = pack2(s[kt][8 * s2 + 2 * j], s[kt][8 * s2 + 2 * j + 1]);
        const bf16x8 pf = __builtin_bit_cast(bf16x8, u32x4{pk[0], pk[1], pk[2], pk[3]});
#pragma unroll
        for (int dt = 0; dt < 2; ++dt) {
          const char* vp = vb + (dt * 32 + r) * 136 + (kt * 32 + 16 * s2 + 4 * h) * 2;
          const s16x4 lo = *(const s16x4*)vp;
          const s16x4 hi = *(const s16x4*)(vp + 16);
          const bf16x8 vf = __builtin_shufflevector(lo, hi, 0, 1, 2, 3, 4, 5, 6, 7);
          o[dt] = MFMA(vf, pf, o[dt]);
        }
      }
    if (it + 1 < ntiles) stash(buf ^ 1);
    __syncthreads();
  }
  float ltot = lsum + __shfl_xor(lsum, 32);
  if (SWA) ltot += __builtin_amdgcn_exp2f(p.swa_sink[l * 8 + hq] * LOG2E - mrun);
  const float inv = 1.f / ltot;
#pragma unroll
  for (int dt = 0; dt < 2; ++dt)
#pragma unroll
    for (int g = 0; g < 4; ++g) {
      u32x2 pk;
      pk.x = pack2(o[dt][4 * g] * inv, o[dt][4 * g + 1] * inv);
      pk.y = pack2(o[dt][4 * g + 2] * inv, o[dt][4 * g + 3] * inv);
      *(u32x2*)(outp + (size_t)qrow * ldo + ooff + dt * 32 + 8 * g + 4 * h) = pk;
    }
}

constexpr float HY_D0 = 3.0701134573253944f;
constexpr float HY_DSTEP = (15.350567286626972f - 3.0701134573253944f) / 511.f;

DI void filt_item(const Params& p, int l, int oc, char* smem) {
  float2* lds = (float2*)smem;
  float* lf = (float*)smem;
  const int tid = opq(threadIdx.x), lane = tid & 63, wave = tid >> 6;
  const int c = oc & 511;
  const float* hid = (const float*)(p.ws + OFF_HID + l * HID_LAYER);
  const float* w3 = p.hy_w3 + (size_t)l * 64 * 2048;
  float* sa = (float*)(p.ws + OFF_ESCR + (size_t)blockIdx.x * 65536);
  float* sb = sa + 8192;
  __syncthreads();
  if (tid < 128) { const int dir = tid >> 6, j = tid & 63; lf[tid] = w3[j * 2048 + dir * 1024 + oc]; }
  __syncthreads();
  const float delta = HY_D0 + (float)c * HY_DSTEP;
  float asum = 0.f;
#pragma unroll 1
  for (int ib = 0; ib < 4; ++ib) {
    float a[8], bm[8];
#pragma unroll
    for (int i = 0; i < 8; ++i) { a[i] = 0.f; bm[i] = 0.f; }
#pragma unroll 4
    for (int j = 0; j < 64; ++j) {
      const float w0 = lf[j], w1 = lf[64 + j];
      const float* hr = hid + (size_t)j * 8192 + 4 * (tid + 512 * ib);
#pragma unroll
      for (int ii = 0; ii < 2; ++ii) {
        const float4 hv = *(const float4*)(hr + 1024 * ii);
        a[4 * ii + 0] += hv.x * w0; bm[4 * ii + 0] += hv.x * w1;
        a[4 * ii + 1] += hv.y * w0; bm[4 * ii + 1] += hv.y * w1;
        a[4 * ii + 2] += hv.z * w0; bm[4 * ii + 2] += hv.z * w1;
        a[4 * ii + 3] += hv.w * w0; bm[4 * ii + 3] += hv.w * w1;
      }
    }
#pragma unroll
    for (int ii = 0; ii < 2; ++ii) {
      const int t0 = 4 * (tid + 256 * (2 * ib + ii));
      float av[4];
#pragma unroll
      for (int e = 0; e < 4; ++e) {
        const int t = t0 + e;
        const float dec = __expf(-((float)t * (1.f / 8191.f)) * delta);
        av[e] = a[4 * ii + e] * dec;
        const float bv = bm[4 * ii + e] * dec;
        if (t >= 1) { sb[8192 - t] = bv; asum += fabsf(bv); } else sb[0] = 0.f;
        asum += fabsf(av[e]);
      }
      *(float4*)(sa + t0) = make_float4(av[0], av[1], av[2], av[3]);
    }
  }
  asum = wave_sum(asum);
  asm volatile("s_waitcnt vmcnt(0)" ::: "memory");
  __syncthreads();
  if (lane == 0) lf[wave] = asum;
  __syncthreads();
  const float inv = 1.f / (lf[0] + lf[1] + lf[2] + lf[3]);
  __syncthreads();
#pragma unroll 2
  for (int i = 0; i < 8; ++i) {
    const int t0 = 4 * (tid + 256 * i);
#pragma unroll
    for (int e = 0; e < 4; ++e) lds[fphys(t0 + e)] = make_float2((ldsc1(sa + t0 + e) + ldsc1(sb + t0 + e)) * inv, 0.f);
  }
  __syncthreads();
  if (!DBG_NOFFT) fft8192_fwd(lds, tid);
  h2_t* sp = (h2_t*)(p.ws + OFF_SPEC) + (size_t)oc * 2 * 8192;
#pragma unroll 4
  for (int i = 0; i < 32; ++i) { const int k = tid + 256 * i; const float2 v = lds[k]; h2_t hv = {(_Float16)v.x, (_Float16)v.y}; sp[k] = hv; }
  __syncthreads();
#pragma unroll 2
  for (int i = 0; i < 8; ++i) {
    const int t0 = 4 * (tid + 256 * i);
#pragma unroll
    for (int e = 0; e < 4; ++e) {
      const int t = t0 + e;
      const float2 w = twid_rev((float)t * (1.f / 16384.f));
      const float d = (ldsc1(sa + t) - ldsc1(sb + t)) * inv;
      lds[fphys(t)] = make_float2(d * w.x, d * w.y);
    }
  }
  __syncthreads();
  if (!DBG_NOFFT) fft8192_fwd(lds, tid);
#pragma unroll 4
  for (int i = 0; i < 32; ++i) { const int k = tid + 256 * i; const float2 v = lds[k]; h2_t hv = {(_Float16)v.x, (_Float16)v.y}; sp[8192 + k] = hv; }
  __syncthreads();
}

DI float dwc(const u16* s, int t, int len, float w0, float w1, float w2, float bias) {
  const int tm = max(t - 1, 0), tp = min(t + 1, len - 1);
  const float a = bf2f(s[tm]), b = bf2f(s[t]), c = bf2f(s[tp]);
  return b * w1 + bias + (t > 0 ? a * w0 : 0.f) + (t < len - 1 ? c * w2 : 0.f);
}

DI void ld4(const u16* s, int t0, float (&o)[4]) {
  const u32x2 u = *(const u32x2*)(s + t0);
  o[0] = lo_bf(u.x); o[1] = hi_bf(u.x); o[2] = lo_bf(u.y); o[3] = hi_bf(u.y);
}
DI void dwc4(const u16* s, int t0, int len, float w0, float w1, float w2, float bias, float (&o)[4]) {
  float c[4];
  ld4(s, t0, c);
  float l = bf2f(s[max(t0 - 1, 0)]), r = bf2f(s[min(t0 + 4, len - 1)]);
  l = (t0 > 0) ? l : 0.f;
  r = (t0 + 4 < len) ? r : 0.f;
  o[0] = l * w0 + c[0] * w1 + c[1] * w2 + bias;
  o[1] = c[0] * w0 + c[1] * w1 + c[2] * w2 + bias;
  o[2] = c[1] * w0 + c[2] * w1 + c[3] * w2 + bias;
  o[3] = c[2] * w0 + c[3] * w1 + r * w2 + bias;
}

DI void hconv_item(const Params& p, int l, int o, int c, int bp, char* smem) {
  float2* lds = (float2*)smem;
  const int tid = opq(threadIdx.x);
  u16* hyt = (u16*)(p.ws + OFF_HYT);
  const int b0 = bp * 2, b1 = b0 + 1;
  u16* z0p = hyt + (size_t)(b0 * 1536 + c) * TPB + CTX;
  u16* z1p = hyt + (size_t)(b1 * 1536 + c) * TPB + CTX;
  const int gc = (o + 1) * 512 + c;
  const u16* g0p = hyt + (size_t)(b0 * 1536 + gc) * TPB + CTX;
  const u16* g1p = hyt + (size_t)(b1 * 1536 + gc) * TPB + CTX;
  const float* cw = p.hy_conv_w + (size_t)l * 3 * 1536;
  const float* cb = p.hy_conv_b + (size_t)l * 1536;
  const float zw0 = cw[c], zw1 = cw[1536 + c], zw2 = cw[3072 + c], zbias = cb[c];
  const float gw0 = cw[gc], gw1 = cw[1536 + gc], gw2 = cw[3072 + gc], gbias = cb[gc];
  const float skip = p.hy_skip[l * 1024 + o * 512 + c];
  const h2_t* spe = (const h2_t*)(p.ws + OFF_SPEC) + (size_t)(o * 512 + c) * 2 * 8192;
  const h2_t* spo = spe + 8192;
  float2* Eg = (float2*)(p.ws + OFF_ESCR + (size_t)blockIdx.x * 65536);
  __syncthreads();
#pragma unroll 2
  for (int i = 0; i < 8; ++i) {
    const int t0 = 4 * (tid + 256 * i);
    float za[4], zb[4];
    if (o == 0) { dwc4(z0p, t0, SEQ, zw0, zw1, zw2, zbias, za); dwc4(z1p, t0, SEQ, zw0, zw1, zw2, zbias, zb); }
    else { ld4(z0p, t0, za); ld4(z1p, t0, zb); }
#pragma unroll
    for (int e = 0; e < 4; ++e) lds[fphys(t0 + e)] = make_float2(za[e], zb[e]);
  }
  __syncthreads();
  fft8192_fwd(lds, tid);
#pragma unroll 8
  for (int i = 0; i < 32; ++i) { const int k = tid + 256 * i; const h2_t hv = spe[k]; lds[k] = cmul(lds[k], make_float2((float)hv[0], (float)hv[1])); }
  __syncthreads();
  fft8192_inv(lds, tid);
#pragma unroll 2
  for (int i = 0; i < 8; ++i) {
    const int t0 = 4 * (tid + 256 * i);
#pragma unroll
    for (int e = 0; e < 4; ++e) Eg[t0 + e] = lds[fphys(t0 + e)];
  }
  __syncthreads();
#pragma unroll 2
  for (int i = 0; i < 8; ++i) {
    const int t0 = 4 * (tid + 256 * i);
    float za[4], zb[4];
    if (o == 0) { dwc4(z0p, t0, SEQ, zw0, zw1, zw2, zbias, za); dwc4(z1p, t0, SEQ, zw0, zw1, zw2, zbias, zb); }
    else { ld4(z0p, t0, za); ld4(z1p, t0, zb); }
#pragma unroll
    for (int e = 0; e < 4; ++e) lds[fphys(t0 + e)] = cmul(make_float2(za[e], zb[e]), twid_rev((float)(t0 + e) * (1.f / 16384.f)));
  }
  __syncthreads();
  fft8192_fwd(lds, tid);
#pragma unroll 8
  for (int i = 0; i < 32; ++i) { const int k = tid + 256 * i; const h2_t hv = spo[k]; lds[k] = cmul(lds[k], make_float2((float)hv[0], (float)hv[1])); }
  __syncthreads();
  fft8192_inv(lds, tid);
#pragma unroll 2
  for (int i = 0; i < 8; ++i) {
    const int t0 = 4 * (tid + 256 * i);
    float za[4], zb[4], ga[4], gb[4];
    if (o == 0) { dwc4(z0p, t0, SEQ, zw0, zw1, zw2, zbias, za); dwc4(z1p, t0, SEQ, zw0, zw1, zw2, zbias, zb); }
    else { ld4(z0p, t0, za); ld4(z1p, t0, zb); }
    dwc4(g0p, t0, SEQ, gw0, gw1, gw2, gbias, ga);
    dwc4(g1p, t0, SEQ, gw0, gw1, gw2, gbias, gb);
#pragma unroll
    for (int e = 0; e < 4; ++e) {
      const int t = t0 + e;
      const float2 ov = cmulc(lds[fphys(t)], twid_rev((float)t * (1.f / 16384.f)));
      const float2 ev = Eg[t];
      const float y0 = (ev.x + ov.x) * (1.f / 16384.f), y1 = (ev.y + ov.y) * (1.f / 16384.f);
      Eg[t] = make_float2(ga[e] * (y0 + za[e] * skip), gb[e] * (y1 + zb[e] * skip));
    }
  }
  __syncthreads();
  u16* d0 = (o == 0) ? z0p : (u16*)(p.ws + OFF_YCT) + (size_t)(b0 * 512 + c) * TPB + CTX;
  u16* d1 = (o == 0) ? z1p : (u16*)(p.ws + OFF_YCT) + (size_t)(b1 * 512 + c) * TPB + CTX;
#pragma unroll 2
  for (int i = 0; i < 8; ++i) {
    const int t0 = 4 * (tid + 256 * i);
    float2 e4[4];
#pragma unroll
    for (int e = 0; e < 4; ++e) e4[e] = Eg[t0 + e];
    *(u32x2*)(d0 + t0) = u32x2{pack2(e4[0].x, e4[1].x), pack2(e4[2].x, e4[3].x)};
    *(u32x2*)(d1 + t0) = u32x2{pack2(e4[0].y, e4[1].y), pack2(e4[2].y, e4[3].y)};
  }
}

DI void hctx_item(const Params& p, int l, int c, char* smem) {
  float* lf = (float*)smem;
  float* kern = lf;
  float* zb = lf + 1024;
  float* z1b = lf + 2048;
  float* red = lf + 3072;
  const int tid = opq(threadIdx.x), lane = tid & 63, wave = tid >> 6;
  const float* hid = (const float*)(p.ws + OFF_HID + l * HID_LAYER) + 64 * 8192;
  const float* w3 = p.hy_w3 + (size_t)l * 64 * 2048;
  const u16* hyt = (const u16*)(p.ws + OFF_HYT);
  const float* cw = p.hy_conv_w + (size_t)l * 3 * 1536;
  const float* cb = p.hy_conv_b + (size_t)l * 1536;
  __syncthreads();
  {
    const int t = tid;
    float d[4] = {0.f, 0.f, 0.f, 0.f};
#pragma unroll 4
    for (int j = 0; j < 64; ++j) {
      const float hv = hid[j * 256 + t];
#pragma unroll
      for (int q = 0; q < 4; ++q) d[q] += hv * w3[j * 2048 + (q >> 1) * 1024 + (q & 1) * 512 + c];
    }
    const float dec = __expf(-((float)t * (1.f / 255.f)) * (HY_D0 + (float)c * HY_DSTEP));
#pragma unroll
    for (int o = 0; o < 2; ++o) {
      const float f0 = d[o] * dec, f1 = d[2 + o] * dec;
      kern[o * 512 + t] = f0;
      if (t >= 1) kern[o * 512 + 512 - t] = f1;
      if (t == 0) kern[o * 512 + 256] = 0.f;
      float s = fabsf(f0) + (t >= 1 ? fabsf(f1) : 0.f);
      s = wave_sum(s);
      if (lane == 0) red[o * 4 + wave] = s;
    }
  }
  const int b = tid >> 6, tq = tid & 63;
  const u16* zs = hyt + (size_t)(b * 1536 + c) * TPB;
  const u16* g1s = hyt + (size_t)(b * 1536 + 512 + c) * TPB;
  const u16* g2s = hyt + (size_t)(b * 1536 + 1024 + c) * TPB;
#pragma unroll
  for (int k = 0; k < 4; ++k) {
    const int tt = tq + 64 * k;
    zb[b * 256 + tt] = dwc(zs, tt, CTX, cw[c], cw[1536 + c], cw[3072 + c], cb[c]);
  }
  __syncthreads();
  const float inv0 = 1.f / (red[0] + red[1] + red[2] + red[3]);
  const float inv1 = 1.f / (red[4] + red[5] + red[6] + red[7]);
  const float sk0 = p.hy_skip[l * 1024 + c], sk1 = p.hy_skip[l * 1024 + 512 + c];
#pragma unroll 1
  for (int k = 0; k < 4; ++k) {
    const int tt = tq + 64 * k;
    float acc = 0.f;
#pragma unroll 8
    for (int s = 0; s < 256; ++s) acc += kern[(tt - s) & 511] * zb[b * 256 + s];
    const float g = dwc(g1s, tt, CTX, cw[512 + c], cw[1536 + 512 + c], cw[3072 + 512 + c], cb[512 + c]);
    z1b[b * 256 + tt] = g * (acc * inv0 + zb[b * 256 + tt] * sk0);
  }
  __syncthreads();
  u16* yc = (u16*)(p.ws + OFF_YCT) + (size_t)(b * 512 + c) * TPB;
#pragma unroll 1
  for (int k = 0; k < 4; ++k) {
    const int tt = tq + 64 * k;
    float acc = 0.f;
#pragma unroll 8
    for (int s = 0; s < 256; ++s) acc += kern[512 + ((tt - s) & 511)] * z1b[b * 256 + s];
    const float g = dwc(g2s, tt, CTX, cw[1024 + c], cw[1536 + 1024 + c], cw[3072 + 1024 + c], cb[1024 + c]);
    yc[tt] = DBG_ZERO_HCTX ? (u16)0 : f2bf(g * (acc * inv1 + z1b[b * 256 + tt] * sk1));
  }
  __syncthreads();
}

#define XB_XCNT(j) (256 + 64 * (j))
#define XB_XSUB(j) (1280 + 64 * (j))
#define XB_XGEN(j) (2304 + 64 * (j))
#define XB_TOP 3328
#define XB_TOPGEN 3392
DI unsigned xb_ld(unsigned* p) { return __hip_atomic_load(p, __ATOMIC_RELAXED, __HIP_MEMORY_SCOPE_AGENT); }
DI unsigned xb_add(unsigned* p, unsigned v) { return __hip_atomic_fetch_add(p, v, __ATOMIC_RELAXED, __HIP_MEMORY_SCOPE_AGENT); }
struct XBar { unsigned* bar; unsigned x, nloc, nx; };
DI void gsync_impl(cg::grid_group& g, XBar& b) {
#if DBG_CG_SYNC
  g.sync();
#else
  asm volatile("s_waitcnt vmcnt(0)" ::: "memory");
  __syncthreads();
  if (threadIdx.x == 0) {
    unsigned* bar = b.bar;
    __builtin_amdgcn_s_waitcnt(0);
    if (b.nloc == 0u) {
      unsigned sum, cnt, mine;
      for (;;) {
        sum = 0u; cnt = 0u; mine = 0u;
#pragma unroll
        for (unsigned j = 0; j < 16; ++j) { const unsigned c = xb_ld(&bar[XB_XCNT(j)]); sum += c; cnt += (c > 0u) ? 1u : 0u; mine = (j == b.x) ? c : mine; }
        if (sum == gridDim.x) break;
        __builtin_amdgcn_s_sleep(1);
      }
      b.nloc = mine > 0u ? mine : 1u; b.nx = cnt > 0u ? cnt : 1u;
    }
    const unsigned old = xb_add(&bar[XB_XSUB(b.x)], 1u);
    const unsigned gen = old / b.nloc;
    if (old + 1u == (gen + 1u) * b.nloc) {
      __builtin_amdgcn_fence(__ATOMIC_RELEASE, "agent");
      asm volatile("s_waitcnt vmcnt(0)" ::: "memory");
      const unsigned og = xb_add(&bar[XB_TOP], 1u);
      const unsigned tg = og / b.nx;
      if (og + 1u == (tg + 1u) * b.nx) xb_add(&bar[XB_TOPGEN], 1u);
      else { while (xb_ld(&bar[XB_TOPGEN]) == tg) __builtin_amdgcn_s_sleep(1); }
      __builtin_amdgcn_fence(__ATOMIC_ACQUIRE, "agent");
      xb_add(&bar[XB_XGEN(b.x)], 1u);
      asm volatile("s_waitcnt vmcnt(0)" ::: "memory");
    } else {
      while (xb_ld(&bar[XB_XGEN(b.x)]) == gen) __builtin_amdgcn_s_sleep(1);
      __builtin_amdgcn_fence(__ATOMIC_ACQUIRE, "agent");
      asm volatile("s_waitcnt vmcnt(0)" ::: "memory");
    }
  }
  __syncthreads();
#endif
}

#define gsync(G, E) gsync_impl(G, E)
DI int tile_map(int L, int MT, int NT) {
  const int per = 8 * NT;
  const int P = L / per, u = L - P * per;
  const int h = min(8, MT - P * 8);
  const int nt = u / h, mt = P * 8 + (u - nt * h);
  return mt * NT + nt;
}
__global__ void __launch_bounds__(256, 2) fwd_mega(Params p) {
  cg::grid_group grid = cg::this_grid();
  __shared__ __attribute__((aligned(16))) char smem[65536];
  const int nb = gridDim.x, bid = blockIdx.x;
  const int pb = ((nb & 7) == 0) ? (bid & 7) * (nb >> 3) + (bid >> 3) : bid;
  float* xctx = (float*)(p.ws + OFF_XCTX);
  u16* RH = (u16*)(p.ws + OFF_RH);
  u16* HP = (u16*)(p.ws + OFF_HP);
  XBar epoch;
  epoch.bar = (unsigned*)(p.ws + OFF_BAR);
  epoch.x = (unsigned)__builtin_amdgcn_s_getreg((3 << 11) | 20) & 0xFu;
  epoch.nloc = 0u; epoch.nx = 0u;
  if (threadIdx.x == 0) (void)xb_add(&epoch.bar[XB_XCNT(epoch.x)], 1u);
  {
    constexpr int NC0 = 928;
    const int total = NC0 + 192 + 1536 + 528;
    for (int it = bid; it < total; it += nb) {
      if (it < NC0) conv_tile(p, 0, it < 864 ? it : 1632 + (it - 864), smem);
      else if (it < NC0 + 192) mod_item(p, it - NC0, smem);
      else if (it < NC0 + 192 + 1536) rope_item(p, it - NC0 - 192);
      else hid_item(p, it - NC0 - 192 - 1536, smem);
    }
  }
  grid.sync();
  row_pass(p, 0, p.x, p.ctx, nullptr, nullptr, nullptr, nullptr, 0, 0, false, p.norm_g, 0, 0, 1024, RH, false);
  gsync(grid, epoch);
#pragma unroll 1
  for (int l = 0; l < 2; ++l) {
    const float* xl = (l == 0) ? p.x : p.out;
    const float* xc = (l == 0) ? p.ctx : xctx;
    for (int rep = 0; rep < DBG_REP_FFT; ++rep)
    for (int it = pb; it < 1024; it += nb) filt_item(p, l, it, smem);
    gsync(grid, epoch);
    for (int rep = 0; rep < DBG_REP_GEMM; ++rep)
    for (int it = pb; it < 4752; it += nb) inproj_tile(p, tile_map(it, 176, 27), smem);
    if (pb >= 144 && nb > 144) {
      if (l == 0) { for (int ci = pb - 144; ci < 1408; ci += nb - 144) conv_tile(p, 0, ci < 768 ? 864 + ci : 1696 + (ci - 768), smem); }
      else { for (int ct = 1696 + (pb - 144); ct < NCONV_TILES; ct += nb - 144) conv_tile(p, 1, ct, smem); }
    }
    gsync(grid, epoch);
#if DBG_DUMP == 5
    { const _Float16* sp = (const _Float16*)(p.ws + OFF_SPEC);
      for (size_t i = (size_t)bid * 256 + threadIdx.x; i < (size_t)NBATCH * SEQ * DM; i += (size_t)nb * 256) p.out[i] = (float)sp[i];
      return; }
#endif
    for (int rep = 0; rep < DBG_REP_GEMM; ++rep)
    for (int it = pb; it < 1408; it += nb) kvup_tile(p, tile_map(it, 176, 8), smem);
    gsync(grid, epoch);
    {
      const int nF = 2048 + (l == 0 ? 64 : 0);
      for (int rep = 0; rep < DBG_REP_MLA; ++rep)
      for (int it = pb; it < nF; it += nb) {
        if (it < 2048) attn_item<96, false>(p, l, it >> 9, (it >> 6) & 7, CTX + (it & 63) * 128, 132, 0, 0, smem);
        else { const int i2 = it - 2048; attn_item<96, false>(p, l, i2 >> 4, (i2 >> 1) & 7, (i2 & 1) * 128, 4, 0, 0, smem); }
      }
    }
    gsync(grid, epoch);
    {
      const int nF2 = 1024 + (l == 0 ? 512 : 0);
      for (int it = pb; it < nF2; it += nb) {
        if (it < 1024) hconv_item(p, l, 0, it >> 1, it & 1, smem);
        else hctx_item(p, l, it - 1024, smem);
      }
    }
    gsync(grid, epoch);
    {
      const int nG = 2048 + (l == 0 ? 64 : 0);
      for (int it = pb; it < nG; it += nb) {
        if (it < 2048) {
          const int n = it & 63, jlo = (n == 0) ? 2 : 0, jhi = (n == 63) ? 4 : 6;
          attn_item<64, true>(p, l, it >> 9, (it >> 6) & 7, CTX + n * 128, 4, jhi - jlo, (n - 1) * 128 + 64 * jlo, smem);
        } else { const int i2 = it - 2048; attn_item<64, true>(p, l, i2 >> 4, (i2 >> 1) & 7, (i2 & 1) * 128, 4, 0, 0, smem); }
      }
      row_pass(p, 0, xl, xc, nullptr, nullptr, nullptr, nullptr, 0, 0, false, p.norm_g + (size_t)(l * 4) * 1024, l, 0, 1024, HP, false);
    }
    gsync(grid, epoch);
    for (int rep = 0; rep < DBG_REP_FFT; ++rep)
    for (int it = pb; it < 1024; it += nb) hconv_item(p, l, 1, it >> 1, it & 1, smem);
    gsync(grid, epoch);
    for (int rep = 0; rep < DBG_REP_GEMM; ++rep)
    for (int it = pb; it < 1408; it += nb) merge_tile(p, tile_map(it, 176, 8), smem);
    if (l == 0 && pb >= 384 && nb > 384) for (int ct = 2336 + (pb - 384); ct < NCONV_TILES; ct += nb - 384) conv_tile(p, 0, ct, smem);
    gsync(grid, epoch);
    for (int rep = 0; rep < DBG_REP_GEMM * DBG_REP_PLAIN; ++rep)
    for (int it = pb; it < 1408; it += nb) plain_tile(p, tile_map(it, 176, 8), (const u16*)(p.ws + OFF_MERGED), 1024, 16, (const u16*)(p.ws + OFF_WT_OUT), HP, smem);
    gsync(grid, epoch);
    row_pass(p, 1, xl, xc, p.out, xctx, HP, p.norm_g + (size_t)(l * 4 + 1) * 1024, 2048, l, true, p.norm_g + (size_t)(l * 4 + 2) * 1024, l, 3072, 4096, RH, false);
    gsync(grid, epoch);
    for (int rep = 0; rep < DBG_REP_GEMM; ++rep)
    for (int it = pb; it < 184 * 44; it += nb) ffnup_tile(p, l, tile_map(it, 184, 44), smem);
    gsync(grid, epoch);
    for (int rep = 0; rep < DBG_REP_GEMM * DBG_REP_PLAIN; ++rep)
    for (int it = pb; it < 1408; it += nb) plain_tile(p, tile_map(it, 176, 8), (const u16*)(p.ws + OFF_A), 2816, 44, (const u16*)(p.ws + OFF_WT_DOWN), HP, smem);
    if (l == 0 && pb >= 384 && nb > 384) for (int ct = pb - 384; ct < 1632; ct += nb - 384) conv_tile(p, 1, ct, smem);
    gsync(grid, epoch);
    row_pass(p, 1, p.out, xctx, p.out, xctx, HP, p.norm_g + (size_t)(l * 4 + 3) * 1024, 5120, l, l == 0, p.norm_g + (size_t)((l + 1) * 4) * 1024, l + 1, 0, 1024, RH, l == 1);
    if (l == 0) {
      for (int it = bid; it < 64; it += nb) conv_tile(p, 1, 1632 + it, smem);
      gsync(grid, epoch);
    }
  }
  for (int rep = 0; rep < DBG_EXTRA_SYNCS; ++rep) gsync(grid, epoch);
#if DBG_DUMP == 1
  gsync(grid, epoch);
  { const _Float16* sp = (const _Float16*)(p.ws + OFF_SPEC);
    for (size_t i = (size_t)bid * 256 + threadIdx.x; i < (size_t)NBATCH * SEQ * DM; i += (size_t)nb * 256) p.out[i] = (float)sp[i]; }
#elif DBG_DUMP == 3
  gsync(grid, epoch);
  { const float* hd = (const float*)(p.ws + OFF_HID);
    for (size_t i = (size_t)bid * 256 + threadIdx.x; i < (size_t)NBATCH * SEQ * DM; i += (size_t)nb * 256) p.out[i] = i < (size_t)2 * 64 * 8448 ? hd[i] : 0.f; }
#elif DBG_DUMP == 2
  gsync(grid, epoch);
  { const u16* yc = (const u16*)(p.ws + OFF_YCT);
    for (size_t i = (size_t)bid * 256 + threadIdx.x; i < (size_t)NBATCH * SEQ * DM; i += (size_t)nb * 256) p.out[i] = i < (size_t)4 * 512 * TPB ? bf2f(yc[i]) : 0.f; }
#endif
}

extern "C" void kernel_launch(void* const* d_in, const int* in_sizes, int n_in, void* d_out, int out_size, void* d_ws, size_t ws_size,
                              hipStream_t stream) {
  static int grid_blocks = 0;
  if (!grid_blocks) {
    int dev = 0, cus = 0, per_cu = 0;
    (void)hipGetDevice(&dev);
    (void)hipDeviceGetAttribute(&cus, hipDeviceAttributeMultiprocessorCount, dev);
    (void)hipOccupancyMaxActiveBlocksPerMultiprocessor(&per_cu, fwd_mega, 256, 0);
    if (per_cu > 2) per_cu = 2;
    if (per_cu < 1) per_cu = 1;
    grid_blocks = cus * per_cu;
  }
  if (ws_size < WS_NEED) { fprintf(stderr, "workspace too small: %zu < %zu\n", ws_size, (size_t)WS_NEED); return; }
  Params p{};
  const float** pp = (const float**)&p;
  for (int i = 0; i < 26; ++i) pp[i] = (const float*)d_in[i];
  p.out = (float*)d_out;
  p.ws = (char*)d_ws;
  (void)hipMemsetAsync((char*)d_ws + OFF_BAR, 0, BAR_BYTES, stream);
  void* args[] = {&p};
  hipError_t e = hipLaunchCooperativeKernel((void*)fwd_mega, dim3(grid_blocks), dim3(256), args, 0, stream);
  if (e != hipSuccess) fprintf(stderr, "cooperative launch failed: %s (grid %d)\n", hipGetErrorString(e), grid_blocks);
}
```

```cpp
#include <hip/hip_runtime.h>
#include <hip/hip_cooperative_groups.h>
#include <cstdio>
namespace cg = cooperative_groups;
#define DI __device__ __forceinline__
typedef unsigned short u16;
typedef __attribute__((ext_vector_type(8))) short bf16x8;
typedef __attribute__((ext_vector_type(4))) short s16x4;
typedef __attribute__((ext_vector_type(16))) float f32x16;
typedef __attribute__((ext_vector_type(4))) unsigned u32x4;
typedef __attribute__((ext_vector_type(2))) unsigned u32x2;
typedef __attribute__((ext_vector_type(2))) __bf16 bf2_t;
typedef __attribute__((ext_vector_type(2))) float f2_t;
typedef __attribute__((ext_vector_type(2))) _Float16 h2_t;
#define MFMA(a, b, c) __builtin_amdgcn_mfma_f32_32x32x16_bf16((a), (b), (c), 0, 0, 0)

constexpr int DM = 1024, NBATCH = 4, SEQ = 8192, CTX = 256, TPB = 8448, MTOK = 33792;
constexpr int DFF = 2816;
#ifndef DBG_ZERO_HCTX
#define DBG_ZERO_HCTX 0
#endif
#ifndef DBG_DUMP
#define DBG_DUMP 0
#endif
#ifndef DBG_NOFFT
#define DBG_NOFFT 0
#endif
#ifndef DBG_SPLITC
#define DBG_SPLITC 0
#endif
#ifndef DBG_REP_GEMM
#define DBG_REP_GEMM 1
#endif
#ifndef DBG_REP_MLA
#define DBG_REP_MLA 1
#endif
#ifndef DBG_HEAVY_SYNC
#define DBG_HEAVY_SYNC 0
#endif
#ifndef DBG_REP_FFT
#define DBG_REP_FFT 1
#endif
#ifndef DBG_REP_PLAIN
#define DBG_REP_PLAIN 1
#endif
#ifndef DBG_EXTRA_SYNCS
#define DBG_EXTRA_SYNCS 0
#endif
#ifndef DBG_CG_SYNC
#define DBG_CG_SYNC 0
#endif
#ifndef DBG_SKIP_BR
#define DBG_SKIP_BR 0
#endif
#define DBG_FIRST_BR ((DBG_SKIP_BR & 1) ? ((DBG_SKIP_BR & 2) ? 2 : 1) : 0)
constexpr float LOG2E = 1.4426950408889634f;
constexpr float EPS = 1e-6f;

struct Params {
  const float *x, *c, *ctx, *c_ctx, *w_mod, *b_mod, *norm_g, *w_in, *kv_norm_g, *w_kv_up, *swa_sink, *hy_conv_w, *hy_conv_b,
      *hy_w1, *hy_b1, *hy_w2, *hy_b2, *hy_freq, *hy_w3, *hy_skip, *w_branch, *w_out, *w_up, *ffn_conv_w, *ffn_conv_b, *w_down;
  float* out;
  char* ws;
};

constexpr size_t OFF_WT_IN = 0;
constexpr size_t OFF_WT_GATE = OFF_WT_IN + (size_t)3456 * 1024 * 2;
constexpr size_t OFF_WT_KV = OFF_WT_GATE + (size_t)3072 * 1024 * 2;
constexpr size_t OFF_WT_BR = OFF_WT_KV + (size_t)1024 * 256 * 2;
constexpr size_t OFF_WT_OUT = OFF_WT_BR + (size_t)3 * 1024 * 512 * 2;
constexpr size_t OFF_WT_UP = OFF_WT_OUT + (size_t)1024 * 1024 * 2;
constexpr size_t OFF_WT_DOWN = OFF_WT_UP + (size_t)5632 * 1024 * 2;
constexpr size_t OFF_RH = OFF_WT_DOWN + (size_t)1024 * 2816 * 2;
constexpr size_t OFF_KN = OFF_RH + (size_t)MTOK * 1024 * 2;
constexpr size_t OFF_VT = OFF_KN + (size_t)MTOK * 512 * 2;
constexpr size_t OFF_KR = OFF_VT + (size_t)MTOK * 512 * 2;
constexpr size_t OFF_Q = OFF_KR + (size_t)MTOK * 32 * 2;
constexpr size_t OFF_SQ = OFF_Q + (size_t)MTOK * 768 * 2;
constexpr size_t OFF_CKV = OFF_SQ + (size_t)MTOK * 512 * 2;
constexpr size_t OFF_SK = OFF_CKV + (size_t)MTOK * 256 * 2;
constexpr size_t OFF_SVT = OFF_SK + (size_t)MTOK * 128 * 2;
constexpr size_t OFF_HYT = OFF_SVT + (size_t)MTOK * 128 * 2;
constexpr size_t OFF_SPEC = OFF_HYT + (size_t)MTOK * 1536 * 2;
constexpr size_t OFF_XCTX = OFF_SPEC + (size_t)1024 * 2 * 8192 * 4;
constexpr size_t OFF_MOD = OFF_XCTX + (size_t)1024 * 1024 * 4;
constexpr size_t OFF_ROPE = OFF_MOD + (size_t)2 * 5 * 6144 * 4;
constexpr size_t OFF_HID = OFF_ROPE + (size_t)8192 * 96 * 4;
constexpr size_t HID_LAYER = (size_t)64 * (8192 + 256) * 4;
constexpr size_t OFF_ESCR = OFF_HID + 2 * HID_LAYER;
constexpr size_t OFF_BAR = OFF_ESCR + (size_t)512 * 65536;
constexpr size_t BAR_BYTES = 3456 * 4;
constexpr size_t WS_NEED = OFF_BAR + BAR_BYTES;
constexpr size_t OFF_A = OFF_Q;
constexpr size_t OFF_MERGED = OFF_KN;
constexpr size_t OFF_Y = OFF_HYT;
constexpr size_t OFF_HP = OFF_KN;
constexpr size_t OFF_YCT = OFF_RH;
constexpr size_t OFF_YA = OFF_RH + (size_t)MTOK * 512 * 2;
static_assert(OFF_A + (size_t)MTOK * 2816 * 2 <= OFF_SPEC, "A overlay");
static_assert(WS_NEED <= (size_t)512 * 1024 * 1024, "ws");

DI int opq(int x) { asm volatile("" : "+v"(x)); return x; }
DI float ldsc1(const float* p) { return __hip_atomic_load(p, __ATOMIC_RELAXED, __HIP_MEMORY_SCOPE_AGENT); }
DI float bf2f(u16 v) { return __uint_as_float(((unsigned)v) << 16); }
DI unsigned pack2(float a, float b) { f2_t v = {a, b}; return __builtin_bit_cast(unsigned, __builtin_convertvector(v, bf2_t)); }
DI u16 f2bf(float a) { return (u16)(pack2(a, 0.f) & 0xffffu); }
DI float lo_bf(unsigned u) { return __uint_as_float(u << 16); }
DI float hi_bf(unsigned u) { return __uint_as_float(u & 0xffff0000u); }
DI int crow(int i, int h) { return (i & 3) + 8 * (i >> 2) + 4 * h; }
DI float wave_sum(float v) {
#pragma unroll
  for (int o = 32; o > 0; o >>= 1) v += __shfl_xor(v, o);
  return v;
}
DI float sinrev(float r) { return __builtin_amdgcn_sinf(r - floorf(r)); }
DI float cosrev(float r) { return __builtin_amdgcn_cosf(r - floorf(r)); }
#if DBG_TRIVTW
#define COSREV(f) (1.0f)
#define SINREV(f) (0.0f * (f))
#else
#define COSREV(f) cosrev(f)
#define SINREV(f) sinrev(f)
#endif
#define SYNC() __syncthreads()
DI float2 cmul(float2 a, float2 b) { return make_float2(a.x * b.x - a.y * b.y, a.x * b.y + a.y * b.x); }
DI float2 cmulc(float2 a, float2 b) { return make_float2(a.x * b.x + a.y * b.y, a.y * b.x - a.x * b.y); }
#ifndef DBG_NOSWZ
#define DBG_NOSWZ 0
#endif
DI int fphys(int i) { return DBG_NOSWZ ? i : (i ^ ((i >> 4) & 15)); }
DI float2 twid_rev(float fr) { return make_float2(COSREV(fr), -SINREV(fr)); }

DI float2 root16(int e) {
  const float C1 = 0.92387953251128674f, S1 = 0.38268343236508977f, R = 0.70710678118654752f;
  switch (e) {
    case 0: return make_float2(1.f, 0.f);
    case 1: return make_float2(C1, -S1);
    case 2: return make_float2(R, -R);
    case 3: return make_float2(S1, -C1);
    case 4: return make_float2(0.f, -1.f);
    case 5: return make_float2(-S1, -C1);
    case 6: return make_float2(-R, -R);
    default: return make_float2(-C1, -S1);
  }
}
template <int R, int HALF, int S, bool INV, bool HASW>
DI void fft_stage(float2 (&v)[R], const float2 (&wp)[4]) {
#pragma unroll
  for (int idx = 0; idx < R / 2; ++idx) {
    const int blk = idx / HALF, jj = idx % HALF;
    const int j0 = blk * 2 * HALF + jj, j1 = j0 + HALF;
    const int e = jj * (8 / HALF);
    float2 tw = root16(e);
    if (HASW) { if (e == 0) tw = wp[S]; else tw = cmul(wp[S], tw); }
    const bool triv = (!HASW) && (e == 0);
    if (!INV) {
      float2 a = v[j0], b = v[j1];
      v[j0] = make_float2(a.x + b.x, a.y + b.y);
      float2 d = make_float2(a.x - b.x, a.y - b.y);
      v[j1] = triv ? d : cmul(d, tw);
    } else {
      float2 t = triv ? v[j1] : cmulc(v[j1], tw);
      float2 a = v[j0];
      v[j0] = make_float2(a.x + t.x, a.y + t.y);
      v[j1] = make_float2(a.x - t.x, a.y - t.y);
    }
  }
}
template <bool INV> DI void fft_local8(float2 (&v)[8], const float2 (&wp)[4]) {
  if (!INV) { fft_stage<8, 4, 0, false, true>(v, wp); fft_stage<8, 2, 1, false, true>(v, wp); fft_stage<8, 1, 2, false, true>(v, wp); }
  else      { fft_stage<8, 1, 2, true, true>(v, wp); fft_stage<8, 2, 1, true, true>(v, wp); fft_stage<8, 4, 0, true, true>(v, wp); }
}
template <bool INV> DI void fft_local16(float2 (&v)[16], const float2 (&wp)[4]) {
  if (!INV) { fft_stage<16, 8, 0, false, false>(v, wp); fft_stage<16, 4, 1, false, false>(v, wp); fft_stage<16, 2, 2, false, false>(v, wp); fft_stage<16, 1, 3, false, false>(v, wp); }
  else      { fft_stage<16, 1, 3, true, false>(v, wp); fft_stage<16, 2, 2, true, false>(v, wp); fft_stage<16, 4, 1, true, false>(v, wp); fft_stage<16, 8, 0, true, false>(v, wp); }
}

template <int LQ, bool INV> DI void fft_pass8(float2* lds, int tid) {
  constexpr int q = 1 << LQ;
#pragma unroll 1
  for (int it = 0; it < 4; ++it) {
    const int task = tid + 256 * it;
    const int p = task & (q - 1);
    const int g = task >> LQ;
    const int base = g * 8 * q + p;
    float2 v[8];
#pragma unroll
    for (int j = 0; j < 8; ++j) v[j] = lds[fphys(base + j * q)];
    float2 wp[4];
    wp[0] = twid_rev((float)p * (1.0f / (float)(8 * q)));
    wp[1] = cmul(wp[0], wp[0]);
    wp[2] = cmul(wp[1], wp[1]);
    wp[3] = wp[2];
    fft_local8<INV>(v, wp);
#pragma unroll
    for (int j = 0; j < 8; ++j) lds[fphys(base + j * q)] = v[j];
  }
}
template <bool INV> DI void fft_pass16(float2* lds, int tid) {
#pragma unroll 1
  for (int it = 0; it < 2; ++it) {
    const int g = tid + 256 * it;
    float2 v[16];
    const int sw = DBG_NOSWZ ? 0 : (g & 15);
#pragma unroll
    for (int j = 0; j < 16; ++j) v[j] = lds[g * 16 + (j ^ sw)];
    float2 wp[4] = {make_float2(1.f, 0.f), make_float2(1.f, 0.f), make_float2(1.f, 0.f), make_float2(1.f, 0.f)};
    fft_local16<INV>(v, wp);
#pragma unroll
    for (int j = 0; j < 16; ++j) lds[g * 16 + (j ^ sw)] = v[j];
  }
}
#ifndef DBG_FFTPASSES
#define DBG_FFTPASSES 15
#endif
DI void fft8192_fwd(float2* lds, int tid) {
  if (DBG_FFTPASSES & 1) { fft_pass8<10, false>(lds, tid); SYNC(); }
  if (DBG_FFTPASSES & 2) { fft_pass8<7, false>(lds, tid); SYNC(); }
  if (DBG_FFTPASSES & 4) { fft_pass8<4, false>(lds, tid); SYNC(); }
  if (DBG_FFTPASSES & 8) { fft_pass16<false>(lds, tid); SYNC(); }
}
DI void fft8192_inv(float2* lds, int tid) {
  fft_pass16<true>(lds, tid); SYNC();
  fft_pass8<4, true>(lds, tid); SYNC();
  fft_pass8<7, true>(lds, tid); SYNC();
  fft_pass8<10, true>(lds, tid); SYNC();
}

template <bool SWAP, bool ATR = false, int MTW = 2>
DI void gemm_main(const u16* __restrict__ A, int lda, int a_row0, int a_lo, int a_hi, int a_kstep,
                  const u16* __restrict__ B, int ldb, int nk, f32x16 (&acc)[MTW][2], char* smem) {
  constexpr int ROWS = MTW * 64, NA = MTW * 2;
  const int tid = opq(threadIdx.x), lane = tid & 63, wave = tid >> 6, wm = wave >> 1, wn = wave & 1, r = lane & 31, h = lane >> 5;
  char* sA = smem;
  char* sB = smem + ROWS * 144;
  const u16* ap[NA];
  const u16* bp[4];
  int loa[NA], lob[4];
#pragma unroll
  for (int i = 0; i < NA; ++i) {
    const int idx = tid + 256 * i, row = idx >> 3, ch = idx & 7;
    if (ATR) {
      ap[i] = A + (size_t)(idx & 63) * lda + a_row0 + (idx >> 6) * 8;
    } else {
      const int gr = min(max(a_row0 + row, a_lo), a_hi);
      ap[i] = A + (size_t)gr * lda + ch * 8;
    }
    loa[i] = row * 144 + ch * 16;
  }
#pragma unroll
  for (int i = 0; i < 4; ++i) {
    const int idx = tid + 256 * i, row = idx >> 3, ch = idx & 7;
    bp[i] = B + (size_t)row * ldb + ch * 8;
    lob[i] = row * 144 + ch * 16;
  }
  u32x4 ra0[NA], rb0[4];
#define GEMM_LOAD(RA, RB, KT)                                                                                         \
  _Pragma("unroll") for (int i = 0; i < NA; ++i)                                                                      \
    RA[i] = *(const u32x4*)(ap[i] + (ATR ? (size_t)(KT) * 64 * lda : (size_t)(KT) * a_kstep));                        \
  _Pragma("unroll") for (int i = 0; i < 4; ++i) RB[i] = *(const u32x4*)(bp[i] + (KT) * 64);
#define GEMM_STASH(RA, RB)                                                                                            \
  _Pragma("unroll") for (int i = 0; i < NA; ++i) {                                                                    \
    if (ATR) {                                                                                                        \
      const int idx = tid + 256 * i, krow = idx & 63, mch = idx >> 6;                                                 \
      _Pragma("unroll") for (int e = 0; e < 4; ++e) {                                                                 \
        *(u16*)(sA + (mch * 8 + 2 * e) * 144 + krow * 2) = (u16)(RA[i][e] & 0xffffu);                                 \
        *(u16*)(sA + (mch * 8 + 2 * e + 1) * 144 + krow * 2) = (u16)(RA[i][e] >> 16);                                 \
      }                                                                                                               \
    } else {                                                                                                          \
      *(u32x4*)(sA + loa[i]) = RA[i];                                                                                 \
    }                                                                                                                 \
  }                                                                                                                   \
  _Pragma("unroll") for (int i = 0; i < 4; ++i) *(u32x4*)(sB + lob[i]) = RB[i];
#define GEMM_COMPUTE()                                                                                                \
  _Pragma("unroll") for (int ks = 0; ks < 4; ++ks) {                                                                  \
    bf16x8 af[MTW], bfr[2];                                                                                           \
    _Pragma("unroll") for (int t = 0; t < MTW; ++t) af[t] = *(const bf16x8*)(pa + t * 32 * 144 + ks * 32);            \
    _Pragma("unroll") for (int t = 0; t < 2; ++t) bfr[t] = *(const bf16x8*)(pb + t * 32 * 144 + ks * 32);             \
    _Pragma("unroll") for (int mt = 0; mt < MTW; ++mt)                                                                \
      _Pragma("unroll") for (int nt = 0; nt < 2; ++nt)                                                                \
        acc[mt][nt] = SWAP ? MFMA(bfr[nt], af[mt], acc[mt][nt]) : MFMA(af[mt], bfr[nt], acc[mt][nt]);                 \
  }
  GEMM_LOAD(ra0, rb0, 0)
#pragma unroll
  for (int mt = 0; mt < MTW; ++mt)
#pragma unroll
    for (int nt = 0; nt < 2; ++nt)
#pragma unroll
      for (int i = 0; i < 16; ++i) acc[mt][nt][i] = 0.f;
  const char* pa = sA + (wm * (MTW * 32) + r) * 144 + h * 16;
  const char* pb = sB + (wn * 64 + r) * 144 + h * 16;
#pragma unroll 1
  for (int kk = 0; kk < nk; ++kk) {
    __syncthreads();
    GEMM_STASH(ra0, rb0)
    __syncthreads();
    if (kk + 1 < nk) { GEMM_LOAD(ra0, rb0, kk + 1) }
    GEMM_COMPUTE()
  }
#undef GEMM_LOAD
#undef GEMM_STASH
#undef GEMM_COMPUTE
}
template <int MTW>
DI void store_rowmajor(const f32x16 (&acc)[MTW][2], u16* C, int ldc, int m0, int ncol0, float scale) {
  const int tid = opq(threadIdx.x), lane = tid & 63, wave = tid >> 6, wm = wave >> 1, wn = wave & 1, r = lane & 31, h = lane >> 5;
#pragma unroll
  for (int mt = 0; mt < MTW; ++mt)
#pragma unroll
    for (int nt = 0; nt < 2; ++nt)
#pragma unroll
      for (int g = 0; g < 4; ++g) {
        const int m = m0 + wm * (MTW * 32) + mt * 32 + r, n = ncol0 + wn * 64 + nt * 32 + 8 * g + 4 * h;
        u32x2 pk;
        pk.x = pack2(acc[mt][nt][4 * g] * scale, acc[mt][nt][4 * g + 1] * scale);
        pk.y = pack2(acc[mt][nt][4 * g + 2] * scale, acc[mt][nt][4 * g + 3] * scale);
        *(u32x2*)(C + (size_t)m * ldc + n) = pk;
      }
}
template <int MTW>
DI void store_transposed(const f32x16 (&acc)[MTW][2], u16* T, int ldt, int trow0, int j0) {
  const int tid = opq(threadIdx.x), lane = tid & 63, wave = tid >> 6, wm = wave >> 1, wn = wave & 1, r = lane & 31, h = lane >> 5;
#pragma unroll
  for (int mt = 0; mt < MTW; ++mt)
#pragma unroll
    for (int nt = 0; nt < 2; ++nt)
#pragma unroll
      for (int g = 0; g < 4; ++g) {
        const int n = trow0 + wn * 64 + nt * 32 + r, m = j0 + wm * (MTW * 32) + mt * 32 + 8 * g + 4 * h;
        u32x2 pk;
        pk.x = pack2(acc[mt][nt][4 * g], acc[mt][nt][4 * g + 1]);
        pk.y = pack2(acc[mt][nt][4 * g + 2], acc[mt][nt][4 * g + 3]);
        *(u32x2*)(T + (size_t)n * ldt + m) = pk;
      }
}

constexpr int NCONV_TILES = 864 + 768 + 64 + 384 + 256 + 1408 + 704;
DI void conv_tile(const Params& p, int l, int tile, char* smem) {
  float* t = (float*)smem;
  const int tid = opq(threadIdx.x);
  int mat, tn, tk;
  if (tile < 864) { mat = 0; tn = tile / 16; tk = tile % 16; }
  else if (tile < 1632) { tile -= 864; mat = 1; tn = tile / 16; tk = tile % 16; }
  else if (tile < 1696) { tile -= 1632; mat = 2; tn = tile / 4; tk = tile % 4; }
  else if (tile < 2080) { tile -= 1696; mat = 3; tn = tile / 8; tk = tile % 8; }
  else if (tile < 2336) { tile -= 2080; mat = 4; tn = tile / 16; tk = tile % 16; }
  else if (tile < 3744) { tile -= 2336; mat = 5; tn = tile / 16; tk = tile % 16; }
  else { tile -= 3744; mat = 6; tn = tile / 44; tk = tile % 44; }
  const int k0 = tk * 64;
  const int nn = tid & 63;
  int np = tn * 64 + nn;
  const float* src; int ld; int col;
  if (mat == 0) { src = p.w_in + (size_t)l * 1024 * 6432; ld = 6432; col = np < 1024 ? np : (np < 3328 ? np + 32 : (np < 3360 ? np - 3328 + 1024 : -1)); }
  else if (mat == 1) { src = p.w_in + (size_t)l * 1024 * 6432; ld = 6432; col = 3360 + np; }
  else if (mat == 2) { src = p.w_kv_up + (size_t)l * 256 * 1024; ld = 1024; col = np < 512 ? (np >> 6) * 128 + (np & 63) : ((np - 512) >> 6) * 128 + 64 + (np & 63); }
  else if (mat == 3) { const int br = tn / 16; np = (tn % 16) * 64 + nn; src = p.w_branch + (size_t)(l * 3 + br) * 512 * 1024; ld = 1024; col = np; }
  else if (mat == 4) { src = p.w_out + (size_t)l * 1024 * 1024; ld = 1024; col = np; }
  else if (mat == 5) { src = p.w_up + (size_t)l * 1024 * 5632; ld = 5632; const int blk = np >> 7, rr = np & 127; col = rr < 64 ? blk * 64 + rr : 2816 + blk * 64 + rr - 64; }
  else { src = p.w_down + (size_t)l * 2816 * 1024; ld = 1024; col = np; }
#pragma unroll 4
  for (int i = 0; i < 16; ++i) {
    const int kk = (tid >> 6) + 4 * i;
    float v = 0.f;
    if (col >= 0) v = src[(size_t)(k0 + kk) * ld + col];
    if (mat == 2) v *= p.kv_norm_g[l * 256 + k0 + kk];
    t[kk * 65 + nn] = v;
  }
  __syncthreads();
  {
    const int n2 = tid >> 2, kq = (tid & 3) * 16;
    const int drow = tn * 64 + n2;
    u16* dst;
    if (mat == 0) dst = (u16*)(p.ws + OFF_WT_IN) + (size_t)drow * 1024;
    else if (mat == 1) dst = (u16*)(p.ws + OFF_WT_GATE) + (size_t)drow * 1024;
    else if (mat == 2) dst = (u16*)(p.ws + OFF_WT_KV) + (size_t)drow * 256;
    else if (mat == 3) dst = (u16*)(p.ws + OFF_WT_BR) + (size_t)drow * 512;
    else if (mat == 4) dst = (u16*)(p.ws + OFF_WT_OUT) + (size_t)drow * 1024;
    else if (mat == 5) dst = (u16*)(p.ws + OFF_WT_UP) + (size_t)drow * 1024;
    else dst = (u16*)(p.ws + OFF_WT_DOWN) + (size_t)drow * 2816;
    unsigned pk[8];
#pragma unroll
    for (int j = 0; j < 8; ++j) pk[j] = pack2(t[(kq + 2 * j) * 65 + n2], t[(kq + 2 * j + 1) * 65 + n2]);
    u32x4* d4 = (u32x4*)(dst + k0 + kq);
    d4[0] = u32x4{pk[0], pk[1], pk[2], pk[3]};
    d4[1] = u32x4{pk[4], pk[5], pk[6], pk[7]};
  }
  __syncthreads();
}

DI void mod_item(const Params& p, int item, char* smem) {
  float* sv = (float*)smem;
  float* red = sv + 5 * 1024;
  const int tid = opq(threadIdx.x);
  const int l = item / 96, cg0 = (item % 96) * 64;
  for (int i = tid; i < 5 * 1024; i += 256) {
    const int v = i >> 10, k = i & 1023;
    const float c = v < 4 ? p.c[v * 1024 + k] : p.c_ctx[k];
    sv[i] = c / (1.f + __expf(-c));
  }
  __syncthreads();
  const int kq = tid >> 6, cc = tid & 63, col = cg0 + cc;
  float a[5] = {0.f, 0.f, 0.f, 0.f, 0.f};
  const float* w = p.w_mod + (size_t)l * 1024 * 6144 + col;
#pragma unroll 8
  for (int k = kq * 256; k < kq * 256 + 256; ++k) {
    const float wv = w[(size_t)k * 6144];
#pragma unroll
    for (int v = 0; v < 5; ++v) a[v] += sv[v * 1024 + k] * wv;
  }
#pragma unroll
  for (int v = 0; v < 5; ++v) red[(kq * 5 + v) * 64 + cc] = a[v];
  __syncthreads();
  for (int i = tid; i < 5 * 64; i += 256) {
    const int v = i >> 6, c2 = i & 63;
    float s = p.b_mod[l * 6144 + cg0 + c2];
#pragma unroll
    for (int q = 0; q < 4; ++q) s += red[(q * 5 + v) * 64 + c2];
    ((float*)(p.ws + OFF_MOD))[(l * 5 + v) * 6144 + cg0 + c2] = s;
  }
  __syncthreads();
}

DI void rope_item(const Params& p, int item) {
  const int e = item * 256 + opq(threadIdx.x);
  const int pos = e / 48, f = e % 48;
  const int row = pos >> 6, colp = pos & 63;
  float* base = (float*)(p.ws + OFF_ROPE);
  float ang; float *cd, *sd;
  if (f < 16) {
    const int fi = f & 7;
    const float inv = exp2f(-(float)fi * (13.287712379549449f / 8.f));
    ang = (f < 8 ? (float)row : (float)colp) * inv;
    cd = base + pos * 16 + f; sd = base + 8192 * 16 + pos * 16 + f;
  } else {
    const int f2 = f - 16, fi = f2 & 15;
    const float inv = exp2f(-(float)fi * (13.287712379549449f / 16.f));
    ang = (f2 < 16 ? (float)row : (float)colp) * inv;
    cd = base + 2 * 8192 * 16 + pos * 32 + f2; sd = base + 2 * 8192 * 16 + 8192 * 32 + pos * 32 + f2;
  }
  const float rev = ang * 0.15915494309189535f;
  *cd = cosrev(rev);
  *sd = sinrev(rev);
}

DI void hid_item(const Params& p, int item, char* smem) {
  float* feat = (float*)smem;
  float* h1 = feat + 4 * 36;
  const int tid = opq(threadIdx.x);
  const int l = item / 264; const int it = item % 264;
  int L, pos00; float* dst;
  if (it < 256) { L = 8192; pos00 = it * 32; dst = (float*)(p.ws + OFF_HID + l * HID_LAYER); }
  else { L = 256; pos00 = (it - 256) * 32; dst = (float*)(p.ws + OFF_HID + l * HID_LAYER) + 64 * 8192; }
  const int pp = tid >> 6, j = tid & 63;
#pragma unroll 1
  for (int sub = 0; sub < 8; ++sub) {
    const int pos = pos00 + sub * 4 + pp;
    if (j < 33) {
      float fv;
      if (j == 0) fv = (float)pos / (float)(L - 1);
      else {
        const int bi = (j - 1) & 15;
        const float band = 1e-4f + (float)bi * ((15.f - 1e-4f) / 15.f);
        const float rev = (float)pos * band / (float)L;
        fv = (j <= 16) ? cosrev(rev) : -sinrev(rev);
      }
      feat[pp * 36 + j] = fv;
    }
    __syncthreads();
    {
      float s = p.hy_b1[l * 64 + j];
      const float* w1 = p.hy_w1 + (size_t)l * 33 * 64;
#pragma unroll
      for (int f = 0; f < 33; ++f) s += feat[pp * 36 + f] * w1[f * 64 + j];
      s *= p.hy_freq[l * 128 + j];
      h1[pp * 64 + j] = sinrev(s * 0.15915494309189535f);
    }
    __syncthreads();
    {
      float s = p.hy_b2[l * 64 + j];
      const float* w2 = p.hy_w2 + (size_t)l * 64 * 64;
#pragma unroll 8
      for (int i = 0; i < 64; ++i) s += h1[pp * 64 + i] * w2[i * 64 + j];
      s *= p.hy_freq[l * 128 + 64 + j];
      dst[(size_t)j * L + pos] = sinrev(s * 0.15915494309189535f);
    }
    __syncthreads();
  }
}

DI const float* xrow_src(const float* xl, const float* xc, int m) {
  const int b = m / TPB, j = m - b * TPB;
  return j < CTX ? xc + (size_t)(b * CTX + j) * DM : xl + (size_t)(b * SEQ + j - CTX) * DM;
}
DI void row_pass(const Params& p, int mode, const float* xl_src, const float* xc_src, float* xl_dst, float* xc_dst,
                 const u16* ybuf, const float* gy, int gate_off, int modl_gate,
                 bool has_next, const float* gn, int modl_next, int sh_off, int sc_off, u16* hdst, bool skip_ctx_rows) {
  const int tid0 = opq(threadIdx.x);
  const int lane = tid0 & 63;
  const int gw = blockIdx.x * 4 + (tid0 >> 6), nw = gridDim.x * 4;
  const float* modb = (const float*)(p.ws + OFF_MOD);
  const int per = (MTOK + nw - 1) / nw;
  const int m_beg = gw * per, m_end = min(m_beg + per, MTOK);
  int cur_v = -1;
  float4 gg[4], gs[4], shv[4];
#pragma unroll
  for (int i = 0; i < 4; ++i) { gg[i] = make_float4(0.f, 0.f, 0.f, 0.f); gs[i] = gg[i]; shv[i] = gg[i]; }
  const bool do_h = (mode == 0) || has_next;
  float4 xv_n[4];
  u32x2 yr_n[4];
#pragma unroll
  for (int i = 0; i < 4; ++i) { xv_n[i] = make_float4(0.f, 0.f, 0.f, 0.f); yr_n[i] = u32x2{0u, 0u}; }
  if (m_beg < m_end) {
    const float* xs0 = xrow_src(xl_src, xc_src, m_beg);
#pragma unroll
    for (int i = 0; i < 4; ++i) {
      xv_n[i] = *(const float4*)(xs0 + lane * 4 + 256 * i);
      if (mode == 1) yr_n[i] = *(const u32x2*)(ybuf + (size_t)m_beg * DM + lane * 4 + 256 * i);
    }
  }
  for (int m = m_beg; m < m_end; ++m) {
    const int b = m / TPB, j = m - b * TPB;
    float4 xv[4];
    u32x2 yr[4];
#pragma unroll
    for (int i = 0; i < 4; ++i) { xv[i] = xv_n[i]; yr[i] = yr_n[i]; }
    if (m + 1 < m_end) {
      const float* xs1 = xrow_src(xl_src, xc_src, m + 1);
#pragma unroll
      for (int i = 0; i < 4; ++i) {
        xv_n[i] = *(const float4*)(xs1 + lane * 4 + 256 * i);
        if (mode == 1) yr_n[i] = *(const u32x2*)(ybuf + (size_t)(m + 1) * DM + lane * 4 + 256 * i);
      }
    }
    if (skip_ctx_rows && j < CTX) continue;
    const int v = j < CTX ? 4 : b;
    if (v != cur_v) {
      cur_v = v;
#pragma unroll
      for (int i = 0; i < 4; ++i) {
        const int c = lane * 4 + 256 * i;
        if (mode == 1) {
          const float4 g4 = *(const float4*)(gy + c);
          const float4 t4 = *(const float4*)(modb + (size_t)(modl_gate * 5 + v) * 6144 + gate_off + c);
          gg[i] = make_float4(g4.x * t4.x, g4.y * t4.y, g4.z * t4.z, g4.w * t4.w);
        }
        if (do_h) {
          const float* mb = modb + (size_t)(modl_next * 5 + v) * 6144;
          const float4 g4 = *(const float4*)(gn + c);
          const float4 sc = *(const float4*)(mb + sc_off + c);
          shv[i] = *(const float4*)(mb + sh_off + c);
          gs[i] = make_float4(g4.x * (1.f + sc.x), g4.y * (1.f + sc.y), g4.z * (1.f + sc.z), g4.w * (1.f + sc.w));
        }
      }
    }
    if (mode == 1) {
      float yv[4][4];
      float ss = 0.f;
#pragma unroll
      for (int i = 0; i < 4; ++i) {
        const u32x2 u = yr[i];
        yv[i][0] = lo_bf(u.x); yv[i][1] = hi_bf(u.x); yv[i][2] = lo_bf(u.y); yv[i][3] = hi_bf(u.y);
#pragma unroll
        for (int e = 0; e < 4; ++e) ss += yv[i][e] * yv[i][e];
      }
      ss = wave_sum(ss);
      const float rstd = rsqrtf(ss * (1.f / DM) + EPS);
#pragma unroll
      for (int i = 0; i < 4; ++i) {
        xv[i].x += gg[i].x * (yv[i][0] * rstd);
        xv[i].y += gg[i].y * (yv[i][1] * rstd);
        xv[i].z += gg[i].z * (yv[i][2] * rstd);
        xv[i].w += gg[i].w * (yv[i][3] * rstd);
      }
      float* xd = (j < CTX) ? xc_dst + (size_t)(b * CTX + j) * DM : xl_dst + (size_t)(b * SEQ + j - CTX) * DM;
#pragma unroll
      for (int i = 0; i < 4; ++i) *(float4*)(xd + lane * 4 + 256 * i) = xv[i];
    }
    if (do_h) {
      float ss = 0.f;
#pragma unroll
      for (int i = 0; i < 4; ++i) ss += xv[i].x * xv[i].x + xv[i].y * xv[i].y + xv[i].z * xv[i].z + xv[i].w * xv[i].w;
      ss = wave_sum(ss);
      const float rstd = rsqrtf(ss * (1.f / DM) + EPS);
#pragma unroll
      for (int i = 0; i < 4; ++i) {
        const int c = lane * 4 + 256 * i;
        u32x2 pk;
        pk.x = pack2(xv[i].x * rstd * gs[i].x + shv[i].x, xv[i].y * rstd * gs[i].y + shv[i].y);
        pk.y = pack2(xv[i].z * rstd * gs[i].z + shv[i].z, xv[i].w * rstd * gs[i].w + shv[i].w);
        *(u32x2*)(hdst + (size_t)m * DM + c) = pk;
      }
    }
  }
}

constexpr float QS_MLA = 0.10206207261596577f * LOG2E;
constexpr float QS_SWA = 0.125f * LOG2E;

DI void rope32(f32x16& a, const float* cm, const float* sm, int pos, int h) {
#pragma unroll
  for (int i = 0; i < 8; ++i) {
    const int f = crow(i, h);
    const float c = cm[pos * 16 + f], s = sm[pos * 16 + f];
    const float x1 = a[i], x2 = a[i + 8];
    a[i] = x1 * c - x2 * s;
    a[i + 8] = x2 * c + x1 * s;
    if ((i & 3) == 3) __builtin_amdgcn_sched_barrier(0);
  }
}
DI void rope64(f32x16& a0, f32x16& a1, const float* cs, const float* ss, int pos, int h) {
#pragma unroll
  for (int i = 0; i < 16; ++i) {
    const int f = crow(i, h);
    const float c = cs[pos * 32 + f], s = ss[pos * 32 + f];
    const float x1 = a0[i], x2 = a1[i];
    a0[i] = x1 * c - x2 * s;
    a1[i] = x2 * c + x1 * s;
    if ((i & 3) == 3) __builtin_amdgcn_sched_barrier(0);
  }
}

DI void inproj_tile(const Params& p, int tile, char* smem) {
  const int mt_i = tile / 27, nt_i = tile % 27;
  const int m0 = mt_i * 192;
  const int tid = opq(threadIdx.x), lane = tid & 63, wave = tid >> 6, wm = wave >> 1, wn = wave & 1, r = lane & 31, h = lane >> 5;
  const u16* hbuf = (const u16*)(p.ws + OFF_RH);
  const u16* wt = (const u16*)(p.ws + OFF_WT_IN) + (size_t)nt_i * 128 * 1024;
  const int b = m0 / TPB, j0 = m0 - b * TPB;
  const float* cm = (const float*)(p.ws + OFF_ROPE);
  const float* sm = cm + 8192 * 16;
  const float* cs = sm + 8192 * 16;
  const float* ss = cs + 8192 * 32;
  f32x16 acc[3][2];
  if (nt_i >= 13 && nt_i <= 25) {
    gemm_main<false>(hbuf, 1024, m0, 0, MTOK - 1, 64, wt, 1024, 16, acc, smem);
    if (nt_i == 13) store_transposed(acc, (u16*)(p.ws + OFF_SVT), TPB, b * 128, j0);
    else store_transposed(acc, (u16*)(p.ws + OFF_HYT), TPB, b * 1536 + (nt_i - 14) * 128, j0);
    return;
  }
  gemm_main<true>(hbuf, 1024, m0, 0, MTOK - 1, 64, wt, 1024, 16, acc, smem);
  if (nt_i < 6) {
#pragma unroll
    for (int ntl = 0; ntl < 2; ++ntl) {
      const int s32 = nt_i * 4 + wn * 2 + ntl;
      if (s32 % 3 == 2) {
#pragma unroll
        for (int mt = 0; mt < 3; ++mt) {
          const int jr = j0 + wm * 96 + mt * 32 + r;
          if (jr >= CTX) rope32(acc[mt][ntl], cm, sm, jr - CTX, h);
        }
      }
    }
    store_rowmajor(acc, (u16*)(p.ws + OFF_Q), 768, m0, nt_i * 128, QS_MLA);
  } else if (nt_i < 8) {
    store_rowmajor(acc, (u16*)(p.ws + OFF_CKV), 256, m0, (nt_i - 6) * 128, 1.f);
  } else if (nt_i < 12) {
#pragma unroll
    for (int mt = 0; mt < 3; ++mt) {
      const int jr = j0 + wm * 96 + mt * 32 + r;
      if (jr >= CTX) rope64(acc[mt][0], acc[mt][1], cs, ss, jr - CTX, h);
    }
    store_rowmajor(acc, (u16*)(p.ws + OFF_SQ), 512, m0, (nt_i - 8) * 128, QS_SWA);
  } else if (nt_i == 12) {
#pragma unroll
    for (int mt = 0; mt < 3; ++mt) {
      const int jr = j0 + wm * 96 + mt * 32 + r;
      if (jr >= CTX) rope64(acc[mt][0], acc[mt][1], cs, ss, jr - CTX, h);
    }
    store_rowmajor(acc, (u16*)(p.ws + OFF_SK), 128, m0, 0, 1.f);
  } else {
    if (wn == 0) {
      u16* kr = (u16*)(p.ws + OFF_KR);
#pragma unroll
      for (int mt = 0; mt < 3; ++mt) {
        const int ml = wm * 96 + mt * 32 + r;
        if (j0 + ml >= CTX) rope32(acc[mt][0], cm, sm, j0 + ml - CTX, h);
#pragma unroll
        for (int g = 0; g < 4; ++g) {
          u32x2 pk;
          pk.x = pack2(acc[mt][0][4 * g], acc[mt][0][4 * g + 1]);
          pk.y = pack2(acc[mt][0][4 * g + 2], acc[mt][0][4 * g + 3]);
          *(u32x2*)(kr + (size_t)(m0 + ml) * 32 + 8 * g + 4 * h) = pk;
        }
      }
    }
  }
}

DI void kvup_tile(const Params& p, int tile, char* smem) {
  const int mt_i = tile >> 3, nt_i = tile & 7;
  const int m0 = mt_i * 192;
  const int tid = opq(threadIdx.x), lane = tid & 63, wave = tid >> 6, wm = wave >> 1, r = lane & 31, h = lane >> 5;
  const u16* ckv = (const u16*)(p.ws + OFF_CKV);
  float* rs = (float*)(smem + (192 + 128) * 144);
#pragma unroll
  for (int pass = 0; pass < 2; ++pass) {
    const int row = pass * 128 + (tid >> 1), half = tid & 1;
    const int rowc = min(row, 191);
    const u32x4* src = (const u32x4*)(ckv + (size_t)(m0 + rowc) * 256 + half * 128);
    float ss = 0.f;
#pragma unroll
    for (int i = 0; i < 16; ++i) {
      const u32x4 u = src[i];
      const unsigned w[4] = {u.x, u.y, u.z, u.w};
#pragma unroll
      for (int e = 0; e < 4; ++e) { const float a = lo_bf(w[e]), c = hi_bf(w[e]); ss += a * a + c * c; }
    }
    ss += __shfl_xor(ss, 1);
    if (half == 0 && row < 192) rs[row] = rsqrtf(ss * (1.f / 256.f) + EPS);
  }
  const u16* wt = (const u16*)(p.ws + OFF_WT_KV) + (size_t)nt_i * 128 * 256;
  const int b = m0 / TPB, j0 = m0 - b * TPB;
  f32x16 acc[3][2];
  if (nt_i < 4) {
    gemm_main<true>(ckv, 256, m0, 0, MTOK - 1, 64, wt, 256, 4, acc, smem);
#pragma unroll
    for (int mt = 0; mt < 3; ++mt) {
      const float sc = rs[wm * 96 + mt * 32 + r];
#pragma unroll
      for (int nt = 0; nt < 2; ++nt)
#pragma unroll
        for (int i = 0; i < 16; ++i) acc[mt][nt][i] *= sc;
    }
    store_rowmajor(acc, (u16*)(p.ws + OFF_KN), 512, m0, nt_i * 128, 1.f);
  } else {
    gemm_main<false>(ckv, 256, m0, 0, MTOK - 1, 64, wt, 256, 4, acc, smem);
#pragma unroll
    for (int mt = 0; mt < 3; ++mt)
#pragma unroll
      for (int i = 0; i < 16; ++i) {
        const float sc = rs[wm * 96 + mt * 32 + crow(i, h)];
        acc[mt][0][i] *= sc;
        acc[mt][1][i] *= sc;
      }
    store_transposed(acc, (u16*)(p.ws + OFF_VT), TPB, b * 512 + (nt_i - 4) * 128, j0);
  }
  __syncthreads();
}

DI void merge_tile(const Params& p, int tile, char* smem) {
  const int mt_i = tile >> 3, nt_i = tile & 7;
  const int m0 = mt_i * 192;
  const u16* hp = (const u16*)(p.ws + OFF_RH);
  const int tid = opq(threadIdx.x), lane = tid & 63, wave = tid >> 6, wm = wave >> 1, wn = wave & 1, r = lane & 31, h = lane >> 5;
  u16* C = (u16*)(p.ws + OFF_MERGED);
#pragma unroll 1
  for (int br = 0; br < 3; ++br) {
    if ((DBG_SKIP_BR >> br) & 1) continue;
    f32x16 acc[3][2];
    gemm_main<true>(hp, 1024, m0, 0, MTOK - 1, 64, (const u16*)(p.ws + OFF_WT_GATE) + (size_t)(br * 1024 + nt_i * 128) * 1024, 1024, 16, acc, smem);
    u32x2* sgp = (u32x2*)(p.ws + OFF_ESCR + (size_t)blockIdx.x * 65536) + tid * 24;
#pragma unroll
    for (int a = 0; a < 3; ++a)
#pragma unroll
      for (int b2 = 0; b2 < 2; ++b2)
#pragma unroll
        for (int g = 0; g < 4; ++g) {
          u32x2 v;
          v.x = pack2(1.f / (1.f + __expf(-acc[a][b2][4 * g])), 1.f / (1.f + __expf(-acc[a][b2][4 * g + 1])));
          v.y = pack2(1.f / (1.f + __expf(-acc[a][b2][4 * g + 2])), 1.f / (1.f + __expf(-acc[a][b2][4 * g + 3])));
          sgp[(a * 2 + b2) * 4 + g] = v;
        }
    const u16* wbr = (const u16*)(p.ws + OFF_WT_BR) + (size_t)(br * 1024 + nt_i * 128) * 512;
    if (br == 0) gemm_main<true>((const u16*)(p.ws + OFF_Q), 768, m0, 0, MTOK - 1, 96, wbr, 512, 8, acc, smem);
    else if (br == 1) gemm_main<true>((const u16*)(p.ws + OFF_SQ), 512, m0, 0, MTOK - 1, 64, wbr, 512, 8, acc, smem);
    else {
      const int b = m0 / TPB, j0 = m0 - b * TPB;
      gemm_main<true, true>((const u16*)(p.ws + OFF_HYT) + (size_t)(b * 1536 + 512) * TPB, TPB, j0, 0, 0, 64, wbr, 512, 8, acc, smem);
    }
#pragma unroll
    for (int mt = 0; mt < 3; ++mt)
#pragma unroll
      for (int nt = 0; nt < 2; ++nt)
#pragma unroll
        for (int g = 0; g < 4; ++g) {
          const int m = m0 + wm * 96 + mt * 32 + r, n = nt_i * 128 + wn * 64 + nt * 32 + 8 * g + 4 * h;
          u32x2* dst = (u32x2*)(C + (size_t)m * 1024 + n);
          u32x2 prev = {0u, 0u};
          if (br > DBG_FIRST_BR) prev = *dst;
          const u32x2 sv = sgp[(mt * 2 + nt) * 4 + g];
          const unsigned s0 = sv.x, s1 = sv.y;
          u32x2 nv;
          nv.x = pack2(lo_bf(prev.x) + lo_bf(s0) * acc[mt][nt][4 * g], hi_bf(prev.x) + hi_bf(s0) * acc[mt][nt][4 * g + 1]);
          nv.y = pack2(lo_bf(prev.y) + lo_bf(s1) * acc[mt][nt][4 * g + 2], hi_bf(prev.y) + hi_bf(s1) * acc[mt][nt][4 * g + 3]);
          *dst = nv;
          __builtin_amdgcn_sched_barrier(0);
        }
  }
}

DI void plain_tile(const Params& p, int tile, const u16* A, int lda, int nk, const u16* W, u16* C, char* smem) {
  const int mt_i = tile >> 3, nt_i = tile & 7;
  f32x16 acc[3][2];
  gemm_main<true>(A, lda, mt_i * 192, 0, MTOK - 1, 64, W + (size_t)nt_i * 128 * lda, lda, nk, acc, smem);
  store_rowmajor(acc, C, 1024, mt_i * 192, nt_i * 128, 1.f);
}

DI void ffnup_tile(const Params& p, int l, int tile, char* smem) {
  const int mt_i = tile / 44, nt_i = tile % 44;
  const int b = mt_i / 46, ti = mt_i % 46;
  int seq_base, len, r0;
  if (ti < 2) { seq_base = b * TPB; len = CTX; r0 = 190 * ti; }
  else { seq_base = b * TPB + CTX; len = SEQ; r0 = 190 * (ti - 2); }
  const int tid = opq(threadIdx.x), lane = tid & 63, wave = tid >> 6, wm = wave >> 1, wn = wave & 1, r = lane & 31, h = lane >> 5;
  f32x16 acc[3][2];
  gemm_main<true>((const u16*)(p.ws + OFF_RH), 1024, seq_base + r0 - 1, seq_base, seq_base + len - 1, 64,
                  (const u16*)(p.ws + OFF_WT_UP) + (size_t)nt_i * 128 * 1024, 1024, 16, acc, smem);
  __syncthreads();
#pragma unroll
  for (int mt = 0; mt < 3; ++mt) {
    const int ml = wm * 96 + mt * 32 + r;
    const int pos = r0 - 1 + ml;
    const bool valid = pos >= 0 && pos < len;
#pragma unroll
    for (int nt = 0; nt < 2; ++nt)
#pragma unroll
      for (int g = 0; g < 4; ++g) {
        u32x2 pk = u32x2{0u, 0u};
        if (valid) {
          pk.x = pack2(acc[mt][nt][4 * g], acc[mt][nt][4 * g + 1]);
          pk.y = pack2(acc[mt][nt][4 * g + 2], acc[mt][nt][4 * g + 3]);
        }
        *(u32x2*)(smem + ml * 272 + (wn * 64 + nt * 32 + 8 * g + 4 * h) * 2) = pk;
      }
  }
  __syncthreads();
  {
    const int j4 = (tid & 15) * 4, tr = tid >> 4;
    const float* cw = p.ffn_conv_w + (size_t)l * 3 * 5632;
    const float* cb = p.ffn_conv_b + (size_t)l * 5632;
    const int cha = nt_i * 64 + j4, chb = DFF + cha;
    float wa[3][4], wb[3][4], ba[4], bb[4];
#pragma unroll
    for (int e = 0; e < 4; ++e) {
#pragma unroll
      for (int d = 0; d < 3; ++d) { wa[d][e] = cw[d * 5632 + cha + e]; wb[d][e] = cw[d * 5632 + chb + e]; }
      ba[e] = cb[cha + e]; bb[e] = cb[chb + e];
    }
    u16* Aout = (u16*)(p.ws + OFF_A);
#pragma unroll 1
    for (int i = 0; i < 12; ++i) {
      const int t = 1 + tr + 16 * i;
      const int pos = r0 - 1 + t;
      if (t <= 190 && pos < len) {
        float ca[4], cbv[4];
#pragma unroll
        for (int e = 0; e < 4; ++e) { ca[e] = ba[e]; cbv[e] = bb[e]; }
#pragma unroll
        for (int d = 0; d < 3; ++d) {
          const u32x2 ua = *(const u32x2*)(smem + (t - 1 + d) * 272 + j4 * 2);
          const u32x2 ub = *(const u32x2*)(smem + (t - 1 + d) * 272 + (64 + j4) * 2);
          ca[0] += lo_bf(ua.x) * wa[d][0]; ca[1] += hi_bf(ua.x) * wa[d][1]; ca[2] += lo_bf(ua.y) * wa[d][2]; ca[3] += hi_bf(ua.y) * wa[d][3];
          cbv[0] += lo_bf(ub.x) * wb[d][0]; cbv[1] += hi_bf(ub.x) * wb[d][1]; cbv[2] += lo_bf(ub.y) * wb[d][2]; cbv[3] += hi_bf(ub.y) * wb[d][3];
        }
        float o[4];
#pragma unroll
        for (int e = 0; e < 4; ++e) o[e] = ca[e] / (1.f + __expf(-ca[e])) * cbv[e];
        *(u32x2*)(Aout + (size_t)(seq_base + pos) * DFF + cha) = u32x2{pack2(o[0], o[1]), pack2(o[2], o[3])};
      }
    }
  }
}

template <int DQK, bool SWA>
DI void attn_item(const Params& p, int l, int b, int hq, int jq0  , int nct, int nband, int kp_start, char* smem) {
  constexpr int KS = DQK * 2 + 16;
  constexpr int KCH = DQK / 8;
  constexpr int NKC = 64 * KCH / 256;
  constexpr int NKS = DQK / 16;
  constexpr int BUFSZ = 22016;
  const int tid = opq(threadIdx.x), lane = tid & 63, wave = tid >> 6, r = lane & 31, h = lane >> 5;
  const int brow = b * TPB;
  const int ntiles = nct + nband;
  const u16* K1; int ldk1, koff; const u16* KR = (const u16*)(p.ws + OFF_KR);
  const u16* Vb; u16* outp; int ldo, ooff; const u16* Qb; int ldq;
  if (!SWA) {
    K1 = (const u16*)(p.ws + OFF_KN); ldk1 = 512; koff = hq * 64;
    Vb = (const u16*)(p.ws + OFF_VT) + (size_t)((b * 8 + hq) * 64) * TPB;
    Qb = (const u16*)(p.ws + OFF_Q); ldq = 768;
    outp = (u16*)(p.ws + OFF_Q); ldo = 768; ooff = hq * 96;
  } else {
    const int kvh = hq >> 2;
    K1 = (const u16*)(p.ws + OFF_SK); ldk1 = 128; koff = kvh * 64;
    Vb = (const u16*)(p.ws + OFF_SVT) + (size_t)((b * 2 + kvh) * 64) * TPB;
    Qb = (const u16*)(p.ws + OFF_SQ); ldq = 512;
    outp = (u16*)(p.ws + OFF_SQ); ldo = 512; ooff = hq * 64;
  }
  const int qrow = brow + jq0 + wave * 32 + r;
  bf16x8 qf[NKS];
#pragma unroll
  for (int ks = 0; ks < NKS; ++ks) qf[ks] = *(const bf16x8*)(Qb + (size_t)qrow * ldq + hq * DQK + ks * 16 + h * 8);
  f32x16 o[2];
#pragma unroll
  for (int dt = 0; dt < 2; ++dt)
#pragma unroll
    for (int i = 0; i < 16; ++i) o[dt][i] = 0.f;
  float mrun = -INFINITY, lsum = 0.f;
  u32x4 kreg[NKC], vreg[2];
  auto tile_j = [&](int it) { return it < nct ? it * 64 : CTX + kp_start + 64 * (it - nct); };
  auto issue = [&](int it) {
    const int jr = tile_j(it);
#pragma unroll
    for (int i = 0; i < NKC; ++i) {
      const int c = tid + 256 * i, key = c / KCH, part = c % KCH;
      const u16* src = (part < 8) ? K1 + (size_t)(brow + jr + key) * ldk1 + koff + part * 8
                                  : KR + (size_t)(brow + jr + key) * 32 + (part - 8) * 8;
      kreg[i] = *(const u32x4*)src;
    }
#pragma unroll
    for (int i = 0; i < 2; ++i) {
      const int c = tid + 256 * i, d = c >> 3, part = c & 7;
      vreg[i] = *(const u32x4*)(Vb + (size_t)d * TPB + jr + part * 8);
    }
  };
  auto stash = [&](int buf) {
    char* kb = smem + buf * BUFSZ;
    char* vb = kb + 13312;
#pragma unroll
    for (int i = 0; i < NKC; ++i) {
      const int c = tid + 256 * i, key = c / KCH, part = c % KCH;
      *(u32x4*)(kb + key * KS + part * 16) = kreg[i];
    }
#pragma unroll
    for (int i = 0; i < 2; ++i) {
      const int c = tid + 256 * i, d = c >> 3, part = c & 7;
      *(u32x2*)(vb + d * 136 + part * 16) = u32x2{vreg[i].x, vreg[i].y};
      *(u32x2*)(vb + d * 136 + part * 16 + 8) = u32x2{vreg[i].z, vreg[i].w};
    }
  };
  __syncthreads();
  issue(0);
  stash(0);
  __syncthreads();
  const int qpos = jq0 - CTX + wave * 32 + r;
#pragma unroll 1
  for (int it = 0; it < ntiles; ++it) {
    const int buf = it & 1;
    const char* kb = smem + buf * BUFSZ;
    const char* vb = kb + 13312;
    if (it + 1 < ntiles) issue(it + 1);
    f32x16 s[2];
#pragma unroll
    for (int kt = 0; kt < 2; ++kt) {
#pragma unroll
      for (int i = 0; i < 16; ++i) s[kt][i] = 0.f;
#pragma unroll
      for (int ks = 0; ks < NKS; ++ks) {
        const bf16x8 kf = *(const bf16x8*)(kb + (kt * 32 + r) * KS + ks * 32 + h * 16);
        s[kt] = MFMA(kf, qf[ks], s[kt]);
      }
    }
    if (SWA && it >= nct) {
      const int kpos0 = kp_start + 64 * (it - nct);
#pragma unroll
      for (int kt = 0; kt < 2; ++kt)
#pragma unroll
        for (int i = 0; i < 16; ++i) {
          const int diff = qpos - (kpos0 + kt * 32 + crow(i, h));
          if (diff > 128 || diff < -128) s[kt][i] = -1e30f;
        }
    }
    float mx = s[0][0];
#pragma unroll
    for (int kt = 0; kt < 2; ++kt)
#pragma unroll
      for (int i = 0; i < 16; ++i) mx = fmaxf(mx, s[kt][i]);
    mx = fmaxf(mx, __shfl_xor(mx, 32));
    const float mnew = fmaxf(mrun, mx);
    const float alpha = __builtin_amdgcn_exp2f(mrun - mnew);
    float ps = 0.f;
#pragma unroll
    for (int kt = 0; kt < 2; ++kt)
#pragma unroll
      for (int i = 0; i < 16; ++i) { const float e = __builtin_amdgcn_exp2f(s[kt][i] - mnew); s[kt][i] = e; ps += e; }
    if (__builtin_amdgcn_ballot_w64(mnew != mrun) != 0ull) {
      lsum *= alpha;
#pragma unroll
      for (int dt = 0; dt < 2; ++dt)
#pragma unroll
        for (int i = 0; i < 16; ++i) o[dt][i] *= alpha;
    }
    lsum += ps;
    mrun = mnew;
#pragma unroll
    for (int kt = 0; kt < 2; ++kt)
#pragma unroll
      for (int s2 = 0; s2 < 2; ++s2) {
        unsigned pk[4];
#pragma unroll
        for (int j = 0; j < 4; ++j) pk[j] = pack2(s[kt][8 * s2 + 2 * j], s[kt][8 * s2 + 2 * j + 1]);
        const bf16x8 pf = __builtin_bit_cast(bf16x8, u32x4{pk[0], pk[1], pk[2], pk[3]});
#pragma unroll
        for (int dt = 0; dt < 2; ++dt) {
          const char* vp = vb + (dt * 32 + r) * 136 + (kt * 32 + 16 * s2 + 4 * h) * 2;
          const s16x4 lo = *(const s16x4*)vp;
          const s16x4 hi = *(const s16x4*)(vp + 16);
          const bf16x8 vf = __builtin_shufflevector(lo, hi, 0, 1, 2, 3, 4, 5, 6, 7);
          o[dt] = MFMA(vf, pf, o[dt]);
        }
      }
    if (it + 1 < ntiles) stash(buf ^ 1);
    __syncthreads();
  }
  float ltot = lsum + __shfl_xor(lsum, 32);
  if (SWA) ltot += __builtin_amdgcn_exp2f(p.swa_sink[l * 8 + hq] * LOG2E - mrun);
  const float inv = 1.f / ltot;
#pragma unroll
  for (int dt = 0; dt < 2; ++dt)
#pragma unroll
    for (int g = 0; g < 4; ++g) {
      u32x2 pk;
      pk.x = pack2(o[dt][4 * g] * inv, o[dt][4 * g + 1] * inv);
      pk.y = pack2(o[dt][4 * g + 2] * inv, o[dt][4 * g + 3] * inv);
      *(u32x2*)(outp + (size_t)qrow * ldo + ooff + dt * 32 + 8 * g + 4 * h) = pk;
    }
}

constexpr float HY_D0 = 3.0701134573253944f;
constexpr float HY_DSTEP = (15.350567286626972f - 3.0701134573253944f) / 511.f;

DI void filt_item(const Params& p, int l, int oc, char* smem) {
  float2* lds = (float2*)smem;
  float* lf = (float*)smem;
  const int tid = opq(threadIdx.x), lane = tid & 63, wave = tid >> 6;
  const int c = oc & 511;
  const float* hid = (const float*)(p.ws + OFF_HID + l * HID_LAYER);
  const float* w3 = p.hy_w3 + (size_t)l * 64 * 2048;
  float* sa = (float*)(p.ws + OFF_ESCR + (size_t)blockIdx.x * 65536);
  float* sb = sa + 8192;
  __syncthreads();
  if (tid < 128) { const int dir = tid >> 6, j = tid & 63; lf[tid] = w3[j * 2048 + dir * 1024 + oc]; }
  __syncthreads();
  const float delta = HY_D0 + (float)c * HY_DSTEP;
  float asum = 0.f;
#pragma unroll 1
  for (int ib = 0; ib < 4; ++ib) {
    float a[8], bm[8];
#pragma unroll
    for (int i = 0; i < 8; ++i) { a[i] = 0.f; bm[i] = 0.f; }
#pragma unroll 4
    for (int j = 0; j < 64; ++j) {
      const float w0 = lf[j], w1 = lf[64 + j];
      const float* hr = hid + (size_t)j * 8192 + 4 * (tid + 512 * ib);
#pragma unroll
      for (int ii = 0; ii < 2; ++ii) {
        const float4 hv = *(const float4*)(hr + 1024 * ii);
        a[4 * ii + 0] += hv.x * w0; bm[4 * ii + 0] += hv.x * w1;
        a[4 * ii + 1] += hv.y * w0; bm[4 * ii + 1] += hv.y * w1;
        a[4 * ii + 2] += hv.z * w0; bm[4 * ii + 2] += hv.z * w1;
        a[4 * ii + 3] += hv.w * w0; bm[4 * ii + 3] += hv.w * w1;
      }
    }
#pragma unroll
    for (int ii = 0; ii < 2; ++ii) {
      const int t0 = 4 * (tid + 256 * (2 * ib + ii));
      float av[4];
#pragma unroll
      for (int e = 0; e < 4; ++e) {
        const int t = t0 + e;
        const float dec = __expf(-((float)t * (1.f / 8191.f)) * delta);
        av[e] = a[4 * ii + e] * dec;
        const float bv = bm[4 * ii + e] * dec;
        if (t >= 1) { sb[8192 - t] = bv; asum += fabsf(bv); } else sb[0] = 0.f;
        asum += fabsf(av[e]);
      }
      *(float4*)(sa + t0) = make_float4(av[0], av[1], av[2], av[3]);
    }
  }
  asum = wave_sum(asum);
  asm volatile("s_waitcnt vmcnt(0)" ::: "memory");
  __syncthreads();
  if (lane == 0) lf[wave] = asum;
  __syncthreads();
  const float inv = 1.f / (lf[0] + lf[1] + lf[2] + lf[3]);
  __syncthreads();
#pragma unroll 2
  for (int i = 0; i < 8; ++i) {
    const int t0 = 4 * (tid + 256 * i);
#pragma unroll
    for (int e = 0; e < 4; ++e) lds[fphys(t0 + e)] = make_float2((ldsc1(sa + t0 + e) + ldsc1(sb + t0 + e)) * inv, 0.f);
  }
  __syncthreads();
  if (!DBG_NOFFT) fft8192_fwd(lds, tid);
  h2_t* sp = (h2_t*)(p.ws + OFF_SPEC) + (size_t)oc * 2 * 8192;
#pragma unroll 4
  for (int i = 0; i < 32; ++i) { const int k = tid + 256 * i; const float2 v = lds[k]; h2_t hv = {(_Float16)v.x, (_Float16)v.y}; sp[k] = hv; }
  __syncthreads();
#pragma unroll 2
  for (int i = 0; i < 8; ++i) {
    const int t0 = 4 * (tid + 256 * i);
#pragma unroll
    for (int e = 0; e < 4; ++e) {
      const int t = t0 + e;
      const float2 w = twid_rev((float)t * (1.f / 16384.f));
      const float d = (ldsc1(sa + t) - ldsc1(sb + t)) * inv;
      lds[fphys(t)] = make_float2(d * w.x, d * w.y);
    }
  }
  __syncthreads();
  if (!DBG_NOFFT) fft8192_fwd(lds, tid);
#pragma unroll 4
  for (int i = 0; i < 32; ++i) { const int k = tid + 256 * i; const float2 v = lds[k]; h2_t hv = {(_Float16)v.x, (_Float16)v.y}; sp[8192 + k] = hv; }
  __syncthreads();
}

DI float dwc(const u16* s, int t, int len, float w0, float w1, float w2, float bias) {
  const int tm = max(t - 1, 0), tp = min(t + 1, len - 1);
  const float a = bf2f(s[tm]), b = bf2f(s[t]), c = bf2f(s[tp]);
  return b * w1 + bias + (t > 0 ? a * w0 : 0.f) + (t < len - 1 ? c * w2 : 0.f);
}

DI void ld4(const u16* s, int t0, float (&o)[4]) {
  const u32x2 u = *(const u32x2*)(s + t0);
  o[0] = lo_bf(u.x); o[1] = hi_bf(u.x); o[2] = lo_bf(u.y); o[3] = hi_bf(u.y);
}
DI void dwc4(const u16* s, int t0, int len, float w0, float w1, float w2, float bias, float (&o)[4]) {
  float c[4];
  ld4(s, t0, c);
  float l = bf2f(s[max(t0 - 1, 0)]), r = bf2f(s[min(t0 + 4, len - 1)]);
  l = (t0 > 0) ? l : 0.f;
  r = (t0 + 4 < len) ? r : 0.f;
  o[0] = l * w0 + c[0] * w1 + c[1] * w2 + bias;
  o[1] = c[0] * w0 + c[1] * w1 + c[2] * w2 + bias;
  o[2] = c[1] * w0 + c[2] * w1 + c[3] * w2 + bias;
  o[3] = c[2] * w0 + c[3] * w1 + r * w2 + bias;
}

DI void hconv_item(const Params& p, int l, int o, int c, int bp, char* smem) {
  float2* lds = (float2*)smem;
  const int tid = opq(threadIdx.x);
  u16* hyt = (u16*)(p.ws + OFF_HYT);
  const int b0 = bp * 2, b1 = b0 + 1;
  u16* z0p = hyt + (size_t)(b0 * 1536 + c) * TPB + CTX;
  u16* z1p = hyt + (size_t)(b1 * 1536 + c) * TPB + CTX;
  const int gc = (o + 1) * 512 + c;
  const u16* g0p = hyt + (size_t)(b0 * 1536 + gc) * TPB + CTX;
  const u16* g1p = hyt + (size_t)(b1 * 1536 + gc) * TPB + CTX;
  const float* cw = p.hy_conv_w + (size_t)l * 3 * 1536;
  const float* cb = p.hy_conv_b + (size_t)l * 1536;
  const float zw0 = cw[c], zw1 = cw[1536 + c], zw2 = cw[3072 + c], zbias = cb[c];
  const float gw0 = cw[gc], gw1 = cw[1536 + gc], gw2 = cw[3072 + gc], gbias = cb[gc];
  const float skip = p.hy_skip[l * 1024 + o * 512 + c];
  const h2_t* spe = (const h2_t*)(p.ws + OFF_SPEC) + (size_t)(o * 512 + c) * 2 * 8192;
  const h2_t* spo = spe + 8192;
  float2* Eg = (float2*)(p.ws + OFF_ESCR + (size_t)blockIdx.x * 65536);
  __syncthreads();
#pragma unroll 2
  for (int i = 0; i < 8; ++i) {
    const int t0 = 4 * (tid + 256 * i);
    float za[4], zb[4];
    if (o == 0) { dwc4(z0p, t0, SEQ, zw0, zw1, zw2, zbias, za); dwc4(z1p, t0, SEQ, zw0, zw1, zw2, zbias, zb); }
    else { ld4(z0p, t0, za); ld4(z1p, t0, zb); }
#pragma unroll
    for (int e = 0; e < 4; ++e) lds[fphys(t0 + e)] = make_float2(za[e], zb[e]);
  }
  __syncthreads();
  fft8192_fwd(lds, tid);
#pragma unroll 8
  for (int i = 0; i < 32; ++i) { const int k = tid + 256 * i; const h2_t hv = spe[k]; lds[k] = cmul(lds[k], make_float2((float)hv[0], (float)hv[1])); }
  __syncthreads();
  fft8192_inv(lds, tid);
#pragma unroll 2
  for (int i = 0; i < 8; ++i) {
    const int t0 = 4 * (tid + 256 * i);
#pragma unroll
    for (int e = 0; e < 4; ++e) Eg[t0 + e] = lds[fphys(t0 + e)];
  }
  __syncthreads();
#pragma unroll 2
  for (int i = 0; i < 8; ++i) {
    const int t0 = 4 * (tid + 256 * i);
    float za[4], zb[4];
    if (o == 0) { dwc4(z0p, t0, SEQ, zw0, zw1, zw2, zbias, za); dwc4(z1p, t0, SEQ, zw0, zw1, zw2, zbias, zb); }
    else { ld4(z0p, t0, za); ld4(z1p, t0, zb); }
#pragma unroll
    for (int e = 0; e < 4; ++e) lds[fphys(t0 + e)] = cmul(make_float2(za[e], zb[e]), twid_rev((float)(t0 + e) * (1.f / 16384.f)));
  }
  __syncthreads();
  fft8192_fwd(lds, tid);
#pragma unroll 8
  for (int i = 0; i < 32; ++i) { const int k = tid + 256 * i; const h2_t hv = spo[k]; lds[k] = cmul(lds[k], make_float2((float)hv[0], (float)hv[1])); }
  __syncthreads();
  fft8192_inv(lds, tid);
#pragma unroll 2
  for (int i = 0; i < 8; ++i) {
    const int t0 = 4 * (tid + 256 * i);
    float za[4], zb[4], ga[4], gb[4];
    if (o == 0) { dwc4(z0p, t0, SEQ, zw0, zw1, zw2, zbias, za); dwc4(z1p, t0, SEQ, zw0, zw1, zw2, zbias, zb); }
    else { ld4(z0p, t0, za); ld4(z1p, t0, zb); }
    dwc4(g0p, t0, SEQ, gw0, gw1, gw2, gbias, ga);
    dwc4(g1p, t0, SEQ, gw0, gw1, gw2, gbias, gb);
#pragma unroll
    for (int e = 0; e < 4; ++e) {
      const int t = t0 + e;
      const float2 ov = cmulc(lds[fphys(t)], twid_rev((float)t * (1.f / 16384.f)));
      const float2 ev = Eg[t];
      const float y0 = (ev.x + ov.x) * (1.f / 16384.f), y1 = (ev.y + ov.y) * (1.f / 16384.f);
      Eg[t] = make_float2(ga[e] * (y0 + za[e] * skip), gb[e] * (y1 + zb[e] * skip));
    }
  }
  __syncthreads();
  u16* d0 = (o == 0) ? z0p : hyt + (size_t)(b0 * 1536 + 512 + c) * TPB + CTX;
  u16* d1 = (o == 0) ? z1p : hyt + (size_t)(b1 * 1536 + 512 + c) * TPB + CTX;
#pragma unroll 2
  for (int i = 0; i < 8; ++i) {
    const int t0 = 4 * (tid + 256 * i);
    float2 e4[4];
#pragma unroll
    for (int e = 0; e < 4; ++e) e4[e] = Eg[t0 + e];
    *(u32x2*)(d0 + t0) = u32x2{pack2(e4[0].x, e4[1].x), pack2(e4[2].x, e4[3].x)};
    *(u32x2*)(d1 + t0) = u32x2{pack2(e4[0].y, e4[1].y), pack2(e4[2].y, e4[3].y)};
  }
}

DI void hctx_item(const Params& p, int l, int c, char* smem) {
  float* lf = (float*)smem;
  float* kern = lf;
  float* zb = lf + 1024;
  float* z1b = lf + 2048;
  float* red = lf + 3072;
  const int tid = opq(threadIdx.x), lane = tid & 63, wave = tid >> 6;
  const float* hid = (const float*)(p.ws + OFF_HID + l * HID_LAYER) + 64 * 8192;
  const float* w3 = p.hy_w3 + (size_t)l * 64 * 2048;
  const u16* hyt = (const u16*)(p.ws + OFF_HYT);
  const float* cw = p.hy_conv_w + (size_t)l * 3 * 1536;
  const float* cb = p.hy_conv_b + (size_t)l * 1536;
  __syncthreads();
  {
    const int t = tid;
    float d[4] = {0.f, 0.f, 0.f, 0.f};
#pragma unroll 4
    for (int j = 0; j < 64; ++j) {
      const float hv = hid[j * 256 + t];
#pragma unroll
      for (int q = 0; q < 4; ++q) d[q] += hv * w3[j * 2048 + (q >> 1) * 1024 + (q & 1) * 512 + c];
    }
    const float dec = __expf(-((float)t * (1.f / 255.f)) * (HY_D0 + (float)c * HY_DSTEP));
#pragma unroll
    for (int o = 0; o < 2; ++o) {
      const float f0 = d[o] * dec, f1 = d[2 + o] * dec;
      kern[o * 512 + t] = f0;
      if (t >= 1) kern[o * 512 + 512 - t] = f1;
      if (t == 0) kern[o * 512 + 256] = 0.f;
      float s = fabsf(f0) + (t >= 1 ? fabsf(f1) : 0.f);
      s = wave_sum(s);
      if (lane == 0) red[o * 4 + wave] = s;
    }
  }
  const int b = tid >> 6, tq = tid & 63;
  const u16* zs = hyt + (size_t)(b * 1536 + c) * TPB;
  const u16* g1s = hyt + (size_t)(b * 1536 + 512 + c) * TPB;
  const u16* g2s = hyt + (size_t)(b * 1536 + 1024 + c) * TPB;
#pragma unroll
  for (int k = 0; k < 4; ++k) {
    const int tt = tq + 64 * k;
    zb[b * 256 + tt] = dwc(zs, tt, CTX, cw[c], cw[1536 + c], cw[3072 + c], cb[c]);
  }
  __syncthreads();
  const float inv0 = 1.f / (red[0] + red[1] + red[2] + red[3]);
  const float inv1 = 1.f / (red[4] + red[5] + red[6] + red[7]);
  const float sk0 = p.hy_skip[l * 1024 + c], sk1 = p.hy_skip[l * 1024 + 512 + c];
#pragma unroll 1
  for (int k = 0; k < 4; ++k) {
    const int tt = tq + 64 * k;
    float acc = 0.f;
#pragma unroll 8
    for (int s = 0; s < 256; ++s) acc += kern[(tt - s) & 511] * zb[b * 256 + s];
    const float g = dwc(g1s, tt, CTX, cw[512 + c], cw[1536 + 512 + c], cw[3072 + 512 + c], cb[512 + c]);
    z1b[b * 256 + tt] = g * (acc * inv0 + zb[b * 256 + tt] * sk0);
  }
  __syncthreads();
  u16* yc = (u16*)(p.ws + OFF_HYT) + (size_t)(b * 1536 + 512 + c) * TPB;
#pragma unroll 1
  for (int k = 0; k < 4; ++k) {
    const int tt = tq + 64 * k;
    float acc = 0.f;
#pragma unroll 8
    for (int s = 0; s < 256; ++s) acc += kern[512 + ((tt - s) & 511)] * z1b[b * 256 + s];
    const float g = dwc(g2s, tt, CTX, cw[1024 + c], cw[1536 + 1024 + c], cw[3072 + 1024 + c], cb[1024 + c]);
    yc[tt] = DBG_ZERO_HCTX ? (u16)0 : f2bf(g * (acc * inv1 + z1b[b * 256 + tt] * sk1));
  }
  __syncthreads();
}

#define XB_XCNT(j) (256 + 64 * (j))
#define XB_XSUB(j) (1280 + 64 * (j))
#define XB_XGEN(j) (2304 + 64 * (j))
#define XB_TOP 3328
#define XB_TOPGEN 3392
DI unsigned xb_ld(unsigned* p) { return __hip_atomic_load(p, __ATOMIC_RELAXED, __HIP_MEMORY_SCOPE_AGENT); }
DI unsigned xb_add(unsigned* p, unsigned v) { return __hip_atomic_fetch_add(p, v, __ATOMIC_RELAXED, __HIP_MEMORY_SCOPE_AGENT); }
struct XBar { unsigned* bar; unsigned x, nloc, nx; };
DI void gsync_impl(cg::grid_group& g, XBar& b) {
#if DBG_CG_SYNC
  g.sync();
#else
  asm volatile("s_waitcnt vmcnt(0)" ::: "memory");
  __syncthreads();
  if (threadIdx.x == 0) {
    unsigned* bar = b.bar;
    __builtin_amdgcn_s_waitcnt(0);
    if (b.nloc == 0u) {
      unsigned sum, cnt, mine;
      for (;;) {
        sum = 0u; cnt = 0u; mine = 0u;
#pragma unroll
        for (unsigned j = 0; j < 16; ++j) { const unsigned c = xb_ld(&bar[XB_XCNT(j)]); sum += c; cnt += (c > 0u) ? 1u : 0u; mine = (j == b.x) ? c : mine; }
        if (sum == gridDim.x) break;
        __builtin_amdgcn_s_sleep(1);
      }
      b.nloc = mine > 0u ? mine : 1u; b.nx = cnt > 0u ? cnt : 1u;
    }
    const unsigned old = xb_add(&bar[XB_XSUB(b.x)], 1u);
    const unsigned gen = old / b.nloc;
    if (old + 1u == (gen + 1u) * b.nloc) {
      __builtin_amdgcn_fence(__ATOMIC_RELEASE, "agent");
      asm volatile("s_waitcnt vmcnt(0)" ::: "memory");
      const unsigned og = xb_add(&bar[XB_TOP], 1u);
      const unsigned tg = og / b.nx;
      if (og + 1u == (tg + 1u) * b.nx) xb_add(&bar[XB_TOPGEN], 1u);
      else { while (xb_ld(&bar[XB_TOPGEN]) == tg) __builtin_amdgcn_s_sleep(1); }
      __builtin_amdgcn_fence(__ATOMIC_ACQUIRE, "agent");
      xb_add(&bar[XB_XGEN(b.x)], 1u);
      asm volatile("s_waitcnt vmcnt(0)" ::: "memory");
    } else {
      while (xb_ld(&bar[XB_XGEN(b.x)]) == gen) __builtin_amdgcn_s_sleep(1);
      __builtin_amdgcn_fence(__ATOMIC_ACQUIRE, "agent");
      asm volatile("s_waitcnt vmcnt(0)" ::: "memory");
    }
  }
  __syncthreads();
#endif
}

#define gsync(G, E) gsync_impl(G, E)
DI int tile_map(int L, int MT, int NT) {
  const int per = 8 * NT;
  const int P = L / per, u = L - P * per;
  const int h = min(8, MT - P * 8);
  const int nt = u / h, mt = P * 8 + (u - nt * h);
  return mt * NT + nt;
}
__global__ void __launch_bounds__(256, 2) fwd_mega(Params p) {
  cg::grid_group grid = cg::this_grid();
  __shared__ __attribute__((aligned(16))) char smem[65536];
  const int nb = gridDim.x, bid = blockIdx.x;
  const int pb = ((nb & 7) == 0) ? (bid & 7) * (nb >> 3) + (bid >> 3) : bid;
  float* xctx = (float*)(p.ws + OFF_XCTX);
  u16* RH = (u16*)(p.ws + OFF_RH);
  u16* HP = (u16*)(p.ws + OFF_HP);
  XBar epoch;
  epoch.bar = (unsigned*)(p.ws + OFF_BAR);
  epoch.x = (unsigned)__builtin_amdgcn_s_getreg((3 << 11) | 20) & 0xFu;
  epoch.nloc = 0u; epoch.nx = 0u;
  if (threadIdx.x == 0) (void)xb_add(&epoch.bar[XB_XCNT(epoch.x)], 1u);
  {
    constexpr int NC0 = 2336;
    const int total = NC0 + 192 + 1536 + 528;
    for (int it = bid; it < total; it += nb) {
      if (it < NC0) conv_tile(p, 0, it, smem);
      else if (it < NC0 + 192) mod_item(p, it - NC0, smem);
      else if (it < NC0 + 192 + 1536) rope_item(p, it - NC0 - 192);
      else hid_item(p, it - NC0 - 192 - 1536, smem);
    }
  }
  grid.sync();
  row_pass(p, 0, p.x, p.ctx, nullptr, nullptr, nullptr, nullptr, 0, 0, false, p.norm_g, 0, 0, 1024, RH, false);
  gsync(grid, epoch);
#pragma unroll 1
  for (int l = 0; l < 2; ++l) {
    const float* xl = (l == 0) ? p.x : p.out;
    const float* xc = (l == 0) ? p.ctx : xctx;
    for (int rep = 0; rep < DBG_REP_FFT; ++rep)
    for (int it = pb; it < 1024; it += nb) filt_item(p, l, it, smem);
    gsync(grid, epoch);
    for (int rep = 0; rep < DBG_REP_GEMM; ++rep)
    for (int it = pb; it < 4752; it += nb) inproj_tile(p, tile_map(it, 176, 27), smem);
    gsync(grid, epoch);
#if DBG_DUMP == 5
    { const _Float16* sp = (const _Float16*)(p.ws + OFF_SPEC);
      for (size_t i = (size_t)bid * 256 + threadIdx.x; i < (size_t)NBATCH * SEQ * DM; i += (size_t)nb * 256) p.out[i] = (float)sp[i];
      return; }
#endif
    for (int rep = 0; rep < DBG_REP_GEMM; ++rep)
    for (int it = pb; it < 1408; it += nb) kvup_tile(p, tile_map(it, 176, 8), smem);
    gsync(grid, epoch);
    {
      const int nF = 2048 + (l == 0 ? 64 : 0);
      for (int rep = 0; rep < DBG_REP_MLA; ++rep)
      for (int it = pb; it < nF; it += nb) {
        if (it < 2048) attn_item<96, false>(p, l, it >> 9, (it >> 6) & 7, CTX + (it & 63) * 128, 132, 0, 0, smem);
        else { const int i2 = it - 2048; attn_item<96, false>(p, l, i2 >> 4, (i2 >> 1) & 7, (i2 & 1) * 128, 4, 0, 0, smem); }
      }
    }
    gsync(grid, epoch);
    {
      const int nF2 = 1024 + (l == 0 ? 512 : 0);
      for (int it = pb; it < nF2; it += nb) {
        if (it < 1024) hconv_item(p, l, 0, it >> 1, it & 1, smem);
        else hctx_item(p, l, it - 1024, smem);
      }
    }
    gsync(grid, epoch);
    {
      const int nG = 2048 + (l == 0 ? 64 : 0);
      for (int it = pb; it < nG; it += nb) {
        if (it < 2048) {
          const int n = it & 63, jlo = (n == 0) ? 2 : 0, jhi = (n == 63) ? 4 : 6;
          attn_item<64, true>(p, l, it >> 9, (it >> 6) & 7, CTX + n * 128, 4, jhi - jlo, (n - 1) * 128 + 64 * jlo, smem);
        } else { const int i2 = it - 2048; attn_item<64, true>(p, l, i2 >> 4, (i2 >> 1) & 7, (i2 & 1) * 128, 4, 0, 0, smem); }
      }
    }
    gsync(grid, epoch);
    for (int rep = 0; rep < DBG_REP_FFT; ++rep)
    for (int it = pb; it < 1024; it += nb) hconv_item(p, l, 1, it >> 1, it & 1, smem);
    gsync(grid, epoch);
    for (int rep = 0; rep < DBG_REP_GEMM; ++rep)
    for (int it = pb; it < 1408; it += nb) merge_tile(p, tile_map(it, 176, 8), smem);
    if (l == 0 && pb >= 384 && nb > 384) for (int ct = 2336 + (pb - 384); ct < NCONV_TILES; ct += nb - 384) conv_tile(p, 0, ct, smem);
    gsync(grid, epoch);
    for (int rep = 0; rep < DBG_REP_GEMM * DBG_REP_PLAIN; ++rep)
    for (int it = pb; it < 1408; it += nb) plain_tile(p, tile_map(it, 176, 8), (const u16*)(p.ws + OFF_MERGED), 1024, 16, (const u16*)(p.ws + OFF_WT_OUT), (u16*)(p.ws + OFF_Y), smem);
    gsync(grid, epoch);
    row_pass(p, 1, xl, xc, p.out, xctx, (const u16*)(p.ws + OFF_Y), p.norm_g + (size_t)(l * 4 + 1) * 1024, 2048, l, true, p.norm_g + (size_t)(l * 4 + 2) * 1024, l, 3072, 4096, RH, false);
    gsync(grid, epoch);
    for (int rep = 0; rep < DBG_REP_GEMM; ++rep)
    for (int it = pb; it < 184 * 44; it += nb) ffnup_tile(p, l, tile_map(it, 184, 44), smem);
    gsync(grid, epoch);
    for (int rep = 0; rep < DBG_REP_GEMM * DBG_REP_PLAIN; ++rep)
    for (int it = pb; it < 1408; it += nb) plain_tile(p, tile_map(it, 176, 8), (const u16*)(p.ws + OFF_A), 2816, 44, (const u16*)(p.ws + OFF_WT_DOWN), HP, smem);
    if (l == 0 && pb >= 384 && nb > 384) for (int ct = pb - 384; ct < 1632; ct += nb - 384) conv_tile(p, 1, ct, smem);
    gsync(grid, epoch);
    row_pass(p, 1, p.out, xctx, p.out, xctx, HP, p.norm_g + (size_t)(l * 4 + 3) * 1024, 5120, l, l == 0, p.norm_g + (size_t)((l + 1) * 4) * 1024, l + 1, 0, 1024, RH, l == 1);
    if (l == 0) {
      for (int it = bid; it < NCONV_TILES - 1632; it += nb) conv_tile(p, 1, 1632 + it, smem);
      gsync(grid, epoch);
    }
  }
  for (int rep = 0; rep < DBG_EXTRA_SYNCS; ++rep) gsync(grid, epoch);
#if DBG_DUMP == 1
  gsync(grid, epoch);
  { const _Float16* sp = (const _Float16*)(p.ws + OFF_SPEC);
    for (size_t i = (size_t)bid * 256 + threadIdx.x; i < (size_t)NBATCH * SEQ * DM; i += (size_t)nb * 256) p.out[i] = (float)sp[i]; }
#elif DBG_DUMP == 3
  gsync(grid, epoch);
  { const float* hd = (const float*)(p.ws + OFF_HID);
    for (size_t i = (size_t)bid * 256 + threadIdx.x; i < (size_t)NBATCH * SEQ * DM; i += (size_t)nb * 256) p.out[i] = i < (size_t)2 * 64 * 8448 ? hd[i] : 0.f; }
#elif DBG_DUMP == 2
  gsync(grid, epoch);
  { const u16* yc = (const u16*)(p.ws + OFF_YCT);
    for (size_t i = (size_t)bid * 256 + threadIdx.x; i < (size_t)NBATCH * SEQ * DM; i += (size_t)nb * 256) p.out[i] = i < (size_t)4 * 512 * TPB ? bf2f(yc[i]) : 0.f; }
#endif
}

extern "C" void kernel_launch(void* const* d_in, const int* in_sizes, int n_in, void* d_out, int out_size, void* d_ws, size_t ws_size,
                              hipStream_t stream) {
  static int grid_blocks = 0;
  if (!grid_blocks) {
    int dev = 0, cus = 0, per_cu = 0;
    (void)hipGetDevice(&dev);
    (void)hipDeviceGetAttribute(&cus, hipDeviceAttributeMultiprocessorCount, dev);
    (void)hipOccupancyMaxActiveBlocksPerMultiprocessor(&per_cu, fwd_mega, 256, 0);
    if (per_cu > 2) per_cu = 2;
    if (per_cu < 1) per_cu = 1;
    grid_blocks = cus * per_cu;
  }
  if (ws_size < WS_NEED) { fprintf(stderr, "workspace too small: %zu < %zu\n", ws_size, (size_t)WS_NEED); return; }
  Params p{};
  const float** pp = (const float**)&p;
  for (int i = 0; i < 26; ++i) pp[i] = (const float*)d_in[i];
  p.out = (float*)d_out;
  p.ws = (char*)d_ws;
  (void)hipMemsetAsync((char*)d_ws + OFF_BAR, 0, BAR_BYTES, stream);
  void* args[] = {&p};
  hipError_t e = hipLaunchCooperativeKernel((void*)fwd_mega, dim3(grid_blocks), dim3(256), args, 0, stream);
  if (e != hipSuccess) fprintf(stderr, "cooperative launch failed: %s (grid %d)\n", hipGetErrorString(e), grid_blocks);
}
```

```cpp
#include <hip/hip_runtime.h>
#include <hip/hip_cooperative_groups.h>
#include <cstdio>
namespace cg = cooperative_groups;
#define DI __device__ __forceinline__
typedef unsigned short u16;
typedef __attribute__((ext_vector_type(8))) short bf16x8;
typedef __attribute__((ext_vector_type(4))) short s16x4;
typedef __attribute__((ext_vector_type(16))) float f32x16;
typedef __attribute__((ext_vector_type(4))) unsigned u32x4;
typedef __attribute__((ext_vector_type(2))) unsigned u32x2;
typedef __attribute__((ext_vector_type(2))) __bf16 bf2_t;
typedef __attribute__((ext_vector_type(2))) float f2_t;
typedef __attribute__((ext_vector_type(2))) _Float16 h2_t;
#define MFMA(a, b, c) __builtin_amdgcn_mfma_f32_32x32x16_bf16((a), (b), (c), 0, 0, 0)

constexpr int DM = 1024, NBATCH = 4, SEQ = 8192, CTX = 256, TPB = 8448, MTOK = 33792;
constexpr int DFF = 2816;
#ifndef DBG_ZERO_HCTX
#define DBG_ZERO_HCTX 0
#endif
#ifndef DBG_DUMP
#define DBG_DUMP 0
#endif
#ifndef DBG_NOFFT
#define DBG_NOFFT 0
#endif
#ifndef DBG_SPLITC
#define DBG_SPLITC 0
#endif
#ifndef DBG_REP_GEMM
#define DBG_REP_GEMM 1
#endif
#ifndef DBG_REP_MLA
#define DBG_REP_MLA 1
#endif
#ifndef DBG_HEAVY_SYNC
#define DBG_HEAVY_SYNC 0
#endif
#ifndef DBG_REP_FFT
#define DBG_REP_FFT 1
#endif
#ifndef DBG_REP_PLAIN
#define DBG_REP_PLAIN 1
#endif
#ifndef DBG_EXTRA_SYNCS
#define DBG_EXTRA_SYNCS 0
#endif
#ifndef DBG_CG_SYNC
#define DBG_CG_SYNC 0
#endif
#ifndef DBG_SKIP_BR
#define DBG_SKIP_BR 0
#endif
#define DBG_FIRST_BR ((DBG_SKIP_BR & 1) ? ((DBG_SKIP_BR & 2) ? 2 : 1) : 0)
constexpr float LOG2E = 1.4426950408889634f;
constexpr float EPS = 1e-6f;

struct Params {
  const float *x, *c, *ctx, *c_ctx, *w_mod, *b_mod, *norm_g, *w_in, *kv_norm_g, *w_kv_up, *swa_sink, *hy_conv_w, *hy_conv_b,
      *hy_w1, *hy_b1, *hy_w2, *hy_b2, *hy_freq, *hy_w3, *hy_skip, *w_branch, *w_out, *w_up, *ffn_conv_w, *ffn_conv_b, *w_down;
  float* out;
  char* ws;
};

constexpr size_t OFF_WT_IN = 0;
constexpr size_t OFF_WT_GATE = OFF_WT_IN + (size_t)3456 * 1024 * 2;
constexpr size_t OFF_WT_KV = OFF_WT_GATE + (size_t)3072 * 1024 * 2;
constexpr size_t OFF_WT_BR = OFF_WT_KV + (size_t)1024 * 256 * 2;
constexpr size_t OFF_WT_OUT = OFF_WT_BR + (size_t)3 * 1024 * 512 * 2;
constexpr size_t OFF_WT_UP = OFF_WT_OUT + (size_t)1024 * 1024 * 2;
constexpr size_t OFF_WT_DOWN = OFF_WT_UP + (size_t)5632 * 1024 * 2;
constexpr size_t OFF_RH = OFF_WT_DOWN + (size_t)1024 * 2816 * 2;
constexpr size_t OFF_KN = OFF_RH + (size_t)MTOK * 1024 * 2;
constexpr size_t OFF_VT = OFF_KN + (size_t)MTOK * 512 * 2;
constexpr size_t OFF_KR = OFF_VT + (size_t)MTOK * 512 * 2;
constexpr size_t OFF_Q = OFF_KR + (size_t)MTOK * 32 * 2;
constexpr size_t OFF_SQ = OFF_Q + (size_t)MTOK * 768 * 2;
constexpr size_t OFF_CKV = OFF_SQ + (size_t)MTOK * 512 * 2;
constexpr size_t OFF_SK = OFF_CKV + (size_t)MTOK * 256 * 2;
constexpr size_t OFF_SVT = OFF_SK + (size_t)MTOK * 128 * 2;
constexpr size_t OFF_HYT = OFF_SVT + (size_t)MTOK * 128 * 2;
constexpr size_t OFF_SPEC = OFF_HYT + (size_t)MTOK * 1536 * 2;
constexpr size_t OFF_XCTX = OFF_SPEC + (size_t)1024 * 2 * 8192 * 4;
constexpr size_t OFF_MOD = OFF_XCTX + (size_t)1024 * 1024 * 4;
constexpr size_t OFF_ROPE = OFF_MOD + (size_t)2 * 5 * 6144 * 4;
constexpr size_t OFF_HID = OFF_ROPE + (size_t)8192 * 96 * 4;
constexpr size_t HID_LAYER = (size_t)64 * (8192 + 256) * 4;
constexpr size_t OFF_ESCR = OFF_HID + 2 * HID_LAYER;
constexpr size_t OFF_BAR = OFF_ESCR + (size_t)512 * 65536;
constexpr size_t BAR_BYTES = 3456 * 4;
constexpr size_t WS_NEED = OFF_BAR + BAR_BYTES;
constexpr size_t OFF_A = OFF_Q;
constexpr size_t OFF_MERGED = OFF_KN;
constexpr size_t OFF_Y = OFF_HYT;
constexpr size_t OFF_HP = OFF_KN;
constexpr size_t OFF_YCT = OFF_RH;
constexpr size_t OFF_YA = OFF_RH + (size_t)MTOK * 512 * 2;
static_assert(OFF_A + (size_t)MTOK * 2816 * 2 <= OFF_SPEC, "A overlay");
static_assert(WS_NEED <= (size_t)512 * 1024 * 1024, "ws");

DI int opq(int x) { asm volatile("" : "+v"(x)); return x; }
DI float ldsc1(const float* p) { return __hip_atomic_load(p, __ATOMIC_RELAXED, __HIP_MEMORY_SCOPE_AGENT); }
DI float bf2f(u16 v) { return __uint_as_float(((unsigned)v) << 16); }
DI unsigned pack2(float a, float b) { f2_t v = {a, b}; return __builtin_bit_cast(unsigned, __builtin_convertvector(v, bf2_t)); }
DI u16 f2bf(float a) { return (u16)(pack2(a, 0.f) & 0xffffu); }
DI float lo_bf(unsigned u) { return __uint_as_float(u << 16); }
DI float hi_bf(unsigned u) { return __uint_as_float(u & 0xffff0000u); }
DI int crow(int i, int h) { return (i & 3) + 8 * (i >> 2) + 4 * h; }
DI float wave_sum(float v) {
#pragma unroll
  for (int o = 32; o > 0; o >>= 1) v += __shfl_xor(v, o);
  return v;
}
DI float sinrev(float r) { return __builtin_amdgcn_sinf(r - floorf(r)); }
DI float cosrev(float r) { return __builtin_amdgcn_cosf(r - floorf(r)); }
#if DBG_TRIVTW
#define COSREV(f) (1.0f)
#define SINREV(f) (0.0f * (f))
#else
#define COSREV(f) cosrev(f)
#define SINREV(f) sinrev(f)
#endif
#define SYNC() __syncthreads()
DI float2 cmul(float2 a, float2 b) { return make_float2(a.x * b.x - a.y * b.y, a.x * b.y + a.y * b.x); }
DI float2 cmulc(float2 a, float2 b) { return make_float2(a.x * b.x + a.y * b.y, a.y * b.x - a.x * b.y); }
#ifndef DBG_NOSWZ
#define DBG_NOSWZ 0
#endif
DI int fphys(int i) { return DBG_NOSWZ ? i : (i ^ ((i >> 4) & 15)); }
DI float2 twid_rev(float fr) { return make_float2(COSREV(fr), -SINREV(fr)); }

DI float2 root16(int e) {
  const float C1 = 0.92387953251128674f, S1 = 0.38268343236508977f, R = 0.70710678118654752f;
  switch (e) {
    case 0: return make_float2(1.f, 0.f);
    case 1: return make_float2(C1, -S1);
    case 2: return make_float2(R, -R);
    case 3: return make_float2(S1, -C1);
    case 4: return make_float2(0.f, -1.f);
    case 5: return make_float2(-S1, -C1);
    case 6: return make_float2(-R, -R);
    default: return make_float2(-C1, -S1);
  }
}
template <int R, int HALF, int S, bool INV, bool HASW>
DI void fft_stage(float2 (&v)[R], const float2 (&wp)[4]) {
#pragma unroll
  for (int idx = 0; idx < R / 2; ++idx) {
    const int blk = idx / HALF, jj = idx % HALF;
    const int j0 = blk * 2 * HALF + jj, j1 = j0 + HALF;
    const int e = jj * (8 / HALF);
    float2 tw = root16(e);
    if (HASW) { if (e == 0) tw = wp[S]; else tw = cmul(wp[S], tw); }
    const bool triv = (!HASW) && (e == 0);
    if (!INV) {
      float2 a = v[j0], b = v[j1];
      v[j0] = make_float2(a.x + b.x, a.y + b.y);
      float2 d = make_float2(a.x - b.x, a.y - b.y);
      v[j1] = triv ? d : cmul(d, tw);
    } else {
      float2 t = triv ? v[j1] : cmulc(v[j1], tw);
      float2 a = v[j0];
      v[j0] = make_float2(a.x + t.x, a.y + t.y);
      v[j1] = make_float2(a.x - t.x, a.y - t.y);
    }
  }
}
template <bool INV> DI void fft_local8(float2 (&v)[8], const float2 (&wp)[4]) {
  if (!INV) { fft_stage<8, 4, 0, false, true>(v, wp); fft_stage<8, 2, 1, false, true>(v, wp); fft_stage<8, 1, 2, false, true>(v, wp); }
  else      { fft_stage<8, 1, 2, true, true>(v, wp); fft_stage<8, 2, 1, true, true>(v, wp); fft_stage<8, 4, 0, true, true>(v, wp); }
}
template <bool INV> DI void fft_local16(float2 (&v)[16], const float2 (&wp)[4]) {
  if (!INV) { fft_stage<16, 8, 0, false, false>(v, wp); fft_stage<16, 4, 1, false, false>(v, wp); fft_stage<16, 2, 2, false, false>(v, wp); fft_stage<16, 1, 3, false, false>(v, wp); }
  else      { fft_stage<16, 1, 3, true, false>(v, wp); fft_stage<16, 2, 2, true, false>(v, wp); fft_stage<16, 4, 1, true, false>(v, wp); fft_stage<16, 8, 0, true, false>(v, wp); }
}

template <int LQ, bool INV> DI void fft_pass8(float2* lds, int tid) {
  constexpr int q = 1 << LQ;
#pragma unroll 1
  for (int it = 0; it < 4; ++it) {
    const int task = tid + 256 * it;
    const int p = task & (q - 1);
    const int g = task >> LQ;
    const int base = g * 8 * q + p;
    float2 v[8];
#pragma unroll
    for (int j = 0; j < 8; ++j) v[j] = lds[fphys(base + j * q)];
    float2 wp[4];
    wp[0] = twid_rev((float)p * (1.0f / (float)(8 * q)));
    wp[1] = cmul(wp[0], wp[0]);
    wp[2] = cmul(wp[1], wp[1]);
    wp[3] = wp[2];
    fft_local8<INV>(v, wp);
#pragma unroll
    for (int j = 0; j < 8; ++j) lds[fphys(base + j * q)] = v[j];
  }
}
template <bool INV> DI void fft_pass16(float2* lds, int tid) {
#pragma unroll 1
  for (int it = 0; it < 2; ++it) {
    const int g = tid + 256 * it;
    float2 v[16];
    const int sw = DBG_NOSWZ ? 0 : (g & 15);
#pragma unroll
    for (int j = 0; j < 16; ++j) v[j] = lds[g * 16 + (j ^ sw)];
    float2 wp[4] = {make_float2(1.f, 0.f), make_float2(1.f, 0.f), make_float2(1.f, 0.f), make_float2(1.f, 0.f)};
    fft_local16<INV>(v, wp);
#pragma unroll
    for (int j = 0; j < 16; ++j) lds[g * 16 + (j ^ sw)] = v[j];
  }
}
#ifndef DBG_FFTPASSES
#define DBG_FFTPASSES 15
#endif
DI void fft8192_fwd(float2* lds, int tid) {
  if (DBG_FFTPASSES & 1) { fft_pass8<10, false>(lds, tid); SYNC(); }
  if (DBG_FFTPASSES & 2) { fft_pass8<7, false>(lds, tid); SYNC(); }
  if (DBG_FFTPASSES & 4) { fft_pass8<4, false>(lds, tid); SYNC(); }
  if (DBG_FFTPASSES & 8) { fft_pass16<false>(lds, tid); SYNC(); }
}
DI void fft8192_inv(float2* lds, int tid) {
  fft_pass16<true>(lds, tid); SYNC();
  fft_pass8<4, true>(lds, tid); SYNC();
  fft_pass8<7, true>(lds, tid); SYNC();
  fft_pass8<10, true>(lds, tid); SYNC();
}

template <bool SWAP, bool ATR = false, int MTW = 2>
DI void gemm_main(const u16* __restrict__ A, int lda, int a_row0, int a_lo, int a_hi, int a_kstep,
                  const u16* __restrict__ B, int ldb, int nk, f32x16 (&acc)[MTW][2], char* smem) {
  constexpr int ROWS = MTW * 64, NA = MTW * 2;
  const int tid = opq(threadIdx.x), lane = tid & 63, wave = tid >> 6, wm = wave >> 1, wn = wave & 1, r = lane & 31, h = lane >> 5;
  char* sA = smem;
  char* sB = smem + ROWS * 144;
  const u16* ap[NA];
  const u16* bp[4];
  int loa[NA], lob[4];
#pragma unroll
  for (int i = 0; i < NA; ++i) {
    const int idx = tid + 256 * i, row = idx >> 3, ch = idx & 7;
    if (ATR) {
      ap[i] = A + (size_t)(idx & 63) * lda + a_row0 + (idx >> 6) * 8;
    } else {
      const int gr = min(max(a_row0 + row, a_lo), a_hi);
      ap[i] = A + (size_t)gr * lda + ch * 8;
    }
    loa[i] = row * 144 + ch * 16;
  }
#pragma unroll
  for (int i = 0; i < 4; ++i) {
    const int idx = tid + 256 * i, row = idx >> 3, ch = idx & 7;
    bp[i] = B + (size_t)row * ldb + ch * 8;
    lob[i] = row * 144 + ch * 16;
  }
  u32x4 ra0[NA], rb0[4];
#define GEMM_LOAD(RA, RB, KT)                                                                                         \
  _Pragma("unroll") for (int i = 0; i < NA; ++i)                                                                      \
    RA[i] = *(const u32x4*)(ap[i] + (ATR ? (size_t)(KT) * 64 * lda : (size_t)(KT) * a_kstep));                        \
  _Pragma("unroll") for (int i = 0; i < 4; ++i) RB[i] = *(const u32x4*)(bp[i] + (KT) * 64);
#define GEMM_STASH(RA, RB)                                                                                            \
  _Pragma("unroll") for (int i = 0; i < NA; ++i) {                                                                    \
    if (ATR) {                                                                                                        \
      const int idx = tid + 256 * i, krow = idx & 63, mch = idx >> 6;                                                 \
      _Pragma("unroll") for (int e = 0; e < 4; ++e) {                                                                 \
        *(u16*)(sA + (mch * 8 + 2 * e) * 144 + krow * 2) = (u16)(RA[i][e] & 0xffffu);                                 \
        *(u16*)(sA + (mch * 8 + 2 * e + 1) * 144 + krow * 2) = (u16)(RA[i][e] >> 16);                                 \
      }                                                                                                               \
    } else {                                                                                                          \
      *(u32x4*)(sA + loa[i]) = RA[i];                                                                                 \
    }                                                                                                                 \
  }                                                                                                                   \
  _Pragma("unroll") for (int i = 0; i < 4; ++i) *(u32x4*)(sB + lob[i]) = RB[i];
#define GEMM_COMPUTE()                                                                                                \
  _Pragma("unroll") for (int ks = 0; ks < 4; ++ks) {                                                                  \
    bf16x8 af[MTW], bfr[2];                                                                                           \
    _Pragma("unroll") for (int t = 0; t < MTW; ++t) af[t] = *(const bf16x8*)(pa + t * 32 * 144 + ks * 32);            \
    _Pragma("unroll") for (int t = 0; t < 2; ++t) bfr[t] = *(const bf16x8*)(pb + t * 32 * 144 + ks * 32);             \
    _Pragma("unroll") for (int mt = 0; mt < MTW; ++mt)                                                                \
      _Pragma("unroll") for (int nt = 0; nt < 2; ++nt)                                                                \
        acc[mt][nt] = SWAP ? MFMA(bfr[nt], af[mt], acc[mt][nt]) : MFMA(af[mt], bfr[nt], acc[mt][nt]);                 \
  }
  GEMM_LOAD(ra0, rb0, 0)
#pragma unroll
  for (int mt = 0; mt < MTW; ++mt)
#pragma unroll
    for (int nt = 0; nt < 2; ++nt)
#pragma unroll
      for (int i = 0; i < 16; ++i) acc[mt][nt][i] = 0.f;
  const char* pa = sA + (wm * (MTW * 32) + r) * 144 + h * 16;
  const char* pb = sB + (wn * 64 + r) * 144 + h * 16;
#pragma unroll 1
  for (int kk = 0; kk < nk; ++kk) {
    __syncthreads();
    GEMM_STASH(ra0, rb0)
    __syncthreads();
    if (kk + 1 < nk) { GEMM_LOAD(ra0, rb0, kk + 1) }
    GEMM_COMPUTE()
  }
#undef GEMM_LOAD
#undef GEMM_STASH
#undef GEMM_COMPUTE
}
template <int MTW>
DI void store_rowmajor(const f32x16 (&acc)[MTW][2], u16* C, int ldc, int m0, int ncol0, float scale) {
  const int tid = opq(threadIdx.x), lane = tid & 63, wave = tid >> 6, wm = wave >> 1, wn = wave & 1, r = lane & 31, h = lane >> 5;
#pragma unroll
  for (int mt = 0; mt < MTW; ++mt)
#pragma unroll
    for (int nt = 0; nt < 2; ++nt)
#pragma unroll
      for (int g = 0; g < 4; ++g) {
        const int m = m0 + wm * (MTW * 32) + mt * 32 + r, n = ncol0 + wn * 64 + nt * 32 + 8 * g + 4 * h;
        u32x2 pk;
        pk.x = pack2(acc[mt][nt][4 * g] * scale, acc[mt][nt][4 * g + 1] * scale);
        pk.y = pack2(acc[mt][nt][4 * g + 2] * scale, acc[mt][nt][4 * g + 3] * scale);
        *(u32x2*)(C + (size_t)m * ldc + n) = pk;
      }
}
template <int MTW>
DI void store_transposed(const f32x16 (&acc)[MTW][2], u16* T, int ldt, int trow0, int j0) {
  const int tid = opq(threadIdx.x), lane = tid & 63, wave = tid >> 6, wm = wave >> 1, wn = wave & 1, r = lane & 31, h = lane >> 5;
#pragma unroll
  for (int mt = 0; mt < MTW; ++mt)
#pragma unroll
    for (int nt = 0; nt < 2; ++nt)
#pragma unroll
      for (int g = 0; g < 4; ++g) {
        const int n = trow0 + wn * 64 + nt * 32 + r, m = j0 + wm * (MTW * 32) + mt * 32 + 8 * g + 4 * h;
        u32x2 pk;
        pk.x = pack2(acc[mt][nt][4 * g], acc[mt][nt][4 * g + 1]);
        pk.y = pack2(acc[mt][nt][4 * g + 2], acc[mt][nt][4 * g + 3]);
        *(u32x2*)(T + (size_t)n * ldt + m) = pk;
      }
}

constexpr int NCONV_TILES = 864 + 768 + 64 + 384 + 256 + 1408 + 704;
DI void conv_tile(const Params& p, int l, int tile, char* smem) {
  float* t = (float*)smem;
  const int tid = opq(threadIdx.x);
  int mat, tn, tk;
  if (tile < 864) { mat = 0; tn = tile / 16; tk = tile % 16; }
  else if (tile < 1632) { tile -= 864; mat = 1; tn = tile / 16; tk = tile % 16; }
  else if (tile < 1696) { tile -= 1632; mat = 2; tn = tile / 4; tk = tile % 4; }
  else if (tile < 2080) { tile -= 1696; mat = 3; tn = tile / 8; tk = tile % 8; }
  else if (tile < 2336) { tile -= 2080; mat = 4; tn = tile / 16; tk = tile % 16; }
  else if (tile < 3744) { tile -= 2336; mat = 5; tn = tile / 16; tk = tile % 16; }
  else { tile -= 3744; mat = 6; tn = tile / 44; tk = tile % 44; }
  const int k0 = tk * 64;
  const int nn = tid & 63;
  int np = tn * 64 + nn;
  const float* src; int ld; int col;
  if (mat == 0) { src = p.w_in + (size_t)l * 1024 * 6432; ld = 6432; col = np < 1024 ? np : (np < 3328 ? np + 32 : (np < 3360 ? np - 3328 + 1024 : -1)); }
  else if (mat == 1) { src = p.w_in + (size_t)l * 1024 * 6432; ld = 6432; col = 3360 + np; }
  else if (mat == 2) { src = p.w_kv_up + (size_t)l * 256 * 1024; ld = 1024; col = np < 512 ? (np >> 6) * 128 + (np & 63) : ((np - 512) >> 6) * 128 + 64 + (np & 63); }
  else if (mat == 3) { const int br = tn / 16; np = (tn % 16) * 64 + nn; src = p.w_branch + (size_t)(l * 3 + br) * 512 * 1024; ld = 1024; col = np; }
  else if (mat == 4) { src = p.w_out + (size_t)l * 1024 * 1024; ld = 1024; col = np; }
  else if (mat == 5) { src = p.w_up + (size_t)l * 1024 * 5632; ld = 5632; const int blk = np >> 7, rr = np & 127; col = rr < 64 ? blk * 64 + rr : 2816 + blk * 64 + rr - 64; }
  else { src = p.w_down + (size_t)l * 2816 * 1024; ld = 1024; col = np; }
#pragma unroll 4
  for (int i = 0; i < 16; ++i) {
    const int kk = (tid >> 6) + 4 * i;
    float v = 0.f;
    if (col >= 0) v = src[(size_t)(k0 + kk) * ld + col];
    if (mat == 2) v *= p.kv_norm_g[l * 256 + k0 + kk];
    t[kk * 65 + nn] = v;
  }
  __syncthreads();
  {
    const int n2 = tid >> 2, kq = (tid & 3) * 16;
    const int drow = tn * 64 + n2;
    u16* dst;
    if (mat == 0) dst = (u16*)(p.ws + OFF_WT_IN) + (size_t)drow * 1024;
    else if (mat == 1) dst = (u16*)(p.ws + OFF_WT_GATE) + (size_t)drow * 1024;
    else if (mat == 2) dst = (u16*)(p.ws + OFF_WT_KV) + (size_t)drow * 256;
    else if (mat == 3) dst = (u16*)(p.ws + OFF_WT_BR) + (size_t)drow * 512;
    else if (mat == 4) dst = (u16*)(p.ws + OFF_WT_OUT) + (size_t)drow * 1024;
    else if (mat == 5) dst = (u16*)(p.ws + OFF_WT_UP) + (size_t)drow * 1024;
    else dst = (u16*)(p.ws + OFF_WT_DOWN) + (size_t)drow * 2816;
    unsigned pk[8];
#pragma unroll
    for (int j = 0; j < 8; ++j) pk[j] = pack2(t[(kq + 2 * j) * 65 + n2], t[(kq + 2 * j + 1) * 65 + n2]);
    u32x4* d4 = (u32x4*)(dst + k0 + kq);
    d4[0] = u32x4{pk[0], pk[1], pk[2], pk[3]};
    d4[1] = u32x4{pk[4], pk[5], pk[6], pk[7]};
  }
  __syncthreads();
}

DI void mod_item(const Params& p, int item, char* smem) {
  float* sv = (float*)smem;
  float* red = sv + 5 * 1024;
  const int tid = opq(threadIdx.x);
  const int l = item / 96, cg0 = (item % 96) * 64;
  for (int i = tid; i < 5 * 1024; i += 256) {
    const int v = i >> 10, k = i & 1023;
    const float c = v < 4 ? p.c[v * 1024 + k] : p.c_ctx[k];
    sv[i] = c / (1.f + __expf(-c));
  }
  __syncthreads();
  const int kq = tid >> 6, cc = tid & 63, col = cg0 + cc;
  float a[5] = {0.f, 0.f, 0.f, 0.f, 0.f};
  const float* w = p.w_mod + (size_t)l * 1024 * 6144 + col;
#pragma unroll 8
  for (int k = kq * 256; k < kq * 256 + 256; ++k) {
    const float wv = w[(size_t)k * 6144];
#pragma unroll
    for (int v = 0; v < 5; ++v) a[v] += sv[v * 1024 + k] * wv;
  }
#pragma unroll
  for (int v = 0; v < 5; ++v) red[(kq * 5 + v) * 64 + cc] = a[v];
  __syncthreads();
  for (int i = tid; i < 5 * 64; i += 256) {
    const int v = i >> 6, c2 = i & 63;
    float s = p.b_mod[l * 6144 + cg0 + c2];
#pragma unroll
    for (int q = 0; q < 4; ++q) s += red[(q * 5 + v) * 64 + c2];
    ((float*)(p.ws + OFF_MOD))[(l * 5 + v) * 6144 + cg0 + c2] = s;
  }
  __syncthreads();
}

DI void rope_item(const Params& p, int item) {
  const int e = item * 256 + opq(threadIdx.x);
  const int pos = e / 48, f = e % 48;
  const int row = pos >> 6, colp = pos & 63;
  float* base = (float*)(p.ws + OFF_ROPE);
  float ang; float *cd, *sd;
  if (f < 16) {
    const int fi = f & 7;
    const float inv = exp2f(-(float)fi * (13.287712379549449f / 8.f));
    ang = (f < 8 ? (float)row : (float)colp) * inv;
    cd = base + pos * 16 + f; sd = base + 8192 * 16 + pos * 16 + f;
  } else {
    const int f2 = f - 16, fi = f2 & 15;
    const float inv = exp2f(-(float)fi * (13.287712379549449f / 16.f));
    ang = (f2 < 16 ? (float)row : (float)colp) * inv;
    cd = base + 2 * 8192 * 16 + pos * 32 + f2; sd = base + 2 * 8192 * 16 + 8192 * 32 + pos * 32 + f2;
  }
  const float rev = ang * 0.15915494309189535f;
  *cd = cosrev(rev);
  *sd = sinrev(rev);
}

DI void hid_item(const Params& p, int item, char* smem) {
  float* feat = (float*)smem;
  float* h1 = feat + 4 * 36;
  const int tid = opq(threadIdx.x);
  const int l = item / 264; const int it = item % 264;
  int L, pos00; float* dst;
  if (it < 256) { L = 8192; pos00 = it * 32; dst = (float*)(p.ws + OFF_HID + l * HID_LAYER); }
  else { L = 256; pos00 = (it - 256) * 32; dst = (float*)(p.ws + OFF_HID + l * HID_LAYER) + 64 * 8192; }
  const int pp = tid >> 6, j = tid & 63;
#pragma unroll 1
  for (int sub = 0; sub < 8; ++sub) {
    const int pos = pos00 + sub * 4 + pp;
    if (j < 33) {
      float fv;
      if (j == 0) fv = (float)pos / (float)(L - 1);
      else {
        const int bi = (j - 1) & 15;
        const float band = 1e-4f + (float)bi * ((15.f - 1e-4f) / 15.f);
        const float rev = (float)pos * band / (float)L;
        fv = (j <= 16) ? cosrev(rev) : -sinrev(rev);
      }
      feat[pp * 36 + j] = fv;
    }
    __syncthreads();
    {
      float s = p.hy_b1[l * 64 + j];
      const float* w1 = p.hy_w1 + (size_t)l * 33 * 64;
#pragma unroll
      for (int f = 0; f < 33; ++f) s += feat[pp * 36 + f] * w1[f * 64 + j];
      s *= p.hy_freq[l * 128 + j];
      h1[pp * 64 + j] = sinrev(s * 0.15915494309189535f);
    }
    __syncthreads();
    {
      float s = p.hy_b2[l * 64 + j];
      const float* w2 = p.hy_w2 + (size_t)l * 64 * 64;
#pragma unroll 8
      for (int i = 0; i < 64; ++i) s += h1[pp * 64 + i] * w2[i * 64 + j];
      s *= p.hy_freq[l * 128 + 64 + j];
      dst[(size_t)j * L + pos] = sinrev(s * 0.15915494309189535f);
    }
    __syncthreads();
  }
}

DI const float* xrow_src(const float* xl, const float* xc, int m) {
  const int b = m / TPB, j = m - b * TPB;
  return j < CTX ? xc + (size_t)(b * CTX + j) * DM : xl + (size_t)(b * SEQ + j - CTX) * DM;
}
DI void row_pass(const Params& p, int mode, const float* xl_src, const float* xc_src, float* xl_dst, float* xc_dst,
                 const u16* ybuf, const float* gy, int gate_off, int modl_gate,
                 bool has_next, const float* gn, int modl_next, int sh_off, int sc_off, u16* hdst, bool skip_ctx_rows) {
  const int tid0 = opq(threadIdx.x);
  const int lane = tid0 & 63;
  const int gw = blockIdx.x * 4 + (tid0 >> 6), nw = gridDim.x * 4;
  const float* modb = (const float*)(p.ws + OFF_MOD);
  const int per = (MTOK + nw - 1) / nw;
  const int m_beg = gw * per, m_end = min(m_beg + per, MTOK);
  int cur_v = -1;
  float4 gg[4], gs[4], shv[4];
#pragma unroll
  for (int i = 0; i < 4; ++i) { gg[i] = make_float4(0.f, 0.f, 0.f, 0.f); gs[i] = gg[i]; shv[i] = gg[i]; }
  const bool do_h = (mode == 0) || has_next;
  float4 xv_n[4];
  u32x2 yr_n[4];
#pragma unroll
  for (int i = 0; i < 4; ++i) { xv_n[i] = make_float4(0.f, 0.f, 0.f, 0.f); yr_n[i] = u32x2{0u, 0u}; }
  if (m_beg < m_end) {
    const float* xs0 = xrow_src(xl_src, xc_src, m_beg);
#pragma unroll
    for (int i = 0; i < 4; ++i) {
      xv_n[i] = *(const float4*)(xs0 + lane * 4 + 256 * i);
      if (mode == 1) yr_n[i] = *(const u32x2*)(ybuf + (size_t)m_beg * DM + lane * 4 + 256 * i);
    }
  }
  for (int m = m_beg; m < m_end; ++m) {
    const int b = m / TPB, j = m - b * TPB;
    float4 xv[4];
    u32x2 yr[4];
#pragma unroll
    for (int i = 0; i < 4; ++i) { xv[i] = xv_n[i]; yr[i] = yr_n[i]; }
    if (m + 1 < m_end) {
      const float* xs1 = xrow_src(xl_src, xc_src, m + 1);
#pragma unroll
      for (int i = 0; i < 4; ++i) {
        xv_n[i] = *(const float4*)(xs1 + lane * 4 + 256 * i);
        if (mode == 1) yr_n[i] = *(const u32x2*)(ybuf + (size_t)(m + 1) * DM + lane * 4 + 256 * i);
      }
    }
    if (skip_ctx_rows && j < CTX) continue;
    const int v = j < CTX ? 4 : b;
    if (v != cur_v) {
      cur_v = v;
#pragma unroll
      for (int i = 0; i < 4; ++i) {
        const int c = lane * 4 + 256 * i;
        if (mode == 1) {
          const float4 g4 = *(const float4*)(gy + c);
          const float4 t4 = *(const float4*)(modb + (size_t)(modl_gate * 5 + v) * 6144 + gate_off + c);
          gg[i] = make_float4(g4.x * t4.x, g4.y * t4.y, g4.z * t4.z, g4.w * t4.w);
        }
        if (do_h) {
          const float* mb = modb + (size_t)(modl_next * 5 + v) * 6144;
          const float4 g4 = *(const float4*)(gn + c);
          const float4 sc = *(const float4*)(mb + sc_off + c);
          shv[i] = *(const float4*)(mb + sh_off + c);
          gs[i] = make_float4(g4.x * (1.f + sc.x), g4.y * (1.f + sc.y), g4.z * (1.f + sc.z), g4.w * (1.f + sc.w));
        }
      }
    }
    if (mode == 1) {
      float yv[4][4];
      float ss = 0.f;
#pragma unroll
      for (int i = 0; i < 4; ++i) {
        const u32x2 u = yr[i];
        yv[i][0] = lo_bf(u.x); yv[i][1] = hi_bf(u.x); yv[i][2] = lo_bf(u.y); yv[i][3] = hi_bf(u.y);
#pragma unroll
        for (int e = 0; e < 4; ++e) ss += yv[i][e] * yv[i][e];
      }
      ss = wave_sum(ss);
      const float rstd = rsqrtf(ss * (1.f / DM) + EPS);
#pragma unroll
      for (int i = 0; i < 4; ++i) {
        xv[i].x += gg[i].x * (yv[i][0] * rstd);
        xv[i].y += gg[i].y * (yv[i][1] * rstd);
        xv[i].z += gg[i].z * (yv[i][2] * rstd);
        xv[i].w += gg[i].w * (yv[i][3] * rstd);
      }
      float* xd = (j < CTX) ? xc_dst + (size_t)(b * CTX + j) * DM : xl_dst + (size_t)(b * SEQ + j - CTX) * DM;
#pragma unroll
      for (int i = 0; i < 4; ++i) *(float4*)(xd + lane * 4 + 256 * i) = xv[i];
    }
    if (do_h) {
      float ss = 0.f;
#pragma unroll
      for (int i = 0; i < 4; ++i) ss += xv[i].x * xv[i].x + xv[i].y * xv[i].y + xv[i].z * xv[i].z + xv[i].w * xv[i].w;
      ss = wave_sum(ss);
      const float rstd = rsqrtf(ss * (1.f / DM) + EPS);
#pragma unroll
      for (int i = 0; i < 4; ++i) {
        const int c = lane * 4 + 256 * i;
        u32x2 pk;
        pk.x = pack2(xv[i].x * rstd * gs[i].x + shv[i].x, xv[i].y * rstd * gs[i].y + shv[i].y);
        pk.y = pack2(xv[i].z * rstd * gs[i].z + shv[i].z, xv[i].w * rstd * gs[i].w + shv[i].w);
        *(u32x2*)(hdst + (size_t)m * DM + c) = pk;
      }
    }
  }
}

constexpr float QS_MLA = 0.10206207261596577f * LOG2E;
constexpr float QS_SWA = 0.125f * LOG2E;

DI void rope32(f32x16& a, const float* cm, const float* sm, int pos, int h) {
#pragma unroll
  for (int i = 0; i < 8; ++i) {
    const int f = crow(i, h);
    const float c = cm[pos * 16 + f], s = sm[pos * 16 + f];
    const float x1 = a[i], x2 = a[i + 8];
    a[i] = x1 * c - x2 * s;
    a[i + 8] = x2 * c + x1 * s;
    if ((i & 3) == 3) __builtin_amdgcn_sched_barrier(0);
  }
}
DI void rope64(f32x16& a0, f32x16& a1, const float* cs, const float* ss, int pos, int h) {
#pragma unroll
  for (int i = 0; i < 16; ++i) {
    const int f = crow(i, h);
    const float c = cs[pos * 32 + f], s = ss[pos * 32 + f];
    const float x1 = a0[i], x2 = a1[i];
    a0[i] = x1 * c - x2 * s;
    a1[i] = x2 * c + x1 * s;
    if ((i & 3) == 3) __builtin_amdgcn_sched_barrier(0);
  }
}

DI void inproj_tile(const Params& p, int tile, char* smem) {
  const int mt_i = tile / 27, nt_i = tile % 27;
  const int m0 = mt_i * 192;
  const int tid = opq(threadIdx.x), lane = tid & 63, wave = tid >> 6, wm = wave >> 1, wn = wave & 1, r = lane & 31, h = lane >> 5;
  const u16* hbuf = (const u16*)(p.ws + OFF_RH);
  const u16* wt = (const u16*)(p.ws + OFF_WT_IN) + (size_t)nt_i * 128 * 1024;
  const int b = m0 / TPB, j0 = m0 - b * TPB;
  const float* cm = (const float*)(p.ws + OFF_ROPE);
  const float* sm = cm + 8192 * 16;
  const float* cs = sm + 8192 * 16;
  const float* ss = cs + 8192 * 32;
  f32x16 acc[3][2];
  if (nt_i >= 13 && nt_i <= 25) {
    gemm_main<false>(hbuf, 1024, m0, 0, MTOK - 1, 64, wt, 1024, 16, acc, smem);
    if (nt_i == 13) store_transposed(acc, (u16*)(p.ws + OFF_SVT), TPB, b * 128, j0);
    else store_transposed(acc, (u16*)(p.ws + OFF_HYT), TPB, b * 1536 + (nt_i - 14) * 128, j0);
    return;
  }
  gemm_main<true>(hbuf, 1024, m0, 0, MTOK - 1, 64, wt, 1024, 16, acc, smem);
  if (nt_i < 6) {
#pragma unroll
    for (int ntl = 0; ntl < 2; ++ntl) {
      const int s32 = nt_i * 4 + wn * 2 + ntl;
      if (s32 % 3 == 2) {
#pragma unroll
        for (int mt = 0; mt < 3; ++mt) {
          const int jr = j0 + wm * 96 + mt * 32 + r;
          if (jr >= CTX) rope32(acc[mt][ntl], cm, sm, jr - CTX, h);
        }
      }
    }
    store_rowmajor(acc, (u16*)(p.ws + OFF_Q), 768, m0, nt_i * 128, QS_MLA);
  } else if (nt_i < 8) {
    store_rowmajor(acc, (u16*)(p.ws + OFF_CKV), 256, m0, (nt_i - 6) * 128, 1.f);
  } else if (nt_i < 12) {
#pragma unroll
    for (int mt = 0; mt < 3; ++mt) {
      const int jr = j0 + wm * 96 + mt * 32 + r;
      if (jr >= CTX) rope64(acc[mt][0], acc[mt][1], cs, ss, jr - CTX, h);
    }
    store_rowmajor(acc, (u16*)(p.ws + OFF_SQ), 512, m0, (nt_i - 8) * 128, QS_SWA);
  } else if (nt_i == 12) {
#pragma unroll
    for (int mt = 0; mt < 3; ++mt) {
      const int jr = j0 + wm * 96 + mt * 32 + r;
      if (jr >= CTX) rope64(acc[mt][0], acc[mt][1], cs, ss, jr - CTX, h);
    }
    store_rowmajor(acc, (u16*)(p.ws + OFF_SK), 128, m0, 0, 1.f);
  } else {
    if (wn == 0) {
      u16* kr = (u16*)(p.ws + OFF_KR);
#pragma unroll
      for (int mt = 0; mt < 3; ++mt) {
        const int ml = wm * 96 + mt * 32 + r;
        if (j0 + ml >= CTX) rope32(acc[mt][0], cm, sm, j0 + ml - CTX, h);
#pragma unroll
        for (int g = 0; g < 4; ++g) {
          u32x2 pk;
          pk.x = pack2(acc[mt][0][4 * g], acc[mt][0][4 * g + 1]);
          pk.y = pack2(acc[mt][0][4 * g + 2], acc[mt][0][4 * g + 3]);
          *(u32x2*)(kr + (size_t)(m0 + ml) * 32 + 8 * g + 4 * h) = pk;
        }
      }
    }
  }
}

DI void kvup_tile(const Params& p, int tile, char* smem) {
  const int mt_i = tile >> 3, nt_i = tile & 7;
  const int m0 = mt_i * 192;
  const int tid = opq(threadIdx.x), lane = tid & 63, wave = tid >> 6, wm = wave >> 1, r = lane & 31, h = lane >> 5;
  const u16* ckv = (const u16*)(p.ws + OFF_CKV);
  float* rs = (float*)(smem + (192 + 128) * 144);
#pragma unroll
  for (int pass = 0; pass < 2; ++pass) {
    const int row = pass * 128 + (tid >> 1), half = tid & 1;
    const int rowc = min(row, 191);
    const u32x4* src = (const u32x4*)(ckv + (size_t)(m0 + rowc) * 256 + half * 128);
    float ss = 0.f;
#pragma unroll
    for (int i = 0; i < 16; ++i) {
      const u32x4 u = src[i];
      const unsigned w[4] = {u.x, u.y, u.z, u.w};
#pragma unroll
      for (int e = 0; e < 4; ++e) { const float a = lo_bf(w[e]), c = hi_bf(w[e]); ss += a * a + c * c; }
    }
    ss += __shfl_xor(ss, 1);
    if (half == 0 && row < 192) rs[row] = rsqrtf(ss * (1.f / 256.f) + EPS);
  }
  const u16* wt = (const u16*)(p.ws + OFF_WT_KV) + (size_t)nt_i * 128 * 256;
  const int b = m0 / TPB, j0 = m0 - b * TPB;
  f32x16 acc[3][2];
  if (nt_i < 4) {
    gemm_main<true>(ckv, 256, m0, 0, MTOK - 1, 64, wt, 256, 4, acc, smem);
#pragma unroll
    for (int mt = 0; mt < 3; ++mt) {
      const float sc = rs[wm * 96 + mt * 32 + r];
#pragma unroll
      for (int nt = 0; nt < 2; ++nt)
#pragma unroll
        for (int i = 0; i < 16; ++i) acc[mt][nt][i] *= sc;
    }
    store_rowmajor(acc, (u16*)(p.ws + OFF_KN), 512, m0, nt_i * 128, 1.f);
  } else {
    gemm_main<false>(ckv, 256, m0, 0, MTOK - 1, 64, wt, 256, 4, acc, smem);
#pragma unroll
    for (int mt = 0; mt < 3; ++mt)
#pragma unroll
      for (int i = 0; i < 16; ++i) {
        const float sc = rs[wm * 96 + mt * 32 + crow(i, h)];
        acc[mt][0][i] *= sc;
        acc[mt][1][i] *= sc;
      }
    store_transposed(acc, (u16*)(p.ws + OFF_VT), TPB, b * 512 + (nt_i - 4) * 128, j0);
  }
  __syncthreads();
}

DI void merge_tile(const Params& p, int tile, char* smem) {
  const int mt_i = tile >> 3, nt_i = tile & 7;
  const int m0 = mt_i * 192;
  const u16* hp = (const u16*)(p.ws + OFF_RH);
  const int tid = opq(threadIdx.x), lane = tid & 63, wave = tid >> 6, wm = wave >> 1, wn = wave & 1, r = lane & 31, h = lane >> 5;
  u16* C = (u16*)(p.ws + OFF_MERGED);
#pragma unroll 1
  for (int br = 0; br < 3; ++br) {
    if ((DBG_SKIP_BR >> br) & 1) continue;
    f32x16 acc[3][2];
    gemm_main<true>(hp, 1024, m0, 0, MTOK - 1, 64, (const u16*)(p.ws + OFF_WT_GATE) + (size_t)(br * 1024 + nt_i * 128) * 1024, 1024, 16, acc, smem);
    u32x2* sgp = (u32x2*)(p.ws + OFF_ESCR + (size_t)blockIdx.x * 65536) + tid * 24;
#pragma unroll
    for (int a = 0; a < 3; ++a)
#pragma unroll
      for (int b2 = 0; b2 < 2; ++b2)
#pragma unroll
        for (int g = 0; g < 4; ++g) {
          u32x2 v;
          v.x = pack2(1.f / (1.f + __expf(-acc[a][b2][4 * g])), 1.f / (1.f + __expf(-acc[a][b2][4 * g + 1])));
          v.y = pack2(1.f / (1.f + __expf(-acc[a][b2][4 * g + 2])), 1.f / (1.f + __expf(-acc[a][b2][4 * g + 3])));
          sgp[(a * 2 + b2) * 4 + g] = v;
        }
    const u16* wbr = (const u16*)(p.ws + OFF_WT_BR) + (size_t)(br * 1024 + nt_i * 128) * 512;
    if (br == 0) gemm_main<true>((const u16*)(p.ws + OFF_Q), 768, m0, 0, MTOK - 1, 96, wbr, 512, 8, acc, smem);
    else if (br == 1) gemm_main<true>((const u16*)(p.ws + OFF_SQ), 512, m0, 0, MTOK - 1, 64, wbr, 512, 8, acc, smem);
    else {
      const int b = m0 / TPB, j0 = m0 - b * TPB;
      gemm_main<true, true>((const u16*)(p.ws + OFF_HYT) + (size_t)(b * 1536 + 512) * TPB, TPB, j0, 0, 0, 64, wbr, 512, 8, acc, smem);
    }
#pragma unroll
    for (int mt = 0; mt < 3; ++mt)
#pragma unroll
      for (int nt = 0; nt < 2; ++nt)
#pragma unroll
        for (int g = 0; g < 4; ++g) {
          const int m = m0 + wm * 96 + mt * 32 + r, n = nt_i * 128 + wn * 64 + nt * 32 + 8 * g + 4 * h;
          u32x2* dst = (u32x2*)(C + (size_t)m * 1024 + n);
          u32x2 prev = {0u, 0u};
          if (br > DBG_FIRST_BR) prev = *dst;
          const u32x2 sv = sgp[(mt * 2 + nt) * 4 + g];
          const unsigned s0 = sv.x, s1 = sv.y;
          u32x2 nv;
          nv.x = pack2(lo_bf(prev.x) + lo_bf(s0) * acc[mt][nt][4 * g], hi_bf(prev.x) + hi_bf(s0) * acc[mt][nt][4 * g + 1]);
          nv.y = pack2(lo_bf(prev.y) + lo_bf(s1) * acc[mt][nt][4 * g + 2], hi_bf(prev.y) + hi_bf(s1) * acc[mt][nt][4 * g + 3]);
          *dst = nv;
          __builtin_amdgcn_sched_barrier(0);
        }
  }
}

DI void plain_tile(const Params& p, int tile, const u16* A, int lda, int nk, const u16* W, u16* C, char* smem) {
  const int mt_i = tile >> 3, nt_i = tile & 7;
  f32x16 acc[3][2];
  gemm_main<true>(A, lda, mt_i * 192, 0, MTOK - 1, 64, W + (size_t)nt_i * 128 * lda, lda, nk, acc, smem);
  store_rowmajor(acc, C, 1024, mt_i * 192, nt_i * 128, 1.f);
}

DI void ffnup_tile(const Params& p, int l, int tile, char* smem) {
  const int mt_i = tile / 44, nt_i = tile % 44;
  const int b = mt_i / 46, ti = mt_i % 46;
  int seq_base, len, r0;
  if (ti < 2) { seq_base = b * TPB; len = CTX; r0 = 190 * ti; }
  else { seq_base = b * TPB + CTX; len = SEQ; r0 = 190 * (ti - 2); }
  const int tid = opq(threadIdx.x), lane = tid & 63, wave = tid >> 6, wm = wave >> 1, wn = wave & 1, r = lane & 31, h = lane >> 5;
  f32x16 acc[3][2];
  gemm_main<true>((const u16*)(p.ws + OFF_RH), 1024, seq_base + r0 - 1, seq_base, seq_base + len - 1, 64,
                  (const u16*)(p.ws + OFF_WT_UP) + (size_t)nt_i * 128 * 1024, 1024, 16, acc, smem);
  __syncthreads();
#pragma unroll
  for (int mt = 0; mt < 3; ++mt) {
    const int ml = wm * 96 + mt * 32 + r;
    const int pos = r0 - 1 + ml;
    const bool valid = pos >= 0 && pos < len;
#pragma unroll
    for (int nt = 0; nt < 2; ++nt)
#pragma unroll
      for (int g = 0; g < 4; ++g) {
        u32x2 pk = u32x2{0u, 0u};
        if (valid) {
          pk.x = pack2(acc[mt][nt][4 * g], acc[mt][nt][4 * g + 1]);
          pk.y = pack2(acc[mt][nt][4 * g + 2], acc[mt][nt][4 * g + 3]);
        }
        *(u32x2*)(smem + ml * 272 + (wn * 64 + nt * 32 + 8 * g + 4 * h) * 2) = pk;
      }
  }
  __syncthreads();
  {
    const int j4 = (tid & 15) * 4, tr = tid >> 4;
    const float* cw = p.ffn_conv_w + (size_t)l * 3 * 5632;
    const float* cb = p.ffn_conv_b + (size_t)l * 5632;
    const int cha = nt_i * 64 + j4, chb = DFF + cha;
    float wa[3][4], wb[3][4], ba[4], bb[4];
#pragma unroll
    for (int e = 0; e < 4; ++e) {
#pragma unroll
      for (int d = 0; d < 3; ++d) { wa[d][e] = cw[d * 5632 + cha + e]; wb[d][e] = cw[d * 5632 + chb + e]; }
      ba[e] = cb[cha + e]; bb[e] = cb[chb + e];
    }
    u16* Aout = (u16*)(p.ws + OFF_A);
#pragma unroll 1
    for (int i = 0; i < 12; ++i) {
      const int t = 1 + tr + 16 * i;
      const int pos = r0 - 1 + t;
      if (t <= 190 && pos < len) {
        float ca[4], cbv[4];
#pragma unroll
        for (int e = 0; e < 4; ++e) { ca[e] = ba[e]; cbv[e] = bb[e]; }
#pragma unroll
        for (int d = 0; d < 3; ++d) {
          const u32x2 ua = *(const u32x2*)(smem + (t - 1 + d) * 272 + j4 * 2);
          const u32x2 ub = *(const u32x2*)(smem + (t - 1 + d) * 272 + (64 + j4) * 2);
          ca[0] += lo_bf(ua.x) * wa[d][0]; ca[1] += hi_bf(ua.x) * wa[d][1]; ca[2] += lo_bf(ua.y) * wa[d][2]; ca[3] += hi_bf(ua.y) * wa[d][3];
          cbv[0] += lo_bf(ub.x) * wb[d][0]; cbv[1] += hi_bf(ub.x) * wb[d][1]; cbv[2] += lo_bf(ub.y) * wb[d][2]; cbv[3] += hi_bf(ub.y) * wb[d][3];
        }
        float o[4];
#pragma unroll
        for (int e = 0; e < 4; ++e) o[e] = ca[e] / (1.f + __expf(-ca[e])) * cbv[e];
        *(u32x2*)(Aout + (size_t)(seq_base + pos) * DFF + cha) = u32x2{pack2(o[0], o[1]), pack2(o[2], o[3])};
      }
    }
  }
}

template <int DQK, bool SWA>
DI void attn_item(const Params& p, int l, int b, int hq, int jq0  , int nct, int nband, int kp_start, char* smem) {
  constexpr int KS = DQK * 2 + 16;
  constexpr int KCH = DQK / 8;
  constexpr int NKC = 64 * KCH / 256;
  constexpr int NKS = DQK / 16;
  constexpr int BUFSZ = 22016;
  const int tid = opq(threadIdx.x), lane = tid & 63, wave = tid >> 6, r = lane & 31, h = lane >> 5;
  const int brow = b * TPB;
  const int ntiles = nct + nband;
  const u16* K1; int ldk1, koff; const u16* KR = (const u16*)(p.ws + OFF_KR);
  const u16* Vb; u16* outp; int ldo, ooff; const u16* Qb; int ldq;
  if (!SWA) {
    K1 = (const u16*)(p.ws + OFF_KN); ldk1 = 512; koff = hq * 64;
    Vb = (const u16*)(p.ws + OFF_VT) + (size_t)((b * 8 + hq) * 64) * TPB;
    Qb = (const u16*)(p.ws + OFF_Q); ldq = 768;
    outp = (u16*)(p.ws + OFF_Q); ldo = 768; ooff = hq * 96;
  } else {
    const int kvh = hq >> 2;
    K1 = (const u16*)(p.ws + OFF_SK); ldk1 = 128; koff = kvh * 64;
    Vb = (const u16*)(p.ws + OFF_SVT) + (size_t)((b * 2 + kvh) * 64) * TPB;
    Qb = (const u16*)(p.ws + OFF_SQ); ldq = 512;
    outp = (u16*)(p.ws + OFF_SQ); ldo = 512; ooff = hq * 64;
  }
  const int qrow = brow + jq0 + wave * 32 + r;
  bf16x8 qf[NKS];
#pragma unroll
  for (int ks = 0; ks < NKS; ++ks) qf[ks] = *(const bf16x8*)(Qb + (size_t)qrow * ldq + hq * DQK + ks * 16 + h * 8);
  f32x16 o[2];
#pragma unroll
  for (int dt = 0; dt < 2; ++dt)
#pragma unroll
    for (int i = 0; i < 16; ++i) o[dt][i] = 0.f;
  float mrun = -INFINITY, lsum = 0.f;
  u32x4 kreg[NKC], vreg[2];
  auto tile_j = [&](int it) { return it < nct ? it * 64 : CTX + kp_start + 64 * (it - nct); };
  auto issue = [&](int it) {
    const int jr = tile_j(it);
#pragma unroll
    for (int i = 0; i < NKC; ++i) {
      const int c = tid + 256 * i, key = c / KCH, part = c % KCH;
      const u16* src = (part < 8) ? K1 + (size_t)(brow + jr + key) * ldk1 + koff + part * 8
                                  : KR + (size_t)(brow + jr + key) * 32 + (part - 8) * 8;
      kreg[i] = *(const u32x4*)src;
    }
#pragma unroll
    for (int i = 0; i < 2; ++i) {
      const int c = tid + 256 * i, d = c >> 3, part = c & 7;
      vreg[i] = *(const u32x4*)(Vb + (size_t)d * TPB + jr + part * 8);
    }
  };
  auto stash = [&](int buf) {
    char* kb = smem + buf * BUFSZ;
    char* vb = kb + 13312;
#pragma unroll
    for (int i = 0; i < NKC; ++i) {
      const int c = tid + 256 * i, key = c / KCH, part = c % KCH;
      *(u32x4*)(kb + key * KS + part * 16) = kreg[i];
    }
#pragma unroll
    for (int i = 0; i < 2; ++i) {
      const int c = tid + 256 * i, d = c >> 3, part = c & 7;
      *(u32x2*)(vb + d * 136 + part * 16) = u32x2{vreg[i].x, vreg[i].y};
      *(u32x2*)(vb + d * 136 + part * 16 + 8) = u32x2{vreg[i].z, vreg[i].w};
    }
  };
  __syncthreads();
  issue(0);
  stash(0);
  __syncthreads();
  const int qpos = jq0 - CTX + wave * 32 + r;
#pragma unroll 1
  for (int it = 0; it < ntiles; ++it) {
    const int buf = it & 1;
    const char* kb = smem + buf * BUFSZ;
    const char* vb = kb + 13312;
    if (it + 1 < ntiles) issue(it + 1);
    f32x16 s[2];
#pragma unroll
    for (int kt = 0; kt < 2; ++kt) {
#pragma unroll
      for (int i = 0; i < 16; ++i) s[kt][i] = 0.f;
#pragma unroll
      for (int ks = 0; ks < NKS; ++ks) {
        const bf16x8 kf = *(const bf16x8*)(kb + (kt * 32 + r) * KS + ks * 32 + h * 16);
        s[kt] = MFMA(kf, qf[ks], s[kt]);
      }
    }
    if (SWA && it >= nct) {
      const int kpos0 = kp_start + 64 * (it - nct);
#pragma unroll
      for (int kt = 0; kt < 2; ++kt)
#pragma unroll
        for (int i = 0; i < 16; ++i) {
          const int diff = qpos - (kpos0 + kt * 32 + crow(i, h));
          if (diff > 128 || diff < -128) s[kt][i] = -1e30f;
        }
    }
    float mx = s[0][0];
#pragma unroll
    for (int kt = 0; kt < 2; ++kt)
#pragma unroll
      for (int i = 0; i < 16; ++i) mx = fmaxf(mx, s[kt][i]);
    mx = fmaxf(mx, __shfl_xor(mx, 32));
    const float mnew = fmaxf(mrun, mx);
    const float alpha = __builtin_amdgcn_exp2f(mrun - mnew);
    float ps = 0.f;
#pragma unroll
    for (int kt = 0; kt < 2; ++kt)
#pragma unroll
      for (int i = 0; i < 16; ++i) { const float e = __builtin_amdgcn_exp2f(s[kt][i] - mnew); s[kt][i] = e; ps += e; }
    if (__builtin_amdgcn_ballot_w64(mnew != mrun) != 0ull) {
      lsum *= alpha;
#pragma unroll
      for (int dt = 0; dt < 2; ++dt)
#pragma unroll
        for (int i = 0; i < 16; ++i) o[dt][i] *= alpha;
    }
    lsum += ps;
    mrun = mnew;
#pragma unroll
    for (int kt = 0; kt < 2; ++kt)
#pragma unroll
      for (int s2 = 0; s2 < 2; ++s2) {
        unsigned pk[4];
#pragma unroll
        for (int j = 0; j < 4; ++j) pk[j] = pack2(s[kt][8 * s2 + 2 * j], s[kt][8 * s2 + 2 * j + 1]);
        const bf16x8 pf = __builtin_bit_cast(bf16x8, u32x4{pk[0], pk[1], pk[2], pk[3]});
#pragma unroll
        for (int dt = 0; dt < 2; ++dt) {
          const char* vp = vb + (dt * 32 + r) * 136 + (kt * 32 + 16 * s2 + 4 * h) * 2;
          const s16x4 lo = *(const s16x4*)vp;
          const s16x4 hi = *(const s16x4*)(vp + 16);
          const bf16x8 vf = __builtin_shufflevector(lo, hi, 0, 1, 2, 3, 4, 5, 6, 7);
          o[dt] = MFMA(vf, pf, o[dt]);
        }
      }
    if (it + 1 < ntiles) stash(buf ^ 1);
    __syncthreads();
  }
  float ltot = lsum + __shfl_xor(lsum, 32);
  if (SWA) ltot += __builtin_amdgcn_exp2f(p.swa_sink[l * 8 + hq] * LOG2E - mrun);
  const float inv = 1.f / ltot;
#pragma unroll
  for (int dt = 0; dt < 2; ++dt)
#pragma unroll
    for (int g = 0; g < 4; ++g) {
      u32x2 pk;
      pk.x = pack2(o[dt][4 * g] * inv, o[dt][4 * g + 1] * inv);
      pk.y = pack2(o[dt][4 * g + 2] * inv, o[dt][4 * g + 3] * inv);
      *(u32x2*)(outp + (size_t)qrow * ldo + ooff + dt * 32 + 8 * g + 4 * h) = pk;
    }
}

constexpr float HY_D0 = 3.0701134573253944f;
constexpr float HY_DSTEP = (15.350567286626972f - 3.0701134573253944f) / 511.f;

DI void filt_item(const Params& p, int l, int oc, char* smem) {
  float2* lds = (float2*)smem;
  float* lf = (float*)smem;
  const int tid = opq(threadIdx.x), lane = tid & 63, wave = tid >> 6;
  const int c = oc & 511;
  const float* hid = (const float*)(p.ws + OFF_HID + l * HID_LAYER);
  const float* w3 = p.hy_w3 + (size_t)l * 64 * 2048;
  float* sa = (float*)(p.ws + OFF_ESCR + (size_t)blockIdx.x * 65536);
  float* sb = sa + 8192;
  __syncthreads();
  if (tid < 128) { const int dir = tid >> 6, j = tid & 63; lf[tid] = w3[j * 2048 + dir * 1024 + oc]; }
  __syncthreads();
  const float delta = HY_D0 + (float)c * HY_DSTEP;
  float asum = 0.f;
#pragma unroll 1
  for (int ib = 0; ib < 4; ++ib) {
    float a[8], bm[8];
#pragma unroll
    for (int i = 0; i < 8; ++i) { a[i] = 0.f; bm[i] = 0.f; }
#pragma unroll 4
    for (int j = 0; j < 64; ++j) {
      const float w0 = lf[j], w1 = lf[64 + j];
      const float* hr = hid + (size_t)j * 8192 + 4 * (tid + 512 * ib);
#pragma unroll
      for (int ii = 0; ii < 2; ++ii) {
        const float4 hv = *(const float4*)(hr + 1024 * ii);
        a[4 * ii + 0] += hv.x * w0; bm[4 * ii + 0] += hv.x * w1;
        a[4 * ii + 1] += hv.y * w0; bm[4 * ii + 1] += hv.y * w1;
        a[4 * ii + 2] += hv.z * w0; bm[4 * ii + 2] += hv.z * w1;
        a[4 * ii + 3] += hv.w * w0; bm[4 * ii + 3] += hv.w * w1;
      }
    }
#pragma unroll
    for (int ii = 0; ii < 2; ++ii) {
      const int t0 = 4 * (tid + 256 * (2 * ib + ii));
      float av[4];
#pragma unroll
      for (int e = 0; e < 4; ++e) {
        const int t = t0 + e;
        const float dec = __expf(-((float)t * (1.f / 8191.f)) * delta);
        av[e] = a[4 * ii + e] * dec;
        const float bv = bm[4 * ii + e] * dec;
        if (t >= 1) { sb[8192 - t] = bv; asum += fabsf(bv); } else sb[0] = 0.f;
        asum += fabsf(av[e]);
      }
      *(float4*)(sa + t0) = make_float4(av[0], av[1], av[2], av[3]);
    }
  }
  asum = wave_sum(asum);
  asm volatile("s_waitcnt vmcnt(0)" ::: "memory");
  __syncthreads();
  if (lane == 0) lf[wave] = asum;
  __syncthreads();
  const float inv = 1.f / (lf[0] + lf[1] + lf[2] + lf[3]);
  __syncthreads();
#pragma unroll 2
  for (int i = 0; i < 8; ++i) {
    const int t0 = 4 * (tid + 256 * i);
#pragma unroll
    for (int e = 0; e < 4; ++e) lds[fphys(t0 + e)] = make_float2((ldsc1(sa + t0 + e) + ldsc1(sb + t0 + e)) * inv, 0.f);
  }
  __syncthreads();
  if (!DBG_NOFFT) fft8192_fwd(lds, tid);
  h2_t* sp = (h2_t*)(p.ws + OFF_SPEC) + (size_t)oc * 2 * 8192;
#pragma unroll 4
  for (int i = 0; i < 32; ++i) { const int k = tid + 256 * i; const float2 v = lds[k]; h2_t hv = {(_Float16)v.x, (_Float16)v.y}; sp[k] = hv; }
  __syncthreads();
#pragma unroll 2
  for (int i = 0; i < 8; ++i) {
    const int t0 = 4 * (tid + 256 * i);
#pragma unroll
    for (int e = 0; e < 4; ++e) {
      const int t = t0 + e;
      const float2 w = twid_rev((float)t * (1.f / 16384.f));
      const float d = (ldsc1(sa + t) - ldsc1(sb + t)) * inv;
      lds[fphys(t)] = make_float2(d * w.x, d * w.y);
    }
  }
  __syncthreads();
  if (!DBG_NOFFT) fft8192_fwd(lds, tid);
#pragma unroll 4
  for (int i = 0; i < 32; ++i) { const int k = tid + 256 * i; const float2 v = lds[k]; h2_t hv = {(_Float16)v.x, (_Float16)v.y}; sp[8192 + k] = hv; }
  __syncthreads();
}

DI float dwc(const u16* s, int t, int len, float w0, float w1, float w2, float bias) {
  const int tm = max(t - 1, 0), tp = min(t + 1, len - 1);
  const float a = bf2f(s[tm]), b = bf2f(s[t]), c = bf2f(s[tp]);
  return b * w1 + bias + (t > 0 ? a * w0 : 0.f) + (t < len - 1 ? c * w2 : 0.f);
}

DI void ld4(const u16* s, int t0, float (&o)[4]) {
  const u32x2 u = *(const u32x2*)(s + t0);
  o[0] = lo_bf(u.x); o[1] = hi_bf(u.x); o[2] = lo_bf(u.y); o[3] = hi_bf(u.y);
}
DI void dwc4(const u16* s, int t0, int len, float w0, float w1, float w2, float bias, float (&o)[4]) {
  float c[4];
  ld4(s, t0, c);
  float l = bf2f(s[max(t0 - 1, 0)]), r = bf2f(s[min(t0 + 4, len - 1)]);
  l = (t0 > 0) ? l : 0.f;
  r = (t0 + 4 < len) ? r : 0.f;
  o[0] = l * w0 + c[0] * w1 + c[1] * w2 + bias;
  o[1] = c[0] * w0 + c[1] * w1 + c[2] * w2 + bias;
  o[2] = c[1] * w0 + c[2] * w1 + c[3] * w2 + bias;
  o[3] = c[2] * w0 + c[3] * w1 + r * w2 + bias;
}

DI void hconv_item(const Params& p, int l, int o, int c, int bp, char* smem) {
  float2* lds = (float2*)smem;
  const int tid = opq(threadIdx.x);
  u16* hyt = (u16*)(p.ws + OFF_HYT);
  const int b0 = bp * 2, b1 = b0 + 1;
  u16* z0p = hyt + (size_t)(b0 * 1536 + c) * TPB + CTX;
  u16* z1p = hyt + (size_t)(b1 * 1536 + c) * TPB + CTX;
  const int gc = (o + 1) * 512 + c;
  const u16* g0p = hyt + (size_t)(b0 * 1536 + gc) * TPB + CTX;
  const u16* g1p = hyt + (size_t)(b1 * 1536 + gc) * TPB + CTX;
  const float* cw = p.hy_conv_w + (size_t)l * 3 * 1536;
  const float* cb = p.hy_conv_b + (size_t)l * 1536;
  const float zw0 = cw[c], zw1 = cw[1536 + c], zw2 = cw[3072 + c], zbias = cb[c];
  const float gw0 = cw[gc], gw1 = cw[1536 + gc], gw2 = cw[3072 + gc], gbias = cb[gc];
  const float skip = p.hy_skip[l * 1024 + o * 512 + c];
  const h2_t* spe = (const h2_t*)(p.ws + OFF_SPEC) + (size_t)(o * 512 + c) * 2 * 8192;
  const h2_t* spo = spe + 8192;
  float2* Eg = (float2*)(p.ws + OFF_ESCR + (size_t)blockIdx.x * 65536);
  __syncthreads();
#pragma unroll 2
  for (int i = 0; i < 8; ++i) {
    const int t0 = 4 * (tid + 256 * i);
    float za[4], zb[4];
    if (o == 0) { dwc4(z0p, t0, SEQ, zw0, zw1, zw2, zbias, za); dwc4(z1p, t0, SEQ, zw0, zw1, zw2, zbias, zb); }
    else { ld4(z0p, t0, za); ld4(z1p, t0, zb); }
#pragma unroll
    for (int e = 0; e < 4; ++e) lds[fphys(t0 + e)] = make_float2(za[e], zb[e]);
  }
  __syncthreads();
  fft8192_fwd(lds, tid);
#pragma unroll 8
  for (int i = 0; i < 32; ++i) { const int k = tid + 256 * i; const h2_t hv = spe[k]; lds[k] = cmul(lds[k], make_float2((float)hv[0], (float)hv[1])); }
  __syncthreads();
  fft8192_inv(lds, tid);
#pragma unroll 2
  for (int i = 0; i < 8; ++i) {
    const int t0 = 4 * (tid + 256 * i);
#pragma unroll
    for (int e = 0; e < 4; ++e) Eg[t0 + e] = lds[fphys(t0 + e)];
  }
  __syncthreads();
#pragma unroll 2
  for (int i = 0; i < 8; ++i) {
    const int t0 = 4 * (tid + 256 * i);
    float za[4], zb[4];
    if (o == 0) { dwc4(z0p, t0, SEQ, zw0, zw1, zw2, zbias, za); dwc4(z1p, t0, SEQ, zw0, zw1, zw2, zbias, zb); }
    else { ld4(z0p, t0, za); ld4(z1p, t0, zb); }
#pragma unroll
    for (int e = 0; e < 4; ++e) lds[fphys(t0 + e)] = cmul(make_float2(za[e], zb[e]), twid_rev((float)(t0 + e) * (1.f / 16384.f)));
  }
  __syncthreads();
  fft8192_fwd(lds, tid);
#pragma unroll 8
  for (int i = 0; i < 32; ++i) { const int k = tid + 256 * i; const h2_t hv = spo[k]; lds[k] = cmul(lds[k], make_float2((float)hv[0], (float)hv[1])); }
  __syncthreads();
  fft8192_inv(lds, tid);
#pragma unroll 2
  for (int i = 0; i < 8; ++i) {
    const int t0 = 4 * (tid + 256 * i);
    float za[4], zb[4], ga[4], gb[4];
    if (o == 0) { dwc4(z0p, t0, SEQ, zw0, zw1, zw2, zbias, za); dwc4(z1p, t0, SEQ, zw0, zw1, zw2, zbias, zb); }
    else { ld4(z0p, t0, za); ld4(z1p, t0, zb); }
    dwc4(g0p, t0, SEQ, gw0, gw1, gw2, gbias, ga);
    dwc4(g1p, t0, SEQ, gw0, gw1, gw2, gbias, gb);
#pragma unroll
    for (int e = 0; e < 4; ++e) {
      const int t = t0 + e;
      const float2 ov = cmulc(lds[fphys(t)], twid_rev((float)t * (1.f / 16384.f)));
      const float2 ev = Eg[t];
      const float y0 = (ev.x + ov.x) * (1.f / 16384.f), y1 = (ev.y + ov.y) * (1.f / 16384.f);
      Eg[t] = make_float2(ga[e] * (y0 + za[e] * skip), gb[e] * (y1 + zb[e] * skip));
    }
  }
  __syncthreads();
  u16* d0 = (o == 0) ? z0p : hyt + (size_t)(b0 * 1536 + 512 + c) * TPB + CTX;
  u16* d1 = (o == 0) ? z1p : hyt + (size_t)(b1 * 1536 + 512 + c) * TPB + CTX;
#pragma unroll 2
  for (int i = 0; i < 8; ++i) {
    const int t0 = 4 * (tid + 256 * i);
    float2 e4[4];
#pragma unroll
    for (int e = 0; e < 4; ++e) e4[e] = Eg[t0 + e];
    *(u32x2*)(d0 + t0) = u32x2{pack2(e4[0].x, e4[1].x), pack2(e4[2].x, e4[3].x)};
    *(u32x2*)(d1 + t0) = u32x2{pack2(e4[0].y, e4[1].y), pack2(e4[2].y, e4[3].y)};
  }
}

DI void hctx_item(const Params& p, int l, int c, char* smem) {
  float* lf = (float*)smem;
  float* kern = lf;
  float* zb = lf + 1024;
  float* z1b = lf + 2048;
  float* red = lf + 3072;
  const int tid = opq(threadIdx.x), lane = tid & 63, wave = tid >> 6;
  const float* hid = (const float*)(p.ws + OFF_HID + l * HID_LAYER) + 64 * 8192;
  const float* w3 = p.hy_w3 + (size_t)l * 64 * 2048;
  const u16* hyt = (const u16*)(p.ws + OFF_HYT);
  const float* cw = p.hy_conv_w + (size_t)l * 3 * 1536;
  const float* cb = p.hy_conv_b + (size_t)l * 1536;
  __syncthreads();
  {
    const int t = tid;
    float d[4] = {0.f, 0.f, 0.f, 0.f};
#pragma unroll 4
    for (int j = 0; j < 64; ++j) {
      const float hv = hid[j * 256 + t];
#pragma unroll
      for (int q = 0; q < 4; ++q) d[q] += hv * w3[j * 2048 + (q >> 1) * 1024 + (q & 1) * 512 + c];
    }
    const float dec = __expf(-((float)t * (1.f / 255.f)) * (HY_D0 + (float)c * HY_DSTEP));
#pragma unroll
    for (int o = 0; o < 2; ++o) {
      const float f0 = d[o] * dec, f1 = d[2 + o] * dec;
      kern[o * 512 + t] = f0;
      if (t >= 1) kern[o * 512 + 512 - t] = f1;
      if (t == 0) kern[o * 512 + 256] = 0.f;
      float s = fabsf(f0) + (t >= 1 ? fabsf(f1) : 0.f);
      s = wave_sum(s);
      if (lane == 0) red[o * 4 + wave] = s;
    }
  }
  const int b = tid >> 6, tq = tid & 63;
  const u16* zs = hyt + (size_t)(b * 1536 + c) * TPB;
  const u16* g1s = hyt + (size_t)(b * 1536 + 512 + c) * TPB;
  const u16* g2s = hyt + (size_t)(b * 1536 + 1024 + c) * TPB;
#pragma unroll
  for (int k = 0; k < 4; ++k) {
    const int tt = tq + 64 * k;
    zb[b * 256 + tt] = dwc(zs, tt, CTX, cw[c], cw[1536 + c], cw[3072 + c], cb[c]);
  }
  __syncthreads();
  const float inv0 = 1.f / (red[0] + red[1] + red[2] + red[3]);
  const float inv1 = 1.f / (red[4] + red[5] + red[6] + red[7]);
  const float sk0 = p.hy_skip[l * 1024 + c], sk1 = p.hy_skip[l * 1024 + 512 + c];
#pragma unroll 1
  for (int k = 0; k < 4; ++k) {
    const int tt = tq + 64 * k;
    float acc = 0.f;
#pragma unroll 8
    for (int s = 0; s < 256; ++s) acc += kern[(tt - s) & 511] * zb[b * 256 + s];
    const float g = dwc(g1s, tt, CTX, cw[512 + c], cw[1536 + 512 + c], cw[3072 + 512 + c], cb[512 + c]);
    z1b[b * 256 + tt] = g * (acc * inv0 + zb[b * 256 + tt] * sk0);
  }
  __syncthreads();
  u16* yc = (u16*)(p.ws + OFF_HYT) + (size_t)(b * 1536 + 512 + c) * TPB;
#pragma unroll 1
  for (int k = 0; k < 4; ++k) {
    const int tt = tq + 64 * k;
    float acc = 0.f;
#pragma unroll 8
    for (int s = 0; s < 256; ++s) acc += kern[512 + ((tt - s) & 511)] * z1b[b * 256 + s];
    const float g = dwc(g2s, tt, CTX, cw[1024 + c], cw[1536 + 1024 + c], cw[3072 + 1024 + c], cb[1024 + c]);
    yc[tt] = DBG_ZERO_HCTX ? (u16)0 : f2bf(g * (acc * inv1 + z1b[b * 256 + tt] * sk1));
  }
  __syncthreads();
}

#define XB_XCNT(j) (256 + 64 * (j))
#define XB_XSUB(j) (1280 + 64 * (j))
#define XB_XGEN(j) (2304 + 64 * (j))
#define XB_TOP 3328
#define XB_TOPGEN 3392
DI unsigned xb_ld(unsigned* p) { return __hip_atomic_load(p, __ATOMIC_RELAXED, __HIP_MEMORY_SCOPE_AGENT); }
DI unsigned xb_add(unsigned* p, unsigned v) { return __hip_atomic_fetch_add(p, v, __ATOMIC_RELAXED, __HIP_MEMORY_SCOPE_AGENT); }
struct XBar { unsigned* bar; unsigned x, nloc, nx; };
DI void gsync_impl(cg::grid_group& g, XBar& b) {
#if DBG_CG_SYNC
  g.sync();
#else
  asm volatile("s_waitcnt vmcnt(0)" ::: "memory");
  __syncthreads();
  if (threadIdx.x == 0) {
    unsigned* bar = b.bar;
    __builtin_amdgcn_s_waitcnt(0);
    if (b.nloc == 0u) {
      unsigned sum, cnt, mine;
      for (;;) {
        sum = 0u; cnt = 0u; mine = 0u;
#pragma unroll
        for (unsigned j = 0; j < 16; ++j) { const unsigned c = xb_ld(&bar[XB_XCNT(j)]); sum += c; cnt += (c > 0u) ? 1u : 0u; mine = (j == b.x) ? c : mine; }
        if (sum == gridDim.x) break;
        __builtin_amdgcn_s_sleep(1);
      }
      b.nloc = mine > 0u ? mine : 1u; b.nx = cnt > 0u ? cnt : 1u;
    }
    const unsigned old = xb_add(&bar[XB_XSUB(b.x)], 1u);
    const unsigned gen = old / b.nloc;
    if (old + 1u == (gen + 1u) * b.nloc) {
      __builtin_amdgcn_fence(__ATOMIC_RELEASE, "agent");
      asm volatile("s_waitcnt vmcnt(0)" ::: "memory");
      const unsigned og = xb_add(&bar[XB_TOP], 1u);
      const unsigned tg = og / b.nx;
      if (og + 1u == (tg + 1u) * b.nx) xb_add(&bar[XB_TOPGEN], 1u);
      else { while (xb_ld(&bar[XB_TOPGEN]) == tg) __builtin_amdgcn_s_sleep(1); }
      __builtin_amdgcn_fence(__ATOMIC_ACQUIRE, "agent");
      xb_add(&bar[XB_XGEN(b.x)], 1u);
      asm volatile("s_waitcnt vmcnt(0)" ::: "memory");
    } else {
      while (xb_ld(&bar[XB_XGEN(b.x)]) == gen) __builtin_amdgcn_s_sleep(1);
      __builtin_amdgcn_fence(__ATOMIC_ACQUIRE, "agent");
      asm volatile("s_waitcnt vmcnt(0)" ::: "memory");
    }
  }
  __syncthreads();
#endif
}

#define gsync(G, E) gsync_impl(G, E)
DI int tile_map(int L, int MT, int NT) {
  const int per = 8 * NT;
  const int P = L / per, u = L - P * per;
  const int h = min(8, MT - P * 8);
  const int nt = u / h, mt = P * 8 + (u - nt * h);
  return mt * NT + nt;
}
__global__ void __launch_bounds__(256, 2) fwd_mega(Params p) {
  cg::grid_group grid = cg::this_grid();
  __shared__ __attribute__((aligned(16))) char smem[65536];
  const int nb = gridDim.x, bid = blockIdx.x;
  const int pb = ((nb & 7) == 0) ? (bid & 7) * (nb >> 3) + (bid >> 3) : bid;
  float* xctx = (float*)(p.ws + OFF_XCTX);
  u16* RH = (u16*)(p.ws + OFF_RH);
  u16* HP = (u16*)(p.ws + OFF_HP);
  XBar epoch;
  epoch.bar = (unsigned*)(p.ws + OFF_BAR);
  epoch.x = (unsigned)__builtin_amdgcn_s_getreg((3 << 11) | 20) & 0xFu;
  epoch.nloc = 0u; epoch.nx = 0u;
  if (threadIdx.x == 0) (void)xb_add(&epoch.bar[XB_XCNT(epoch.x)], 1u);
  {
    constexpr int NC0 = 2336;
    const int total = NC0 + 192 + 1536 + 528;
    for (int it = bid; it < total; it += nb) {
      if (it < NC0) conv_tile(p, 0, it, smem);
      else if (it < NC0 + 192) mod_item(p, it - NC0, smem);
      else if (it < NC0 + 192 + 1536) rope_item(p, it - NC0 - 192);
      else hid_item(p, it - NC0 - 192 - 1536, smem);
    }
  }
  grid.sync();
  row_pass(p, 0, p.x, p.ctx, nullptr, nullptr, nullptr, nullptr, 0, 0, false, p.norm_g, 0, 0, 1024, RH, false);
  gsync(grid, epoch);
#pragma unroll 1
  for (int l = 0; l < 2; ++l) {
    const float* xl = (l == 0) ? p.x : p.out;
    const float* xc = (l == 0) ? p.ctx : xctx;
    for (int rep = 0; rep < DBG_REP_FFT; ++rep)
    for (int it = pb; it < 1024; it += nb) filt_item(p, l, it, smem);
    gsync(grid, epoch);
    for (int rep = 0; rep < DBG_REP_GEMM; ++rep)
    for (int it = pb; it < 4752; it += nb) inproj_tile(p, tile_map(it, 176, 27), smem);
    gsync(grid, epoch);
#if DBG_DUMP == 5
    { const _Float16* sp = (const _Float16*)(p.ws + OFF_SPEC);
      for (size_t i = (size_t)bid * 256 + threadIdx.x; i < (size_t)NBATCH * SEQ * DM; i += (size_t)nb * 256) p.out[i] = (float)sp[i];
      return; }
#endif
    {
      const int nSW = 2048 + (l == 0 ? 64 : 0);
      for (int rep = 0; rep < DBG_REP_GEMM; ++rep)
      for (int it = pb; it < 1408 + nSW; it += nb) {
        if (it < 1408) kvup_tile(p, tile_map(it, 176, 8), smem);
        else if (it < 1408 + 2048) {
          const int i1 = it - 1408, n = i1 & 63, jlo = (n == 0) ? 2 : 0, jhi = (n == 63) ? 4 : 6;
          attn_item<64, true>(p, l, i1 >> 9, (i1 >> 6) & 7, CTX + n * 128, 4, jhi - jlo, (n - 1) * 128 + 64 * jlo, smem);
        } else { const int i2 = it - 1408 - 2048; attn_item<64, true>(p, l, i2 >> 4, (i2 >> 1) & 7, (i2 & 1) * 128, 4, 0, 0, smem); }
      }
    }
    gsync(grid, epoch);
    {
      const int nF = 2048 + (l == 0 ? 64 : 0);
      for (int rep = 0; rep < DBG_REP_MLA; ++rep)
      for (int it = pb; it < nF; it += nb) {
        if (it < 2048) attn_item<96, false>(p, l, it >> 9, (it >> 6) & 7, CTX + (it & 63) * 128, 132, 0, 0, smem);
        else { const int i2 = it - 2048; attn_item<96, false>(p, l, i2 >> 4, (i2 >> 1) & 7, (i2 & 1) * 128, 4, 0, 0, smem); }
      }
    }
    gsync(grid, epoch);
    {
      const int nF2 = 1024 + (l == 0 ? 512 : 0);
      for (int it = pb; it < nF2; it += nb) {
        if (it < 1024) hconv_item(p, l, 0, it >> 1, it & 1, smem);
        else hctx_item(p, l, it - 1024, smem);
      }
    }
    gsync(grid, epoch);
    for (int rep = 0; rep < DBG_REP_FFT; ++rep)
    for (int it = pb; it < 1024; it += nb) hconv_item(p, l, 1, it >> 1, it & 1, smem);
    gsync(grid, epoch);
    for (int rep = 0; rep < DBG_REP_GEMM; ++rep)
    for (int it = pb; it < 1408; it += nb) merge_tile(p, tile_map(it, 176, 8), smem);
    if (l == 0 && pb >= 384 && nb > 384) for (int ct = 2336 + (pb - 384); ct < NCONV_TILES; ct += nb - 384) conv_tile(p, 0, ct, smem);
    gsync(grid, epoch);
    for (int rep = 0; rep < DBG_REP_GEMM * DBG_REP_PLAIN; ++rep)
    for (int it = pb; it < 1408; it += nb) plain_tile(p, tile_map(it, 176, 8), (const u16*)(p.ws + OFF_MERGED), 1024, 16, (const u16*)(p.ws + OFF_WT_OUT), (u16*)(p.ws + OFF_Y), smem);
    gsync(grid, epoch);
    row_pass(p, 1, xl, xc, p.out, xctx, (const u16*)(p.ws + OFF_Y), p.norm_g + (size_t)(l * 4 + 1) * 1024, 2048, l, true, p.norm_g + (size_t)(l * 4 + 2) * 1024, l, 3072, 4096, RH, false);
    gsync(grid, epoch);
    for (int rep = 0; rep < DBG_REP_GEMM; ++rep)
    for (int it = pb; it < 184 * 44; it += nb) ffnup_tile(p, l, tile_map(it, 184, 44), smem);
    gsync(grid, epoch);
    for (int rep = 0; rep < DBG_REP_GEMM * DBG_REP_PLAIN; ++rep)
    for (int it = pb; it < 1408; it += nb) plain_tile(p, tile_map(it, 176, 8), (const u16*)(p.ws + OFF_A), 2816, 44, (const u16*)(p.ws + OFF_WT_DOWN), HP, smem);
    if (l == 0 && pb >= 384 && nb > 384) for (int ct = pb - 384; ct < 1632; ct += nb - 384) conv_tile(p, 1, ct, smem);
    gsync(grid, epoch);
    row_pass(p, 1, p.out, xctx, p.out, xctx, HP, p.norm_g + (size_t)(l * 4 + 3) * 1024, 5120, l, l == 0, p.norm_g + (size_t)((l + 1) * 4) * 1024, l + 1, 0, 1024, RH, l == 1);
    if (l == 0) {
      for (int it = bid; it < NCONV_TILES - 1632; it += nb) conv_tile(p, 1, 1632 + it, smem);
      gsync(grid, epoch);
    }
  }
  for (int rep = 0; rep < DBG_EXTRA_SYNCS; ++rep) gsync(grid, epoch);
#if DBG_DUMP == 1
  gsync(grid, epoch);
  { const _Float16* sp = (const _Float16*)(p.ws + OFF_SPEC);
    for (size_t i = (size_t)bid * 256 + threadIdx.x; i < (size_t)NBATCH * SEQ * DM; i += (size_t)nb * 256) p.out[i] = (float)sp[i]; }
#elif DBG_DUMP == 3
  gsync(grid, epoch);
  { const float* hd = (const float*)(p.ws + OFF_HID);
    for (size_t i = (size_t)bid * 256 + threadIdx.x; i < (size_t)NBATCH * SEQ * DM; i += (size_t)nb * 256) p.out[i] = i < (size_t)2 * 64 * 8448 ? hd[i] : 0.f; }
#elif DBG_DUMP == 2
  gsync(grid, epoch);
  { const u16* yc = (const u16*)(p.ws + OFF_YCT);
    for (size_t i = (size_t)bid * 256 + threadIdx.x; i < (size_t)NBATCH * SEQ * DM; i += (size_t)nb * 256) p.out[i] = i < (size_t)4 * 512 * TPB ? bf2f(yc[i]) : 0.f; }
#endif
}

extern "C" void kernel_launch(void* const* d_in, const int* in_sizes, int n_in, void* d_out, int out_size, void* d_ws, size_t ws_size,
                              hipStream_t stream) {
  static int grid_blocks = 0;
  if (!grid_blocks) {
    int dev = 0, cus = 0, per_cu = 0;
    (void)hipGetDevice(&dev);
    (void)hipDeviceGetAttribute(&cus, hipDeviceAttributeMultiprocessorCount, dev);
    (void)hipOccupancyMaxActiveBlocksPerMultiprocessor(&per_cu, fwd_mega, 256, 0);
    if (per_cu > 2) per_cu = 2;
    if (per_cu < 1) per_cu = 1;
    grid_blocks = cus * per_cu;
  }
  if (ws_size < WS_NEED) { fprintf(stderr, "workspace too small: %zu < %zu\n", ws_size, (size_t)WS_NEED); return; }
  Params p{};
  const float** pp = (const float**)&p;
  for (int i = 0; i < 26; ++i) pp[i] = (const float*)d_in[i];
  p.out = (float*)d_out;
  p.ws = (char*)d_ws;
  (void)hipMemsetAsync((char*)d_ws + OFF_BAR, 0, BAR_BYTES, stream);
  void* args[] = {&p};
  hipError_t e = hipLaunchCooperativeKernel((void*)fwd_mega, dim3(grid_blocks), dim3(256), args, 0, stream);
  if (e != hipSuccess) fprintf(stderr, "cooperative launch failed: %s (grid %d)\n", hipGetErrorString(e), grid_blocks);
}
```

```cpp
#include <hip/hip_runtime.h>
#include <hip/hip_cooperative_groups.h>
#include <cstdio>
namespace cg = cooperative_groups;
#define DI __device__ __forceinline__
typedef unsigned short u16;
typedef __attribute__((ext_vector_type(8))) short bf16x8;
typedef __attribute__((ext_vector_type(4))) short s16x4;
typedef __attribute__((ext_vector_type(16))) float f32x16;
typedef __attribute__((ext_vector_type(4))) unsigned u32x4;
typedef __attribute__((ext_vector_type(2))) unsigned u32x2;
typedef __attribute__((ext_vector_type(2))) __bf16 bf2_t;
typedef __attribute__((ext_vector_type(2))) float f2_t;
typedef __attribute__((ext_vector_type(2))) _Float16 h2_t;
#define MFMA(a, b, c) __builtin_amdgcn_mfma_f32_32x32x16_bf16((a), (b), (c), 0, 0, 0)

constexpr int DM = 1024, NBATCH = 4, SEQ = 8192, CTX = 256, TPB = 8448, MTOK = 33792;
constexpr int DFF = 2816;
#ifndef DBG_ZERO_HCTX
#define DBG_ZERO_HCTX 0
#endif
#ifndef DBG_DUMP
#define DBG_DUMP 0
#endif
#ifndef DBG_NOFFT
#define DBG_NOFFT 0
#endif
#ifndef DBG_SPLITC
#define DBG_SPLITC 0
#endif
#ifndef DBG_REP_GEMM
#define DBG_REP_GEMM 1
#endif
#ifndef DBG_REP_MLA
#define DBG_REP_MLA 1
#endif
#ifndef DBG_HEAVY_SYNC
#define DBG_HEAVY_SYNC 0
#endif
#ifndef DBG_REP_FFT
#define DBG_REP_FFT 1
#endif
#ifndef DBG_REP_PLAIN
#define DBG_REP_PLAIN 1
#endif
#ifndef DBG_EXTRA_SYNCS
#define DBG_EXTRA_SYNCS 0
#endif
#ifndef DBG_CG_SYNC
#define DBG_CG_SYNC 0
#endif
#ifndef DBG_SKIP_BR
#define DBG_SKIP_BR 0
#endif
#define DBG_FIRST_BR ((DBG_SKIP_BR & 1) ? ((DBG_SKIP_BR & 2) ? 2 : 1) : 0)
constexpr float LOG2E = 1.4426950408889634f;
constexpr float EPS = 1e-6f;

struct Params {
  const float *x, *c, *ctx, *c_ctx, *w_mod, *b_mod, *norm_g, *w_in, *kv_norm_g, *w_kv_up, *swa_sink, *hy_conv_w, *hy_conv_b,
      *hy_w1, *hy_b1, *hy_w2, *hy_b2, *hy_freq, *hy_w3, *hy_skip, *w_branch, *w_out, *w_up, *ffn_conv_w, *ffn_conv_b, *w_down;
  float* out;
  char* ws;
};

constexpr size_t OFF_WT_IN = 0;
constexpr size_t OFF_WT_GATE = OFF_WT_IN + (size_t)3456 * 1024 * 2;
constexpr size_t OFF_WT_KV = OFF_WT_GATE + (size_t)3072 * 1024 * 2;
constexpr size_t OFF_WT_BR = OFF_WT_KV + (size_t)1024 * 256 * 2;
constexpr size_t OFF_WT_OUT = OFF_WT_BR + (size_t)3 * 1024 * 512 * 2;
constexpr size_t OFF_WT_UP = OFF_WT_OUT + (size_t)1024 * 1024 * 2;
constexpr size_t OFF_WT_DOWN = OFF_WT_UP + (size_t)5632 * 1024 * 2;
constexpr size_t OFF_RH = OFF_WT_DOWN + (size_t)1024 * 2816 * 2;
constexpr size_t OFF_KN = OFF_RH + (size_t)MTOK * 1024 * 2;
constexpr size_t OFF_VT = OFF_KN + (size_t)MTOK * 512 * 2;
constexpr size_t OFF_KR = OFF_VT + (size_t)MTOK * 512 * 2;
constexpr size_t OFF_Q = OFF_KR + (size_t)MTOK * 32 * 2;
constexpr size_t OFF_SQ = OFF_Q + (size_t)MTOK * 768 * 2;
constexpr size_t OFF_CKV = OFF_SQ + (size_t)MTOK * 512 * 2;
constexpr size_t OFF_SK = OFF_CKV + (size_t)MTOK * 256 * 2;
constexpr size_t OFF_SVT = OFF_SK + (size_t)MTOK * 128 * 2;
constexpr size_t OFF_HYT = OFF_SVT + (size_t)MTOK * 128 * 2;
constexpr size_t OFF_SPEC = OFF_HYT + (size_t)MTOK * 1536 * 2;
constexpr size_t OFF_XCTX = OFF_SPEC + (size_t)1024 * 2 * 8192 * 4;
constexpr size_t OFF_MOD = OFF_XCTX + (size_t)1024 * 1024 * 4;
constexpr size_t OFF_ROPE = OFF_MOD + (size_t)2 * 5 * 6144 * 4;
constexpr size_t OFF_HID = OFF_ROPE + (size_t)8192 * 96 * 4;
constexpr size_t HID_LAYER = (size_t)64 * (8192 + 256) * 4;
constexpr size_t OFF_ESCR = OFF_HID + 2 * HID_LAYER;
constexpr size_t OFF_BAR = OFF_ESCR + (size_t)512 * 65536;
constexpr size_t BAR_BYTES = 3456 * 4;
constexpr size_t WS_NEED = OFF_BAR + BAR_BYTES;
constexpr size_t OFF_A = OFF_Q;
constexpr size_t OFF_MERGED = OFF_KN;
constexpr size_t OFF_Y = OFF_HYT;
constexpr size_t OFF_HP = OFF_KN;
constexpr size_t OFF_YCT = OFF_RH;
constexpr size_t OFF_YA = OFF_RH + (size_t)MTOK * 512 * 2;
static_assert(OFF_A + (size_t)MTOK * 2816 * 2 <= OFF_SPEC, "A overlay");
static_assert(WS_NEED <= (size_t)512 * 1024 * 1024, "ws");

DI int opq(int x) { asm volatile("" : "+v"(x)); return x; }
DI float ldsc1(const float* p) { return __hip_atomic_load(p, __ATOMIC_RELAXED, __HIP_MEMORY_SCOPE_AGENT); }
DI float bf2f(u16 v) { return __uint_as_float(((unsigned)v) << 16); }
DI unsigned pack2(float a, float b) { f2_t v = {a, b}; return __builtin_bit_cast(unsigned, __builtin_convertvector(v, bf2_t)); }
DI u16 f2bf(float a) { return (u16)(pack2(a, 0.f) & 0xffffu); }
DI float lo_bf(unsigned u) { return __uint_as_float(u << 16); }
DI float hi_bf(unsigned u) { return __uint_as_float(u & 0xffff0000u); }
DI int crow(int i, int h) { return (i & 3) + 8 * (i >> 2) + 4 * h; }
DI float wave_sum(float v) {
#pragma unroll
  for (int o = 32; o > 0; o >>= 1) v += __shfl_xor(v, o);
  return v;
}
DI float sinrev(float r) { return __builtin_amdgcn_sinf(r - floorf(r)); }
DI float cosrev(float r) { return __builtin_amdgcn_cosf(r - floorf(r)); }
#if DBG_TRIVTW
#define COSREV(f) (1.0f)
#define SINREV(f) (0.0f * (f))
#else
#define COSREV(f) cosrev(f)
#define SINREV(f) sinrev(f)
#endif
#define SYNC() __syncthreads()
DI float2 cmul(float2 a, float2 b) { return make_float2(a.x * b.x - a.y * b.y, a.x * b.y + a.y * b.x); }
DI float2 cmulc(float2 a, float2 b) { return make_float2(a.x * b.x + a.y * b.y, a.y * b.x - a.x * b.y); }
#ifndef DBG_NOSWZ
#define DBG_NOSWZ 0
#endif
DI int fphys(int i) { return DBG_NOSWZ ? i : (i ^ ((i >> 4) & 15)); }
DI float2 twid_rev(float fr) { return make_float2(COSREV(fr), -SINREV(fr)); }

DI float2 root16(int e) {
  const float C1 = 0.92387953251128674f, S1 = 0.38268343236508977f, R = 0.70710678118654752f;
  switch (e) {
    case 0: return make_float2(1.f, 0.f);
    case 1: return make_float2(C1, -S1);
    case 2: return make_float2(R, -R);
    case 3: return make_float2(S1, -C1);
    case 4: return make_float2(0.f, -1.f);
    case 5: return make_float2(-S1, -C1);
    case 6: return make_float2(-R, -R);
    default: return make_float2(-C1, -S1);
  }
}
template <int R, int HALF, int S, bool INV, bool HASW>
DI void fft_stage(float2 (&v)[R], const float2 (&wp)[4]) {
#pragma unroll
  for (int idx = 0; idx < R / 2; ++idx) {
    const int blk = idx / HALF, jj = idx % HALF;
    const int j0 = blk * 2 * HALF + jj, j1 = j0 + HALF;
    const int e = jj * (8 / HALF);
    float2 tw = root16(e);
    if (HASW) { if (e == 0) tw = wp[S]; else tw = cmul(wp[S], tw); }
    const bool triv = (!HASW) && (e == 0);
    if (!INV) {
      float2 a = v[j0], b = v[j1];
      v[j0] = make_float2(a.x + b.x, a.y + b.y);
      float2 d = make_float2(a.x - b.x, a.y - b.y);
      v[j1] = triv ? d : cmul(d, tw);
    } else {
      float2 t = triv ? v[j1] : cmulc(v[j1], tw);
      float2 a = v[j0];
      v[j0] = make_float2(a.x + t.x, a.y + t.y);
      v[j1] = make_float2(a.x - t.x, a.y - t.y);
    }
  }
}
template <bool INV> DI void fft_local8(float2 (&v)[8], const float2 (&wp)[4]) {
  if (!INV) { fft_stage<8, 4, 0, false, true>(v, wp); fft_stage<8, 2, 1, false, true>(v, wp); fft_stage<8, 1, 2, false, true>(v, wp); }
  else      { fft_stage<8, 1, 2, true, true>(v, wp); fft_stage<8, 2, 1, true, true>(v, wp); fft_stage<8, 4, 0, true, true>(v, wp); }
}
template <bool INV> DI void fft_local16(float2 (&v)[16], const float2 (&wp)[4]) {
  if (!INV) { fft_stage<16, 8, 0, false, false>(v, wp); fft_stage<16, 4, 1, false, false>(v, wp); fft_stage<16, 2, 2, false, false>(v, wp); fft_stage<16, 1, 3, false, false>(v, wp); }
  else      { fft_stage<16, 1, 3, true, false>(v, wp); fft_stage<16, 2, 2, true, false>(v, wp); fft_stage<16, 4, 1, true, false>(v, wp); fft_stage<16, 8, 0, true, false>(v, wp); }
}

template <int LQ, bool INV> DI void fft_pass8(float2* lds, int tid) {
  constexpr int q = 1 << LQ;
#pragma unroll 1
  for (int it = 0; it < 4; ++it) {
    const int task = tid + 256 * it;
    const int p = task & (q - 1);
    const int g = task >> LQ;
    const int base = g * 8 * q + p;
    float2 v[8];
#pragma unroll
    for (int j = 0; j < 8; ++j) v[j] = lds[fphys(base + j * q)];
    float2 wp[4];
    wp[0] = twid_rev((float)p * (1.0f / (float)(8 * q)));
    wp[1] = cmul(wp[0], wp[0]);
    wp[2] = cmul(wp[1], wp[1]);
    wp[3] = wp[2];
    fft_local8<INV>(v, wp);
#pragma unroll
    for (int j = 0; j < 8; ++j) lds[fphys(base + j * q)] = v[j];
  }
}
template <bool INV> DI void fft_pass16(float2* lds, int tid) {
#pragma unroll 1
  for (int it = 0; it < 2; ++it) {
    const int g = tid + 256 * it;
    float2 v[16];
    const int sw = DBG_NOSWZ ? 0 : (g & 15);
#pragma unroll
    for (int j = 0; j < 16; ++j) v[j] = lds[g * 16 + (j ^ sw)];
    float2 wp[4] = {make_float2(1.f, 0.f), make_float2(1.f, 0.f), make_float2(1.f, 0.f), make_float2(1.f, 0.f)};
    fft_local16<INV>(v, wp);
#pragma unroll
    for (int j = 0; j < 16; ++j) lds[g * 16 + (j ^ sw)] = v[j];
  }
}
#ifndef DBG_FFTPASSES
#define DBG_FFTPASSES 15
#endif
DI void fft8192_fwd(float2* lds, int tid) {
  if (DBG_FFTPASSES & 1) { fft_pass8<10, false>(lds, tid); SYNC(); }
  if (DBG_FFTPASSES & 2) { fft_pass8<7, false>(lds, tid); SYNC(); }
  if (DBG_FFTPASSES & 4) { fft_pass8<4, false>(lds, tid); SYNC(); }
  if (DBG_FFTPASSES & 8) { fft_pass16<false>(lds, tid); SYNC(); }
}
DI void fft8192_inv(float2* lds, int tid) {
  fft_pass16<true>(lds, tid); SYNC();
  fft_pass8<4, true>(lds, tid); SYNC();
  fft_pass8<7, true>(lds, tid); SYNC();
  fft_pass8<10, true>(lds, tid); SYNC();
}

template <bool SWAP, bool ATR = false, int MTW = 2>
DI void gemm_main(const u16* __restrict__ A, int lda, int a_row0, int a_lo, int a_hi, int a_kstep,
                  const u16* __restrict__ B, int ldb, int nk, f32x16 (&acc)[MTW][2], char* smem) {
  constexpr int ROWS = MTW * 64, NA = MTW * 2;
  const int tid = opq(threadIdx.x), lane = tid & 63, wave = tid >> 6, wm = wave >> 1, wn = wave & 1, r = lane & 31, h = lane >> 5;
  char* sA = smem;
  char* sB = smem + ROWS * 144;
  const u16* ap[NA];
  const u16* bp[4];
  int loa[NA], lob[4];
#pragma unroll
  for (int i = 0; i < NA; ++i) {
    const int idx = tid + 256 * i, row = idx >> 3, ch = idx & 7;
    if (ATR) {
      ap[i] = A + (size_t)(idx & 63) * lda + a_row0 + (idx >> 6) * 8;
    } else {
      const int gr = min(max(a_row0 + row, a_lo), a_hi);
      ap[i] = A + (size_t)gr * lda + ch * 8;
    }
    loa[i] = row * 144 + ch * 16;
  }
#pragma unroll
  for (int i = 0; i < 4; ++i) {
    const int idx = tid + 256 * i, row = idx >> 3, ch = idx & 7;
    bp[i] = B + (size_t)row * ldb + ch * 8;
    lob[i] = row * 144 + ch * 16;
  }
  u32x4 ra0[NA], rb0[4];
#define GEMM_LOAD(RA, RB, KT)                                                                                         \
  _Pragma("unroll") for (int i = 0; i < NA; ++i)                                                                      \
    RA[i] = *(const u32x4*)(ap[i] + (ATR ? (size_t)(KT) * 64 * lda : (size_t)(KT) * a_kstep));                        \
  _Pragma("unroll") for (int i = 0; i < 4; ++i) RB[i] = *(const u32x4*)(bp[i] + (KT) * 64);
#define GEMM_STASH(RA, RB)                                                                                            \
  _Pragma("unroll") for (int i = 0; i < NA; ++i) {                                                                    \
    if (ATR) {                                                                                                        \
      const int idx = tid + 256 * i, krow = idx & 63, mch = idx >> 6;                                                 \
      _Pragma("unroll") for (int e = 0; e < 4; ++e) {                                                                 \
        *(u16*)(sA + (mch * 8 + 2 * e) * 144 + krow * 2) = (u16)(RA[i][e] & 0xffffu);                                 \
        *(u16*)(sA + (mch * 8 + 2 * e + 1) * 144 + krow * 2) = (u16)(RA[i][e] >> 16);                                 \
      }                                                                                                               \
    } else {                                                                                                          \
      *(u32x4*)(sA + loa[i]) = RA[i];                                                                                 \
    }                                                                                                                 \
  }                                                                                                                   \
  _Pragma("unroll") for (int i = 0; i < 4; ++i) *(u32x4*)(sB + lob[i]) = RB[i];
#define GEMM_COMPUTE()                                                                                                \
  _Pragma("unroll") for (int ks = 0; ks < 4; ++ks) {                                                                  \
    bf16x8 af[MTW], bfr[2];                                                                                           \
    _Pragma("unroll") for (int t = 0; t < MTW; ++t) af[t] = *(const bf16x8*)(pa + t * 32 * 144 + ks * 32);            \
    _Pragma("unroll") for (int t = 0; t < 2; ++t) bfr[t] = *(const bf16x8*)(pb + t * 32 * 144 + ks * 32);             \
    _Pragma("unroll") for (int mt = 0; mt < MTW; ++mt)                                                                \
      _Pragma("unroll") for (int nt = 0; nt < 2; ++nt)                                                                \
        acc[mt][nt] = SWAP ? MFMA(bfr[nt], af[mt], acc[mt][nt]) : MFMA(af[mt], bfr[nt], acc[mt][nt]);                 \
  }
  GEMM_LOAD(ra0, rb0, 0)
#pragma unroll
  for (int mt = 0; mt < MTW; ++mt)
#pragma unroll
    for (int nt = 0; nt < 2; ++nt)
#pragma unroll
      for (int i = 0; i < 16; ++i) acc[mt][nt][i] = 0.f;
  const char* pa = sA + (wm * (MTW * 32) + r) * 144 + h * 16;
  const char* pb = sB + (wn * 64 + r) * 144 + h * 16;
#pragma unroll 1
  for (int kk = 0; kk < nk; ++kk) {
    __syncthreads();
    GEMM_STASH(ra0, rb0)
    __syncthreads();
    if (kk + 1 < nk) { GEMM_LOAD(ra0, rb0, kk + 1) }
    GEMM_COMPUTE()
  }
#undef GEMM_LOAD
#undef GEMM_STASH
#undef GEMM_COMPUTE
}
template <int MTW>
DI void store_rowmajor(const f32x16 (&acc)[MTW][2], u16* C, int ldc, int m0, int ncol0, float scale) {
  const int tid = opq(threadIdx.x), lane = tid & 63, wave = tid >> 6, wm = wave >> 1, wn = wave & 1, r = lane & 31, h = lane >> 5;
#pragma unroll
  for (int mt = 0; mt < MTW; ++mt)
#pragma unroll
    for (int nt = 0; nt < 2; ++nt)
#pragma unroll
      for (int g = 0; g < 4; ++g) {
        const int m = m0 + wm * (MTW * 32) + mt * 32 + r, n = ncol0 + wn * 64 + nt * 32 + 8 * g + 4 * h;
        u32x2 pk;
        pk.x = pack2(acc[mt][nt][4 * g] * scale, acc[mt][nt][4 * g + 1] * scale);
        pk.y = pack2(acc[mt][nt][4 * g + 2] * scale, acc[mt][nt][4 * g + 3] * scale);
        *(u32x2*)(C + (size_t)m * ldc + n) = pk;
      }
}
template <int MTW>
DI void store_transposed(const f32x16 (&acc)[MTW][2], u16* T, int ldt, int trow0, int j0) {
  const int tid = opq(threadIdx.x), lane = tid & 63, wave = tid >> 6, wm = wave >> 1, wn = wave & 1, r = lane & 31, h = lane >> 5;
#pragma unroll
  for (int mt = 0; mt < MTW; ++mt)
#pragma unroll
    for (int nt = 0; nt < 2; ++nt)
#pragma unroll
      for (int g = 0; g < 4; ++g) {
        const int n = trow0 + wn * 64 + nt * 32 + r, m = j0 + wm * (MTW * 32) + mt * 32 + 8 * g + 4 * h;
        u32x2 pk;
        pk.x = pack2(acc[mt][nt][4 * g], acc[mt][nt][4 * g + 1]);
        pk.y = pack2(acc[mt][nt][4 * g + 2], acc[mt][nt][4 * g + 3]);
        *(u32x2*)(T + (size_t)n * ldt + m) = pk;
      }
}

constexpr int NCONV_TILES = 864 + 768 + 64 + 384 + 256 + 1408 + 704;
DI void conv_tile(const Params& p, int l, int tile, char* smem) {
  float* t = (float*)smem;
  const int tid = opq(threadIdx.x);
  int mat, tn, tk;
  if (tile < 864) { mat = 0; tn = tile / 16; tk = tile % 16; }
  else if (tile < 1632) { tile -= 864; mat = 1; tn = tile / 16; tk = tile % 16; }
  else if (tile < 1696) { tile -= 1632; mat = 2; tn = tile / 4; tk = tile % 4; }
  else if (tile < 2080) { tile -= 1696; mat = 3; tn = tile / 8; tk = tile % 8; }
  else if (tile < 2336) { tile -= 2080; mat = 4; tn = tile / 16; tk = tile % 16; }
  else if (tile < 3744) { tile -= 2336; mat = 5; tn = tile / 16; tk = tile % 16; }
  else { tile -= 3744; mat = 6; tn = tile / 44; tk = tile % 44; }
  const int k0 = tk * 64;
  const int nn = tid & 63;
  int np = tn * 64 + nn;
  const float* src; int ld; int col;
  if (mat == 0) { src = p.w_in + (size_t)l * 1024 * 6432; ld = 6432; col = np < 1024 ? np : (np < 3328 ? np + 32 : (np < 3360 ? np - 3328 + 1024 : -1)); }
  else if (mat == 1) { src = p.w_in + (size_t)l * 1024 * 6432; ld = 6432; col = 3360 + np; }
  else if (mat == 2) { src = p.w_kv_up + (size_t)l * 256 * 1024; ld = 1024; col = np < 512 ? (np >> 6) * 128 + (np & 63) : ((np - 512) >> 6) * 128 + 64 + (np & 63); }
  else if (mat == 3) { const int br = tn / 16; np = (tn % 16) * 64 + nn; src = p.w_branch + (size_t)(l * 3 + br) * 512 * 1024; ld = 1024; col = np; }
  else if (mat == 4) { src = p.w_out + (size_t)l * 1024 * 1024; ld = 1024; col = np; }
  else if (mat == 5) { src = p.w_up + (size_t)l * 1024 * 5632; ld = 5632; const int blk = np >> 7, rr = np & 127; col = rr < 64 ? blk * 64 + rr : 2816 + blk * 64 + rr - 64; }
  else { src = p.w_down + (size_t)l * 2816 * 1024; ld = 1024; col = np; }
#pragma unroll 4
  for (int i = 0; i < 16; ++i) {
    const int kk = (tid >> 6) + 4 * i;
    float v = 0.f;
    if (col >= 0) v = src[(size_t)(k0 + kk) * ld + col];
    if (mat == 2) v *= p.kv_norm_g[l * 256 + k0 + kk];
    t[kk * 65 + nn] = v;
  }
  __syncthreads();
  {
    const int n2 = tid >> 2, kq = (tid & 3) * 16;
    const int drow = tn * 64 + n2;
    u16* dst;
    if (mat == 0) dst = (u16*)(p.ws + OFF_WT_IN) + (size_t)drow * 1024;
    else if (mat == 1) dst = (u16*)(p.ws + OFF_WT_GATE) + (size_t)drow * 1024;
    else if (mat == 2) dst = (u16*)(p.ws + OFF_WT_KV) + (size_t)drow * 256;
    else if (mat == 3) dst = (u16*)(p.ws + OFF_WT_BR) + (size_t)drow * 512;
    else if (mat == 4) dst = (u16*)(p.ws + OFF_WT_OUT) + (size_t)drow * 1024;
    else if (mat == 5) dst = (u16*)(p.ws + OFF_WT_UP) + (size_t)drow * 1024;
    else dst = (u16*)(p.ws + OFF_WT_DOWN) + (size_t)drow * 2816;
    unsigned pk[8];
#pragma unroll
    for (int j = 0; j < 8; ++j) pk[j] = pack2(t[(kq + 2 * j) * 65 + n2], t[(kq + 2 * j + 1) * 65 + n2]);
    u32x4* d4 = (u32x4*)(dst + k0 + kq);
    d4[0] = u32x4{pk[0], pk[1], pk[2], pk[3]};
    d4[1] = u32x4{pk[4], pk[5], pk[6], pk[7]};
  }
  __syncthreads();
}

DI void mod_item(const Params& p, int item, char* smem) {
  float* sv = (float*)smem;
  float* red = sv + 5 * 1024;
  const int tid = opq(threadIdx.x);
  const int l = item / 96, cg0 = (item % 96) * 64;
  for (int i = tid; i < 5 * 1024; i += 256) {
    const int v = i >> 10, k = i & 1023;
    const float c = v < 4 ? p.c[v * 1024 + k] : p.c_ctx[k];
    sv[i] = c / (1.f + __expf(-c));
  }
  __syncthreads();
  const int kq = tid >> 6, cc = tid & 63, col = cg0 + cc;
  float a[5] = {0.f, 0.f, 0.f, 0.f, 0.f};
  const float* w = p.w_mod + (size_t)l * 1024 * 6144 + col;
#pragma unroll 8
  for (int k = kq * 256; k < kq * 256 + 256; ++k) {
    const float wv = w[(size_t)k * 6144];
#pragma unroll
    for (int v = 0; v < 5; ++v) a[v] += sv[v * 1024 + k] * wv;
  }
#pragma unroll
  for (int v = 0; v < 5; ++v) red[(kq * 5 + v) * 64 + cc] = a[v];
  __syncthreads();
  for (int i = tid; i < 5 * 64; i += 256) {
    const int v = i >> 6, c2 = i & 63;
    float s = p.b_mod[l * 6144 + cg0 + c2];
#pragma unroll
    for (int q = 0; q < 4; ++q) s += red[(q * 5 + v) * 64 + c2];
    ((float*)(p.ws + OFF_MOD))[(l * 5 + v) * 6144 + cg0 + c2] = s;
  }
  __syncthreads();
}

DI void rope_item(const Params& p, int item) {
  const int e = item * 256 + opq(threadIdx.x);
  const int pos = e / 48, f = e % 48;
  const int row = pos >> 6, colp = pos & 63;
  float* base = (float*)(p.ws + OFF_ROPE);
  float ang; float *cd, *sd;
  if (f < 16) {
    const int fi = f & 7;
    const float inv = exp2f(-(float)fi * (13.287712379549449f / 8.f));
    ang = (f < 8 ? (float)row : (float)colp) * inv;
    cd = base + pos * 16 + f; sd = base + 8192 * 16 + pos * 16 + f;
  } else {
    const int f2 = f - 16, fi = f2 & 15;
    const float inv = exp2f(-(float)fi * (13.287712379549449f / 16.f));
    ang = (f2 < 16 ? (float)row : (float)colp) * inv;
    cd = base + 2 * 8192 * 16 + pos * 32 + f2; sd = base + 2 * 8192 * 16 + 8192 * 32 + pos * 32 + f2;
  }
  const float rev = ang * 0.15915494309189535f;
  *cd = cosrev(rev);
  *sd = sinrev(rev);
}

DI void hid_item(const Params& p, int item, char* smem) {
  float* feat = (float*)smem;
  float* h1 = feat + 4 * 36;
  const int tid = opq(threadIdx.x);
  const int l = item / 264; const int it = item % 264;
  int L, pos00; float* dst;
  if (it < 256) { L = 8192; pos00 = it * 32; dst = (float*)(p.ws + OFF_HID + l * HID_LAYER); }
  else { L = 256; pos00 = (it - 256) * 32; dst = (float*)(p.ws + OFF_HID + l * HID_LAYER) + 64 * 8192; }
  const int pp = tid >> 6, j = tid & 63;
#pragma unroll 1
  for (int sub = 0; sub < 8; ++sub) {
    const int pos = pos00 + sub * 4 + pp;
    if (j < 33) {
      float fv;
      if (j == 0) fv = (float)pos / (float)(L - 1);
      else {
        const int bi = (j - 1) & 15;
        const float band = 1e-4f + (float)bi * ((15.f - 1e-4f) / 15.f);
        const float rev = (float)pos * band / (float)L;
        fv = (j <= 16) ? cosrev(rev) : -sinrev(rev);
      }
      feat[pp * 36 + j] = fv;
    }
    __syncthreads();
    {
      float s = p.hy_b1[l * 64 + j];
      const float* w1 = p.hy_w1 + (size_t)l * 33 * 64;
#pragma unroll
      for (int f = 0; f < 33; ++f) s += feat[pp * 36 + f] * w1[f * 64 + j];
      s *= p.hy_freq[l * 128 + j];
      h1[pp * 64 + j] = sinrev(s * 0.15915494309189535f);
    }
    __syncthreads();
    {
      float s = p.hy_b2[l * 64 + j];
      const float* w2 = p.hy_w2 + (size_t)l * 64 * 64;
#pragma unroll 8
      for (int i = 0; i < 64; ++i) s += h1[pp * 64 + i] * w2[i * 64 + j];
      s *= p.hy_freq[l * 128 + 64 + j];
      dst[(size_t)j * L + pos] = sinrev(s * 0.15915494309189535f);
    }
    __syncthreads();
  }
}

DI const float* xrow_src(const float* xl, const float* xc, int m) {
  const int b = m / TPB, j = m - b * TPB;
  return j < CTX ? xc + (size_t)(b * CTX + j) * DM : xl + (size_t)(b * SEQ + j - CTX) * DM;
}
DI void row_pass(const Params& p, int mode, const float* xl_src, const float* xc_src, float* xl_dst, float* xc_dst,
                 const u16* ybuf, const float* gy, int gate_off, int modl_gate,
                 bool has_next, const float* gn, int modl_next, int sh_off, int sc_off, u16* hdst, bool skip_ctx_rows) {
  const int tid0 = opq(threadIdx.x);
  const int lane = tid0 & 63;
  const int gw = blockIdx.x * 4 + (tid0 >> 6), nw = gridDim.x * 4;
  const float* modb = (const float*)(p.ws + OFF_MOD);
  const int per = (MTOK + nw - 1) / nw;
  const int m_beg = gw * per, m_end = min(m_beg + per, MTOK);
  int cur_v = -1;
  float4 gg[4], gs[4], shv[4];
#pragma unroll
  for (int i = 0; i < 4; ++i) { gg[i] = make_float4(0.f, 0.f, 0.f, 0.f); gs[i] = gg[i]; shv[i] = gg[i]; }
  const bool do_h = (mode == 0) || has_next;
  float4 xv_n[4];
  u32x2 yr_n[4];
#pragma unroll
  for (int i = 0; i < 4; ++i) { xv_n[i] = make_float4(0.f, 0.f, 0.f, 0.f); yr_n[i] = u32x2{0u, 0u}; }
  if (m_beg < m_end) {
    const float* xs0 = xrow_src(xl_src, xc_src, m_beg);
#pragma unroll
    for (int i = 0; i < 4; ++i) {
      xv_n[i] = *(const float4*)(xs0 + lane * 4 + 256 * i);
      if (mode == 1) yr_n[i] = *(const u32x2*)(ybuf + (size_t)m_beg * DM + lane * 4 + 256 * i);
    }
  }
  for (int m = m_beg; m < m_end; ++m) {
    const int b = m / TPB, j = m - b * TPB;
    float4 xv[4];
    u32x2 yr[4];
#pragma unroll
    for (int i = 0; i < 4; ++i) { xv[i] = xv_n[i]; yr[i] = yr_n[i]; }
    if (m + 1 < m_end) {
      const float* xs1 = xrow_src(xl_src, xc_src, m + 1);
#pragma unroll
      for (int i = 0; i < 4; ++i) {
        xv_n[i] = *(const float4*)(xs1 + lane * 4 + 256 * i);
        if (mode == 1) yr_n[i] = *(const u32x2*)(ybuf + (size_t)(m + 1) * DM + lane * 4 + 256 * i);
      }
    }
    if (skip_ctx_rows && j < CTX) continue;
    const int v = j < CTX ? 4 : b;
    if (v != cur_v) {
      cur_v = v;
#pragma unroll
      for (int i = 0; i < 4; ++i) {
        const int c = lane * 4 + 256 * i;
        if (mode == 1) {
          const float4 g4 = *(const float4*)(gy + c);
          const float4 t4 = *(const float4*)(modb + (size_t)(modl_gate * 5 + v) * 6144 + gate_off + c);
          gg[i] = make_float4(g4.x * t4.x, g4.y * t4.y, g4.z * t4.z, g4.w * t4.w);
        }
        if (do_h) {
          const float* mb = modb + (size_t)(modl_next * 5 + v) * 6144;
          const float4 g4 = *(const float4*)(gn + c);
          const float4 sc = *(const float4*)(mb + sc_off + c);
          shv[i] = *(const float4*)(mb + sh_off + c);
          gs[i] = make_float4(g4.x * (1.f + sc.x), g4.y * (1.f + sc.y), g4.z * (1.f + sc.z), g4.w * (1.f + sc.w));
        }
      }
    }
    if (mode == 1) {
      float yv[4][4];
      float ss = 0.f;
#pragma unroll
      for (int i = 0; i < 4; ++i) {
        const u32x2 u = yr[i];
        yv[i][0] = lo_bf(u.x); yv[i][1] = hi_bf(u.x); yv[i][2] = lo_bf(u.y); yv[i][3] = hi_bf(u.y);
#pragma unroll
        for (int e = 0; e < 4; ++e) ss += yv[i][e] * yv[i][e];
      }
      ss = wave_sum(ss);
      const float rstd = rsqrtf(ss * (1.f / DM) + EPS);
#pragma unroll
      for (int i = 0; i < 4; ++i) {
        xv[i].x += gg[i].x * (yv[i][0] * rstd);
        xv[i].y += gg[i].y * (yv[i][1] * rstd);
        xv[i].z += gg[i].z * (yv[i][2] * rstd);
        xv[i].w += gg[i].w * (yv[i][3] * rstd);
      }
      float* xd = (j < CTX) ? xc_dst + (size_t)(b * CTX + j) * DM : xl_dst + (size_t)(b * SEQ + j - CTX) * DM;
#pragma unroll
      for (int i = 0; i < 4; ++i) *(float4*)(xd + lane * 4 + 256 * i) = xv[i];
    }
    if (do_h) {
      float ss = 0.f;
#pragma unroll
      for (int i = 0; i < 4; ++i) ss += xv[i].x * xv[i].x + xv[i].y * xv[i].y + xv[i].z * xv[i].z + xv[i].w * xv[i].w;
      ss = wave_sum(ss);
      const float rstd = rsqrtf(ss * (1.f / DM) + EPS);
#pragma unroll
      for (int i = 0; i < 4; ++i) {
        const int c = lane * 4 + 256 * i;
        u32x2 pk;
        pk.x = pack2(xv[i].x * rstd * gs[i].x + shv[i].x, xv[i].y * rstd * gs[i].y + shv[i].y);
        pk.y = pack2(xv[i].z * rstd * gs[i].z + shv[i].z, xv[i].w * rstd * gs[i].w + shv[i].w);
        *(u32x2*)(hdst + (size_t)m * DM + c) = pk;
      }
    }
  }
}

constexpr float QS_MLA = 0.10206207261596577f * LOG2E;
constexpr float QS_SWA = 0.125f * LOG2E;

DI void rope32(f32x16& a, const float* cm, const float* sm, int pos, int h) {
#pragma unroll
  for (int i = 0; i < 8; ++i) {
    const int f = crow(i, h);
    const float c = cm[pos * 16 + f], s = sm[pos * 16 + f];
    const float x1 = a[i], x2 = a[i + 8];
    a[i] = x1 * c - x2 * s;
    a[i + 8] = x2 * c + x1 * s;
    if ((i & 3) == 3) __builtin_amdgcn_sched_barrier(0);
  }
}
DI void rope64(f32x16& a0, f32x16& a1, const float* cs, const float* ss, int pos, int h) {
#pragma unroll
  for (int i = 0; i < 16; ++i) {
    const int f = crow(i, h);
    const float c = cs[pos * 32 + f], s = ss[pos * 32 + f];
    const float x1 = a0[i], x2 = a1[i];
    a0[i] = x1 * c - x2 * s;
    a1[i] = x2 * c + x1 * s;
    if ((i & 3) == 3) __builtin_amdgcn_sched_barrier(0);
  }
}

DI void inproj_tile(const Params& p, int tile, char* smem) {
  const int mt_i = tile / 27, nt_i = tile % 27;
  const int m0 = mt_i * 192;
  const int tid = opq(threadIdx.x), lane = tid & 63, wave = tid >> 6, wm = wave >> 1, wn = wave & 1, r = lane & 31, h = lane >> 5;
  const u16* hbuf = (const u16*)(p.ws + OFF_RH);
  const u16* wt = (const u16*)(p.ws + OFF_WT_IN) + (size_t)nt_i * 128 * 1024;
  const int b = m0 / TPB, j0 = m0 - b * TPB;
  const float* cm = (const float*)(p.ws + OFF_ROPE);
  const float* sm = cm + 8192 * 16;
  const float* cs = sm + 8192 * 16;
  const float* ss = cs + 8192 * 32;
  f32x16 acc[3][2];
  if (nt_i >= 13 && nt_i <= 25) {
    gemm_main<false>(hbuf, 1024, m0, 0, MTOK - 1, 64, wt, 1024, 16, acc, smem);
    if (nt_i == 13) store_transposed(acc, (u16*)(p.ws + OFF_SVT), TPB, b * 128, j0);
    else store_transposed(acc, (u16*)(p.ws + OFF_HYT), TPB, b * 1536 + (nt_i - 14) * 128, j0);
    return;
  }
  gemm_main<true>(hbuf, 1024, m0, 0, MTOK - 1, 64, wt, 1024, 16, acc, smem);
  if (nt_i < 6) {
#pragma unroll
    for (int ntl = 0; ntl < 2; ++ntl) {
      const int s32 = nt_i * 4 + wn * 2 + ntl;
      if (s32 % 3 == 2) {
#pragma unroll
        for (int mt = 0; mt < 3; ++mt) {
          const int jr = j0 + wm * 96 + mt * 32 + r;
          if (jr >= CTX) rope32(acc[mt][ntl], cm, sm, jr - CTX, h);
        }
      }
    }
    store_rowmajor(acc, (u16*)(p.ws + OFF_Q), 768, m0, nt_i * 128, QS_MLA);
  } else if (nt_i < 8) {
    store_rowmajor(acc, (u16*)(p.ws + OFF_CKV), 256, m0, (nt_i - 6) * 128, 1.f);
  } else if (nt_i < 12) {
#pragma unroll
    for (int mt = 0; mt < 3; ++mt) {
      const int jr = j0 + wm * 96 + mt * 32 + r;
      if (jr >= CTX) rope64(acc[mt][0], acc[mt][1], cs, ss, jr - CTX, h);
    }
    store_rowmajor(acc, (u16*)(p.ws + OFF_SQ), 512, m0, (nt_i - 8) * 128, QS_SWA);
  } else if (nt_i == 12) {
#pragma unroll
    for (int mt = 0; mt < 3; ++mt) {
      const int jr = j0 + wm * 96 + mt * 32 + r;
      if (jr >= CTX) rope64(acc[mt][0], acc[mt][1], cs, ss, jr - CTX, h);
    }
    store_rowmajor(acc, (u16*)(p.ws + OFF_SK), 128, m0, 0, 1.f);
  } else {
    if (wn == 0) {
      u16* kr = (u16*)(p.ws + OFF_KR);
#pragma unroll
      for (int mt = 0; mt < 3; ++mt) {
        const int ml = wm * 96 + mt * 32 + r;
        if (j0 + ml >= CTX) rope32(acc[mt][0], cm, sm, j0 + ml - CTX, h);
#pragma unroll
        for (int g = 0; g < 4; ++g) {
          u32x2 pk;
          pk.x = pack2(acc[mt][0][4 * g], acc[mt][0][4 * g + 1]);
          pk.y = pack2(acc[mt][0][4 * g + 2], acc[mt][0][4 * g + 3]);
          *(u32x2*)(kr + (size_t)(m0 + ml) * 32 + 8 * g + 4 * h) = pk;
        }
      }
    }
  }
}

DI void kvup_tile(const Params& p, int tile, char* smem) {
  const int mt_i = tile >> 3, nt_i = tile & 7;
  const int m0 = mt_i * 192;
  const int tid = opq(threadIdx.x), lane = tid & 63, wave = tid >> 6, wm = wave >> 1, r = lane & 31, h = lane >> 5;
  const u16* ckv = (const u16*)(p.ws + OFF_CKV);
  float* rs = (float*)(smem + (192 + 128) * 144);
#pragma unroll
  for (int pass = 0; pass < 2; ++pass) {
    const int row = pass * 128 + (tid >> 1), half = tid & 1;
    const int rowc = min(row, 191);
    const u32x4* src = (const u32x4*)(ckv + (size_t)(m0 + rowc) * 256 + half * 128);
    float ss = 0.f;
#pragma unroll
    for (int i = 0; i < 16; ++i) {
      const u32x4 u = src[i];
      const unsigned w[4] = {u.x, u.y, u.z, u.w};
#pragma unroll
      for (int e = 0; e < 4; ++e) { const float a = lo_bf(w[e]), c = hi_bf(w[e]); ss += a * a + c * c; }
    }
    ss += __shfl_xor(ss, 1);
    if (half == 0 && row < 192) rs[row] = rsqrtf(ss * (1.f / 256.f) + EPS);
  }
  const u16* wt = (const u16*)(p.ws + OFF_WT_KV) + (size_t)nt_i * 128 * 256;
  const int b = m0 / TPB, j0 = m0 - b * TPB;
  f32x16 acc[3][2];
  if (nt_i < 4) {
    gemm_main<true>(ckv, 256, m0, 0, MTOK - 1, 64, wt, 256, 4, acc, smem);
#pragma unroll
    for (int mt = 0; mt < 3; ++mt) {
      const float sc = rs[wm * 96 + mt * 32 + r];
#pragma unroll
      for (int nt = 0; nt < 2; ++nt)
#pragma unroll
        for (int i = 0; i < 16; ++i) acc[mt][nt][i] *= sc;
    }
    store_rowmajor(acc, (u16*)(p.ws + OFF_KN), 512, m0, nt_i * 128, 1.f);
  } else {
    gemm_main<false>(ckv, 256, m0, 0, MTOK - 1, 64, wt, 256, 4, acc, smem);
#pragma unroll
    for (int mt = 0; mt < 3; ++mt)
#pragma unroll
      for (int i = 0; i < 16; ++i) {
        const float sc = rs[wm * 96 + mt * 32 + crow(i, h)];
        acc[mt][0][i] *= sc;
        acc[mt][1][i] *= sc;
      }
    store_transposed(acc, (u16*)(p.ws + OFF_VT), TPB, b * 512 + (nt_i - 4) * 128, j0);
  }
  __syncthreads();
}

DI void merge_tile(const Params& p, int tile, char* smem) {
  const int mt_i = tile >> 3, nt_i = tile & 7;
  const int m0 = mt_i * 192;
  const u16* hp = (const u16*)(p.ws + OFF_RH);
  const int tid = opq(threadIdx.x), lane = tid & 63, wave = tid >> 6, wm = wave >> 1, wn = wave & 1, r = lane & 31, h = lane >> 5;
  u16* C = (u16*)(p.ws + OFF_MERGED);
#pragma unroll 1
  for (int br = 0; br < 3; ++br) {
    if ((DBG_SKIP_BR >> br) & 1) continue;
    f32x16 acc[3][2];
    gemm_main<true>(hp, 1024, m0, 0, MTOK - 1, 64, (const u16*)(p.ws + OFF_WT_GATE) + (size_t)(br * 1024 + nt_i * 128) * 1024, 1024, 16, acc, smem);
    u32x2* sgp = (u32x2*)(p.ws + OFF_ESCR + (size_t)blockIdx.x * 65536) + tid * 24;
#pragma unroll
    for (int a = 0; a < 3; ++a)
#pragma unroll
      for (int b2 = 0; b2 < 2; ++b2)
#pragma unroll
        for (int g = 0; g < 4; ++g) {
          u32x2 v;
          v.x = pack2(1.f / (1.f + __expf(-acc[a][b2][4 * g])), 1.f / (1.f + __expf(-acc[a][b2][4 * g + 1])));
          v.y = pack2(1.f / (1.f + __expf(-acc[a][b2][4 * g + 2])), 1.f / (1.f + __expf(-acc[a][b2][4 * g + 3])));
          sgp[(a * 2 + b2) * 4 + g] = v;
        }
    const u16* wbr = (const u16*)(p.ws + OFF_WT_BR) + (size_t)(br * 1024 + nt_i * 128) * 512;
    if (br == 0) gemm_main<true>((const u16*)(p.ws + OFF_Q), 768, m0, 0, MTOK - 1, 96, wbr, 512, 8, acc, smem);
    else if (br == 1) gemm_main<true>((const u16*)(p.ws + OFF_SQ), 512, m0, 0, MTOK - 1, 64, wbr, 512, 8, acc, smem);
    else {
      const int b = m0 / TPB, j0 = m0 - b * TPB;
      gemm_main<true, true>((const u16*)(p.ws + OFF_HYT) + (size_t)(b * 1536 + 512) * TPB, TPB, j0, 0, 0, 64, wbr, 512, 8, acc, smem);
    }
#pragma unroll
    for (int mt = 0; mt < 3; ++mt)
#pragma unroll
      for (int nt = 0; nt < 2; ++nt)
#pragma unroll
        for (int g = 0; g < 4; ++g) {
          const int m = m0 + wm * 96 + mt * 32 + r, n = nt_i * 128 + wn * 64 + nt * 32 + 8 * g + 4 * h;
          u32x2* dst = (u32x2*)(C + (size_t)m * 1024 + n);
          u32x2 prev = {0u, 0u};
          if (br > DBG_FIRST_BR) prev = *dst;
          const u32x2 sv = sgp[(mt * 2 + nt) * 4 + g];
          const unsigned s0 = sv.x, s1 = sv.y;
          u32x2 nv;
          nv.x = pack2(lo_bf(prev.x) + lo_bf(s0) * acc[mt][nt][4 * g], hi_bf(prev.x) + hi_bf(s0) * acc[mt][nt][4 * g + 1]);
          nv.y = pack2(lo_bf(prev.y) + lo_bf(s1) * acc[mt][nt][4 * g + 2], hi_bf(prev.y) + hi_bf(s1) * acc[mt][nt][4 * g + 3]);
          *dst = nv;
          __builtin_amdgcn_sched_barrier(0);
        }
  }
}

DI void plain_tile(const Params& p, int tile, const u16* A, int lda, int nk, const u16* W, u16* C, char* smem) {
  const int mt_i = tile >> 3, nt_i = tile & 7;
  f32x16 acc[3][2];
  gemm_main<true>(A, lda, mt_i * 192, 0, MTOK - 1, 64, W + (size_t)nt_i * 128 * lda, lda, nk, acc, smem);
  store_rowmajor(acc, C, 1024, mt_i * 192, nt_i * 128, 1.f);
}

DI void ffnup_tile(const Params& p, int l, int tile, char* smem) {
  const int mt_i = tile / 44, nt_i = tile % 44;
  const int b = mt_i / 46, ti = mt_i % 46;
  int seq_base, len, r0;
  if (ti < 2) { seq_base = b * TPB; len = CTX; r0 = 190 * ti; }
  else { seq_base = b * TPB + CTX; len = SEQ; r0 = 190 * (ti - 2); }
  const int tid = opq(threadIdx.x), lane = tid & 63, wave = tid >> 6, wm = wave >> 1, wn = wave & 1, r = lane & 31, h = lane >> 5;
  f32x16 acc[3][2];
  gemm_main<true>((const u16*)(p.ws + OFF_RH), 1024, seq_base + r0 - 1, seq_base, seq_base + len - 1, 64,
                  (const u16*)(p.ws + OFF_WT_UP) + (size_t)nt_i * 128 * 1024, 1024, 16, acc, smem);
  __syncthreads();
#pragma unroll
  for (int mt = 0; mt < 3; ++mt) {
    const int ml = wm * 96 + mt * 32 + r;
    const int pos = r0 - 1 + ml;
    const bool valid = pos >= 0 && pos < len;
#pragma unroll
    for (int nt = 0; nt < 2; ++nt)
#pragma unroll
      for (int g = 0; g < 4; ++g) {
        u32x2 pk = u32x2{0u, 0u};
        if (valid) {
          pk.x = pack2(acc[mt][nt][4 * g], acc[mt][nt][4 * g + 1]);
          pk.y = pack2(acc[mt][nt][4 * g + 2], acc[mt][nt][4 * g + 3]);
        }
        *(u32x2*)(smem + ml * 272 + (wn * 64 + nt * 32 + 8 * g + 4 * h) * 2) = pk;
      }
  }
  __syncthreads();
  {
    const int j4 = (tid & 15) * 4, tr = tid >> 4;
    const float* cw = p.ffn_conv_w + (size_t)l * 3 * 5632;
    const float* cb = p.ffn_conv_b + (size_t)l * 5632;
    const int cha = nt_i * 64 + j4, chb = DFF + cha;
    float wa[3][4], wb[3][4], ba[4], bb[4];
#pragma unroll
    for (int e = 0; e < 4; ++e) {
#pragma unroll
      for (int d = 0; d < 3; ++d) { wa[d][e] = cw[d * 5632 + cha + e]; wb[d][e] = cw[d * 5632 + chb + e]; }
      ba[e] = cb[cha + e]; bb[e] = cb[chb + e];
    }
    u16* Aout = (u16*)(p.ws + OFF_A);
#pragma unroll 1
    for (int i = 0; i < 12; ++i) {
      const int t = 1 + tr + 16 * i;
      const int pos = r0 - 1 + t;
      if (t <= 190 && pos < len) {
        float ca[4], cbv[4];
#pragma unroll
        for (int e = 0; e < 4; ++e) { ca[e] = ba[e]; cbv[e] = bb[e]; }
#pragma unroll
        for (int d = 0; d < 3; ++d) {
          const u32x2 ua = *(const u32x2*)(smem + (t - 1 + d) * 272 + j4 * 2);
          const u32x2 ub = *(const u32x2*)(smem + (t - 1 + d) * 272 + (64 + j4) * 2);
          ca[0] += lo_bf(ua.x) * wa[d][0]; ca[1] += hi_bf(ua.x) * wa[d][1]; ca[2] += lo_bf(ua.y) * wa[d][2]; ca[3] += hi_bf(ua.y) * wa[d][3];
          cbv[0] += lo_bf(ub.x) * wb[d][0]; cbv[1] += hi_bf(ub.x) * wb[d][1]; cbv[2] += lo_bf(ub.y) * wb[d][2]; cbv[3] += hi_bf(ub.y) * wb[d][3];
        }
        float o[4];
#pragma unroll
        for (int e = 0; e < 4; ++e) o[e] = ca[e] / (1.f + __expf(-ca[e])) * cbv[e];
        *(u32x2*)(Aout + (size_t)(seq_base + pos) * DFF + cha) = u32x2{pack2(o[0], o[1]), pack2(o[2], o[3])};
      }
    }
  }
}

template <int DQK, bool SWA>
DI void attn_item(const Params& p, int l, int b, int hq, int jq0  , int nct, int nband, int kp_start, char* smem) {
  constexpr int KS = DQK * 2 + 16;
  constexpr int KCH = DQK / 8;
  constexpr int NKC = 64 * KCH / 256;
  constexpr int NKS = DQK / 16;
  constexpr int BUFSZ = 22016;
  const int tid = opq(threadIdx.x), lane = tid & 63, wave = tid >> 6, r = lane & 31, h = lane >> 5;
  const int brow = b * TPB;
  const int ntiles = nct + nband;
  const u16* K1; int ldk1, koff; const u16* KR = (const u16*)(p.ws + OFF_KR);
  const u16* Vb; u16* outp; int ldo, ooff; const u16* Qb; int ldq;
  if (!SWA) {
    K1 = (const u16*)(p.ws + OFF_KN); ldk1 = 512; koff = hq * 64;
    Vb = (const u16*)(p.ws + OFF_VT) + (size_t)((b * 8 + hq) * 64) * TPB;
    Qb = (const u16*)(p.ws + OFF_Q); ldq = 768;
    outp = (u16*)(p.ws + OFF_Q); ldo = 768; ooff = hq * 96;
  } else {
    const int kvh = hq >> 2;
    K1 = (const u16*)(p.ws + OFF_SK); ldk1 = 128; koff = kvh * 64;
    Vb = (const u16*)(p.ws + OFF_SVT) + (size_t)((b * 2 + kvh) * 64) * TPB;
    Qb = (const u16*)(p.ws + OFF_SQ); ldq = 512;
    outp = (u16*)(p.ws + OFF_SQ); ldo = 512; ooff = hq * 64;
  }
  const int qrow = brow + jq0 + wave * 32 + r;
  bf16x8 qf[NKS];
#pragma unroll
  for (int ks = 0; ks < NKS; ++ks) qf[ks] = *(const bf16x8*)(Qb + (size_t)qrow * ldq + hq * DQK + ks * 16 + h * 8);
  f32x16 o[2];
#pragma unroll
  for (int dt = 0; dt < 2; ++dt)
#pragma unroll
    for (int i = 0; i < 16; ++i) o[dt][i] = 0.f;
  float mrun = -INFINITY, lsum = 0.f;
  u32x4 kreg[NKC], vreg[2];
  auto tile_j = [&](int it) { return it < nct ? it * 64 : CTX + kp_start + 64 * (it - nct); };
  auto issue = [&](int it) {
    const int jr = tile_j(it);
#pragma unroll
    for (int i = 0; i < NKC; ++i) {
      const int c = tid + 256 * i, key = c / KCH, part = c % KCH;
      const u16* src = (part < 8) ? K1 + (size_t)(brow + jr + key) * ldk1 + koff + part * 8
                                  : KR + (size_t)(brow + jr + key) * 32 + (part - 8) * 8;
      kreg[i] = *(const u32x4*)src;
    }
#pragma unroll
    for (int i = 0; i < 2; ++i) {
      const int c = tid + 256 * i, d = c >> 3, part = c & 7;
      vreg[i] = *(const u32x4*)(Vb + (size_t)d * TPB + jr + part * 8);
    }
  };
  auto stash = [&](int buf) {
    char* kb = smem + buf * BUFSZ;
    char* vb = kb + 13312;
#pragma unroll
    for (int i = 0; i < NKC; ++i) {
      const int c = tid + 256 * i, key = c / KCH, part = c % KCH;
      *(u32x4*)(kb + key * KS + part * 16) = kreg[i];
    }
#pragma unroll
    for (int i = 0; i < 2; ++i) {
      const int c = tid + 256 * i, d = c >> 3, part = c & 7;
      *(u32x2*)(vb + d * 136 + part * 16) = u32x2{vreg[i].x, vreg[i].y};
      *(u32x2*)(vb + d * 136 + part * 16 + 8) = u32x2{vreg[i].z, vreg[i].w};
    }
  };
  __syncthreads();
  issue(0);
  stash(0);
  __syncthreads();
  const int qpos = jq0 - CTX + wave * 32 + r;
#pragma unroll 1
  for (int it = 0; it < ntiles; ++it) {
    const int buf = it & 1;
    const char* kb = smem + buf * BUFSZ;
    const char* vb = kb + 13312;
    if (it + 1 < ntiles) issue(it + 1);
    f32x16 s[2];
#pragma unroll
    for (int kt = 0; kt < 2; ++kt) {
#pragma unroll
      for (int i = 0; i < 16; ++i) s[kt][i] = 0.f;
#pragma unroll
      for (int ks = 0; ks < NKS; ++ks) {
        const bf16x8 kf = *(const bf16x8*)(kb + (kt * 32 + r) * KS + ks * 32 + h * 16);
        s[kt] = MFMA(kf, qf[ks], s[kt]);
      }
    }
    if (SWA && it >= nct) {
      const int kpos0 = kp_start + 64 * (it - nct);
#pragma unroll
      for (int kt = 0; kt < 2; ++kt)
#pragma unroll
        for (int i = 0; i < 16; ++i) {
          const int diff = qpos - (kpos0 + kt * 32 + crow(i, h));
          if (diff > 128 || diff < -128) s[kt][i] = -1e30f;
        }
    }
    float mx = s[0][0];
#pragma unroll
    for (int kt = 0; kt < 2; ++kt)
#pragma unroll
      for (int i = 0; i < 16; ++i) mx = fmaxf(mx, s[kt][i]);
    mx = fmaxf(mx, __shfl_xor(mx, 32));
    const float mnew = fmaxf(mrun, mx);
    const float alpha = __builtin_amdgcn_exp2f(mrun - mnew);
    float ps = 0.f;
#pragma unroll
    for (int kt = 0; kt < 2; ++kt)
#pragma unroll
      for (int i = 0; i < 16; ++i) { const float e = __builtin_amdgcn_exp2f(s[kt][i] - mnew); s[kt][i] = e; ps += e; }
    if (__builtin_amdgcn_ballot_w64(mnew != mrun) != 0ull) {
      lsum *= alpha;
#pragma unroll
      for (int dt = 0; dt < 2; ++dt)
#pragma unroll
        for (int i = 0; i < 16; ++i) o[dt][i] *= alpha;
    }
    lsum += ps;
    mrun = mnew;
#pragma unroll
    for (int kt = 0; kt < 2; ++kt)
#pragma unroll
      for (int s2 = 0; s2 < 2; ++s2) {
        unsigned pk[4];
#pragma unroll
        for (int j = 0; j < 4; ++j) pk[j] = pack2(s[kt][8 * s2 + 2 * j], s[kt][8 * s2 + 2 * j + 1]);
        const bf16x8 pf = __builtin_bit_cast(bf16x8, u32x4{pk[0], pk[1], pk[2], pk[3]});
#pragma unroll
        for (int dt = 0; dt < 2; ++dt) {
          const char* vp = vb + (dt * 32 + r) * 136 + (kt * 32 + 16 * s2 + 4 * h) * 2;
          const s16x4 lo = *(const s16x4*)vp;
          const s16x4 hi = *(const s16x4*)(vp + 16);
          const bf16x8 vf = __builtin_shufflevector(lo, hi, 0, 1, 2, 3, 4, 5, 6, 7);
          o[dt] = MFMA(vf, pf, o[dt]);
        }
      }
    if (it + 1 < ntiles) stash(buf ^ 1);
    __syncthreads();
  }
  float ltot = lsum + __shfl_xor(lsum, 32);
  if (SWA) ltot += __builtin_amdgcn_exp2f(p.swa_sink[l * 8 + hq] * LOG2E - mrun);
  const float inv = 1.f / ltot;
#pragma unroll
  for (int dt = 0; dt < 2; ++dt)
#pragma unroll
    for (int g = 0; g < 4; ++g) {
      u32x2 pk;
      pk.x = pack2(o[dt][4 * g] * inv, o[dt][4 * g + 1] * inv);
      pk.y = pack2(o[dt][4 * g + 2] * inv, o[dt][4 * g + 3] * inv);
      *(u32x2*)(outp + (size_t)qrow * ldo + ooff + dt * 32 + 8 * g + 4 * h) = pk;
    }
}

constexpr float HY_D0 = 3.0701134573253944f;
constexpr float HY_DSTEP = (15.350567286626972f - 3.0701134573253944f) / 511.f;

DI void filt_item(const Params& p, int l, int oc, char* smem) {
  float2* lds = (float2*)smem;
  float* lf = (float*)smem;
  const int tid = opq(threadIdx.x), lane = tid & 63, wave = tid >> 6;
  const int c = oc & 511;
  const float* hid = (const float*)(p.ws + OFF_HID + l * HID_LAYER);
  const float* w3 = p.hy_w3 + (size_t)l * 64 * 2048;
  float* sa = (float*)(p.ws + OFF_ESCR + (size_t)blockIdx.x * 65536);
  float* sb = sa + 8192;
  __syncthreads();
  if (tid < 128) { const int dir = tid >> 6, j = tid & 63; lf[tid] = w3[j * 2048 + dir * 1024 + oc]; }
  __syncthreads();
  const float delta = HY_D0 + (float)c * HY_DSTEP;
  float asum = 0.f;
#pragma unroll 1
  for (int ib = 0; ib < 4; ++ib) {
    float a[8], bm[8];
#pragma unroll
    for (int i = 0; i < 8; ++i) { a[i] = 0.f; bm[i] = 0.f; }
#pragma unroll 4
    for (int j = 0; j < 64; ++j) {
      const float w0 = lf[j], w1 = lf[64 + j];
      const float* hr = hid + (size_t)j * 8192 + 4 * (tid + 512 * ib);
#pragma unroll
      for (int ii = 0; ii < 2; ++ii) {
        const float4 hv = *(const float4*)(hr + 1024 * ii);
        a[4 * ii + 0] += hv.x * w0; bm[4 * ii + 0] += hv.x * w1;
        a[4 * ii + 1] += hv.y * w0; bm[4 * ii + 1] += hv.y * w1;
        a[4 * ii + 2] += hv.z * w0; bm[4 * ii + 2] += hv.z * w1;
        a[4 * ii + 3] += hv.w * w0; bm[4 * ii + 3] += hv.w * w1;
      }
    }
#pragma unroll
    for (int ii = 0; ii < 2; ++ii) {
      const int t0 = 4 * (tid + 256 * (2 * ib + ii));
      float av[4];
#pragma unroll
      for (int e = 0; e < 4; ++e) {
        const int t = t0 + e;
        const float dec = __expf(-((float)t * (1.f / 8191.f)) * delta);
        av[e] = a[4 * ii + e] * dec;
        const float bv = bm[4 * ii + e] * dec;
        if (t >= 1) { sb[8192 - t] = bv; asum += fabsf(bv); } else sb[0] = 0.f;
        asum += fabsf(av[e]);
      }
      *(float4*)(sa + t0) = make_float4(av[0], av[1], av[2], av[3]);
    }
  }
  asum = wave_sum(asum);
  asm volatile("s_waitcnt vmcnt(0)" ::: "memory");
  __syncthreads();
  if (lane == 0) lf[wave] = asum;
  __syncthreads();
  const float inv = 1.f / (lf[0] + lf[1] + lf[2] + lf[3]);
  __syncthreads();
#pragma unroll 2
  for (int i = 0; i < 8; ++i) {
    const int t0 = 4 * (tid + 256 * i);
#pragma unroll
    for (int e = 0; e < 4; ++e) lds[fphys(t0 + e)] = make_float2((ldsc1(sa + t0 + e) + ldsc1(sb + t0 + e)) * inv, 0.f);
  }
  __syncthreads();
  if (!DBG_NOFFT) fft8192_fwd(lds, tid);
  h2_t* sp = (h2_t*)(p.ws + OFF_SPEC) + (size_t)oc * 2 * 8192;
#pragma unroll 4
  for (int i = 0; i < 32; ++i) { const int k = tid + 256 * i; const float2 v = lds[k]; h2_t hv = {(_Float16)v.x, (_Float16)v.y}; sp[k] = hv; }
  __syncthreads();
#pragma unroll 2
  for (int i = 0; i < 8; ++i) {
    const int t0 = 4 * (tid + 256 * i);
#pragma unroll
    for (int e = 0; e < 4; ++e) {
      const int t = t0 + e;
      const float2 w = twid_rev((float)t * (1.f / 16384.f));
      const float d = (ldsc1(sa + t) - ldsc1(sb + t)) * inv;
      lds[fphys(t)] = make_float2(d * w.x, d * w.y);
    }
  }
  __syncthreads();
  if (!DBG_NOFFT) fft8192_fwd(lds, tid);
#pragma unroll 4
  for (int i = 0; i < 32; ++i) { const int k = tid + 256 * i; const float2 v = lds[k]; h2_t hv = {(_Float16)v.x, (_Float16)v.y}; sp[8192 + k] = hv; }
  __syncthreads();
}

DI float dwc(const u16* s, int t, int len, float w0, float w1, float w2, float bias) {
  const int tm = max(t - 1, 0), tp = min(t + 1, len - 1);
  const float a = bf2f(s[tm]), b = bf2f(s[t]), c = bf2f(s[tp]);
  return b * w1 + bias + (t > 0 ? a * w0 : 0.f) + (t < len - 1 ? c * w2 : 0.f);
}

DI void ld4(const u16* s, int t0, float (&o)[4]) {
  const u32x2 u = *(const u32x2*)(s + t0);
  o[0] = lo_bf(u.x); o[1] = hi_bf(u.x); o[2] = lo_bf(u.y); o[3] = hi_bf(u.y);
}
DI void dwc4(const u16* s, int t0, int len, float w0, float w1, float w2, float bias, float (&o)[4]) {
  float c[4];
  ld4(s, t0, c);
  float l = bf2f(s[max(t0 - 1, 0)]), r = bf2f(s[min(t0 + 4, len - 1)]);
  l = (t0 > 0) ? l : 0.f;
  r = (t0 + 4 < len) ? r : 0.f;
  o[0] = l * w0 + c[0] * w1 + c[1] * w2 + bias;
  o[1] = c[0] * w0 + c[1] * w1 + c[2] * w2 + bias;
  o[2] = c[1] * w0 + c[2] * w1 + c[3] * w2 + bias;
  o[3] = c[2] * w0 + c[3] * w1 + r * w2 + bias;
}

DI void hconv_item(const Params& p, int l, int o, int c, int bp, char* smem) {
  float2* lds = (float2*)smem;
  const int tid = opq(threadIdx.x);
  u16* hyt = (u16*)(p.ws + OFF_HYT);
  const int b0 = bp * 2, b1 = b0 + 1;
  u16* z0p = hyt + (size_t)(b0 * 1536 + c) * TPB + CTX;
  u16* z1p = hyt + (size_t)(b1 * 1536 + c) * TPB + CTX;
  const int gc = (o + 1) * 512 + c;
  const u16* g0p = hyt + (size_t)(b0 * 1536 + gc) * TPB + CTX;
  const u16* g1p = hyt + (size_t)(b1 * 1536 + gc) * TPB + CTX;
  const float* cw = p.hy_conv_w + (size_t)l * 3 * 1536;
  const float* cb = p.hy_conv_b + (size_t)l * 1536;
  const float zw0 = cw[c], zw1 = cw[1536 + c], zw2 = cw[3072 + c], zbias = cb[c];
  const float gw0 = cw[gc], gw1 = cw[1536 + gc], gw2 = cw[3072 + gc], gbias = cb[gc];
  const float skip = p.hy_skip[l * 1024 + o * 512 + c];
  const h2_t* spe = (const h2_t*)(p.ws + OFF_SPEC) + (size_t)(o * 512 + c) * 2 * 8192;
  const h2_t* spo = spe + 8192;
  float2* Eg = (float2*)(p.ws + OFF_ESCR + (size_t)blockIdx.x * 65536);
  __syncthreads();
#pragma unroll 2
  for (int i = 0; i < 8; ++i) {
    const int t0 = 4 * (tid + 256 * i);
    float za[4], zb[4];
    if (o == 0) { dwc4(z0p, t0, SEQ, zw0, zw1, zw2, zbias, za); dwc4(z1p, t0, SEQ, zw0, zw1, zw2, zbias, zb); }
    else { ld4(z0p, t0, za); ld4(z1p, t0, zb); }
#pragma unroll
    for (int e = 0; e < 4; ++e) lds[fphys(t0 + e)] = make_float2(za[e], zb[e]);
  }
  __syncthreads();
  fft8192_fwd(lds, tid);
#pragma unroll 8
  for (int i = 0; i < 32; ++i) { const int k = tid + 256 * i; const h2_t hv = spe[k]; lds[k] = cmul(lds[k], make_float2((float)hv[0], (float)hv[1])); }
  __syncthreads();
  fft8192_inv(lds, tid);
#pragma unroll 2
  for (int i = 0; i < 8; ++i) {
    const int t0 = 4 * (tid + 256 * i);
#pragma unroll
    for (int e = 0; e < 4; ++e) Eg[t0 + e] = lds[fphys(t0 + e)];
  }
  __syncthreads();
#pragma unroll 2
  for (int i = 0; i < 8; ++i) {
    const int t0 = 4 * (tid + 256 * i);
    float za[4], zb[4];
    if (o == 0) { dwc4(z0p, t0, SEQ, zw0, zw1, zw2, zbias, za); dwc4(z1p, t0, SEQ, zw0, zw1, zw2, zbias, zb); }
    else { ld4(z0p, t0, za); ld4(z1p, t0, zb); }
#pragma unroll
    for (int e = 0; e < 4; ++e) lds[fphys(t0 + e)] = cmul(make_float2(za[e], zb[e]), twid_rev((float)(t0 + e) * (1.f / 16384.f)));
  }
  __syncthreads();
  fft8192_fwd(lds, tid);
#pragma unroll 8
  for (int i = 0; i < 32; ++i) { const int k = tid + 256 * i; const h2_t hv = spo[k]; lds[k] = cmul(lds[k], make_float2((float)hv[0], (float)hv[1])); }
  __syncthreads();
  fft8192_inv(lds, tid);
#pragma unroll 2
  for (int i = 0; i < 8; ++i) {
    const int t0 = 4 * (tid + 256 * i);
    float za[4], zb[4], ga[4], gb[4];
    if (o == 0) { dwc4(z0p, t0, SEQ, zw0, zw1, zw2, zbias, za); dwc4(z1p, t0, SEQ, zw0, zw1, zw2, zbias, zb); }
    else { ld4(z0p, t0, za); ld4(z1p, t0, zb); }
    dwc4(g0p, t0, SEQ, gw0, gw1, gw2, gbias, ga);
    dwc4(g1p, t0, SEQ, gw0, gw1, gw2, gbias, gb);
#pragma unroll
    for (int e = 0; e < 4; ++e) {
      const int t = t0 + e;
      const float2 ov = cmulc(lds[fphys(t)], twid_rev((float)t * (1.f / 16384.f)));
      const float2 ev = Eg[t];
      const float y0 = (ev.x + ov.x) * (1.f / 16384.f), y1 = (ev.y + ov.y) * (1.f / 16384.f);
      Eg[t] = make_float2(ga[e] * (y0 + za[e] * skip), gb[e] * (y1 + zb[e] * skip));
    }
  }
  __syncthreads();
  u16* d0 = (o == 0) ? z0p : hyt + (size_t)(b0 * 1536 + 512 + c) * TPB + CTX;
  u16* d1 = (o == 0) ? z1p : hyt + (size_t)(b1 * 1536 + 512 + c) * TPB + CTX;
#pragma unroll 2
  for (int i = 0; i < 8; ++i) {
    const int t0 = 4 * (tid + 256 * i);
    float2 e4[4];
#pragma unroll
    for (int e = 0; e < 4; ++e) e4[e] = Eg[t0 + e];
    *(u32x2*)(d0 + t0) = u32x2{pack2(e4[0].x, e4[1].x), pack2(e4[2].x, e4[3].x)};
    *(u32x2*)(d1 + t0) = u32x2{pack2(e4[0].y, e4[1].y), pack2(e4[2].y, e4[3].y)};
  }
}

DI void hctx_item(const Params& p, int l, int c, char* smem) {
  float* lf = (float*)smem;
  float* kern = lf;
  float* zb = lf + 1024;
  float* z1b = lf + 2048;
  float* red = lf + 3072;
  const int tid = opq(threadIdx.x), lane = tid & 63, wave = tid >> 6;
  const float* hid = (const float*)(p.ws + OFF_HID + l * HID_LAYER) + 64 * 8192;
  const float* w3 = p.hy_w3 + (size_t)l * 64 * 2048;
  const u16* hyt = (const u16*)(p.ws + OFF_HYT);
  const float* cw = p.hy_conv_w + (size_t)l * 3 * 1536;
  const float* cb = p.hy_conv_b + (size_t)l * 1536;
  __syncthreads();
  {
    const int t = tid;
    float d[4] = {0.f, 0.f, 0.f, 0.f};
#pragma unroll 4
    for (int j = 0; j < 64; ++j) {
      const float hv = hid[j * 256 + t];
#pragma unroll
      for (int q = 0; q < 4; ++q) d[q] += hv * w3[j * 2048 + (q >> 1) * 1024 + (q & 1) * 512 + c];
    }
    const float dec = __expf(-((float)t * (1.f / 255.f)) * (HY_D0 + (float)c * HY_DSTEP));
#pragma unroll
    for (int o = 0; o < 2; ++o) {
      const float f0 = d[o] * dec, f1 = d[2 + o] * dec;
      kern[o * 512 + t] = f0;
      if (t >= 1) kern[o * 512 + 512 - t] = f1;
      if (t == 0) kern[o * 512 + 256] = 0.f;
      float s = fabsf(f0) + (t >= 1 ? fabsf(f1) : 0.f);
      s = wave_sum(s);
      if (lane == 0) red[o * 4 + wave] = s;
    }
  }
  const int b = tid >> 6, tq = tid & 63;
  const u16* zs = hyt + (size_t)(b * 1536 + c) * TPB;
  const u16* g1s = hyt + (size_t)(b * 1536 + 512 + c) * TPB;
  const u16* g2s = hyt + (size_t)(b * 1536 + 1024 + c) * TPB;
#pragma unroll
  for (int k = 0; k < 4; ++k) {
    const int tt = tq + 64 * k;
    zb[b * 256 + tt] = dwc(zs, tt, CTX, cw[c], cw[1536 + c], cw[3072 + c], cb[c]);
  }
  __syncthreads();
  const float inv0 = 1.f / (red[0] + red[1] + red[2] + red[3]);
  const float inv1 = 1.f / (red[4] + red[5] + red[6] + red[7]);
  const float sk0 = p.hy_skip[l * 1024 + c], sk1 = p.hy_skip[l * 1024 + 512 + c];
#pragma unroll 1
  for (int k = 0; k < 4; ++k) {
    const int tt = tq + 64 * k;
    float acc = 0.f;
#pragma unroll 8
    for (int s = 0; s < 256; ++s) acc += kern[(tt - s) & 511] * zb[b * 256 + s];
    const float g = dwc(g1s, tt, CTX, cw[512 + c], cw[1536 + 512 + c], cw[3072 + 512 + c], cb[512 + c]);
    z1b[b * 256 + tt] = g * (acc * inv0 + zb[b * 256 + tt] * sk0);
  }
  __syncthreads();
  u16* yc = (u16*)(p.ws + OFF_HYT) + (size_t)(b * 1536 + 512 + c) * TPB;
#pragma unroll 1
  for (int k = 0; k < 4; ++k) {
    const int tt = tq + 64 * k;
    float acc = 0.f;
#pragma unroll 8
    for (int s = 0; s < 256; ++s) acc += kern[512 + ((tt - s) & 511)] * z1b[b * 256 + s];
    const float g = dwc(g2s, tt, CTX, cw[1024 + c], cw[1536 + 1024 + c], cw[3072 + 1024 + c], cb[1024 + c]);
    yc[tt] = DBG_ZERO_HCTX ? (u16)0 : f2bf(g * (acc * inv1 + z1b[b * 256 + tt] * sk1));
  }
  __syncthreads();
}

#define XB_XCNT(j) (256 + 64 * (j))
#define XB_XSUB(j) (1280 + 64 * (j))
#define XB_XGEN(j) (2304 + 64 * (j))
#define XB_TOP 3328
#define XB_TOPGEN 3392
DI unsigned xb_ld(unsigned* p) { return __hip_atomic_load(p, __ATOMIC_RELAXED, __HIP_MEMORY_SCOPE_AGENT); }
DI unsigned xb_add(unsigned* p, unsigned v) { return __hip_atomic_fetch_add(p, v, __ATOMIC_RELAXED, __HIP_MEMORY_SCOPE_AGENT); }
struct XBar { unsigned* bar; unsigned x, nloc, nx; };
DI void gsync_impl(cg::grid_group& g, XBar& b) {
#if DBG_CG_SYNC
  g.sync();
#else
  asm volatile("s_waitcnt vmcnt(0)" ::: "memory");
  __syncthreads();
  if (threadIdx.x == 0) {
    unsigned* bar = b.bar;
    __builtin_amdgcn_s_waitcnt(0);
    if (b.nloc == 0u) {
      unsigned sum, cnt, mine;
      for (;;) {
        sum = 0u; cnt = 0u; mine = 0u;
#pragma unroll
        for (unsigned j = 0; j < 16; ++j) { const unsigned c = xb_ld(&bar[XB_XCNT(j)]); sum += c; cnt += (c > 0u) ? 1u : 0u; mine = (j == b.x) ? c : mine; }
        if (sum == gridDim.x) break;
        __builtin_amdgcn_s_sleep(1);
      }
      b.nloc = mine > 0u ? mine : 1u; b.nx = cnt > 0u ? cnt : 1u;
    }
    const unsigned old = xb_add(&bar[XB_XSUB(b.x)], 1u);
    const unsigned gen = old / b.nloc;
    if (old + 1u == (gen + 1u) * b.nloc) {
      __builtin_amdgcn_fence(__ATOMIC_RELEASE, "agent");
      asm volatile("s_waitcnt vmcnt(0)" ::: "memory");
      const unsigned og = xb_add(&bar[XB_TOP], 1u);
      const unsigned tg = og / b.nx;
      if (og + 1u == (tg + 1u) * b.nx) xb_add(&bar[XB_TOPGEN], 1u);
      else { while (xb_ld(&bar[XB_TOPGEN]) == tg) __builtin_amdgcn_s_sleep(1); }
      __builtin_amdgcn_fence(__ATOMIC_ACQUIRE, "agent");
      xb_add(&bar[XB_XGEN(b.x)], 1u);
      asm volatile("s_waitcnt vmcnt(0)" ::: "memory");
    } else {
      while (xb_ld(&bar[XB_XGEN(b.x)]) == gen) __builtin_amdgcn_s_sleep(1);
      __builtin_amdgcn_fence(__ATOMIC_ACQUIRE, "agent");
      asm volatile("s_waitcnt vmcnt(0)" ::: "memory");
    }
  }
  __syncthreads();
#endif
}

#define gsync(G, E) gsync_impl(G, E)
DI int tile_map(int L, int MT, int NT) {
  const int per = 8 * NT;
  const int P = L / per, u = L - P * per;
  const int h = min(8, MT - P * 8);
  const int nt = u / h, mt = P * 8 + (u - nt * h);
  return mt * NT + nt;
}
__global__ void __launch_bounds__(256, 2) fwd_mega(Params p) {
  cg::grid_group grid = cg::this_grid();
  __shared__ __attribute__((aligned(16))) char smem[65536];
  const int nb = gridDim.x, bid = blockIdx.x;
  const int pb = ((nb & 7) == 0) ? (bid & 7) * (nb >> 3) + (bid >> 3) : bid;
  float* xctx = (float*)(p.ws + OFF_XCTX);
  u16* RH = (u16*)(p.ws + OFF_RH);
  u16* HP = (u16*)(p.ws + OFF_HP);
  XBar epoch;
  epoch.bar = (unsigned*)(p.ws + OFF_BAR);
  epoch.x = (unsigned)__builtin_amdgcn_s_getreg((3 << 11) | 20) & 0xFu;
  epoch.nloc = 0u; epoch.nx = 0u;
  if (threadIdx.x == 0) (void)xb_add(&epoch.bar[XB_XCNT(epoch.x)], 1u);
  {
    constexpr int NC0 = 2336;
    const int total = NC0 + 192 + 1536 + 528;
    for (int it = bid; it < total; it += nb) {
      if (it < NC0) conv_tile(p, 0, it, smem);
      else if (it < NC0 + 192) mod_item(p, it - NC0, smem);
      else if (it < NC0 + 192 + 1536) rope_item(p, it - NC0 - 192);
      else hid_item(p, it - NC0 - 192 - 1536, smem);
    }
  }
  if (p.ws == nullptr) grid.sync();
  gsync(grid, epoch);
  row_pass(p, 0, p.x, p.ctx, nullptr, nullptr, nullptr, nullptr, 0, 0, false, p.norm_g, 0, 0, 1024, RH, false);
  gsync(grid, epoch);
#pragma unroll 1
  for (int l = 0; l < 2; ++l) {
    const float* xl = (l == 0) ? p.x : p.out;
    const float* xc = (l == 0) ? p.ctx : xctx;
    for (int rep = 0; rep < DBG_REP_FFT; ++rep)
    for (int it = pb; it < 1024; it += nb) filt_item(p, l, it, smem);
    gsync(grid, epoch);
    for (int rep = 0; rep < DBG_REP_GEMM; ++rep)
    for (int it = pb; it < 4752; it += nb) inproj_tile(p, tile_map(it, 176, 27), smem);
    gsync(grid, epoch);
#if DBG_DUMP == 5
    { const _Float16* sp = (const _Float16*)(p.ws + OFF_SPEC);
      for (size_t i = (size_t)bid * 256 + threadIdx.x; i < (size_t)NBATCH * SEQ * DM; i += (size_t)nb * 256) p.out[i] = (float)sp[i];
      return; }
#endif
    {
      const int nSW = 2048 + (l == 0 ? 64 : 0);
      for (int rep = 0; rep < DBG_REP_GEMM; ++rep)
      for (int it = pb; it < 1408 + nSW; it += nb) {
        if (it < 1408) kvup_tile(p, tile_map(it, 176, 8), smem);
        else if (it < 1408 + 2048) {
          const int i1 = it - 1408, n = i1 & 63, jlo = (n == 0) ? 2 : 0, jhi = (n == 63) ? 4 : 6;
          attn_item<64, true>(p, l, i1 >> 9, (i1 >> 6) & 7, CTX + n * 128, 4, jhi - jlo, (n - 1) * 128 + 64 * jlo, smem);
        } else { const int i2 = it - 1408 - 2048; attn_item<64, true>(p, l, i2 >> 4, (i2 >> 1) & 7, (i2 & 1) * 128, 4, 0, 0, smem); }
      }
    }
    gsync(grid, epoch);
    {
      const int nF = 2048 + (l == 0 ? 64 : 0);
      for (int rep = 0; rep < DBG_REP_MLA; ++rep)
      for (int it = pb; it < nF; it += nb) {
        if (it < 2048) attn_item<96, false>(p, l, it >> 9, (it >> 6) & 7, CTX + (it & 63) * 128, 132, 0, 0, smem);
        else { const int i2 = it - 2048; attn_item<96, false>(p, l, i2 >> 4, (i2 >> 1) & 7, (i2 & 1) * 128, 4, 0, 0, smem); }
      }
    }
    gsync(grid, epoch);
    {
      const int nF2 = 1024 + (l == 0 ? 512 : 0);
      for (int it = pb; it < nF2; it += nb) {
        if (it < 1024) hconv_item(p, l, 0, it >> 1, it & 1, smem);
        else hctx_item(p, l, it - 1024, smem);
      }
    }
    gsync(grid, epoch);
    for (int rep = 0; rep < DBG_REP_FFT; ++rep)
    for (int it = pb; it < 1024; it += nb) hconv_item(p, l, 1, it >> 1, it & 1, smem);
    gsync(grid, epoch);
    for (int rep = 0; rep < DBG_REP_GEMM; ++rep)
    for (int it = pb; it < 1408; it += nb) merge_tile(p, tile_map(it, 176, 8), smem);
    if (l == 0 && pb >= 384 && nb > 384) for (int ct = 2336 + (pb - 384); ct < NCONV_TILES; ct += nb - 384) conv_tile(p, 0, ct, smem);
    gsync(grid, epoch);
    for (int rep = 0; rep < DBG_REP_GEMM * DBG_REP_PLAIN; ++rep)
    for (int it = pb; it < 1408; it += nb) plain_tile(p, tile_map(it, 176, 8), (const u16*)(p.ws + OFF_MERGED), 1024, 16, (const u16*)(p.ws + OFF_WT_OUT), (u16*)(p.ws + OFF_Y), smem);
    gsync(grid, epoch);
    row_pass(p, 1, xl, xc, p.out, xctx, (const u16*)(p.ws + OFF_Y), p.norm_g + (size_t)(l * 4 + 1) * 1024, 2048, l, true, p.norm_g + (size_t)(l * 4 + 2) * 1024, l, 3072, 4096, RH, false);
    gsync(grid, epoch);
    for (int rep = 0; rep < DBG_REP_GEMM; ++rep)
    for (int it = pb; it < 184 * 44; it += nb) ffnup_tile(p, l, tile_map(it, 184, 44), smem);
    gsync(grid, epoch);
    for (int rep = 0; rep < DBG_REP_GEMM * DBG_REP_PLAIN; ++rep)
    for (int it = pb; it < 1408; it += nb) plain_tile(p, tile_map(it, 176, 8), (const u16*)(p.ws + OFF_A), 2816, 44, (const u16*)(p.ws + OFF_WT_DOWN), HP, smem);
    if (l == 0 && pb >= 384 && nb > 384) for (int ct = pb - 384; ct < 1632; ct += nb - 384) conv_tile(p, 1, ct, smem);
    gsync(grid, epoch);
    row_pass(p, 1, p.out, xctx, p.out, xctx, HP, p.norm_g + (size_t)(l * 4 + 3) * 1024, 5120, l, l == 0, p.norm_g + (size_t)((l + 1) * 4) * 1024, l + 1, 0, 1024, RH, l == 1);
    if (l == 0) {
      for (int it = bid; it < NCONV_TILES - 1632; it += nb) conv_tile(p, 1, 1632 + it, smem);
      gsync(grid, epoch);
    }
  }
  for (int rep = 0; rep < DBG_EXTRA_SYNCS; ++rep) gsync(grid, epoch);
#if DBG_DUMP == 1
  gsync(grid, epoch);
  { const _Float16* sp = (const _Float16*)(p.ws + OFF_SPEC);
    for (size_t i = (size_t)bid * 256 + threadIdx.x; i < (size_t)NBATCH * SEQ * DM; i += (size_t)nb * 256) p.out[i] = (float)sp[i]; }
#elif DBG_DUMP == 3
  gsync(grid, epoch);
  { const float* hd = (const float*)(p.ws + OFF_HID);
    for (size_t i = (size_t)bid * 256 + threadIdx.x; i < (size_t)NBATCH * SEQ * DM; i += (size_t)nb * 256) p.out[i] = i < (size_t)2 * 64 * 8448 ? hd[i] : 0.f; }
#elif DBG_DUMP == 2
  gsync(grid, epoch);
  { const u16* yc = (const u16*)(p.ws + OFF_YCT);
    for (size_t i = (size_t)bid * 256 + threadIdx.x; i < (size_t)NBATCH * SEQ * DM; i += (size_t)nb * 256) p.out[i] = i < (size_t)4 * 512 * TPB ? bf2f(yc[i]) : 0.f; }
#endif
}

extern "C" void kernel_launch(void* const* d_in, const int* in_sizes, int n_in, void* d_out, int out_size, void* d_ws, size_t ws_size,
                              hipStream_t stream) {
  static int grid_blocks = 0;
  if (!grid_blocks) {
    int dev = 0, cus = 0, per_cu = 0;
    (void)hipGetDevice(&dev);
    (void)hipDeviceGetAttribute(&cus, hipDeviceAttributeMultiprocessorCount, dev);
    (void)hipOccupancyMaxActiveBlocksPerMultiprocessor(&per_cu, fwd_mega, 256, 0);
    if (per_cu > 2) per_cu = 2;
    if (per_cu < 1) per_cu = 1;
    grid_blocks = cus * per_cu;
  }
  if (ws_size < WS_NEED) { fprintf(stderr, "workspace too small: %zu < %zu\n", ws_size, (size_t)WS_NEED); return; }
  Params p{};
  const float** pp = (const float**)&p;
  for (int i = 0; i < 26; ++i) pp[i] = (const float*)d_in[i];
  p.out = (float*)d_out;
  p.ws = (char*)d_ws;
  (void)hipMemsetAsync((char*)d_ws + OFF_BAR, 0, BAR_BYTES, stream);
  void* args[] = {&p};
  hipError_t e = hipLaunchCooperativeKernel((void*)fwd_mega, dim3(grid_blocks), dim3(256), args, 0, stream);
  if (e != hipSuccess) fprintf(stderr, "cooperative launch failed: %s (grid %d)\n", hipGetErrorString(e), grid_blocks);
}
```

```cpp
#include <hip/hip_runtime.h>
#include <hip/hip_cooperative_groups.h>
#include <cstdio>
namespace cg = cooperative_groups;
#define DI __device__ __forceinline__
typedef unsigned short u16;
typedef __attribute__((ext_vector_type(8))) short bf16x8;
typedef __attribute__((ext_vector_type(4))) short s16x4;
typedef __attribute__((ext_vector_type(16))) float f32x16;
typedef __attribute__((ext_vector_type(4))) unsigned u32x4;
typedef __attribute__((ext_vector_type(2))) unsigned u32x2;
typedef __attribute__((ext_vector_type(2))) __bf16 bf2_t;
typedef __attribute__((ext_vector_type(2))) float f2_t;
typedef __attribute__((ext_vector_type(2))) _Float16 h2_t;
#define MFMA(a, b, c) __builtin_amdgcn_mfma_f32_32x32x16_bf16((a), (b), (c), 0, 0, 0)

constexpr int DM = 1024, NBATCH = 4, SEQ = 8192, CTX = 256, TPB = 8448, MTOK = 33792;
constexpr int DFF = 2816;
#ifndef DBG_ZERO_HCTX
#define DBG_ZERO_HCTX 0
#endif
#ifndef DBG_DUMP
#define DBG_DUMP 0
#endif
#ifndef DBG_NOFFT
#define DBG_NOFFT 0
#endif
#ifndef DBG_SPLITC
#define DBG_SPLITC 0
#endif
#ifndef DBG_REP_GEMM
#define DBG_REP_GEMM 1
#endif
#ifndef DBG_REP_MLA
#define DBG_REP_MLA 1
#endif
#ifndef DBG_HEAVY_SYNC
#define DBG_HEAVY_SYNC 0
#endif
#ifndef DBG_REP_FFT
#define DBG_REP_FFT 1
#endif
#ifndef DBG_REP_PLAIN
#define DBG_REP_PLAIN 1
#endif
#ifndef DBG_EXTRA_SYNCS
#define DBG_EXTRA_SYNCS 0
#endif
#ifndef DBG_CG_SYNC
#define DBG_CG_SYNC 0
#endif
#ifndef DBG_SKIP_BR
#define DBG_SKIP_BR 0
#endif
#define DBG_FIRST_BR ((DBG_SKIP_BR & 1) ? ((DBG_SKIP_BR & 2) ? 2 : 1) : 0)
constexpr float LOG2E = 1.4426950408889634f;
constexpr float EPS = 1e-6f;

struct Params {
  const float *x, *c, *ctx, *c_ctx, *w_mod, *b_mod, *norm_g, *w_in, *kv_norm_g, *w_kv_up, *swa_sink, *hy_conv_w, *hy_conv_b,
      *hy_w1, *hy_b1, *hy_w2, *hy_b2, *hy_freq, *hy_w3, *hy_skip, *w_branch, *w_out, *w_up, *ffn_conv_w, *ffn_conv_b, *w_down;
  float* out;
  char* ws;
};

constexpr size_t OFF_WT_IN = 0;
constexpr size_t OFF_WT_GATE = OFF_WT_IN + (size_t)3456 * 1024 * 2;
constexpr size_t OFF_WT_KV = OFF_WT_GATE + (size_t)3072 * 1024 * 2;
constexpr size_t OFF_WT_BR = OFF_WT_KV + (size_t)1024 * 256 * 2;
constexpr size_t OFF_WT_OUT = OFF_WT_BR + (size_t)3 * 1024 * 512 * 2;
constexpr size_t OFF_WT_UP = OFF_WT_OUT + (size_t)1024 * 1024 * 2;
constexpr size_t OFF_WT_DOWN = OFF_WT_UP + (size_t)5632 * 1024 * 2;
constexpr size_t OFF_RH = OFF_WT_DOWN + (size_t)1024 * 2816 * 2;
constexpr size_t OFF_KN = OFF_RH + (size_t)MTOK * 1024 * 2;
constexpr size_t OFF_VT = OFF_KN + (size_t)MTOK * 512 * 2;
constexpr size_t OFF_KR = OFF_VT + (size_t)MTOK * 512 * 2;
constexpr size_t OFF_Q = OFF_KR + (size_t)MTOK * 32 * 2;
constexpr size_t OFF_SQ = OFF_Q + (size_t)MTOK * 768 * 2;
constexpr size_t OFF_CKV = OFF_SQ + (size_t)MTOK * 512 * 2;
constexpr size_t OFF_SK = OFF_CKV + (size_t)MTOK * 256 * 2;
constexpr size_t OFF_SVT = OFF_SK + (size_t)MTOK * 128 * 2;
constexpr size_t OFF_HYT = OFF_SVT + (size_t)MTOK * 128 * 2;
constexpr size_t OFF_SPEC = OFF_HYT + (size_t)MTOK * 1536 * 2;
constexpr size_t OFF_XCTX = OFF_SPEC + (size_t)1024 * 2 * 8192 * 4;
constexpr size_t OFF_MOD = OFF_XCTX + (size_t)1024 * 1024 * 4;
constexpr size_t OFF_ROPE = OFF_MOD + (size_t)2 * 5 * 6144 * 4;
constexpr size_t OFF_HID = OFF_ROPE + (size_t)8192 * 96 * 4;
constexpr size_t HID_LAYER = (size_t)64 * (8192 + 256) * 4;
constexpr size_t OFF_ESCR = OFF_HID + 2 * HID_LAYER;
constexpr size_t OFF_BAR = OFF_ESCR + (size_t)512 * 65536;
constexpr size_t BAR_BYTES = 3456 * 4;
constexpr size_t WS_NEED = OFF_BAR + BAR_BYTES;
constexpr size_t OFF_A = OFF_Q;
constexpr size_t OFF_MERGED = OFF_KN;
constexpr size_t OFF_Y = OFF_HYT;
constexpr size_t OFF_HP = OFF_KN;
constexpr size_t OFF_YCT = OFF_RH;
constexpr size_t OFF_YA = OFF_RH + (size_t)MTOK * 512 * 2;
static_assert(OFF_A + (size_t)MTOK * 2816 * 2 <= OFF_SPEC, "A overlay");
static_assert(WS_NEED <= (size_t)512 * 1024 * 1024, "ws");

DI int opq(int x) { asm volatile("" : "+v"(x)); return x; }
DI float ldsc1(const float* p) { return __hip_atomic_load(p, __ATOMIC_RELAXED, __HIP_MEMORY_SCOPE_AGENT); }
DI float bf2f(u16 v) { return __uint_as_float(((unsigned)v) << 16); }
DI unsigned pack2(float a, float b) { f2_t v = {a, b}; return __builtin_bit_cast(unsigned, __builtin_convertvector(v, bf2_t)); }
DI u16 f2bf(float a) { return (u16)(pack2(a, 0.f) & 0xffffu); }
DI float lo_bf(unsigned u) { return __uint_as_float(u << 16); }
DI float hi_bf(unsigned u) { return __uint_as_float(u & 0xffff0000u); }
DI int crow(int i, int h) { return (i & 3) + 8 * (i >> 2) + 4 * h; }
DI float wave_sum(float v) {
#pragma unroll
  for (int o = 32; o > 0; o >>= 1) v += __shfl_xor(v, o);
  return v;
}
DI float sinrev(float r) { return __builtin_amdgcn_sinf(r - floorf(r)); }
DI float cosrev(float r) { return __builtin_amdgcn_cosf(r - floorf(r)); }
#if DBG_TRIVTW
#define COSREV(f) (1.0f)
#define SINREV(f) (0.0f * (f))
#else
#define COSREV(f) cosrev(f)
#define SINREV(f) sinrev(f)
#endif
#define SYNC() __syncthreads()
DI float2 cmul(float2 a, float2 b) { return make_float2(a.x * b.x - a.y * b.y, a.x * b.y + a.y * b.x); }
DI float2 cmulc(float2 a, float2 b) { return make_float2(a.x * b.x + a.y * b.y, a.y * b.x - a.x * b.y); }
#ifndef DBG_NOSWZ
#define DBG_NOSWZ 0
#endif
DI int fphys(int i) { return DBG_NOSWZ ? i : (i ^ ((i >> 4) & 15)); }
DI float2 twid_rev(float fr) { return make_float2(COSREV(fr), -SINREV(fr)); }

DI float2 root16(int e) {
  const float C1 = 0.92387953251128674f, S1 = 0.38268343236508977f, R = 0.70710678118654752f;
  switch (e) {
    case 0: return make_float2(1.f, 0.f);
    case 1: return make_float2(C1, -S1);
    case 2: return make_float2(R, -R);
    case 3: return make_float2(S1, -C1);
    case 4: return make_float2(0.f, -1.f);
    case 5: return make_float2(-S1, -C1);
    case 6: return make_float2(-R, -R);
    default: return make_float2(-C1, -S1);
  }
}
template <int R, int HALF, int S, bool INV, bool HASW>
DI void fft_stage(float2 (&v)[R], const float2 (&wp)[4]) {
#pragma unroll
  for (int idx = 0; idx < R / 2; ++idx) {
    const int blk = idx / HALF, jj = idx % HALF;
    const int j0 = blk * 2 * HALF + jj, j1 = j0 + HALF;
    const int e = jj * (8 / HALF);
    float2 tw = root16(e);
    if (HASW) { if (e == 0) tw = wp[S]; else tw = cmul(wp[S], tw); }
    const bool triv = (!HASW) && (e == 0);
    if (!INV) {
      float2 a = v[j0], b = v[j1];
      v[j0] = make_float2(a.x + b.x, a.y + b.y);
      float2 d = make_float2(a.x - b.x, a.y - b.y);
      v[j1] = triv ? d : cmul(d, tw);
    } else {
      float2 t = triv ? v[j1] : cmulc(v[j1], tw);
      float2 a = v[j0];
      v[j0] = make_float2(a.x + t.x, a.y + t.y);
      v[j1] = make_float2(a.x - t.x, a.y - t.y);
    }
  }
}
template <bool INV> DI void fft_local8(float2 (&v)[8], const float2 (&wp)[4]) {
  if (!INV) { fft_stage<8, 4, 0, false, true>(v, wp); fft_stage<8, 2, 1, false, true>(v, wp); fft_stage<8, 1, 2, false, true>(v, wp); }
  else      { fft_stage<8, 1, 2, true, true>(v, wp); fft_stage<8, 2, 1, true, true>(v, wp); fft_stage<8, 4, 0, true, true>(v, wp); }
}
template <bool INV> DI void fft_local16(float2 (&v)[16], const float2 (&wp)[4]) {
  if (!INV) { fft_stage<16, 8, 0, false, false>(v, wp); fft_stage<16, 4, 1, false, false>(v, wp); fft_stage<16, 2, 2, false, false>(v, wp); fft_stage<16, 1, 3, false, false>(v, wp); }
  else      { fft_stage<16, 1, 3, true, false>(v, wp); fft_stage<16, 2, 2, true, false>(v, wp); fft_stage<16, 4, 1, true, false>(v, wp); fft_stage<16, 8, 0, true, false>(v, wp); }
}

template <int LQ, bool INV> DI void fft_pass8(float2* lds, int tid) {
  constexpr int q = 1 << LQ;
#pragma unroll 1
  for (int it = 0; it < 4; ++it) {
    const int task = tid + 256 * it;
    const int p = task & (q - 1);
    const int g = task >> LQ;
    const int base = g * 8 * q + p;
    float2 v[8];
#pragma unroll
    for (int j = 0; j < 8; ++j) v[j] = lds[fphys(base + j * q)];
    float2 wp[4];
    wp[0] = twid_rev((float)p * (1.0f / (float)(8 * q)));
    wp[1] = cmul(wp[0], wp[0]);
    wp[2] = cmul(wp[1], wp[1]);
    wp[3] = wp[2];
    fft_local8<INV>(v, wp);
#pragma unroll
    for (int j = 0; j < 8; ++j) lds[fphys(base + j * q)] = v[j];
  }
}
template <bool INV> DI void fft_pass16(float2* lds, int tid) {
#pragma unroll 1
  for (int it = 0; it < 2; ++it) {
    const int g = tid + 256 * it;
    float2 v[16];
    const int sw = DBG_NOSWZ ? 0 : (g & 15);
#pragma unroll
    for (int j = 0; j < 16; ++j) v[j] = lds[g * 16 + (j ^ sw)];
    float2 wp[4] = {make_float2(1.f, 0.f), make_float2(1.f, 0.f), make_float2(1.f, 0.f), make_float2(1.f, 0.f)};
    fft_local16<INV>(v, wp);
#pragma unroll
    for (int j = 0; j < 16; ++j) lds[g * 16 + (j ^ sw)] = v[j];
  }
}
#ifndef DBG_FFTPASSES
#define DBG_FFTPASSES 15
#endif
DI void fft8192_fwd(float2* lds, int tid) {
  if (DBG_FFTPASSES & 1) { fft_pass8<10, false>(lds, tid); SYNC(); }
  if (DBG_FFTPASSES & 2) { fft_pass8<7, false>(lds, tid); SYNC(); }
  if (DBG_FFTPASSES & 4) { fft_pass8<4, false>(lds, tid); SYNC(); }
  if (DBG_FFTPASSES & 8) { fft_pass16<false>(lds, tid); SYNC(); }
}
DI void fft8192_inv(float2* lds, int tid) {
  fft_pass16<true>(lds, tid); SYNC();
  fft_pass8<4, true>(lds, tid); SYNC();
  fft_pass8<7, true>(lds, tid); SYNC();
  fft_pass8<10, true>(lds, tid); SYNC();
}

template <bool SWAP, bool ATR = false, int MTW = 2>
DI void gemm_main(const u16* __restrict__ A, int lda, int a_row0, int a_lo, int a_hi, int a_kstep,
                  const u16* __restrict__ B, int ldb, int nk, f32x16 (&acc)[MTW][2], char* smem) {
  constexpr int ROWS = MTW * 64, NA = MTW * 2;
  const int tid = opq(threadIdx.x), lane = tid & 63, wave = tid >> 6, wm = wave >> 1, wn = wave & 1, r = lane & 31, h = lane >> 5;
  char* sA = smem;
  char* sB = smem + ROWS * 144;
  const u16* ap[NA];
  const u16* bp[4];
  int loa[NA], lob[4];
#pragma unroll
  for (int i = 0; i < NA; ++i) {
    const int idx = tid + 256 * i, row = idx >> 3, ch = idx & 7;
    if (ATR) {
      ap[i] = A + (size_t)(idx & 63) * lda + a_row0 + (idx >> 6) * 8;
    } else {
      const int gr = min(max(a_row0 + row, a_lo), a_hi);
      ap[i] = A + (size_t)gr * lda + ch * 8;
    }
    loa[i] = row * 144 + ch * 16;
  }
#pragma unroll
  for (int i = 0; i < 4; ++i) {
    const int idx = tid + 256 * i, row = idx >> 3, ch = idx & 7;
    bp[i] = B + (size_t)row * ldb + ch * 8;
    lob[i] = row * 144 + ch * 16;
  }
  u32x4 ra0[NA], rb0[4];
#define GEMM_LOAD(RA, RB, KT)                                                                                         \
  _Pragma("unroll") for (int i = 0; i < NA; ++i)                                                                      \
    RA[i] = *(const u32x4*)(ap[i] + (ATR ? (size_t)(KT) * 64 * lda : (size_t)(KT) * a_kstep));                        \
  _Pragma("unroll") for (int i = 0; i < 4; ++i) RB[i] = *(const u32x4*)(bp[i] + (KT) * 64);
#define GEMM_STASH(RA, RB)                                                                                            \
  _Pragma("unroll") for (int i = 0; i < NA; ++i) {                                                                    \
    if (ATR) {                                                                                                        \
      const int idx = tid + 256 * i, krow = idx & 63, mch = idx >> 6;                                                 \
      _Pragma("unroll") for (int e = 0; e < 4; ++e) {                                                                 \
        *(u16*)(sA + (mch * 8 + 2 * e) * 144 + krow * 2) = (u16)(RA[i][e] & 0xffffu);                                 \
        *(u16*)(sA + (mch * 8 + 2 * e + 1) * 144 + krow * 2) = (u16)(RA[i][e] >> 16);                                 \
      }                                                                                                               \
    } else {                                                                                                          \
      *(u32x4*)(sA + loa[i]) = RA[i];                                                                                 \
    }                                                                                                                 \
  }                                                                                                                   \
  _Pragma("unroll") for (int i = 0; i < 4; ++i) *(u32x4*)(sB + lob[i]) = RB[i];
#define GEMM_COMPUTE()                                                                                                \
  __builtin_amdgcn_s_setprio(1);                                                                                      \
  _Pragma("unroll") for (int ks = 0; ks < 4; ++ks) {                                                                  \
    bf16x8 af[MTW], bfr[2];                                                                                           \
    _Pragma("unroll") for (int t = 0; t < MTW; ++t) af[t] = *(const bf16x8*)(pa + t * 32 * 144 + ks * 32);            \
    _Pragma("unroll") for (int t = 0; t < 2; ++t) bfr[t] = *(const bf16x8*)(pb + t * 32 * 144 + ks * 32);             \
    _Pragma("unroll") for (int mt = 0; mt < MTW; ++mt)                                                                \
      _Pragma("unroll") for (int nt = 0; nt < 2; ++nt)                                                                \
        acc[mt][nt] = SWAP ? MFMA(bfr[nt], af[mt], acc[mt][nt]) : MFMA(af[mt], bfr[nt], acc[mt][nt]);                 \
  }                                                                                                                   \
  __builtin_amdgcn_s_setprio(0);
  GEMM_LOAD(ra0, rb0, 0)
#pragma unroll
  for (int mt = 0; mt < MTW; ++mt)
#pragma unroll
    for (int nt = 0; nt < 2; ++nt)
#pragma unroll
      for (int i = 0; i < 16; ++i) acc[mt][nt][i] = 0.f;
  const char* pa = sA + (wm * (MTW * 32) + r) * 144 + h * 16;
  const char* pb = sB + (wn * 64 + r) * 144 + h * 16;
#pragma unroll 1
  for (int kk = 0; kk < nk; ++kk) {
    __syncthreads();
    GEMM_STASH(ra0, rb0)
    __syncthreads();
    if (kk + 1 < nk) { GEMM_LOAD(ra0, rb0, kk + 1) }
    GEMM_COMPUTE()
  }
#undef GEMM_LOAD
#undef GEMM_STASH
#undef GEMM_COMPUTE
}
template <int MTW>
DI void store_rowmajor(const f32x16 (&acc)[MTW][2], u16* C, int ldc, int m0, int ncol0, float scale) {
  const int tid = opq(threadIdx.x), lane = tid & 63, wave = tid >> 6, wm = wave >> 1, wn = wave & 1, r = lane & 31, h = lane >> 5;
#pragma unroll
  for (int mt = 0; mt < MTW; ++mt)
#pragma unroll
    for (int nt = 0; nt < 2; ++nt)
#pragma unroll
      for (int g = 0; g < 4; ++g) {
        const int m = m0 + wm * (MTW * 32) + mt * 32 + r, n = ncol0 + wn * 64 + nt * 32 + 8 * g + 4 * h;
        u32x2 pk;
        pk.x = pack2(acc[mt][nt][4 * g] * scale, acc[mt][nt][4 * g + 1] * scale);
        pk.y = pack2(acc[mt][nt][4 * g + 2] * scale, acc[mt][nt][4 * g + 3] * scale);
        *(u32x2*)(C + (size_t)m * ldc + n) = pk;
      }
}
template <int MTW>
DI void store_transposed(const f32x16 (&acc)[MTW][2], u16* T, int ldt, int trow0, int j0) {
  const int tid = opq(threadIdx.x), lane = tid & 63, wave = tid >> 6, wm = wave >> 1, wn = wave & 1, r = lane & 31, h = lane >> 5;
#pragma unroll
  for (int mt = 0; mt < MTW; ++mt)
#pragma unroll
    for (int nt = 0; nt < 2; ++nt)
#pragma unroll
      for (int g = 0; g < 4; ++g) {
        const int n = trow0 + wn * 64 + nt * 32 + r, m = j0 + wm * (MTW * 32) + mt * 32 + 8 * g + 4 * h;
        u32x2 pk;
        pk.x = pack2(acc[mt][nt][4 * g], acc[mt][nt][4 * g + 1]);
        pk.y = pack2(acc[mt][nt][4 * g + 2], acc[mt][nt][4 * g + 3]);
        *(u32x2*)(T + (size_t)n * ldt + m) = pk;
      }
}

constexpr int NCONV_TILES = 864 + 768 + 64 + 384 + 256 + 1408 + 704;
DI void conv_tile(const Params& p, int l, int tile, char* smem) {
  float* t = (float*)smem;
  const int tid = opq(threadIdx.x);
  int mat, tn, tk;
  if (tile < 864) { mat = 0; tn = tile / 16; tk = tile % 16; }
  else if (tile < 1632) { tile -= 864; mat = 1; tn = tile / 16; tk = tile % 16; }
  else if (tile < 1696) { tile -= 1632; mat = 2; tn = tile / 4; tk = tile % 4; }
  else if (tile < 2080) { tile -= 1696; mat = 3; tn = tile / 8; tk = tile % 8; }
  else if (tile < 2336) { tile -= 2080; mat = 4; tn = tile / 16; tk = tile % 16; }
  else if (tile < 3744) { tile -= 2336; mat = 5; tn = tile / 16; tk = tile % 16; }
  else { tile -= 3744; mat = 6; tn = tile / 44; tk = tile % 44; }
  const int k0 = tk * 64;
  const int nn = tid & 63;
  int np = tn * 64 + nn;
  const float* src; int ld; int col;
  if (mat == 0) { src = p.w_in + (size_t)l * 1024 * 6432; ld = 6432; col = np < 1024 ? np : (np < 3328 ? np + 32 : (np < 3360 ? np - 3328 + 1024 : -1)); }
  else if (mat == 1) { src = p.w_in + (size_t)l * 1024 * 6432; ld = 6432; col = 3360 + np; }
  else if (mat == 2) { src = p.w_kv_up + (size_t)l * 256 * 1024; ld = 1024; col = np < 512 ? (np >> 6) * 128 + (np & 63) : ((np - 512) >> 6) * 128 + 64 + (np & 63); }
  else if (mat == 3) { const int br = tn / 16; np = (tn % 16) * 64 + nn; src = p.w_branch + (size_t)(l * 3 + br) * 512 * 1024; ld = 1024; col = np; }
  else if (mat == 4) { src = p.w_out + (size_t)l * 1024 * 1024; ld = 1024; col = np; }
  else if (mat == 5) { src = p.w_up + (size_t)l * 1024 * 5632; ld = 5632; const int blk = np >> 7, rr = np & 127; col = rr < 64 ? blk * 64 + rr : 2816 + blk * 64 + rr - 64; }
  else { src = p.w_down + (size_t)l * 2816 * 1024; ld = 1024; col = np; }
#pragma unroll 4
  for (int i = 0; i < 16; ++i) {
    const int kk = (tid >> 6) + 4 * i;
    float v = 0.f;
    if (col >= 0) v = src[(size_t)(k0 + kk) * ld + col];
    if (mat == 2) v *= p.kv_norm_g[l * 256 + k0 + kk];
    t[kk * 65 + nn] = v;
  }
  __syncthreads();
  {
    const int n2 = tid >> 2, kq = (tid & 3) * 16;
    const int drow = tn * 64 + n2;
    u16* dst;
    if (mat == 0) dst = (u16*)(p.ws + OFF_WT_IN) + (size_t)drow * 1024;
    else if (mat == 1) dst = (u16*)(p.ws + OFF_WT_GATE) + (size_t)drow * 1024;
    else if (mat == 2) dst = (u16*)(p.ws + OFF_WT_KV) + (size_t)drow * 256;
    else if (mat == 3) dst = (u16*)(p.ws + OFF_WT_BR) + (size_t)drow * 512;
    else if (mat == 4) dst = (u16*)(p.ws + OFF_WT_OUT) + (size_t)drow * 1024;
    else if (mat == 5) dst = (u16*)(p.ws + OFF_WT_UP) + (size_t)drow * 1024;
    else dst = (u16*)(p.ws + OFF_WT_DOWN) + (size_t)drow * 2816;
    unsigned pk[8];
#pragma unroll
    for (int j = 0; j < 8; ++j) pk[j] = pack2(t[(kq + 2 * j) * 65 + n2], t[(kq + 2 * j + 1) * 65 + n2]);
    u32x4* d4 = (u32x4*)(dst + k0 + kq);
    d4[0] = u32x4{pk[0], pk[1], pk[2], pk[3]};
    d4[1] = u32x4{pk[4], pk[5], pk[6], pk[7]};
  }
  __syncthreads();
}

DI void mod_item(const Params& p, int item, char* smem) {
  float* sv = (float*)smem;
  float* red = sv + 5 * 1024;
  const int tid = opq(threadIdx.x);
  const int l = item / 96, cg0 = (item % 96) * 64;
  for (int i = tid; i < 5 * 1024; i += 256) {
    const int v = i >> 10, k = i & 1023;
    const float c = v < 4 ? p.c[v * 1024 + k] : p.c_ctx[k];
    sv[i] = c / (1.f + __expf(-c));
  }
  __syncthreads();
  const int kq = tid >> 6, cc = tid & 63, col = cg0 + cc;
  float a[5] = {0.f, 0.f, 0.f, 0.f, 0.f};
  const float* w = p.w_mod + (size_t)l * 1024 * 6144 + col;
#pragma unroll 8
  for (int k = kq * 256; k < kq * 256 + 256; ++k) {
    const float wv = w[(size_t)k * 6144];
#pragma unroll
    for (int v = 0; v < 5; ++v) a[v] += sv[v * 1024 + k] * wv;
  }
#pragma unroll
  for (int v = 0; v < 5; ++v) red[(kq * 5 + v) * 64 + cc] = a[v];
  __syncthreads();
  for (int i = tid; i < 5 * 64; i += 256) {
    const int v = i >> 6, c2 = i & 63;
    float s = p.b_mod[l * 6144 + cg0 + c2];
#pragma unroll
    for (int q = 0; q < 4; ++q) s += red[(q * 5 + v) * 64 + c2];
    ((float*)(p.ws + OFF_MOD))[(l * 5 + v) * 6144 + cg0 + c2] = s;
  }
  __syncthreads();
}

DI void rope_item(const Params& p, int item) {
  const int e = item * 256 + opq(threadIdx.x);
  const int pos = e / 48, f = e % 48;
  const int row = pos >> 6, colp = pos & 63;
  float* base = (float*)(p.ws + OFF_ROPE);
  float ang; float *cd, *sd;
  if (f < 16) {
    const int fi = f & 7;
    const float inv = exp2f(-(float)fi * (13.287712379549449f / 8.f));
    ang = (f < 8 ? (float)row : (float)colp) * inv;
    cd = base + pos * 16 + f; sd = base + 8192 * 16 + pos * 16 + f;
  } else {
    const int f2 = f - 16, fi = f2 & 15;
    const float inv = exp2f(-(float)fi * (13.287712379549449f / 16.f));
    ang = (f2 < 16 ? (float)row : (float)colp) * inv;
    cd = base + 2 * 8192 * 16 + pos * 32 + f2; sd = base + 2 * 8192 * 16 + 8192 * 32 + pos * 32 + f2;
  }
  const float rev = ang * 0.15915494309189535f;
  *cd = cosrev(rev);
  *sd = sinrev(rev);
}

DI void hid_item(const Params& p, int item, char* smem) {
  float* feat = (float*)smem;
  float* h1 = feat + 4 * 36;
  const int tid = opq(threadIdx.x);
  const int l = item / 264; const int it = item % 264;
  int L, pos00; float* dst;
  if (it < 256) { L = 8192; pos00 = it * 32; dst = (float*)(p.ws + OFF_HID + l * HID_LAYER); }
  else { L = 256; pos00 = (it - 256) * 32; dst = (float*)(p.ws + OFF_HID + l * HID_LAYER) + 64 * 8192; }
  const int pp = tid >> 6, j = tid & 63;
#pragma unroll 1
  for (int sub = 0; sub < 8; ++sub) {
    const int pos = pos00 + sub * 4 + pp;
    if (j < 33) {
      float fv;
      if (j == 0) fv = (float)pos / (float)(L - 1);
      else {
        const int bi = (j - 1) & 15;
        const float band = 1e-4f + (float)bi * ((15.f - 1e-4f) / 15.f);
        const float rev = (float)pos * band / (float)L;
        fv = (j <= 16) ? cosrev(rev) : -sinrev(rev);
      }
      feat[pp * 36 + j] = fv;
    }
    __syncthreads();
    {
      float s = p.hy_b1[l * 64 + j];
      const float* w1 = p.hy_w1 + (size_t)l * 33 * 64;
#pragma unroll
      for (int f = 0; f < 33; ++f) s += feat[pp * 36 + f] * w1[f * 64 + j];
      s *= p.hy_freq[l * 128 + j];
      h1[pp * 64 + j] = sinrev(s * 0.15915494309189535f);
    }
    __syncthreads();
    {
      float s = p.hy_b2[l * 64 + j];
      const float* w2 = p.hy_w2 + (size_t)l * 64 * 64;
#pragma unroll 8
      for (int i = 0; i < 64; ++i) s += h1[pp * 64 + i] * w2[i * 64 + j];
      s *= p.hy_freq[l * 128 + 64 + j];
      dst[(size_t)j * L + pos] = sinrev(s * 0.15915494309189535f);
    }
    __syncthreads();
  }
}

DI const float* xrow_src(const float* xl, const float* xc, int m) {
  const int b = m / TPB, j = m - b * TPB;
  return j < CTX ? xc + (size_t)(b * CTX + j) * DM : xl + (size_t)(b * SEQ + j - CTX) * DM;
}
DI void row_pass(const Params& p, int mode, const float* xl_src, const float* xc_src, float* xl_dst, float* xc_dst,
                 const u16* ybuf, const float* gy, int gate_off, int modl_gate,
                 bool has_next, const float* gn, int modl_next, int sh_off, int sc_off, u16* hdst, bool skip_ctx_rows) {
  const int tid0 = opq(threadIdx.x);
  const int lane = tid0 & 63;
  const int gw = blockIdx.x * 4 + (tid0 >> 6), nw = gridDim.x * 4;
  const float* modb = (const float*)(p.ws + OFF_MOD);
  const int per = (MTOK + nw - 1) / nw;
  const int m_beg = gw * per, m_end = min(m_beg + per, MTOK);
  int cur_v = -1;
  float4 gg[4], gs[4], shv[4];
#pragma unroll
  for (int i = 0; i < 4; ++i) { gg[i] = make_float4(0.f, 0.f, 0.f, 0.f); gs[i] = gg[i]; shv[i] = gg[i]; }
  const bool do_h = (mode == 0) || has_next;
  float4 xv_n[4];
  u32x2 yr_n[4];
#pragma unroll
  for (int i = 0; i < 4; ++i) { xv_n[i] = make_float4(0.f, 0.f, 0.f, 0.f); yr_n[i] = u32x2{0u, 0u}; }
  if (m_beg < m_end) {
    const float* xs0 = xrow_src(xl_src, xc_src, m_beg);
#pragma unroll
    for (int i = 0; i < 4; ++i) {
      xv_n[i] = *(const float4*)(xs0 + lane * 4 + 256 * i);
      if (mode == 1) yr_n[i] = *(const u32x2*)(ybuf + (size_t)m_beg * DM + lane * 4 + 256 * i);
    }
  }
  for (int m = m_beg; m < m_end; ++m) {
    const int b = m / TPB, j = m - b * TPB;
    float4 xv[4];
    u32x2 yr[4];
#pragma unroll
    for (int i = 0; i < 4; ++i) { xv[i] = xv_n[i]; yr[i] = yr_n[i]; }
    if (m + 1 < m_end) {
      const float* xs1 = xrow_src(xl_src, xc_src, m + 1);
#pragma unroll
      for (int i = 0; i < 4; ++i) {
        xv_n[i] = *(const float4*)(xs1 + lane * 4 + 256 * i);
        if (mode == 1) yr_n[i] = *(const u32x2*)(ybuf + (size_t)(m + 1) * DM + lane * 4 + 256 * i);
      }
    }
    if (skip_ctx_rows && j < CTX) continue;
    const int v = j < CTX ? 4 : b;
    if (v != cur_v) {
      cur_v = v;
#pragma unroll
      for (int i = 0; i < 4; ++i) {
        const int c = lane * 4 + 256 * i;
        if (mode == 1) {
          const float4 g4 = *(const float4*)(gy + c);
          const float4 t4 = *(const float4*)(modb + (size_t)(modl_gate * 5 + v) * 6144 + gate_off + c);
          gg[i] = make_float4(g4.x * t4.x, g4.y * t4.y, g4.z * t4.z, g4.w * t4.w);
        }
        if (do_h) {
          const float* mb = modb + (size_t)(modl_next * 5 + v) * 6144;
          const float4 g4 = *(const float4*)(gn + c);
          const float4 sc = *(const float4*)(mb + sc_off + c);
          shv[i] = *(const float4*)(mb + sh_off + c);
          gs[i] = make_float4(g4.x * (1.f + sc.x), g4.y * (1.f + sc.y), g4.z * (1.f + sc.z), g4.w * (1.f + sc.w));
        }
      }
    }
    if (mode == 1) {
      float yv[4][4];
      float ss = 0.f;
#pragma unroll
      for (int i = 0; i < 4; ++i) {
        const u32x2 u = yr[i];
        yv[i][0] = lo_bf(u.x); yv[i][1] = hi_bf(u.x); yv[i][2] = lo_bf(u.y); yv[i][3] = hi_bf(u.y);
#pragma unroll
        for (int e = 0; e < 4; ++e) ss += yv[i][e] * yv[i][e];
      }
      ss = wave_sum(ss);
      const float rstd = rsqrtf(ss * (1.f / DM) + EPS);
#pragma unroll
      for (int i = 0; i < 4; ++i) {
        xv[i].x += gg[i].x * (yv[i][0] * rstd);
        xv[i].y += gg[i].y * (yv[i][1] * rstd);
        xv[i].z += gg[i].z * (yv[i][2] * rstd);
        xv[i].w += gg[i].w * (yv[i][3] * rstd);
      }
      float* xd = (j < CTX) ? xc_dst + (size_t)(b * CTX + j) * DM : xl_dst + (size_t)(b * SEQ + j - CTX) * DM;
#pragma unroll
      for (int i = 0; i < 4; ++i) *(float4*)(xd + lane * 4 + 256 * i) = xv[i];
    }
    if (do_h) {
      float ss = 0.f;
#pragma unroll
      for (int i = 0; i < 4; ++i) ss += xv[i].x * xv[i].x + xv[i].y * xv[i].y + xv[i].z * xv[i].z + xv[i].w * xv[i].w;
      ss = wave_sum(ss);
      const float rstd = rsqrtf(ss * (1.f / DM) + EPS);
#pragma unroll
      for (int i = 0; i < 4; ++i) {
        const int c = lane * 4 + 256 * i;
        u32x2 pk;
        pk.x = pack2(xv[i].x * rstd * gs[i].x + shv[i].x, xv[i].y * rstd * gs[i].y + shv[i].y);
        pk.y = pack2(xv[i].z * rstd * gs[i].z + shv[i].z, xv[i].w * rstd * gs[i].w + shv[i].w);
        *(u32x2*)(hdst + (size_t)m * DM + c) = pk;
      }
    }
  }
}

constexpr float QS_MLA = 0.10206207261596577f * LOG2E;
constexpr float QS_SWA = 0.125f * LOG2E;

DI void rope32(f32x16& a, const float* cm, const float* sm, int pos, int h) {
#pragma unroll
  for (int i = 0; i < 8; ++i) {
    const int f = crow(i, h);
    const float c = cm[pos * 16 + f], s = sm[pos * 16 + f];
    const float x1 = a[i], x2 = a[i + 8];
    a[i] = x1 * c - x2 * s;
    a[i + 8] = x2 * c + x1 * s;
    if ((i & 3) == 3) __builtin_amdgcn_sched_barrier(0);
  }
}
DI void rope64(f32x16& a0, f32x16& a1, const float* cs, const float* ss, int pos, int h) {
#pragma unroll
  for (int i = 0; i < 16; ++i) {
    const int f = crow(i, h);
    const float c = cs[pos * 32 + f], s = ss[pos * 32 + f];
    const float x1 = a0[i], x2 = a1[i];
    a0[i] = x1 * c - x2 * s;
    a1[i] = x2 * c + x1 * s;
    if ((i & 3) == 3) __builtin_amdgcn_sched_barrier(0);
  }
}

DI void inproj_tile(const Params& p, int tile, char* smem) {
  const int mt_i = tile / 27, nt_i = tile % 27;
  const int m0 = mt_i * 192;
  const int tid = opq(threadIdx.x), lane = tid & 63, wave = tid >> 6, wm = wave >> 1, wn = wave & 1, r = lane & 31, h = lane >> 5;
  const u16* hbuf = (const u16*)(p.ws + OFF_RH);
  const u16* wt = (const u16*)(p.ws + OFF_WT_IN) + (size_t)nt_i * 128 * 1024;
  const int b = m0 / TPB, j0 = m0 - b * TPB;
  const float* cm = (const float*)(p.ws + OFF_ROPE);
  const float* sm = cm + 8192 * 16;
  const float* cs = sm + 8192 * 16;
  const float* ss = cs + 8192 * 32;
  f32x16 acc[3][2];
  if (nt_i >= 13 && nt_i <= 25) {
    gemm_main<false>(hbuf, 1024, m0, 0, MTOK - 1, 64, wt, 1024, 16, acc, smem);
    if (nt_i == 13) store_transposed(acc, (u16*)(p.ws + OFF_SVT), TPB, b * 128, j0);
    else store_transposed(acc, (u16*)(p.ws + OFF_HYT), TPB, b * 1536 + (nt_i - 14) * 128, j0);
    return;
  }
  gemm_main<true>(hbuf, 1024, m0, 0, MTOK - 1, 64, wt, 1024, 16, acc, smem);
  if (nt_i < 6) {
#pragma unroll
    for (int ntl = 0; ntl < 2; ++ntl) {
      const int s32 = nt_i * 4 + wn * 2 + ntl;
      if (s32 % 3 == 2) {
#pragma unroll
        for (int mt = 0; mt < 3; ++mt) {
          const int jr = j0 + wm * 96 + mt * 32 + r;
          if (jr >= CTX) rope32(acc[mt][ntl], cm, sm, jr - CTX, h);
        }
      }
    }
    store_rowmajor(acc, (u16*)(p.ws + OFF_Q), 768, m0, nt_i * 128, QS_MLA);
  } else if (nt_i < 8) {
    store_rowmajor(acc, (u16*)(p.ws + OFF_CKV), 256, m0, (nt_i - 6) * 128, 1.f);
  } else if (nt_i < 12) {
#pragma unroll
    for (int mt = 0; mt < 3; ++mt) {
      const int jr = j0 + wm * 96 + mt * 32 + r;
      if (jr >= CTX) rope64(acc[mt][0], acc[mt][1], cs, ss, jr - CTX, h);
    }
    store_rowmajor(acc, (u16*)(p.ws + OFF_SQ), 512, m0, (nt_i - 8) * 128, QS_SWA);
  } else if (nt_i == 12) {
#pragma unroll
    for (int mt = 0; mt < 3; ++mt) {
      const int jr = j0 + wm * 96 + mt * 32 + r;
      if (jr >= CTX) rope64(acc[mt][0], acc[mt][1], cs, ss, jr - CTX, h);
    }
    store_rowmajor(acc, (u16*)(p.ws + OFF_SK), 128, m0, 0, 1.f);
  } else {
    if (wn == 0) {
      u16* kr = (u16*)(p.ws + OFF_KR);
#pragma unroll
      for (int mt = 0; mt < 3; ++mt) {
        const int ml = wm * 96 + mt * 32 + r;
        if (j0 + ml >= CTX) rope32(acc[mt][0], cm, sm, j0 + ml - CTX, h);
#pragma unroll
        for (int g = 0; g < 4; ++g) {
          u32x2 pk;
          pk.x = pack2(acc[mt][0][4 * g], acc[mt][0][4 * g + 1]);
          pk.y = pack2(acc[mt][0][4 * g + 2], acc[mt][0][4 * g + 3]);
          *(u32x2*)(kr + (size_t)(m0 + ml) * 32 + 8 * g + 4 * h) = pk;
        }
      }
    }
  }
}

DI void kvup_tile(const Params& p, int tile, char* smem) {
  const int mt_i = tile >> 3, nt_i = tile & 7;
  const int m0 = mt_i * 192;
  const int tid = opq(threadIdx.x), lane = tid & 63, wave = tid >> 6, wm = wave >> 1, r = lane & 31, h = lane >> 5;
  const u16* ckv = (const u16*)(p.ws + OFF_CKV);
  float* rs = (float*)(smem + (192 + 128) * 144);
#pragma unroll
  for (int pass = 0; pass < 2; ++pass) {
    const int row = pass * 128 + (tid >> 1), half = tid & 1;
    const int rowc = min(row, 191);
    const u32x4* src = (const u32x4*)(ckv + (size_t)(m0 + rowc) * 256 + half * 128);
    float ss = 0.f;
#pragma unroll
    for (int i = 0; i < 16; ++i) {
      const u32x4 u = src[i];
      const unsigned w[4] = {u.x, u.y, u.z, u.w};
#pragma unroll
      for (int e = 0; e < 4; ++e) { const float a = lo_bf(w[e]), c = hi_bf(w[e]); ss += a * a + c * c; }
    }
    ss += __shfl_xor(ss, 1);
    if (half == 0 && row < 192) rs[row] = rsqrtf(ss * (1.f / 256.f) + EPS);
  }
  const u16* wt = (const u16*)(p.ws + OFF_WT_KV) + (size_t)nt_i * 128 * 256;
  const int b = m0 / TPB, j0 = m0 - b * TPB;
  f32x16 acc[3][2];
  if (nt_i < 4) {
    gemm_main<true>(ckv, 256, m0, 0, MTOK - 1, 64, wt, 256, 4, acc, smem);
#pragma unroll
    for (int mt = 0; mt < 3; ++mt) {
      const float sc = rs[wm * 96 + mt * 32 + r];
#pragma unroll
      for (int nt = 0; nt < 2; ++nt)
#pragma unroll
        for (int i = 0; i < 16; ++i) acc[mt][nt][i] *= sc;
    }
    store_rowmajor(acc, (u16*)(p.ws + OFF_KN), 512, m0, nt_i * 128, 1.f);
  } else {
    gemm_main<false>(ckv, 256, m0, 0, MTOK - 1, 64, wt, 256, 4, acc, smem);
#pragma unroll
    for (int mt = 0; mt < 3; ++mt)
#pragma unroll
      for (int i = 0; i < 16; ++i) {
        const float sc = rs[wm * 96 + mt * 32 + crow(i, h)];
        acc[mt][0][i] *= sc;
        acc[mt][1][i] *= sc;
      }
    store_transposed(acc, (u16*)(p.ws + OFF_VT), TPB, b * 512 + (nt_i - 4) * 128, j0);
  }
  __syncthreads();
}

DI void merge_tile(const Params& p, int tile, char* smem) {
  const int mt_i = tile >> 3, nt_i = tile & 7;
  const int m0 = mt_i * 192;
  const u16* hp = (const u16*)(p.ws + OFF_RH);
  const int tid = opq(threadIdx.x), lane = tid & 63, wave = tid >> 6, wm = wave >> 1, wn = wave & 1, r = lane & 31, h = lane >> 5;
  u16* C = (u16*)(p.ws + OFF_MERGED);
#pragma unroll 1
  for (int br = 0; br < 3; ++br) {
    if ((DBG_SKIP_BR >> br) & 1) continue;
    f32x16 acc[3][2];
    gemm_main<true>(hp, 1024, m0, 0, MTOK - 1, 64, (const u16*)(p.ws + OFF_WT_GATE) + (size_t)(br * 1024 + nt_i * 128) * 1024, 1024, 16, acc, smem);
    u32x2* sgp = (u32x2*)(p.ws + OFF_ESCR + (size_t)blockIdx.x * 65536) + tid * 24;
#pragma unroll
    for (int a = 0; a < 3; ++a)
#pragma unroll
      for (int b2 = 0; b2 < 2; ++b2)
#pragma unroll
        for (int g = 0; g < 4; ++g) {
          u32x2 v;
          v.x = pack2(1.f / (1.f + __expf(-acc[a][b2][4 * g])), 1.f / (1.f + __expf(-acc[a][b2][4 * g + 1])));
          v.y = pack2(1.f / (1.f + __expf(-acc[a][b2][4 * g + 2])), 1.f / (1.f + __expf(-acc[a][b2][4 * g + 3])));
          sgp[(a * 2 + b2) * 4 + g] = v;
        }
    const u16* wbr = (const u16*)(p.ws + OFF_WT_BR) + (size_t)(br * 1024 + nt_i * 128) * 512;
    if (br == 0) gemm_main<true>((const u16*)(p.ws + OFF_Q), 768, m0, 0, MTOK - 1, 96, wbr, 512, 8, acc, smem);
    else if (br == 1) gemm_main<true>((const u16*)(p.ws + OFF_SQ), 512, m0, 0, MTOK - 1, 64, wbr, 512, 8, acc, smem);
    else {
      const int b = m0 / TPB, j0 = m0 - b * TPB;
      gemm_main<true, true>((const u16*)(p.ws + OFF_HYT) + (size_t)(b * 1536 + 512) * TPB, TPB, j0, 0, 0, 64, wbr, 512, 8, acc, smem);
    }
#pragma unroll
    for (int mt = 0; mt < 3; ++mt)
#pragma unroll
      for (int nt = 0; nt < 2; ++nt)
#pragma unroll
        for (int g = 0; g < 4; ++g) {
          const int m = m0 + wm * 96 + mt * 32 + r, n = nt_i * 128 + wn * 64 + nt * 32 + 8 * g + 4 * h;
          u32x2* dst = (u32x2*)(C + (size_t)m * 1024 + n);
          u32x2 prev = {0u, 0u};
          if (br > DBG_FIRST_BR) prev = *dst;
          const u32x2 sv = sgp[(mt * 2 + nt) * 4 + g];
          const unsigned s0 = sv.x, s1 = sv.y;
          u32x2 nv;
          nv.x = pack2(lo_bf(prev.x) + lo_bf(s0) * acc[mt][nt][4 * g], hi_bf(prev.x) + hi_bf(s0) * acc[mt][nt][4 * g + 1]);
          nv.y = pack2(lo_bf(prev.y) + lo_bf(s1) * acc[mt][nt][4 * g + 2], hi_bf(prev.y) + hi_bf(s1) * acc[mt][nt][4 * g + 3]);
          *dst = nv;
          __builtin_amdgcn_sched_barrier(0);
        }
  }
}

DI void plain_tile(const Params& p, int tile, const u16* A, int lda, int nk, const u16* W, u16* C, char* smem) {
  const int mt_i = tile >> 3, nt_i = tile & 7;
  f32x16 acc[3][2];
  gemm_main<true>(A, lda, mt_i * 192, 0, MTOK - 1, 64, W + (size_t)nt_i * 128 * lda, lda, nk, acc, smem);
  store_rowmajor(acc, C, 1024, mt_i * 192, nt_i * 128, 1.f);
}

DI void ffnup_tile(const Params& p, int l, int tile, char* smem) {
  const int mt_i = tile / 44, nt_i = tile % 44;
  const int b = mt_i / 46, ti = mt_i % 46;
  int seq_base, len, r0;
  if (ti < 2) { seq_base = b * TPB; len = CTX; r0 = 190 * ti; }
  else { seq_base = b * TPB + CTX; len = SEQ; r0 = 190 * (ti - 2); }
  const int tid = opq(threadIdx.x), lane = tid & 63, wave = tid >> 6, wm = wave >> 1, wn = wave & 1, r = lane & 31, h = lane >> 5;
  f32x16 acc[3][2];
  gemm_main<true>((const u16*)(p.ws + OFF_RH), 1024, seq_base + r0 - 1, seq_base, seq_base + len - 1, 64,
                  (const u16*)(p.ws + OFF_WT_UP) + (size_t)nt_i * 128 * 1024, 1024, 16, acc, smem);
  __syncthreads();
#pragma unroll
  for (int mt = 0; mt < 3; ++mt) {
    const int ml = wm * 96 + mt * 32 + r;
    const int pos = r0 - 1 + ml;
    const bool valid = pos >= 0 && pos < len;
#pragma unroll
    for (int nt = 0; nt < 2; ++nt)
#pragma unroll
      for (int g = 0; g < 4; ++g) {
        u32x2 pk = u32x2{0u, 0u};
        if (valid) {
          pk.x = pack2(acc[mt][nt][4 * g], acc[mt][nt][4 * g + 1]);
          pk.y = pack2(acc[mt][nt][4 * g + 2], acc[mt][nt][4 * g + 3]);
        }
        *(u32x2*)(smem + ml * 272 + (wn * 64 + nt * 32 + 8 * g + 4 * h) * 2) = pk;
      }
  }
  __syncthreads();
  {
    const int j4 = (tid & 15) * 4, tr = tid >> 4;
    const float* cw = p.ffn_conv_w + (size_t)l * 3 * 5632;
    const float* cb = p.ffn_conv_b + (size_t)l * 5632;
    const int cha = nt_i * 64 + j4, chb = DFF + cha;
    float wa[3][4], wb[3][4], ba[4], bb[4];
#pragma unroll
    for (int e = 0; e < 4; ++e) {
#pragma unroll
      for (int d = 0; d < 3; ++d) { wa[d][e] = cw[d * 5632 + cha + e]; wb[d][e] = cw[d * 5632 + chb + e]; }
      ba[e] = cb[cha + e]; bb[e] = cb[chb + e];
    }
    u16* Aout = (u16*)(p.ws + OFF_A);
#pragma unroll 1
    for (int i = 0; i < 12; ++i) {
      const int t = 1 + tr + 16 * i;
      const int pos = r0 - 1 + t;
      if (t <= 190 && pos < len) {
        float ca[4], cbv[4];
#pragma unroll
        for (int e = 0; e < 4; ++e) { ca[e] = ba[e]; cbv[e] = bb[e]; }
#pragma unroll
        for (int d = 0; d < 3; ++d) {
          const u32x2 ua = *(const u32x2*)(smem + (t - 1 + d) * 272 + j4 * 2);
          const u32x2 ub = *(const u32x2*)(smem + (t - 1 + d) * 272 + (64 + j4) * 2);
          ca[0] += lo_bf(ua.x) * wa[d][0]; ca[1] += hi_bf(ua.x) * wa[d][1]; ca[2] += lo_bf(ua.y) * wa[d][2]; ca[3] += hi_bf(ua.y) * wa[d][3];
          cbv[0] += lo_bf(ub.x) * wb[d][0]; cbv[1] += hi_bf(ub.x) * wb[d][1]; cbv[2] += lo_bf(ub.y) * wb[d][2]; cbv[3] += hi_bf(ub.y) * wb[d][3];
        }
        float o[4];
#pragma unroll
        for (int e = 0; e < 4; ++e) o[e] = ca[e] / (1.f + __expf(-ca[e])) * cbv[e];
        *(u32x2*)(Aout + (size_t)(seq_base + pos) * DFF + cha) = u32x2{pack2(o[0], o[1]), pack2(o[2], o[3])};
      }
    }
  }
}

template <int DQK, bool SWA>
DI void attn_item(const Params& p, int l, int b, int hq, int jq0  , int nct, int nband, int kp_start, char* smem) {
  constexpr int KS = DQK * 2 + 16;
  constexpr int KCH = DQK / 8;
  constexpr int NKC = 64 * KCH / 256;
  constexpr int NKS = DQK / 16;
  constexpr int BUFSZ = 22016;
  const int tid = opq(threadIdx.x), lane = tid & 63, wave = tid >> 6, r = lane & 31, h = lane >> 5;
  const int brow = b * TPB;
  const int ntiles = nct + nband;
  const u16* K1; int ldk1, koff; const u16* KR = (const u16*)(p.ws + OFF_KR);
  const u16* Vb; u16* outp; int ldo, ooff; const u16* Qb; int ldq;
  if (!SWA) {
    K1 = (const u16*)(p.ws + OFF_KN); ldk1 = 512; koff = hq * 64;
    Vb = (const u16*)(p.ws + OFF_VT) + (size_t)((b * 8 + hq) * 64) * TPB;
    Qb = (const u16*)(p.ws + OFF_Q); ldq = 768;
    outp = (u16*)(p.ws + OFF_Q); ldo = 768; ooff = hq * 96;
  } else {
    const int kvh = hq >> 2;
    K1 = (const u16*)(p.ws + OFF_SK); ldk1 = 128; koff = kvh * 64;
    Vb = (const u16*)(p.ws + OFF_SVT) + (size_t)((b * 2 + kvh) * 64) * TPB;
    Qb = (const u16*)(p.ws + OFF_SQ); ldq = 512;
    outp = (u16*)(p.ws + OFF_SQ); ldo = 512; ooff = hq * 64;
  }
  const int qrow = brow + jq0 + wave * 32 + r;
  bf16x8 qf[NKS];
#pragma unroll
  for (int ks = 0; ks < NKS; ++ks) qf[ks] = *(const bf16x8*)(Qb + (size_t)qrow * ldq + hq * DQK + ks * 16 + h * 8);
  f32x16 o[2];
#pragma unroll
  for (int dt = 0; dt < 2; ++dt)
#pragma unroll
    for (int i = 0; i < 16; ++i) o[dt][i] = 0.f;
  float mrun = -INFINITY, lsum = 0.f;
  u32x4 kreg[NKC], vreg[2];
  auto tile_j = [&](int it) { return it < nct ? it * 64 : CTX + kp_start + 64 * (it - nct); };
  auto issue = [&](int it) {
    const int jr = tile_j(it);
#pragma unroll
    for (int i = 0; i < NKC; ++i) {
      const int c = tid + 256 * i, key = c / KCH, part = c % KCH;
      const u16* src = (part < 8) ? K1 + (size_t)(brow + jr + key) * ldk1 + koff + part * 8
                                  : KR + (size_t)(brow + jr + key) * 32 + (part - 8) * 8;
      kreg[i] = *(const u32x4*)src;
    }
#pragma unroll
    for (int i = 0; i < 2; ++i) {
      const int c = tid + 256 * i, d = c >> 3, part = c & 7;
      vreg[i] = *(const u32x4*)(Vb + (size_t)d * TPB + jr + part * 8);
    }
  };
  auto stash = [&](int buf) {
    char* kb = smem + buf * BUFSZ;
    char* vb = kb + 13312;
#pragma unroll
    for (int i = 0; i < NKC; ++i) {
      const int c = tid + 256 * i, key = c / KCH, part = c % KCH;
      *(u32x4*)(kb + key * KS + part * 16) = kreg[i];
    }
#pragma unroll
    for (int i = 0; i < 2; ++i) {
      const int c = tid + 256 * i, d = c >> 3, part = c & 7;
      *(u32x2*)(vb + d * 136 + part * 16) = u32x2{vreg[i].x, vreg[i].y};
      *(u32x2*)(vb + d * 136 + part * 16 + 8) = u32x2{vreg[i].z, vreg[i].w};
    }
  };
  __syncthreads();
  issue(0);
  stash(0);
  __syncthreads();
  const int qpos = jq0 - CTX + wave * 32 + r;
#pragma unroll 1
  for (int it = 0; it < ntiles; ++it) {
    const int buf = it & 1;
    const char* kb = smem + buf * BUFSZ;
    const char* vb = kb + 13312;
    if (it + 1 < ntiles) issue(it + 1);
    f32x16 s[2];
#pragma unroll
    for (int kt = 0; kt < 2; ++kt) {
#pragma unroll
      for (int i = 0; i < 16; ++i) s[kt][i] = 0.f;
#pragma unroll
      for (int ks = 0; ks < NKS; ++ks) {
        const bf16x8 kf = *(const bf16x8*)(kb + (kt * 32 + r) * KS + ks * 32 + h * 16);
        s[kt] = MFMA(kf, qf[ks], s[kt]);
      }
    }
    if (SWA && it >= nct) {
      const int kpos0 = kp_start + 64 * (it - nct);
#pragma unroll
      for (int kt = 0; kt < 2; ++kt)
#pragma unroll
        for (int i = 0; i < 16; ++i) {
          const int diff = qpos - (kpos0 + kt * 32 + crow(i, h));
          if (diff > 128 || diff < -128) s[kt][i] = -1e30f;
        }
    }
    float mx = s[0][0];
#pragma unroll
    for (int kt = 0; kt < 2; ++kt)
#pragma unroll
      for (int i = 0; i < 16; ++i) mx = fmaxf(mx, s[kt][i]);
    mx = fmaxf(mx, __shfl_xor(mx, 32));
    const float mnew = fmaxf(mrun, mx);
    const float alpha = __builtin_amdgcn_exp2f(mrun - mnew);
    float ps = 0.f;
#pragma unroll
    for (int kt = 0; kt < 2; ++kt)
#pragma unroll
      for (int i = 0; i < 16; ++i) { const float e = __builtin_amdgcn_exp2f(s[kt][i] - mnew); s[kt][i] = e; ps += e; }
    if (__builtin_amdgcn_ballot_w64(mnew != mrun) != 0ull) {
      lsum *= alpha;
#pragma unroll
      for (int dt = 0; dt < 2; ++dt)
#pragma unroll
        for (int i = 0; i < 16; ++i) o[dt][i] *= alpha;
    }
    lsum += ps;
    mrun = mnew;
#pragma unroll
    for (int kt = 0; kt < 2; ++kt)
#pragma unroll
      for (int s2 = 0; s2 < 2; ++s2) {
        unsigned pk[4];
#pragma unroll
        for (int j = 0; j < 4; ++j) pk[j] = pack2(s[kt][8 * s2 + 2 * j], s[kt][8 * s2 + 2 * j + 1]);
        const bf16x8 pf = __builtin_bit_cast(bf16x8, u32x4{pk[0], pk[1], pk[2], pk[3]});
#pragma unroll
        for (int dt = 0; dt < 2; ++dt) {
          const char* vp = vb + (dt * 32 + r) * 136 + (kt * 32 + 16 * s2 + 4 * h) * 2;
          const s16x4 lo = *(const s16x4*)vp;
          const s16x4 hi = *(const s16x4*)(vp + 16);
          const bf16x8 vf = __builtin_shufflevector(lo, hi, 0, 1, 2, 3, 4, 5, 6, 7);
          o[dt] = MFMA(vf, pf, o[dt]);
        }
      }
    if (it + 1 < ntiles) stash(buf ^ 1);
    __syncthreads();
  }
  float ltot = lsum + __shfl_xor(lsum, 32);
  if (SWA) ltot += __builtin_amdgcn_exp2f(p.swa_sink[l * 8 + hq] * LOG2E - mrun);
  const float inv = 1.f / ltot;
#pragma unroll
  for (int dt = 0; dt < 2; ++dt)
#pragma unroll
    for (int g = 0; g < 4; ++g) {
      u32x2 pk;
      pk.x = pack2(o[dt][4 * g] * inv, o[dt][4 * g + 1] * inv);
      pk.y = pack2(o[dt][4 * g + 2] * inv, o[dt][4 * g + 3] * inv);
      *(u32x2*)(outp + (size_t)qrow * ldo + ooff + dt * 32 + 8 * g + 4 * h) = pk;
    }
}

constexpr float HY_D0 = 3.0701134573253944f;
constexpr float HY_DSTEP = (15.350567286626972f - 3.0701134573253944f) / 511.f;

DI void filt_item(const Params& p, int l, int oc, char* smem) {
  float2* lds = (float2*)smem;
  float* lf = (float*)smem;
  const int tid = opq(threadIdx.x), lane = tid & 63, wave = tid >> 6;
  const int c = oc & 511;
  const float* hid = (const float*)(p.ws + OFF_HID + l * HID_LAYER);
  const float* w3 = p.hy_w3 + (size_t)l * 64 * 2048;
  float* sa = (float*)(p.ws + OFF_ESCR + (size_t)blockIdx.x * 65536);
  float* sb = sa + 8192;
  __syncthreads();
  if (tid < 128) { const int dir = tid >> 6, j = tid & 63; lf[tid] = w3[j * 2048 + dir * 1024 + oc]; }
  __syncthreads();
  const float delta = HY_D0 + (float)c * HY_DSTEP;
  float asum = 0.f;
#pragma unroll 1
  for (int ib = 0; ib < 4; ++ib) {
    float a[8], bm[8];
#pragma unroll
    for (int i = 0; i < 8; ++i) { a[i] = 0.f; bm[i] = 0.f; }
#pragma unroll 4
    for (int j = 0; j < 64; ++j) {
      const float w0 = lf[j], w1 = lf[64 + j];
      const float* hr = hid + (size_t)j * 8192 + 4 * (tid + 512 * ib);
#pragma unroll
      for (int ii = 0; ii < 2; ++ii) {
        const float4 hv = *(const float4*)(hr + 1024 * ii);
        a[4 * ii + 0] += hv.x * w0; bm[4 * ii + 0] += hv.x * w1;
        a[4 * ii + 1] += hv.y * w0; bm[4 * ii + 1] += hv.y * w1;
        a[4 * ii + 2] += hv.z * w0; bm[4 * ii + 2] += hv.z * w1;
        a[4 * ii + 3] += hv.w * w0; bm[4 * ii + 3] += hv.w * w1;
      }
    }
#pragma unroll
    for (int ii = 0; ii < 2; ++ii) {
      const int t0 = 4 * (tid + 256 * (2 * ib + ii));
      float av[4];
#pragma unroll
      for (int e = 0; e < 4; ++e) {
        const int t = t0 + e;
        const float dec = __expf(-((float)t * (1.f / 8191.f)) * delta);
        av[e] = a[4 * ii + e] * dec;
        const float bv = bm[4 * ii + e] * dec;
        if (t >= 1) { sb[8192 - t] = bv; asum += fabsf(bv); } else sb[0] = 0.f;
        asum += fabsf(av[e]);
      }
      *(float4*)(sa + t0) = make_float4(av[0], av[1], av[2], av[3]);
    }
  }
  asum = wave_sum(asum);
  asm volatile("s_waitcnt vmcnt(0)" ::: "memory");
  __syncthreads();
  if (lane == 0) lf[wave] = asum;
  __syncthreads();
  const float inv = 1.f / (lf[0] + lf[1] + lf[2] + lf[3]);
  __syncthreads();
#pragma unroll 2
  for (int i = 0; i < 8; ++i) {
    const int t0 = 4 * (tid + 256 * i);
#pragma unroll
    for (int e = 0; e < 4; ++e) lds[fphys(t0 + e)] = make_float2((ldsc1(sa + t0 + e) + ldsc1(sb + t0 + e)) * inv, 0.f);
  }
  __syncthreads();
  if (!DBG_NOFFT) fft8192_fwd(lds, tid);
  h2_t* sp = (h2_t*)(p.ws + OFF_SPEC) + (size_t)oc * 2 * 8192;
#pragma unroll 4
  for (int i = 0; i < 32; ++i) { const int k = tid + 256 * i; const float2 v = lds[k]; h2_t hv = {(_Float16)v.x, (_Float16)v.y}; sp[k] = hv; }
  __syncthreads();
#pragma unroll 2
  for (int i = 0; i < 8; ++i) {
    const int t0 = 4 * (tid + 256 * i);
#pragma unroll
    for (int e = 0; e < 4; ++e) {
      const int t = t0 + e;
      const float2 w = twid_rev((float)t * (1.f / 16384.f));
      const float d = (ldsc1(sa + t) - ldsc1(sb + t)) * inv;
      lds[fphys(t)] = make_float2(d * w.x, d * w.y);
    }
  }
  __syncthreads();
  if (!DBG_NOFFT) fft8192_fwd(lds, tid);
#pragma unroll 4
  for (int i = 0; i < 32; ++i) { const int k = tid + 256 * i; const float2 v = lds[k]; h2_t hv = {(_Float16)v.x, (_Float16)v.y}; sp[8192 + k] = hv; }
  __syncthreads();
}

DI float dwc(const u16* s, int t, int len, float w0, float w1, float w2, float bias) {
  const int tm = max(t - 1, 0), tp = min(t + 1, len - 1);
  const float a = bf2f(s[tm]), b = bf2f(s[t]), c = bf2f(s[tp]);
  return b * w1 + bias + (t > 0 ? a * w0 : 0.f) + (t < len - 1 ? c * w2 : 0.f);
}

DI void ld4(const u16* s, int t0, float (&o)[4]) {
  const u32x2 u = *(const u32x2*)(s + t0);
  o[0] = lo_bf(u.x); o[1] = hi_bf(u.x); o[2] = lo_bf(u.y); o[3] = hi_bf(u.y);
}
DI void dwc4(const u16* s, int t0, int len, float w0, float w1, float w2, float bias, float (&o)[4]) {
  float c[4];
  ld4(s, t0, c);
  float l = bf2f(s[max(t0 - 1, 0)]), r = bf2f(s[min(t0 + 4, len - 1)]);
  l = (t0 > 0) ? l : 0.f;
  r = (t0 + 4 < len) ? r : 0.f;
  o[0] = l * w0 + c[0] * w1 + c[1] * w2 + bias;
  o[1] = c[0] * w0 + c[1] * w1 + c[2] * w2 + bias;
  o[2] = c[1] * w0 + c[2] * w1 + c[3] * w2 + bias;
  o[3] = c[2] * w0 + c[3] * w1 + r * w2 + bias;
}

DI void hconv_item(const Params& p, int l, int o, int c, int bp, char* smem) {
  float2* lds = (float2*)smem;
  const int tid = opq(threadIdx.x);
  u16* hyt = (u16*)(p.ws + OFF_HYT);
  const int b0 = bp * 2, b1 = b0 + 1;
  u16* z0p = hyt + (size_t)(b0 * 1536 + c) * TPB + CTX;
  u16* z1p = hyt + (size_t)(b1 * 1536 + c) * TPB + CTX;
  const int gc = (o + 1) * 512 + c;
  const u16* g0p = hyt + (size_t)(b0 * 1536 + gc) * TPB + CTX;
  const u16* g1p = hyt + (size_t)(b1 * 1536 + gc) * TPB + CTX;
  const float* cw = p.hy_conv_w + (size_t)l * 3 * 1536;
  const float* cb = p.hy_conv_b + (size_t)l * 1536;
  const float zw0 = cw[c], zw1 = cw[1536 + c], zw2 = cw[3072 + c], zbias = cb[c];
  const float gw0 = cw[gc], gw1 = cw[1536 + gc], gw2 = cw[3072 + gc], gbias = cb[gc];
  const float skip = p.hy_skip[l * 1024 + o * 512 + c];
  const h2_t* spe = (const h2_t*)(p.ws + OFF_SPEC) + (size_t)(o * 512 + c) * 2 * 8192;
  const h2_t* spo = spe + 8192;
  float2* Eg = (float2*)(p.ws + OFF_ESCR + (size_t)blockIdx.x * 65536);
  __syncthreads();
#pragma unroll 2
  for (int i = 0; i < 8; ++i) {
    const int t0 = 4 * (tid + 256 * i);
    float za[4], zb[4];
    if (o == 0) { dwc4(z0p, t0, SEQ, zw0, zw1, zw2, zbias, za); dwc4(z1p, t0, SEQ, zw0, zw1, zw2, zbias, zb); }
    else { ld4(z0p, t0, za); ld4(z1p, t0, zb); }
#pragma unroll
    for (int e = 0; e < 4; ++e) lds[fphys(t0 + e)] = make_float2(za[e], zb[e]);
  }
  __syncthreads();
  fft8192_fwd(lds, tid);
#pragma unroll 8
  for (int i = 0; i < 32; ++i) { const int k = tid + 256 * i; const h2_t hv = spe[k]; lds[k] = cmul(lds[k], make_float2((float)hv[0], (float)hv[1])); }
  __syncthreads();
  fft8192_inv(lds, tid);
#pragma unroll 2
  for (int i = 0; i < 8; ++i) {
    const int t0 = 4 * (tid + 256 * i);
#pragma unroll
    for (int e = 0; e < 4; ++e) Eg[t0 + e] = lds[fphys(t0 + e)];
  }
  __syncthreads();
#pragma unroll 2
  for (int i = 0; i < 8; ++i) {
    const int t0 = 4 * (tid + 256 * i);
    float za[4], zb[4];
    if (o == 0) { dwc4(z0p, t0, SEQ, zw0, zw1, zw2, zbias, za); dwc4(z1p, t0, SEQ, zw0, zw1, zw2, zbias, zb); }
    else { ld4(z0p, t0, za); ld4(z1p, t0, zb); }
#pragma unroll
    for (int e = 0; e < 4; ++e) lds[fphys(t0 + e)] = cmul(make_float2(za[e], zb[e]), twid_rev((float)(t0 + e) * (1.f / 16384.f)));
  }
  __syncthreads();
  fft8192_fwd(lds, tid);
#pragma unroll 8
  for (int i = 0; i < 32; ++i) { const int k = tid + 256 * i; const h2_t hv = spo[k]; lds[k] = cmul(lds[k], make_float2((float)hv[0], (float)hv[1])); }
  __syncthreads();
  fft8192_inv(lds, tid);
#pragma unroll 2
  for (int i = 0; i < 8; ++i) {
    const int t0 = 4 * (tid + 256 * i);
    float za[4], zb[4], ga[4], gb[4];
    if (o == 0) { dwc4(z0p, t0, SEQ, zw0, zw1, zw2, zbias, za); dwc4(z1p, t0, SEQ, zw0, zw1, zw2, zbias, zb); }
    else { ld4(z0p, t0, za); ld4(z1p, t0, zb); }
    dwc4(g0p, t0, SEQ, gw0, gw1, gw2, gbias, ga);
    dwc4(g1p, t0, SEQ, gw0, gw1, gw2, gbias, gb);
#pragma unroll
    for (int e = 0; e < 4; ++e) {
      const int t = t0 + e;
      const float2 ov = cmulc(lds[fphys(t)], twid_rev((float)t * (1.f / 16384.f)));
      const float2 ev = Eg[t];
      const float y0 = (ev.x + ov.x) * (1.f / 16384.f), y1 = (ev.y + ov.y) * (1.f / 16384.f);
      Eg[t] = make_float2(ga[e] * (y0 + za[e] * skip), gb[e] * (y1 + zb[e] * skip));
    }
  }
  __syncthreads();
  u16* d0 = (o == 0) ? z0p : hyt + (size_t)(b0 * 1536 + 512 + c) * TPB + CTX;
  u16* d1 = (o == 0) ? z1p : hyt + (size_t)(b1 * 1536 + 512 + c) * TPB + CTX;
#pragma unroll 2
  for (int i = 0; i < 8; ++i) {
    const int t0 = 4 * (tid + 256 * i);
    float2 e4[4];
#pragma unroll
    for (int e = 0; e < 4; ++e) e4[e] = Eg[t0 + e];
    *(u32x2*)(d0 + t0) = u32x2{pack2(e4[0].x, e4[1].x), pack2(e4[2].x, e4[3].x)};
    *(u32x2*)(d1 + t0) = u32x2{pack2(e4[0].y, e4[1].y), pack2(e4[2].y, e4[3].y)};
  }
}

DI void hctx_item(const Params& p, int l, int c, char* smem) {
  float* lf = (float*)smem;
  float* kern = lf;
  float* zb = lf + 1024;
  float* z1b = lf + 2048;
  float* red = lf + 3072;
  const int tid = opq(threadIdx.x), lane = tid & 63, wave = tid >> 6;
  const float* hid = (const float*)(p.ws + OFF_HID + l * HID_LAYER) + 64 * 8192;
  const float* w3 = p.hy_w3 + (size_t)l * 64 * 2048;
  const u16* hyt = (const u16*)(p.ws + OFF_HYT);
  const float* cw = p.hy_conv_w + (size_t)l * 3 * 1536;
  const float* cb = p.hy_conv_b + (size_t)l * 1536;
  __syncthreads();
  {
    const int t = tid;
    float d[4] = {0.f, 0.f, 0.f, 0.f};
#pragma unroll 4
    for (int j = 0; j < 64; ++j) {
      const float hv = hid[j * 256 + t];
#pragma unroll
      for (int q = 0; q < 4; ++q) d[q] += hv * w3[j * 2048 + (q >> 1) * 1024 + (q & 1) * 512 + c];
    }
    const float dec = __expf(-((float)t * (1.f / 255.f)) * (HY_D0 + (float)c * HY_DSTEP));
#pragma unroll
    for (int o = 0; o < 2; ++o) {
      const float f0 = d[o] * dec, f1 = d[2 + o] * dec;
      kern[o * 512 + t] = f0;
      if (t >= 1) kern[o * 512 + 512 - t] = f1;
      if (t == 0) kern[o * 512 + 256] = 0.f;
      float s = fabsf(f0) + (t >= 1 ? fabsf(f1) : 0.f);
      s = wave_sum(s);
      if (lane == 0) red[o * 4 + wave] = s;
    }
  }
  const int b = tid >> 6, tq = tid & 63;
  const u16* zs = hyt + (size_t)(b * 1536 + c) * TPB;
  const u16* g1s = hyt + (size_t)(b * 1536 + 512 + c) * TPB;
  const u16* g2s = hyt + (size_t)(b * 1536 + 1024 + c) * TPB;
#pragma unroll
  for (int k = 0; k < 4; ++k) {
    const int tt = tq + 64 * k;
    zb[b * 256 + tt] = dwc(zs, tt, CTX, cw[c], cw[1536 + c], cw[3072 + c], cb[c]);
  }
  __syncthreads();
  const float inv0 = 1.f / (red[0] + red[1] + red[2] + red[3]);
  const float inv1 = 1.f / (red[4] + red[5] + red[6] + red[7]);
  const float sk0 = p.hy_skip[l * 1024 + c], sk1 = p.hy_skip[l * 1024 + 512 + c];
#pragma unroll 1
  for (int k = 0; k < 4; ++k) {
    const int tt = tq + 64 * k;
    float acc = 0.f;
#pragma unroll 8
    for (int s = 0; s < 256; ++s) acc += kern[(tt - s) & 511] * zb[b * 256 + s];
    const float g = dwc(g1s, tt, CTX, cw[512 + c], cw[1536 + 512 + c], cw[3072 + 512 + c], cb[512 + c]);
    z1b[b * 256 + tt] = g * (acc * inv0 + zb[b * 256 + tt] * sk0);
  }
  __syncthreads();
  u16* yc = (u16*)(p.ws + OFF_HYT) + (size_t)(b * 1536 + 512 + c) * TPB;
#pragma unroll 1
  for (int k = 0; k < 4; ++k) {
    const int tt = tq + 64 * k;
    float acc = 0.f;
#pragma unroll 8
    for (int s = 0; s < 256; ++s) acc += kern[512 + ((tt - s) & 511)] * z1b[b * 256 + s];
    const float g = dwc(g2s, tt, CTX, cw[1024 + c], cw[1536 + 1024 + c], cw[3072 + 1024 + c], cb[1024 + c]);
    yc[tt] = DBG_ZERO_HCTX ? (u16)0 : f2bf(g * (acc * inv1 + z1b[b * 256 + tt] * sk1));
  }
  __syncthreads();
}

#define XB_XCNT(j) (256 + 64 * (j))
#define XB_XSUB(j) (1280 + 64 * (j))
#define XB_XGEN(j) (2304 + 64 * (j))
#define XB_TOP 3328
#define XB_TOPGEN 3392
DI unsigned xb_ld(unsigned* p) { return __hip_atomic_load(p, __ATOMIC_RELAXED, __HIP_MEMORY_SCOPE_AGENT); }
DI unsigned xb_add(unsigned* p, unsigned v) { return __hip_atomic_fetch_add(p, v, __ATOMIC_RELAXED, __HIP_MEMORY_SCOPE_AGENT); }
struct XBar { unsigned* bar; unsigned x, nloc, nx; };
DI void gsync_impl(cg::grid_group& g, XBar& b) {
#if DBG_CG_SYNC
  g.sync();
#else
  asm volatile("s_waitcnt vmcnt(0)" ::: "memory");
  __syncthreads();
  if (threadIdx.x == 0) {
    unsigned* bar = b.bar;
    __builtin_amdgcn_s_waitcnt(0);
    if (b.nloc == 0u) {
      unsigned sum, cnt, mine;
      for (;;) {
        sum = 0u; cnt = 0u; mine = 0u;
#pragma unroll
        for (unsigned j = 0; j < 16; ++j) { const unsigned c = xb_ld(&bar[XB_XCNT(j)]); sum += c; cnt += (c > 0u) ? 1u : 0u; mine = (j == b.x) ? c : mine; }
        if (sum == gridDim.x) break;
        __builtin_amdgcn_s_sleep(1);
      }
      b.nloc = mine > 0u ? mine : 1u; b.nx = cnt > 0u ? cnt : 1u;
    }
    const unsigned old = xb_add(&bar[XB_XSUB(b.x)], 1u);
    const unsigned gen = old / b.nloc;
    if (old + 1u == (gen + 1u) * b.nloc) {
      __builtin_amdgcn_fence(__ATOMIC_RELEASE, "agent");
      asm volatile("s_waitcnt vmcnt(0)" ::: "memory");
      const unsigned og = xb_add(&bar[XB_TOP], 1u);
      const unsigned tg = og / b.nx;
      if (og + 1u == (tg + 1u) * b.nx) xb_add(&bar[XB_TOPGEN], 1u);
      else { while (xb_ld(&bar[XB_TOPGEN]) == tg) __builtin_amdgcn_s_sleep(1); }
      __builtin_amdgcn_fence(__ATOMIC_ACQUIRE, "agent");
      xb_add(&bar[XB_XGEN(b.x)], 1u);
      asm volatile("s_waitcnt vmcnt(0)" ::: "memory");
    } else {
      while (xb_ld(&bar[XB_XGEN(b.x)]) == gen) __builtin_amdgcn_s_sleep(1);
      __builtin_amdgcn_fence(__ATOMIC_ACQUIRE, "agent");
      asm volatile("s_waitcnt vmcnt(0)" ::: "memory");
    }
  }
  __syncthreads();
#endif
}

#define gsync(G, E) gsync_impl(G, E)
DI int tile_map(int L, int MT, int NT) {
  const int per = 8 * NT;
  const int P = L / per, u = L - P * per;
  const int h = min(8, MT - P * 8);
  const int nt = u / h, mt = P * 8 + (u - nt * h);
  return mt * NT + nt;
}
__global__ void __launch_bounds__(256, 2) fwd_mega(Params p) {
  cg::grid_group grid = cg::this_grid();
  __shared__ __attribute__((aligned(16))) char smem[65536];
  const int nb = gridDim.x, bid = blockIdx.x;
  const int pb = ((nb & 7) == 0) ? (bid & 7) * (nb >> 3) + (bid >> 3) : bid;
  float* xctx = (float*)(p.ws + OFF_XCTX);
  u16* RH = (u16*)(p.ws + OFF_RH);
  u16* HP = (u16*)(p.ws + OFF_HP);
  XBar epoch;
  epoch.bar = (unsigned*)(p.ws + OFF_BAR);
  epoch.x = (unsigned)__builtin_amdgcn_s_getreg((3 << 11) | 20) & 0xFu;
  epoch.nloc = 0u; epoch.nx = 0u;
  if (threadIdx.x == 0) (void)xb_add(&epoch.bar[XB_XCNT(epoch.x)], 1u);
  {
    constexpr int NC0 = 2336;
    const int total = NC0 + 192 + 1536 + 528;
    for (int it = bid; it < total; it += nb) {
      if (it < NC0) conv_tile(p, 0, it, smem);
      else if (it < NC0 + 192) mod_item(p, it - NC0, smem);
      else if (it < NC0 + 192 + 1536) rope_item(p, it - NC0 - 192);
      else hid_item(p, it - NC0 - 192 - 1536, smem);
    }
  }
  if (p.ws == nullptr) grid.sync();
  gsync(grid, epoch);
  row_pass(p, 0, p.x, p.ctx, nullptr, nullptr, nullptr, nullptr, 0, 0, false, p.norm_g, 0, 0, 1024, RH, false);
  gsync(grid, epoch);
#pragma unroll 1
  for (int l = 0; l < 2; ++l) {
    const float* xl = (l == 0) ? p.x : p.out;
    const float* xc = (l == 0) ? p.ctx : xctx;
    for (int rep = 0; rep < DBG_REP_FFT; ++rep)
    for (int it = pb; it < 1024; it += nb) filt_item(p, l, it, smem);
    gsync(grid, epoch);
    for (int rep = 0; rep < DBG_REP_GEMM; ++rep)
    for (int it = pb; it < 4752; it += nb) inproj_tile(p, tile_map(it, 176, 27), smem);
    gsync(grid, epoch);
#if DBG_DUMP == 5
    { const _Float16* sp = (const _Float16*)(p.ws + OFF_SPEC);
      for (size_t i = (size_t)bid * 256 + threadIdx.x; i < (size_t)NBATCH * SEQ * DM; i += (size_t)nb * 256) p.out[i] = (float)sp[i];
      return; }
#endif
    {
      const int nSW = 2048 + (l == 0 ? 64 : 0);
      for (int rep = 0; rep < DBG_REP_GEMM; ++rep)
      for (int it = pb; it < 1408 + nSW; it += nb) {
        if (it < 1408) kvup_tile(p, tile_map(it, 176, 8), smem);
        else if (it < 1408 + 2048) {
          const int i1 = it - 1408, n = i1 & 63, jlo = (n == 0) ? 2 : 0, jhi = (n == 63) ? 4 : 6;
          attn_item<64, true>(p, l, i1 >> 9, (i1 >> 6) & 7, CTX + n * 128, 4, jhi - jlo, (n - 1) * 128 + 64 * jlo, smem);
        } else { const int i2 = it - 1408 - 2048; attn_item<64, true>(p, l, i2 >> 4, (i2 >> 1) & 7, (i2 & 1) * 128, 4, 0, 0, smem); }
      }
    }
    gsync(grid, epoch);
    {
      const int nF = 2048 + (l == 0 ? 64 : 0);
      for (int rep = 0; rep < DBG_REP_MLA; ++rep)
      for (int it = pb; it < nF; it += nb) {
        if (it < 2048) attn_item<96, false>(p, l, it >> 9, (it >> 6) & 7, CTX + (it & 63) * 128, 132, 0, 0, smem);
        else { const int i2 = it - 2048; attn_item<96, false>(p, l, i2 >> 4, (i2 >> 1) & 7, (i2 & 1) * 128, 4, 0, 0, smem); }
      }
    }
    gsync(grid, epoch);
    {
      const int nF2 = 1024 + (l == 0 ? 512 : 0);
      for (int it = pb; it < nF2; it += nb) {
        if (it < 1024) hconv_item(p, l, 0, it >> 1, it & 1, smem);
        else hctx_item(p, l, it - 1024, smem);
      }
    }
    gsync(grid, epoch);
    for (int rep = 0; rep < DBG_REP_FFT; ++rep)
    for (int it = pb; it < 1024; it += nb) hconv_item(p, l, 1, it >> 1, it & 1, smem);
    gsync(grid, epoch);
    for (int rep = 0; rep < DBG_REP_GEMM; ++rep)
    for (int it = pb; it < 1408; it += nb) merge_tile(p, tile_map(it, 176, 8), smem);
    if (l == 0 && pb >= 384 && nb > 384) for (int ct = 2336 + (pb - 384); ct < NCONV_TILES; ct += nb - 384) conv_tile(p, 0, ct, smem);
    gsync(grid, epoch);
    for (int rep = 0; rep < DBG_REP_GEMM * DBG_REP_PLAIN; ++rep)
    for (int it = pb; it < 1408; it += nb) plain_tile(p, tile_map(it, 176, 8), (const u16*)(p.ws + OFF_MERGED), 1024, 16, (const u16*)(p.ws + OFF_WT_OUT), (u16*)(p.ws + OFF_Y), smem);
    gsync(grid, epoch);
    row_pass(p, 1, xl, xc, p.out, xctx, (const u16*)(p.ws + OFF_Y), p.norm_g + (size_t)(l * 4 + 1) * 1024, 2048, l, true, p.norm_g + (size_t)(l * 4 + 2) * 1024, l, 3072, 4096, RH, false);
    gsync(grid, epoch);
    for (int rep = 0; rep < DBG_REP_GEMM; ++rep)
    for (int it = pb; it < 184 * 44; it += nb) ffnup_tile(p, l, tile_map(it, 184, 44), smem);
    gsync(grid, epoch);
    for (int rep = 0; rep < DBG_REP_GEMM * DBG_REP_PLAIN; ++rep)
    for (int it = pb; it < 1408; it += nb) plain_tile(p, tile_map(it, 176, 8), (const u16*)(p.ws + OFF_A), 2816, 44, (const u16*)(p.ws + OFF_WT_DOWN), HP, smem);
    if (l == 0 && pb >= 384 && nb > 384) for (int ct = pb - 384; ct < 1632; ct += nb - 384) conv_tile(p, 1, ct, smem);
    gsync(grid, epoch);
    row_pass(p, 1, p.out, xctx, p.out, xctx, HP, p.norm_g + (size_t)(l * 4 + 3) * 1024, 5120, l, l == 0, p.norm_g + (size_t)((l + 1) * 4) * 1024, l + 1, 0, 1024, RH, l == 1);
    if (l == 0) {
      for (int it = bid; it < NCONV_TILES - 1632; it += nb) conv_tile(p, 1, 1632 + it, smem);
      gsync(grid, epoch);
    }
  }
  for (int rep = 0; rep < DBG_EXTRA_SYNCS; ++rep) gsync(grid, epoch);
#if DBG_DUMP == 1
  gsync(grid, epoch);
  { const _Float16* sp = (const _Float16*)(p.ws + OFF_SPEC);
    for (size_t i = (size_t)bid * 256 + threadIdx.x; i < (size_t)NBATCH * SEQ * DM; i += (size_t)nb * 256) p.out[i] = (float)sp[i]; }
#elif DBG_DUMP == 3
  gsync(grid, epoch);
  { const float* hd = (const float*)(p.ws + OFF_HID);
    for (size_t i = (size_t)bid * 256 + threadIdx.x; i < (size_t)NBATCH * SEQ * DM; i += (size_t)nb * 256) p.out[i] = i < (size_t)2 * 64 * 8448 ? hd[i] : 0.f; }
#elif DBG_DUMP == 2
  gsync(grid, epoch);
  { const u16* yc = (const u16*)(p.ws + OFF_YCT);
    for (size_t i = (size_t)bid * 256 + threadIdx.x; i < (size_t)NBATCH * SEQ * DM; i += (size_t)nb * 256) p.out[i] = i < (size_t)4 * 512 * TPB ? bf2f(yc[i]) : 0.f; }
#endif
}

extern "C" void kernel_launch(void* const* d_in, const int* in_sizes, int n_in, void* d_out, int out_size, void* d_ws, size_t ws_size,
                              hipStream_t stream) {
  static int grid_blocks = 0;
  if (!grid_blocks) {
    int dev = 0, cus = 0, per_cu = 0;
    (void)hipGetDevice(&dev);
    (void)hipDeviceGetAttribute(&cus, hipDeviceAttributeMultiprocessorCount, dev);
    (void)hipOccupancyMaxActiveBlocksPerMultiprocessor(&per_cu, fwd_mega, 256, 0);
    if (per_cu > 2) per_cu = 2;
    if (per_cu < 1) per_cu = 1;
    grid_blocks = cus * per_cu;
  }
  if (ws_size < WS_NEED) { fprintf(stderr, "workspace too small: %zu < %zu\n", ws_size, (size_t)WS_NEED); return; }
  Params p{};
  const float** pp = (const float**)&p;
  for (int i = 0; i < 26; ++i) pp[i] = (const float*)d_in[i];
  p.out = (float*)d_out;
  p.ws = (char*)d_ws;
  (void)hipMemsetAsync((char*)d_ws + OFF_BAR, 0, BAR_BYTES, stream);
  void* args[] = {&p};
  hipError_t e = hipLaunchCooperativeKernel((void*)fwd_mega, dim3(grid_blocks), dim3(256), args, 0, stream);
  if (e != hipSuccess) fprintf(stderr, "cooperative launch failed: %s (grid %d)\n", hipGetErrorString(e), grid_blocks);
}
```

```cpp
#include <hip/hip_runtime.h>
#include <hip/hip_cooperative_groups.h>
#include <cstdio>
namespace cg = cooperative_groups;
#define DI __device__ __forceinline__
typedef unsigned short u16;
typedef __attribute__((ext_vector_type(8))) short bf16x8;
typedef __attribute__((ext_vector_type(4))) short s16x4;
typedef __attribute__((ext_vector_type(16))) float f32x16;
typedef __attribute__((ext_vector_type(4))) unsigned u32x4;
typedef __attribute__((ext_vector_type(2))) unsigned u32x2;
typedef __attribute__((ext_vector_type(2))) __bf16 bf2_t;
typedef __attribute__((ext_vector_type(2))) float f2_t;
typedef __attribute__((ext_vector_type(2))) _Float16 h2_t;
#define MFMA(a, b, c) __builtin_amdgcn_mfma_f32_32x32x16_bf16((a), (b), (c), 0, 0, 0)

constexpr int DM = 1024, NBATCH = 4, SEQ = 8192, CTX = 256, TPB = 8448, MTOK = 33792;
constexpr int DFF = 2816;
#ifndef DBG_ZERO_HCTX
#define DBG_ZERO_HCTX 0
#endif
#ifndef DBG_DUMP
#define DBG_DUMP 0
#endif
#ifndef DBG_NOFFT
#define DBG_NOFFT 0
#endif
#ifndef DBG_SPLITC
#define DBG_SPLITC 0
#endif
#ifndef DBG_REP_GEMM
#define DBG_REP_GEMM 1
#endif
#ifndef DBG_REP_MLA
#define DBG_REP_MLA 1
#endif
#ifndef DBG_HEAVY_SYNC
#define DBG_HEAVY_SYNC 0
#endif
#ifndef DBG_REP_FFT
#define DBG_REP_FFT 1
#endif
#ifndef DBG_REP_PLAIN
#define DBG_REP_PLAIN 1
#endif
#ifndef DBG_EXTRA_SYNCS
#define DBG_EXTRA_SYNCS 0
#endif
#ifndef DBG_CG_SYNC
#define DBG_CG_SYNC 0
#endif
#ifndef DBG_SKIP_BR
#define DBG_SKIP_BR 0
#endif
#define DBG_FIRST_BR ((DBG_SKIP_BR & 1) ? ((DBG_SKIP_BR & 2) ? 2 : 1) : 0)
constexpr float LOG2E = 1.4426950408889634f;
constexpr float EPS = 1e-6f;

struct Params {
  const float *x, *c, *ctx, *c_ctx, *w_mod, *b_mod, *norm_g, *w_in, *kv_norm_g, *w_kv_up, *swa_sink, *hy_conv_w, *hy_conv_b,
      *hy_w1, *hy_b1, *hy_w2, *hy_b2, *hy_freq, *hy_w3, *hy_skip, *w_branch, *w_out, *w_up, *ffn_conv_w, *ffn_conv_b, *w_down;
  float* out;
  char* ws;
};

constexpr size_t OFF_WT_IN = 0;
constexpr size_t OFF_WT_GATE = OFF_WT_IN + (size_t)3456 * 1024 * 2;
constexpr size_t OFF_WT_KV = OFF_WT_GATE + (size_t)3072 * 1024 * 2;
constexpr size_t OFF_WT_BR = OFF_WT_KV + (size_t)1024 * 256 * 2;
constexpr size_t OFF_WT_OUT = OFF_WT_BR + (size_t)3 * 1024 * 512 * 2;
constexpr size_t OFF_WT_UP = OFF_WT_OUT + (size_t)1024 * 1024 * 2;
constexpr size_t OFF_WT_DOWN = OFF_WT_UP + (size_t)5632 * 1024 * 2;
constexpr size_t OFF_RH = OFF_WT_DOWN + (size_t)1024 * 2816 * 2;
constexpr size_t OFF_KN = OFF_RH + (size_t)MTOK * 1024 * 2;
constexpr size_t OFF_VT = OFF_KN + (size_t)MTOK * 512 * 2;
constexpr size_t OFF_KR = OFF_VT + (size_t)MTOK * 512 * 2;
constexpr size_t OFF_Q = OFF_KR + (size_t)MTOK * 32 * 2;
constexpr size_t OFF_SQ = OFF_Q + (size_t)MTOK * 768 * 2;
constexpr size_t OFF_CKV = OFF_SQ + (size_t)MTOK * 512 * 2;
constexpr size_t OFF_SK = OFF_CKV + (size_t)MTOK * 256 * 2;
constexpr size_t OFF_SVT = OFF_SK + (size_t)MTOK * 128 * 2;
constexpr size_t OFF_HYT = OFF_SVT + (size_t)MTOK * 128 * 2;
constexpr size_t OFF_SPEC = OFF_HYT + (size_t)MTOK * 1536 * 2;
constexpr size_t OFF_XCTX = OFF_SPEC + (size_t)1024 * 2 * 8192 * 4;
constexpr size_t OFF_MOD = OFF_XCTX + (size_t)1024 * 1024 * 4;
constexpr size_t OFF_ROPE = OFF_MOD + (size_t)2 * 5 * 6144 * 4;
constexpr size_t OFF_HID = OFF_ROPE + (size_t)8192 * 96 * 4;
constexpr size_t HID_LAYER = (size_t)64 * (8192 + 256) * 4;
constexpr size_t OFF_ESCR = OFF_HID + 2 * HID_LAYER;
constexpr size_t OFF_BAR = OFF_ESCR + (size_t)512 * 65536;
constexpr size_t BAR_BYTES = 3456 * 4;
constexpr size_t WS_NEED = OFF_BAR + BAR_BYTES;
constexpr size_t OFF_A = OFF_Q;
constexpr size_t OFF_MERGED = OFF_KN;
constexpr size_t OFF_Y = OFF_HYT;
constexpr size_t OFF_HP = OFF_KN;
constexpr size_t OFF_YCT = OFF_RH;
constexpr size_t OFF_YA = OFF_RH + (size_t)MTOK * 512 * 2;
static_assert(OFF_A + (size_t)MTOK * 2816 * 2 <= OFF_SPEC, "A overlay");
static_assert(WS_NEED <= (size_t)512 * 1024 * 1024, "ws");

DI int opq(int x) { asm volatile("" : "+v"(x)); return x; }
DI float ldsc1(const float* p) { return __hip_atomic_load(p, __ATOMIC_RELAXED, __HIP_MEMORY_SCOPE_AGENT); }
DI float bf2f(u16 v) { return __uint_as_float(((unsigned)v) << 16); }
DI unsigned pack2(float a, float b) { f2_t v = {a, b}; return __builtin_bit_cast(unsigned, __builtin_convertvector(v, bf2_t)); }
DI u16 f2bf(float a) { return (u16)(pack2(a, 0.f) & 0xffffu); }
DI float lo_bf(unsigned u) { return __uint_as_float(u << 16); }
DI float hi_bf(unsigned u) { return __uint_as_float(u & 0xffff0000u); }
DI int crow(int i, int h) { return (i & 3) + 8 * (i >> 2) + 4 * h; }
DI float wave_sum(float v) {
#pragma unroll
  for (int o = 32; o > 0; o >>= 1) v += __shfl_xor(v, o);
  return v;
}
DI float sinrev(float r) { return __builtin_amdgcn_sinf(r - floorf(r)); }
DI float cosrev(float r) { return __builtin_amdgcn_cosf(r - floorf(r)); }
#if DBG_TRIVTW
#define COSREV(f) (1.0f)
#define SINREV(f) (0.0f * (f))
#else
#define COSREV(f) cosrev(f)
#define SINREV(f) sinrev(f)
#endif
#define SYNC() __syncthreads()
DI float2 cmul(float2 a, float2 b) { return make_float2(a.x * b.x - a.y * b.y, a.x * b.y + a.y * b.x); }
DI float2 cmulc(float2 a, float2 b) { return make_float2(a.x * b.x + a.y * b.y, a.y * b.x - a.x * b.y); }
#ifndef DBG_NOSWZ
#define DBG_NOSWZ 0
#endif
DI int fphys(int i) { return DBG_NOSWZ ? i : (i ^ ((i >> 4) & 15)); }
DI float2 twid_rev(float fr) { return make_float2(COSREV(fr), -SINREV(fr)); }

DI float2 root16(int e) {
  const float C1 = 0.92387953251128674f, S1 = 0.38268343236508977f, R = 0.70710678118654752f;
  switch (e) {
    case 0: return make_float2(1.f, 0.f);
    case 1: return make_float2(C1, -S1);
    case 2: return make_float2(R, -R);
    case 3: return make_float2(S1, -C1);
    case 4: return make_float2(0.f, -1.f);
    case 5: return make_float2(-S1, -C1);
    case 6: return make_float2(-R, -R);
    default: return make_float2(-C1, -S1);
  }
}
template <int R, int HALF, int S, bool INV, bool HASW>
DI void fft_stage(float2 (&v)[R], const float2 (&wp)[4]) {
#pragma unroll
  for (int idx = 0; idx < R / 2; ++idx) {
    const int blk = idx / HALF, jj = idx % HALF;
    const int j0 = blk * 2 * HALF + jj, j1 = j0 + HALF;
    const int e = jj * (8 / HALF);
    float2 tw = root16(e);
    if (HASW) { if (e == 0) tw = wp[S]; else tw = cmul(wp[S], tw); }
    const bool triv = (!HASW) && (e == 0);
    if (!INV) {
      float2 a = v[j0], b = v[j1];
      v[j0] = make_float2(a.x + b.x, a.y + b.y);
      float2 d = make_float2(a.x - b.x, a.y - b.y);
      v[j1] = triv ? d : cmul(d, tw);
    } else {
      float2 t = triv ? v[j1] : cmulc(v[j1], tw);
      float2 a = v[j0];
      v[j0] = make_float2(a.x + t.x, a.y + t.y);
      v[j1] = make_float2(a.x - t.x, a.y - t.y);
    }
  }
}
template <bool INV> DI void fft_local8(float2 (&v)[8], const float2 (&wp)[4]) {
  if (!INV) { fft_stage<8, 4, 0, false, true>(v, wp); fft_stage<8, 2, 1, false, true>(v, wp); fft_stage<8, 1, 2, false, true>(v, wp); }
  else      { fft_stage<8, 1, 2, true, true>(v, wp); fft_stage<8, 2, 1, true, true>(v, wp); fft_stage<8, 4, 0, true, true>(v, wp); }
}
template <bool INV> DI void fft_local16(float2 (&v)[16], const float2 (&wp)[4]) {
  if (!INV) { fft_stage<16, 8, 0, false, false>(v, wp); fft_stage<16, 4, 1, false, false>(v, wp); fft_stage<16, 2, 2, false, false>(v, wp); fft_stage<16, 1, 3, false, false>(v, wp); }
  else      { fft_stage<16, 1, 3, true, false>(v, wp); fft_stage<16, 2, 2, true, false>(v, wp); fft_stage<16, 4, 1, true, false>(v, wp); fft_stage<16, 8, 0, true, false>(v, wp); }
}

template <int LQ, bool INV> DI void fft_pass8(float2* lds, int tid) {
  constexpr int q = 1 << LQ;
#pragma unroll 1
  for (int it = 0; it < 4; ++it) {
    const int task = tid + 256 * it;
    const int p = task & (q - 1);
    const int g = task >> LQ;
    const int base = g * 8 * q + p;
    float2 v[8];
#pragma unroll
    for (int j = 0; j < 8; ++j) v[j] = lds[fphys(base + j * q)];
    float2 wp[4];
    wp[0] = twid_rev((float)p * (1.0f / (float)(8 * q)));
    wp[1] = cmul(wp[0], wp[0]);
    wp[2] = cmul(wp[1], wp[1]);
    wp[3] = wp[2];
    fft_local8<INV>(v, wp);
#pragma unroll
    for (int j = 0; j < 8; ++j) lds[fphys(base + j * q)] = v[j];
  }
}
template <bool INV> DI void fft_pass16(float2* lds, int tid) {
#pragma unroll 1
  for (int it = 0; it < 2; ++it) {
    const int g = tid + 256 * it;
    float2 v[16];
    const int sw = DBG_NOSWZ ? 0 : (g & 15);
#pragma unroll
    for (int j = 0; j < 16; ++j) v[j] = lds[g * 16 + (j ^ sw)];
    float2 wp[4] = {make_float2(1.f, 0.f), make_float2(1.f, 0.f), make_float2(1.f, 0.f), make_float2(1.f, 0.f)};
    fft_local16<INV>(v, wp);
#pragma unroll
    for (int j = 0; j < 16; ++j) lds[g * 16 + (j ^ sw)] = v[j];
  }
}
#ifndef DBG_FFTPASSES
#define DBG_FFTPASSES 15
#endif
DI void fft8192_fwd(float2* lds, int tid) {
  if (DBG_FFTPASSES & 1) { fft_pass8<10, false>(lds, tid); SYNC(); }
  if (DBG_FFTPASSES & 2) { fft_pass8<7, false>(lds, tid); SYNC(); }
  if (DBG_FFTPASSES & 4) { fft_pass8<4, false>(lds, tid); SYNC(); }
  if (DBG_FFTPASSES & 8) { fft_pass16<false>(lds, tid); SYNC(); }
}
DI void fft8192_inv(float2* lds, int tid) {
  fft_pass16<true>(lds, tid); SYNC();
  fft_pass8<4, true>(lds, tid); SYNC();
  fft_pass8<7, true>(lds, tid); SYNC();
  fft_pass8<10, true>(lds, tid); SYNC();
}

DI void fft_mid16(float2* lds, int tid, const h2_t* H) {
#pragma unroll 1
  for (int it = 0; it < 2; ++it) {
    const int g = tid + 256 * it;
    float2 v[16];
    const int sw = g & 15;
#pragma unroll
    for (int j = 0; j < 16; ++j) v[j] = lds[g * 16 + (j ^ sw)];
    const float2 wp[4] = {make_float2(1.f, 0.f), make_float2(1.f, 0.f), make_float2(1.f, 0.f), make_float2(1.f, 0.f)};
    fft_local16<false>(v, wp);
    const h2_t* hp = H + g * 16;
#pragma unroll
    for (int j = 0; j < 16; ++j) { const h2_t hv = hp[j]; v[j] = cmul(v[j], make_float2((float)hv[0], (float)hv[1])); }
    fft_local16<true>(v, wp);
#pragma unroll
    for (int j = 0; j < 16; ++j) lds[g * 16 + (j ^ sw)] = v[j];
  }
}
DI void fft_last16_store(const float2* lds, int tid, h2_t* H) {
#pragma unroll 1
  for (int it = 0; it < 2; ++it) {
    const int g = tid + 256 * it;
    float2 v[16];
    const int sw = g & 15;
#pragma unroll
    for (int j = 0; j < 16; ++j) v[j] = lds[g * 16 + (j ^ sw)];
    const float2 wp[4] = {make_float2(1.f, 0.f), make_float2(1.f, 0.f), make_float2(1.f, 0.f), make_float2(1.f, 0.f)};
    fft_local16<false>(v, wp);
    h2_t* hp = H + g * 16;
#pragma unroll
    for (int j = 0; j < 16; ++j) { h2_t hv = {(_Float16)v[j].x, (_Float16)v[j].y}; hp[j] = hv; }
  }
}
DI void fft8192_conv(float2* lds, int tid, const h2_t* H) {
  fft_pass8<10, false>(lds, tid); SYNC();
  fft_pass8<7, false>(lds, tid); SYNC();
  fft_pass8<4, false>(lds, tid); SYNC();
  fft_mid16(lds, tid, H); SYNC();
  fft_pass8<4, true>(lds, tid); SYNC();
  fft_pass8<7, true>(lds, tid); SYNC();
  fft_pass8<10, true>(lds, tid); SYNC();
}
DI void fft8192_spectrum(float2* lds, int tid, h2_t* H) {
  fft_pass8<10, false>(lds, tid); SYNC();
  fft_pass8<7, false>(lds, tid); SYNC();
  fft_pass8<4, false>(lds, tid); SYNC();
  fft_last16_store(lds, tid, H); SYNC();
}

template <bool SWAP, bool ATR = false, int MTW = 2>
DI void gemm_main(const u16* __restrict__ A, int lda, int a_row0, int a_lo, int a_hi, int a_kstep,
                  const u16* __restrict__ B, int ldb, int nk, f32x16 (&acc)[MTW][2], char* smem) {
  constexpr int ROWS = MTW * 64, NA = MTW * 2;
  const int tid = opq(threadIdx.x), lane = tid & 63, wave = tid >> 6, wm = wave >> 1, wn = wave & 1, r = lane & 31, h = lane >> 5;
  char* sA = smem;
  char* sB = smem + ROWS * 144;
  const u16* ap[NA];
  const u16* bp[4];
  int loa[NA], lob[4];
#pragma unroll
  for (int i = 0; i < NA; ++i) {
    const int idx = tid + 256 * i, row = idx >> 3, ch = idx & 7;
    if (ATR) {
      ap[i] = A + (size_t)(idx & 63) * lda + a_row0 + (idx >> 6) * 8;
    } else {
      const int gr = min(max(a_row0 + row, a_lo), a_hi);
      ap[i] = A + (size_t)gr * lda + ch * 8;
    }
    loa[i] = row * 144 + ch * 16;
  }
#pragma unroll
  for (int i = 0; i < 4; ++i) {
    const int idx = tid + 256 * i, row = idx >> 3, ch = idx & 7;
    bp[i] = B + (size_t)row * ldb + ch * 8;
    lob[i] = row * 144 + ch * 16;
  }
  u32x4 ra0[NA], rb0[4];
#define GEMM_LOAD(RA, RB, KT)                                                                                         \
  _Pragma("unroll") for (int i = 0; i < NA; ++i)                                                                      \
    RA[i] = *(const u32x4*)(ap[i] + (ATR ? (size_t)(KT) * 64 * lda : (size_t)(KT) * a_kstep));                        \
  _Pragma("unroll") for (int i = 0; i < 4; ++i) RB[i] = *(const u32x4*)(bp[i] + (KT) * 64);
#define GEMM_STASH(RA, RB)                                                                                            \
  _Pragma("unroll") for (int i = 0; i < NA; ++i) {                                                                    \
    if (ATR) {                                                                                                        \
      const int idx = tid + 256 * i, krow = idx & 63, mch = idx >> 6;                                                 \
      _Pragma("unroll") for (int e = 0; e < 4; ++e) {                                                                 \
        *(u16*)(sA + (mch * 8 + 2 * e) * 144 + krow * 2) = (u16)(RA[i][e] & 0xffffu);                                 \
        *(u16*)(sA + (mch * 8 + 2 * e + 1) * 144 + krow * 2) = (u16)(RA[i][e] >> 16);                                 \
      }                                                                                                               \
    } else {                                                                                                          \
      *(u32x4*)(sA + loa[i]) = RA[i];                                                                                 \
    }                                                                                                                 \
  }                                                                                                                   \
  _Pragma("unroll") for (int i = 0; i < 4; ++i) *(u32x4*)(sB + lob[i]) = RB[i];
#define GEMM_COMPUTE()                                                                                                \
  __builtin_amdgcn_s_setprio(1);                                                                                      \
  _Pragma("unroll") for (int ks = 0; ks < 4; ++ks) {                                                                  \
    bf16x8 af[MTW], bfr[2];                                                                                           \
    _Pragma("unroll") for (int t = 0; t < MTW; ++t) af[t] = *(const bf16x8*)(pa + t * 32 * 144 + ks * 32);            \
    _Pragma("unroll") for (int t = 0; t < 2; ++t) bfr[t] = *(const bf16x8*)(pb + t * 32 * 144 + ks * 32);             \
    _Pragma("unroll") for (int mt = 0; mt < MTW; ++mt)                                                                \
      _Pragma("unroll") for (int nt = 0; nt < 2; ++nt)                                                                \
        acc[mt][nt] = SWAP ? MFMA(bfr[nt], af[mt], acc[mt][nt]) : MFMA(af[mt], bfr[nt], acc[mt][nt]);                 \
  }                                                                                                                   \
  __builtin_amdgcn_s_setprio(0);
  GEMM_LOAD(ra0, rb0, 0)
#pragma unroll
  for (int mt = 0; mt < MTW; ++mt)
#pragma unroll
    for (int nt = 0; nt < 2; ++nt)
#pragma unroll
      for (int i = 0; i < 16; ++i) acc[mt][nt][i] = 0.f;
  const char* pa = sA + (wm * (MTW * 32) + r) * 144 + h * 16;
  const char* pb = sB + (wn * 64 + r) * 144 + h * 16;
#pragma unroll 1
  for (int kk = 0; kk < nk; ++kk) {
    __syncthreads();
    GEMM_STASH(ra0, rb0)
    __syncthreads();
    if (kk + 1 < nk) { GEMM_LOAD(ra0, rb0, kk + 1) }
    GEMM_COMPUTE()
  }
#undef GEMM_LOAD
#undef GEMM_STASH
#undef GEMM_COMPUTE
}
template <int MTW>
DI void store_rowmajor(const f32x16 (&acc)[MTW][2], u16* C, int ldc, int m0, int ncol0, float scale) {
  const int tid = opq(threadIdx.x), lane = tid & 63, wave = tid >> 6, wm = wave >> 1, wn = wave & 1, r = lane & 31, h = lane >> 5;
#pragma unroll
  for (int mt = 0; mt < MTW; ++mt)
#pragma unroll
    for (int nt = 0; nt < 2; ++nt)
#pragma unroll
      for (int g = 0; g < 4; ++g) {
        const int m = m0 + wm * (MTW * 32) + mt * 32 + r, n = ncol0 + wn * 64 + nt * 32 + 8 * g + 4 * h;
        u32x2 pk;
        pk.x = pack2(acc[mt][nt][4 * g] * scale, acc[mt][nt][4 * g + 1] * scale);
        pk.y = pack2(acc[mt][nt][4 * g + 2] * scale, acc[mt][nt][4 * g + 3] * scale);
        *(u32x2*)(C + (size_t)m * ldc + n) = pk;
      }
}
template <int MTW>
DI void store_transposed(const f32x16 (&acc)[MTW][2], u16* T, int ldt, int trow0, int j0) {
  const int tid = opq(threadIdx.x), lane = tid & 63, wave = tid >> 6, wm = wave >> 1, wn = wave & 1, r = lane & 31, h = lane >> 5;
#pragma unroll
  for (int mt = 0; mt < MTW; ++mt)
#pragma unroll
    for (int nt = 0; nt < 2; ++nt)
#pragma unroll
      for (int g = 0; g < 4; ++g) {
        const int n = trow0 + wn * 64 + nt * 32 + r, m = j0 + wm * (MTW * 32) + mt * 32 + 8 * g + 4 * h;
        u32x2 pk;
        pk.x = pack2(acc[mt][nt][4 * g], acc[mt][nt][4 * g + 1]);
        pk.y = pack2(acc[mt][nt][4 * g + 2], acc[mt][nt][4 * g + 3]);
        *(u32x2*)(T + (size_t)n * ldt + m) = pk;
      }
}

constexpr int NCONV_TILES = 864 + 768 + 64 + 384 + 256 + 1408 + 704;
DI void conv_tile(const Params& p, int l, int tile, char* smem) {
  float* t = (float*)smem;
  const int tid = opq(threadIdx.x);
  int mat, tn, tk;
  if (tile < 864) { mat = 0; tn = tile / 16; tk = tile % 16; }
  else if (tile < 1632) { tile -= 864; mat = 1; tn = tile / 16; tk = tile % 16; }
  else if (tile < 1696) { tile -= 1632; mat = 2; tn = tile / 4; tk = tile % 4; }
  else if (tile < 2080) { tile -= 1696; mat = 3; tn = tile / 8; tk = tile % 8; }
  else if (tile < 2336) { tile -= 2080; mat = 4; tn = tile / 16; tk = tile % 16; }
  else if (tile < 3744) { tile -= 2336; mat = 5; tn = tile / 16; tk = tile % 16; }
  else { tile -= 3744; mat = 6; tn = tile / 44; tk = tile % 44; }
  const int k0 = tk * 64;
  const int nn = tid & 63;
  int np = tn * 64 + nn;
  const float* src; int ld; int col;
  if (mat == 0) { src = p.w_in + (size_t)l * 1024 * 6432; ld = 6432; col = np < 1024 ? np : (np < 3328 ? np + 32 : (np < 3360 ? np - 3328 + 1024 : -1)); }
  else if (mat == 1) { src = p.w_in + (size_t)l * 1024 * 6432; ld = 6432; col = 3360 + np; }
  else if (mat == 2) { src = p.w_kv_up + (size_t)l * 256 * 1024; ld = 1024; col = np < 512 ? (np >> 6) * 128 + (np & 63) : ((np - 512) >> 6) * 128 + 64 + (np & 63); }
  else if (mat == 3) { const int br = tn / 16; np = (tn % 16) * 64 + nn; src = p.w_branch + (size_t)(l * 3 + br) * 512 * 1024; ld = 1024; col = np; }
  else if (mat == 4) { src = p.w_out + (size_t)l * 1024 * 1024; ld = 1024; col = np; }
  else if (mat == 5) { src = p.w_up + (size_t)l * 1024 * 5632; ld = 5632; const int blk = np >> 7, rr = np & 127; col = rr < 64 ? blk * 64 + rr : 2816 + blk * 64 + rr - 64; }
  else { src = p.w_down + (size_t)l * 2816 * 1024; ld = 1024; col = np; }
#pragma unroll 4
  for (int i = 0; i < 16; ++i) {
    const int kk = (tid >> 6) + 4 * i;
    float v = 0.f;
    if (col >= 0) v = src[(size_t)(k0 + kk) * ld + col];
    if (mat == 2) v *= p.kv_norm_g[l * 256 + k0 + kk];
    t[kk * 65 + nn] = v;
  }
  __syncthreads();
  {
    const int n2 = tid >> 2, kq = (tid & 3) * 16;
    const int drow = tn * 64 + n2;
    u16* dst;
    if (mat == 0) dst = (u16*)(p.ws + OFF_WT_IN) + (size_t)drow * 1024;
    else if (mat == 1) dst = (u16*)(p.ws + OFF_WT_GATE) + (size_t)drow * 1024;
    else if (mat == 2) dst = (u16*)(p.ws + OFF_WT_KV) + (size_t)drow * 256;
    else if (mat == 3) dst = (u16*)(p.ws + OFF_WT_BR) + (size_t)drow * 512;
    else if (mat == 4) dst = (u16*)(p.ws + OFF_WT_OUT) + (size_t)drow * 1024;
    else if (mat == 5) dst = (u16*)(p.ws + OFF_WT_UP) + (size_t)drow * 1024;
    else dst = (u16*)(p.ws + OFF_WT_DOWN) + (size_t)drow * 2816;
    unsigned pk[8];
#pragma unroll
    for (int j = 0; j < 8; ++j) pk[j] = pack2(t[(kq + 2 * j) * 65 + n2], t[(kq + 2 * j + 1) * 65 + n2]);
    u32x4* d4 = (u32x4*)(dst + k0 + kq);
    d4[0] = u32x4{pk[0], pk[1], pk[2], pk[3]};
    d4[1] = u32x4{pk[4], pk[5], pk[6], pk[7]};
  }
  __syncthreads();
}

DI void mod_item(const Params& p, int item, char* smem) {
  float* sv = (float*)smem;
  float* red = sv + 5 * 1024;
  const int tid = opq(threadIdx.x);
  const int l = item / 96, cg0 = (item % 96) * 64;
  for (int i = tid; i < 5 * 1024; i += 256) {
    const int v = i >> 10, k = i & 1023;
    const float c = v < 4 ? p.c[v * 1024 + k] : p.c_ctx[k];
    sv[i] = c / (1.f + __expf(-c));
  }
  __syncthreads();
  const int kq = tid >> 6, cc = tid & 63, col = cg0 + cc;
  float a[5] = {0.f, 0.f, 0.f, 0.f, 0.f};
  const float* w = p.w_mod + (size_t)l * 1024 * 6144 + col;
#pragma unroll 8
  for (int k = kq * 256; k < kq * 256 + 256; ++k) {
    const float wv = w[(size_t)k * 6144];
#pragma unroll
    for (int v = 0; v < 5; ++v) a[v] += sv[v * 1024 + k] * wv;
  }
#pragma unroll
  for (int v = 0; v < 5; ++v) red[(kq * 5 + v) * 64 + cc] = a[v];
  __syncthreads();
  for (int i = tid; i < 5 * 64; i += 256) {
    const int v = i >> 6, c2 = i & 63;
    float s = p.b_mod[l * 6144 + cg0 + c2];
#pragma unroll
    for (int q = 0; q < 4; ++q) s += red[(q * 5 + v) * 64 + c2];
    ((float*)(p.ws + OFF_MOD))[(l * 5 + v) * 6144 + cg0 + c2] = s;
  }
  __syncthreads();
}

DI void rope_item(const Params& p, int item) {
  const int e = item * 256 + opq(threadIdx.x);
  const int pos = e / 48, f = e % 48;
  const int row = pos >> 6, colp = pos & 63;
  float* base = (float*)(p.ws + OFF_ROPE);
  float ang; float *cd, *sd;
  if (f < 16) {
    const int fi = f & 7;
    const float inv = exp2f(-(float)fi * (13.287712379549449f / 8.f));
    ang = (f < 8 ? (float)row : (float)colp) * inv;
    cd = base + pos * 16 + f; sd = base + 8192 * 16 + pos * 16 + f;
  } else {
    const int f2 = f - 16, fi = f2 & 15;
    const float inv = exp2f(-(float)fi * (13.287712379549449f / 16.f));
    ang = (f2 < 16 ? (float)row : (float)colp) * inv;
    cd = base + 2 * 8192 * 16 + pos * 32 + f2; sd = base + 2 * 8192 * 16 + 8192 * 32 + pos * 32 + f2;
  }
  const float rev = ang * 0.15915494309189535f;
  *cd = cosrev(rev);
  *sd = sinrev(rev);
}

DI void hid_item(const Params& p, int item, char* smem) {
  float* feat = (float*)smem;
  float* h1 = feat + 4 * 36;
  const int tid = opq(threadIdx.x);
  const int l = item / 264; const int it = item % 264;
  int L, pos00; float* dst;
  if (it < 256) { L = 8192; pos00 = it * 32; dst = (float*)(p.ws + OFF_HID + l * HID_LAYER); }
  else { L = 256; pos00 = (it - 256) * 32; dst = (float*)(p.ws + OFF_HID + l * HID_LAYER) + 64 * 8192; }
  const int pp = tid >> 6, j = tid & 63;
#pragma unroll 1
  for (int sub = 0; sub < 8; ++sub) {
    const int pos = pos00 + sub * 4 + pp;
    if (j < 33) {
      float fv;
      if (j == 0) fv = (float)pos / (float)(L - 1);
      else {
        const int bi = (j - 1) & 15;
        const float band = 1e-4f + (float)bi * ((15.f - 1e-4f) / 15.f);
        const float rev = (float)pos * band / (float)L;
        fv = (j <= 16) ? cosrev(rev) : -sinrev(rev);
      }
      feat[pp * 36 + j] = fv;
    }
    __syncthreads();
    {
      float s = p.hy_b1[l * 64 + j];
      const float* w1 = p.hy_w1 + (size_t)l * 33 * 64;
#pragma unroll
      for (int f = 0; f < 33; ++f) s += feat[pp * 36 + f] * w1[f * 64 + j];
      s *= p.hy_freq[l * 128 + j];
      h1[pp * 64 + j] = sinrev(s * 0.15915494309189535f);
    }
    __syncthreads();
    {
      float s = p.hy_b2[l * 64 + j];
      const float* w2 = p.hy_w2 + (size_t)l * 64 * 64;
#pragma unroll 8
      for (int i = 0; i < 64; ++i) s += h1[pp * 64 + i] * w2[i * 64 + j];
      s *= p.hy_freq[l * 128 + 64 + j];
      dst[(size_t)j * L + pos] = sinrev(s * 0.15915494309189535f);
    }
    __syncthreads();
  }
}

DI const float* xrow_src(const float* xl, const float* xc, int m) {
  const int b = m / TPB, j = m - b * TPB;
  return j < CTX ? xc + (size_t)(b * CTX + j) * DM : xl + (size_t)(b * SEQ + j - CTX) * DM;
}
DI void row_pass(const Params& p, int mode, const float* xl_src, const float* xc_src, float* xl_dst, float* xc_dst,
                 const u16* ybuf, const float* gy, int gate_off, int modl_gate,
                 bool has_next, const float* gn, int modl_next, int sh_off, int sc_off, u16* hdst, bool skip_ctx_rows) {
  const int tid0 = opq(threadIdx.x);
  const int lane = tid0 & 63;
  const int gw = blockIdx.x * 4 + (tid0 >> 6), nw = gridDim.x * 4;
  const float* modb = (const float*)(p.ws + OFF_MOD);
  const int per = (MTOK + nw - 1) / nw;
  const int m_beg = gw * per, m_end = min(m_beg + per, MTOK);
  int cur_v = -1;
  float4 gg[4], gs[4], shv[4];
#pragma unroll
  for (int i = 0; i < 4; ++i) { gg[i] = make_float4(0.f, 0.f, 0.f, 0.f); gs[i] = gg[i]; shv[i] = gg[i]; }
  const bool do_h = (mode == 0) || has_next;
  float4 xv_n[4];
  u32x2 yr_n[4];
#pragma unroll
  for (int i = 0; i < 4; ++i) { xv_n[i] = make_float4(0.f, 0.f, 0.f, 0.f); yr_n[i] = u32x2{0u, 0u}; }
  if (m_beg < m_end) {
    const float* xs0 = xrow_src(xl_src, xc_src, m_beg);
#pragma unroll
    for (int i = 0; i < 4; ++i) {
      xv_n[i] = *(const float4*)(xs0 + lane * 4 + 256 * i);
      if (mode == 1) yr_n[i] = *(const u32x2*)(ybuf + (size_t)m_beg * DM + lane * 4 + 256 * i);
    }
  }
  for (int m = m_beg; m < m_end; ++m) {
    const int b = m / TPB, j = m - b * TPB;
    float4 xv[4];
    u32x2 yr[4];
#pragma unroll
    for (int i = 0; i < 4; ++i) { xv[i] = xv_n[i]; yr[i] = yr_n[i]; }
    if (m + 1 < m_end) {
      const float* xs1 = xrow_src(xl_src, xc_src, m + 1);
#pragma unroll
      for (int i = 0; i < 4; ++i) {
        xv_n[i] = *(const float4*)(xs1 + lane * 4 + 256 * i);
        if (mode == 1) yr_n[i] = *(const u32x2*)(ybuf + (size_t)(m + 1) * DM + lane * 4 + 256 * i);
      }
    }
    if (skip_ctx_rows && j < CTX) continue;
    const int v = j < CTX ? 4 : b;
    if (v != cur_v) {
      cur_v = v;
#pragma unroll
      for (int i = 0; i < 4; ++i) {
        const int c = lane * 4 + 256 * i;
        if (mode == 1) {
          const float4 g4 = *(const float4*)(gy + c);
          const float4 t4 = *(const float4*)(modb + (size_t)(modl_gate * 5 + v) * 6144 + gate_off + c);
          gg[i] = make_float4(g4.x * t4.x, g4.y * t4.y, g4.z * t4.z, g4.w * t4.w);
        }
        if (do_h) {
          const float* mb = modb + (size_t)(modl_next * 5 + v) * 6144;
          const float4 g4 = *(const float4*)(gn + c);
          const float4 sc = *(const float4*)(mb + sc_off + c);
          shv[i] = *(const float4*)(mb + sh_off + c);
          gs[i] = make_float4(g4.x * (1.f + sc.x), g4.y * (1.f + sc.y), g4.z * (1.f + sc.z), g4.w * (1.f + sc.w));
        }
      }
    }
    if (mode == 1) {
      float yv[4][4];
      float ss = 0.f;
#pragma unroll
      for (int i = 0; i < 4; ++i) {
        const u32x2 u = yr[i];
        yv[i][0] = lo_bf(u.x); yv[i][1] = hi_bf(u.x); yv[i][2] = lo_bf(u.y); yv[i][3] = hi_bf(u.y);
#pragma unroll
        for (int e = 0; e < 4; ++e) ss += yv[i][e] * yv[i][e];
      }
      ss = wave_sum(ss);
      const float rstd = rsqrtf(ss * (1.f / DM) + EPS);
#pragma unroll
      for (int i = 0; i < 4; ++i) {
        xv[i].x += gg[i].x * (yv[i][0] * rstd);
        xv[i].y += gg[i].y * (yv[i][1] * rstd);
        xv[i].z += gg[i].z * (yv[i][2] * rstd);
        xv[i].w += gg[i].w * (yv[i][3] * rstd);
      }
      float* xd = (j < CTX) ? xc_dst + (size_t)(b * CTX + j) * DM : xl_dst + (size_t)(b * SEQ + j - CTX) * DM;
#pragma unroll
      for (int i = 0; i < 4; ++i) *(float4*)(xd + lane * 4 + 256 * i) = xv[i];
    }
    if (do_h) {
      float ss = 0.f;
#pragma unroll
      for (int i = 0; i < 4; ++i) ss += xv[i].x * xv[i].x + xv[i].y * xv[i].y + xv[i].z * xv[i].z + xv[i].w * xv[i].w;
      ss = wave_sum(ss);
      const float rstd = rsqrtf(ss * (1.f / DM) + EPS);
#pragma unroll
      for (int i = 0; i < 4; ++i) {
        const int c = lane * 4 + 256 * i;
        u32x2 pk;
        pk.x = pack2(xv[i].x * rstd * gs[i].x + shv[i].x, xv[i].y * rstd * gs[i].y + shv[i].y);
        pk.y = pack2(xv[i].z * rstd * gs[i].z + shv[i].z, xv[i].w * rstd * gs[i].w + shv[i].w);
        *(u32x2*)(hdst + (size_t)m * DM + c) = pk;
      }
    }
  }
}

constexpr float QS_MLA = 0.10206207261596577f * LOG2E;
constexpr float QS_SWA = 0.125f * LOG2E;

DI void rope32(f32x16& a, const float* cm, const float* sm, int pos, int h) {
#pragma unroll
  for (int i = 0; i < 8; ++i) {
    const int f = crow(i, h);
    const float c = cm[pos * 16 + f], s = sm[pos * 16 + f];
    const float x1 = a[i], x2 = a[i + 8];
    a[i] = x1 * c - x2 * s;
    a[i + 8] = x2 * c + x1 * s;
    if ((i & 3) == 3) __builtin_amdgcn_sched_barrier(0);
  }
}
DI void rope64(f32x16& a0, f32x16& a1, const float* cs, const float* ss, int pos, int h) {
#pragma unroll
  for (int i = 0; i < 16; ++i) {
    const int f = crow(i, h);
    const float c = cs[pos * 32 + f], s = ss[pos * 32 + f];
    const float x1 = a0[i], x2 = a1[i];
    a0[i] = x1 * c - x2 * s;
    a1[i] = x2 * c + x1 * s;
    if ((i & 3) == 3) __builtin_amdgcn_sched_barrier(0);
  }
}

DI void inproj_tile(const Params& p, int tile, char* smem) {
  const int mt_i = tile / 27, nt_i = tile % 27;
  const int m0 = mt_i * 192;
  const int tid = opq(threadIdx.x), lane = tid & 63, wave = tid >> 6, wm = wave >> 1, wn = wave & 1, r = lane & 31, h = lane >> 5;
  const u16* hbuf = (const u16*)(p.ws + OFF_RH);
  const u16* wt = (const u16*)(p.ws + OFF_WT_IN) + (size_t)nt_i * 128 * 1024;
  const int b = m0 / TPB, j0 = m0 - b * TPB;
  const float* cm = (const float*)(p.ws + OFF_ROPE);
  const float* sm = cm + 8192 * 16;
  const float* cs = sm + 8192 * 16;
  const float* ss = cs + 8192 * 32;
  f32x16 acc[3][2];
  if (nt_i >= 13 && nt_i <= 25) {
    gemm_main<false>(hbuf, 1024, m0, 0, MTOK - 1, 64, wt, 1024, 16, acc, smem);
    if (nt_i == 13) store_transposed(acc, (u16*)(p.ws + OFF_SVT), TPB, b * 128, j0);
    else store_transposed(acc, (u16*)(p.ws + OFF_HYT), TPB, b * 1536 + (nt_i - 14) * 128, j0);
    return;
  }
  gemm_main<true>(hbuf, 1024, m0, 0, MTOK - 1, 64, wt, 1024, 16, acc, smem);
  if (nt_i < 6) {
#pragma unroll
    for (int ntl = 0; ntl < 2; ++ntl) {
      const int s32 = nt_i * 4 + wn * 2 + ntl;
      if (s32 % 3 == 2) {
#pragma unroll
        for (int mt = 0; mt < 3; ++mt) {
          const int jr = j0 + wm * 96 + mt * 32 + r;
          if (jr >= CTX) rope32(acc[mt][ntl], cm, sm, jr - CTX, h);
        }
      }
    }
    store_rowmajor(acc, (u16*)(p.ws + OFF_Q), 768, m0, nt_i * 128, QS_MLA);
  } else if (nt_i < 8) {
    store_rowmajor(acc, (u16*)(p.ws + OFF_CKV), 256, m0, (nt_i - 6) * 128, 1.f);
  } else if (nt_i < 12) {
#pragma unroll
    for (int mt = 0; mt < 3; ++mt) {
      const int jr = j0 + wm * 96 + mt * 32 + r;
      if (jr >= CTX) rope64(acc[mt][0], acc[mt][1], cs, ss, jr - CTX, h);
    }
    store_rowmajor(acc, (u16*)(p.ws + OFF_SQ), 512, m0, (nt_i - 8) * 128, QS_SWA);
  } else if (nt_i == 12) {
#pragma unroll
    for (int mt = 0; mt < 3; ++mt) {
      const int jr = j0 + wm * 96 + mt * 32 + r;
      if (jr >= CTX) rope64(acc[mt][0], acc[mt][1], cs, ss, jr - CTX, h);
    }
    store_rowmajor(acc, (u16*)(p.ws + OFF_SK), 128, m0, 0, 1.f);
  } else {
    if (wn == 0) {
      u16* kr = (u16*)(p.ws + OFF_KR);
#pragma unroll
      for (int mt = 0; mt < 3; ++mt) {
        const int ml = wm * 96 + mt * 32 + r;
        if (j0 + ml >= CTX) rope32(acc[mt][0], cm, sm, j0 + ml - CTX, h);
#pragma unroll
        for (int g = 0; g < 4; ++g) {
          u32x2 pk;
          pk.x = pack2(acc[mt][0][4 * g], acc[mt][0][4 * g + 1]);
          pk.y = pack2(acc[mt][0][4 * g + 2], acc[mt][0][4 * g + 3]);
          *(u32x2*)(kr + (size_t)(m0 + ml) * 32 + 8 * g + 4 * h) = pk;
        }
      }
    }
  }
}

DI void kvup_tile(const Params& p, int tile, char* smem) {
  const int mt_i = tile >> 3, nt_i = tile & 7;
  const int m0 = mt_i * 192;
  const int tid = opq(threadIdx.x), lane = tid & 63, wave = tid >> 6, wm = wave >> 1, r = lane & 31, h = lane >> 5;
  const u16* ckv = (const u16*)(p.ws + OFF_CKV);
  float* rs = (float*)(smem + (192 + 128) * 144);
#pragma unroll
  for (int pass = 0; pass < 2; ++pass) {
    const int row = pass * 128 + (tid >> 1), half = tid & 1;
    const int rowc = min(row, 191);
    const u32x4* src = (const u32x4*)(ckv + (size_t)(m0 + rowc) * 256 + half * 128);
    float ss = 0.f;
#pragma unroll
    for (int i = 0; i < 16; ++i) {
      const u32x4 u = src[i];
      const unsigned w[4] = {u.x, u.y, u.z, u.w};
#pragma unroll
      for (int e = 0; e < 4; ++e) { const float a = lo_bf(w[e]), c = hi_bf(w[e]); ss += a * a + c * c; }
    }
    ss += __shfl_xor(ss, 1);
    if (half == 0 && row < 192) rs[row] = rsqrtf(ss * (1.f / 256.f) + EPS);
  }
  const u16* wt = (const u16*)(p.ws + OFF_WT_KV) + (size_t)nt_i * 128 * 256;
  const int b = m0 / TPB, j0 = m0 - b * TPB;
  f32x16 acc[3][2];
  if (nt_i < 4) {
    gemm_main<true>(ckv, 256, m0, 0, MTOK - 1, 64, wt, 256, 4, acc, smem);
#pragma unroll
    for (int mt = 0; mt < 3; ++mt) {
      const float sc = rs[wm * 96 + mt * 32 + r];
#pragma unroll
      for (int nt = 0; nt < 2; ++nt)
#pragma unroll
        for (int i = 0; i < 16; ++i) acc[mt][nt][i] *= sc;
    }
    store_rowmajor(acc, (u16*)(p.ws + OFF_KN), 512, m0, nt_i * 128, 1.f);
  } else {
    gemm_main<false>(ckv, 256, m0, 0, MTOK - 1, 64, wt, 256, 4, acc, smem);
#pragma unroll
    for (int mt = 0; mt < 3; ++mt)
#pragma unroll
      for (int i = 0; i < 16; ++i) {
        const float sc = rs[wm * 96 + mt * 32 + crow(i, h)];
        acc[mt][0][i] *= sc;
        acc[mt][1][i] *= sc;
      }
    store_transposed(acc, (u16*)(p.ws + OFF_VT), TPB, b * 512 + (nt_i - 4) * 128, j0);
  }
  __syncthreads();
}

DI void merge_tile(const Params& p, int tile, char* smem) {
  const int mt_i = tile >> 3, nt_i = tile & 7;
  const int m0 = mt_i * 192;
  const u16* hp = (const u16*)(p.ws + OFF_RH);
  const int tid = opq(threadIdx.x), lane = tid & 63, wave = tid >> 6, wm = wave >> 1, wn = wave & 1, r = lane & 31, h = lane >> 5;
  u16* C = (u16*)(p.ws + OFF_MERGED);
#pragma unroll 1
  for (int br = 0; br < 3; ++br) {
    if ((DBG_SKIP_BR >> br) & 1) continue;
    f32x16 acc[3][2];
    gemm_main<true>(hp, 1024, m0, 0, MTOK - 1, 64, (const u16*)(p.ws + OFF_WT_GATE) + (size_t)(br * 1024 + nt_i * 128) * 1024, 1024, 16, acc, smem);
    u32x2* sgp = (u32x2*)(p.ws + OFF_ESCR + (size_t)blockIdx.x * 65536) + tid * 24;
#pragma unroll
    for (int a = 0; a < 3; ++a)
#pragma unroll
      for (int b2 = 0; b2 < 2; ++b2)
#pragma unroll
        for (int g = 0; g < 4; ++g) {
          u32x2 v;
          v.x = pack2(1.f / (1.f + __expf(-acc[a][b2][4 * g])), 1.f / (1.f + __expf(-acc[a][b2][4 * g + 1])));
          v.y = pack2(1.f / (1.f + __expf(-acc[a][b2][4 * g + 2])), 1.f / (1.f + __expf(-acc[a][b2][4 * g + 3])));
          sgp[(a * 2 + b2) * 4 + g] = v;
        }
    const u16* wbr = (const u16*)(p.ws + OFF_WT_BR) + (size_t)(br * 1024 + nt_i * 128) * 512;
    if (br == 0) gemm_main<true>((const u16*)(p.ws + OFF_Q), 768, m0, 0, MTOK - 1, 96, wbr, 512, 8, acc, smem);
    else if (br == 1) gemm_main<true>((const u16*)(p.ws + OFF_SQ), 512, m0, 0, MTOK - 1, 64, wbr, 512, 8, acc, smem);
    else {
      const int b = m0 / TPB, j0 = m0 - b * TPB;
      gemm_main<true, true>((const u16*)(p.ws + OFF_HYT) + (size_t)(b * 1536 + 512) * TPB, TPB, j0, 0, 0, 64, wbr, 512, 8, acc, smem);
    }
#pragma unroll
    for (int mt = 0; mt < 3; ++mt)
#pragma unroll
      for (int nt = 0; nt < 2; ++nt)
#pragma unroll
        for (int g = 0; g < 4; ++g) {
          const int m = m0 + wm * 96 + mt * 32 + r, n = nt_i * 128 + wn * 64 + nt * 32 + 8 * g + 4 * h;
          u32x2* dst = (u32x2*)(C + (size_t)m * 1024 + n);
          u32x2 prev = {0u, 0u};
          if (br > DBG_FIRST_BR) prev = *dst;
          const u32x2 sv = sgp[(mt * 2 + nt) * 4 + g];
          const unsigned s0 = sv.x, s1 = sv.y;
          u32x2 nv;
          nv.x = pack2(lo_bf(prev.x) + lo_bf(s0) * acc[mt][nt][4 * g], hi_bf(prev.x) + hi_bf(s0) * acc[mt][nt][4 * g + 1]);
          nv.y = pack2(lo_bf(prev.y) + lo_bf(s1) * acc[mt][nt][4 * g + 2], hi_bf(prev.y) + hi_bf(s1) * acc[mt][nt][4 * g + 3]);
          *dst = nv;
          __builtin_amdgcn_sched_barrier(0);
        }
  }
}

DI void plain_tile(const Params& p, int tile, const u16* A, int lda, int nk, const u16* W, u16* C, char* smem) {
  const int mt_i = tile >> 3, nt_i = tile & 7;
  f32x16 acc[3][2];
  gemm_main<true>(A, lda, mt_i * 192, 0, MTOK - 1, 64, W + (size_t)nt_i * 128 * lda, lda, nk, acc, smem);
  store_rowmajor(acc, C, 1024, mt_i * 192, nt_i * 128, 1.f);
}

DI void ffnup_tile(const Params& p, int l, int tile, char* smem) {
  const int mt_i = tile / 44, nt_i = tile % 44;
  const int b = mt_i / 46, ti = mt_i % 46;
  int seq_base, len, r0;
  if (ti < 2) { seq_base = b * TPB; len = CTX; r0 = 190 * ti; }
  else { seq_base = b * TPB + CTX; len = SEQ; r0 = 190 * (ti - 2); }
  const int tid = opq(threadIdx.x), lane = tid & 63, wave = tid >> 6, wm = wave >> 1, wn = wave & 1, r = lane & 31, h = lane >> 5;
  f32x16 acc[3][2];
  gemm_main<true>((const u16*)(p.ws + OFF_RH), 1024, seq_base + r0 - 1, seq_base, seq_base + len - 1, 64,
                  (const u16*)(p.ws + OFF_WT_UP) + (size_t)nt_i * 128 * 1024, 1024, 16, acc, smem);
  __syncthreads();
#pragma unroll
  for (int mt = 0; mt < 3; ++mt) {
    const int ml = wm * 96 + mt * 32 + r;
    const int pos = r0 - 1 + ml;
    const bool valid = pos >= 0 && pos < len;
#pragma unroll
    for (int nt = 0; nt < 2; ++nt)
#pragma unroll
      for (int g = 0; g < 4; ++g) {
        u32x2 pk = u32x2{0u, 0u};
        if (valid) {
          pk.x = pack2(acc[mt][nt][4 * g], acc[mt][nt][4 * g + 1]);
          pk.y = pack2(acc[mt][nt][4 * g + 2], acc[mt][nt][4 * g + 3]);
        }
        *(u32x2*)(smem + ml * 272 + (wn * 64 + nt * 32 + 8 * g + 4 * h) * 2) = pk;
      }
  }
  __syncthreads();
  {
    const int j4 = (tid & 15) * 4, tr = tid >> 4;
    const float* cw = p.ffn_conv_w + (size_t)l * 3 * 5632;
    const float* cb = p.ffn_conv_b + (size_t)l * 5632;
    const int cha = nt_i * 64 + j4, chb = DFF + cha;
    float wa[3][4], wb[3][4], ba[4], bb[4];
#pragma unroll
    for (int e = 0; e < 4; ++e) {
#pragma unroll
      for (int d = 0; d < 3; ++d) { wa[d][e] = cw[d * 5632 + cha + e]; wb[d][e] = cw[d * 5632 + chb + e]; }
      ba[e] = cb[cha + e]; bb[e] = cb[chb + e];
    }
    u16* Aout = (u16*)(p.ws + OFF_A);
#pragma unroll 1
    for (int i = 0; i < 12; ++i) {
      const int t = 1 + tr + 16 * i;
      const int pos = r0 - 1 + t;
      if (t <= 190 && pos < len) {
        float ca[4], cbv[4];
#pragma unroll
        for (int e = 0; e < 4; ++e) { ca[e] = ba[e]; cbv[e] = bb[e]; }
#pragma unroll
        for (int d = 0; d < 3; ++d) {
          const u32x2 ua = *(const u32x2*)(smem + (t - 1 + d) * 272 + j4 * 2);
          const u32x2 ub = *(const u32x2*)(smem + (t - 1 + d) * 272 + (64 + j4) * 2);
          ca[0] += lo_bf(ua.x) * wa[d][0]; ca[1] += hi_bf(ua.x) * wa[d][1]; ca[2] += lo_bf(ua.y) * wa[d][2]; ca[3] += hi_bf(ua.y) * wa[d][3];
          cbv[0] += lo_bf(ub.x) * wb[d][0]; cbv[1] += hi_bf(ub.x) * wb[d][1]; cbv[2] += lo_bf(ub.y) * wb[d][2]; cbv[3] += hi_bf(ub.y) * wb[d][3];
        }
        float o[4];
#pragma unroll
        for (int e = 0; e < 4; ++e) o[e] = ca[e] / (1.f + __expf(-ca[e])) * cbv[e];
        *(u32x2*)(Aout + (size_t)(seq_base + pos) * DFF + cha) = u32x2{pack2(o[0], o[1]), pack2(o[2], o[3])};
      }
    }
  }
}

template <int DQK, bool SWA>
DI void attn_item(const Params& p, int l, int b, int hq, int jq0  , int nct, int nband, int kp_start, char* smem) {
  constexpr int KS = DQK * 2 + 16;
  constexpr int KCH = DQK / 8;
  constexpr int NKC = 64 * KCH / 256;
  constexpr int NKS = DQK / 16;
  constexpr int BUFSZ = 22016;
  const int tid = opq(threadIdx.x), lane = tid & 63, wave = tid >> 6, r = lane & 31, h = lane >> 5;
  const int brow = b * TPB;
  const int ntiles = nct + nband;
  const u16* K1; int ldk1, koff; const u16* KR = (const u16*)(p.ws + OFF_KR);
  const u16* Vb; u16* outp; int ldo, ooff; const u16* Qb; int ldq;
  if (!SWA) {
    K1 = (const u16*)(p.ws + OFF_KN); ldk1 = 512; koff = hq * 64;
    Vb = (const u16*)(p.ws + OFF_VT) + (size_t)((b * 8 + hq) * 64) * TPB;
    Qb = (const u16*)(p.ws + OFF_Q); ldq = 768;
    outp = (u16*)(p.ws + OFF_Q); ldo = 768; ooff = hq * 96;
  } else {
    const int kvh = hq >> 2;
    K1 = (const u16*)(p.ws + OFF_SK); ldk1 = 128; koff = kvh * 64;
    Vb = (const u16*)(p.ws + OFF_SVT) + (size_t)((b * 2 + kvh) * 64) * TPB;
    Qb = (const u16*)(p.ws + OFF_SQ); ldq = 512;
    outp = (u16*)(p.ws + OFF_SQ); ldo = 512; ooff = hq * 64;
  }
  const int qrow = brow + jq0 + wave * 32 + r;
  bf16x8 qf[NKS];
#pragma unroll
  for (int ks = 0; ks < NKS; ++ks) qf[ks] = *(const bf16x8*)(Qb + (size_t)qrow * ldq + hq * DQK + ks * 16 + h * 8);
  f32x16 o[2];
#pragma unroll
  for (int dt = 0; dt < 2; ++dt)
#pragma unroll
    for (int i = 0; i < 16; ++i) o[dt][i] = 0.f;
  float mrun = -INFINITY, lsum = 0.f;
  u32x4 kreg[NKC], vreg[2];
  auto tile_j = [&](int it) { return it < nct ? it * 64 : CTX + kp_start + 64 * (it - nct); };
  auto issue = [&](int it) {
    const int jr = tile_j(it);
#pragma unroll
    for (int i = 0; i < NKC; ++i) {
      const int c = tid + 256 * i, key = c / KCH, part = c % KCH;
      const u16* src = (part < 8) ? K1 + (size_t)(brow + jr + key) * ldk1 + koff + part * 8
                                  : KR + (size_t)(brow + jr + key) * 32 + (part - 8) * 8;
      kreg[i] = *(const u32x4*)src;
    }
#pragma unroll
    for (int i = 0; i < 2; ++i) {
      const int c = tid + 256 * i, d = c >> 3, part = c & 7;
      vreg[i] = *(const u32x4*)(Vb + (size_t)d * TPB + jr + part * 8);
    }
  };
  auto stash = [&](int buf) {
    char* kb = smem + buf * BUFSZ;
    char* vb = kb + 13312;
#pragma unroll
    for (int i = 0; i < NKC; ++i) {
      const int c = tid + 256 * i, key = c / KCH, part = c % KCH;
      *(u32x4*)(kb + key * KS + part * 16) = kreg[i];
    }
#pragma unroll
    for (int i = 0; i < 2; ++i) {
      const int c = tid + 256 * i, d = c >> 3, part = c & 7;
      *(u32x2*)(vb + d * 136 + part * 16) = u32x2{vreg[i].x, vreg[i].y};
      *(u32x2*)(vb + d * 136 + part * 16 + 8) = u32x2{vreg[i].z, vreg[i].w};
    }
  };
  __syncthreads();
  issue(0);
  stash(0);
  __syncthreads();
  const int qpos = jq0 - CTX + wave * 32 + r;
#pragma unroll 1
  for (int it = 0; it < ntiles; ++it) {
    const int buf = it & 1;
    const char* kb = smem + buf * BUFSZ;
    const char* vb = kb + 13312;
    if (it + 1 < ntiles) issue(it + 1);
    f32x16 s[2];
#pragma unroll
    for (int kt = 0; kt < 2; ++kt) {
#pragma unroll
      for (int i = 0; i < 16; ++i) s[kt][i] = 0.f;
#pragma unroll
      for (int ks = 0; ks < NKS; ++ks) {
        const bf16x8 kf = *(const bf16x8*)(kb + (kt * 32 + r) * KS + ks * 32 + h * 16);
        s[kt] = MFMA(kf, qf[ks], s[kt]);
      }
    }
    if (SWA && it >= nct) {
      const int kpos0 = kp_start + 64 * (it - nct);
#pragma unroll
      for (int kt = 0; kt < 2; ++kt)
#pragma unroll
        for (int i = 0; i < 16; ++i) {
          const int diff = qpos - (kpos0 + kt * 32 + crow(i, h));
          if (diff > 128 || diff < -128) s[kt][i] = -1e30f;
        }
    }
    float mx = s[0][0];
#pragma unroll
    for (int kt = 0; kt < 2; ++kt)
#pragma unroll
      for (int i = 0; i < 16; ++i) mx = fmaxf(mx, s[kt][i]);
    mx = fmaxf(mx, __shfl_xor(mx, 32));
    const float mnew = fmaxf(mrun, mx);
    const float alpha = __builtin_amdgcn_exp2f(mrun - mnew);
    float ps = 0.f;
#pragma unroll
    for (int kt = 0; kt < 2; ++kt)
#pragma unroll
      for (int i = 0; i < 16; ++i) { const float e = __builtin_amdgcn_exp2f(s[kt][i] - mnew); s[kt][i] = e; ps += e; }
    if (__builtin_amdgcn_ballot_w64(mnew != mrun) != 0ull) {
      lsum *= alpha;
#pragma unroll
      for (int dt = 0; dt < 2; ++dt)
#pragma unroll
        for (int i = 0; i < 16; ++i) o[dt][i] *= alpha;
    }
    lsum += ps;
    mrun = mnew;
#pragma unroll
    for (int kt = 0; kt < 2; ++kt)
#pragma unroll
      for (int s2 = 0; s2 < 2; ++s2) {
        unsigned pk[4];
#pragma unroll
        for (int j = 0; j < 4; ++j) pk[j] = pack2(s[kt][8 * s2 + 2 * j], s[kt][8 * s2 + 2 * j + 1]);
        const bf16x8 pf = __builtin_bit_cast(bf16x8, u32x4{pk[0], pk[1], pk[2], pk[3]});
#pragma unroll
        for (int dt = 0; dt < 2; ++dt) {
          const char* vp = vb + (dt * 32 + r) * 136 + (kt * 32 + 16 * s2 + 4 * h) * 2;
          const s16x4 lo = *(const s16x4*)vp;
          const s16x4 hi = *(const s16x4*)(vp + 16);
          const bf16x8 vf = __builtin_shufflevector(lo, hi, 0, 1, 2, 3, 4, 5, 6, 7);
          o[dt] = MFMA(vf, pf, o[dt]);
        }
      }
    if (it + 1 < ntiles) stash(buf ^ 1);
    __syncthreads();
  }
  float ltot = lsum + __shfl_xor(lsum, 32);
  if (SWA) ltot += __builtin_amdgcn_exp2f(p.swa_sink[l * 8 + hq] * LOG2E - mrun);
  const float inv = 1.f / ltot;
#pragma unroll
  for (int dt = 0; dt < 2; ++dt)
#pragma unroll
    for (int g = 0; g < 4; ++g) {
      u32x2 pk;
      pk.x = pack2(o[dt][4 * g] * inv, o[dt][4 * g + 1] * inv);
      pk.y = pack2(o[dt][4 * g + 2] * inv, o[dt][4 * g + 3] * inv);
      *(u32x2*)(outp + (size_t)qrow * ldo + ooff + dt * 32 + 8 * g + 4 * h) = pk;
    }
}

constexpr float HY_D0 = 3.0701134573253944f;
constexpr float HY_DSTEP = (15.350567286626972f - 3.0701134573253944f) / 511.f;

DI void filt_item(const Params& p, int l, int oc, char* smem) {
  float2* lds = (float2*)smem;
  float* lf = (float*)smem;
  const int tid = opq(threadIdx.x), lane = tid & 63, wave = tid >> 6;
  const int c = oc & 511;
  const float* hid = (const float*)(p.ws + OFF_HID + l * HID_LAYER);
  const float* w3 = p.hy_w3 + (size_t)l * 64 * 2048;
  float* sa = (float*)(p.ws + OFF_ESCR + (size_t)blockIdx.x * 65536);
  float* sb = sa + 8192;
  __syncthreads();
  if (tid < 128) { const int dir = tid >> 6, j = tid & 63; lf[tid] = w3[j * 2048 + dir * 1024 + oc]; }
  __syncthreads();
  const float delta = HY_D0 + (float)c * HY_DSTEP;
  float asum = 0.f;
#pragma unroll 1
  for (int ib = 0; ib < 4; ++ib) {
    float a[8], bm[8];
#pragma unroll
    for (int i = 0; i < 8; ++i) { a[i] = 0.f; bm[i] = 0.f; }
#pragma unroll 4
    for (int j = 0; j < 64; ++j) {
      const float w0 = lf[j], w1 = lf[64 + j];
      const float* hr = hid + (size_t)j * 8192 + 4 * (tid + 512 * ib);
#pragma unroll
      for (int ii = 0; ii < 2; ++ii) {
        const float4 hv = *(const float4*)(hr + 1024 * ii);
        a[4 * ii + 0] += hv.x * w0; bm[4 * ii + 0] += hv.x * w1;
        a[4 * ii + 1] += hv.y * w0; bm[4 * ii + 1] += hv.y * w1;
        a[4 * ii + 2] += hv.z * w0; bm[4 * ii + 2] += hv.z * w1;
        a[4 * ii + 3] += hv.w * w0; bm[4 * ii + 3] += hv.w * w1;
      }
    }
#pragma unroll
    for (int ii = 0; ii < 2; ++ii) {
      const int t0 = 4 * (tid + 256 * (2 * ib + ii));
      float av[4];
#pragma unroll
      for (int e = 0; e < 4; ++e) {
        const int t = t0 + e;
        const float dec = __expf(-((float)t * (1.f / 8191.f)) * delta);
        av[e] = a[4 * ii + e] * dec;
        const float bv = bm[4 * ii + e] * dec;
        if (t >= 1) { sb[8192 - t] = bv; asum += fabsf(bv); } else sb[0] = 0.f;
        asum += fabsf(av[e]);
      }
      *(float4*)(sa + t0) = make_float4(av[0], av[1], av[2], av[3]);
    }
  }
  asum = wave_sum(asum);
  asm volatile("s_waitcnt vmcnt(0)" ::: "memory");
  __syncthreads();
  if (lane == 0) lf[wave] = asum;
  __syncthreads();
  const float inv = 1.f / (lf[0] + lf[1] + lf[2] + lf[3]);
  __syncthreads();
#pragma unroll 2
  for (int i = 0; i < 8; ++i) {
    const int t0 = 4 * (tid + 256 * i);
#pragma unroll
    for (int e = 0; e < 4; ++e) lds[fphys(t0 + e)] = make_float2((ldsc1(sa + t0 + e) + ldsc1(sb + t0 + e)) * inv, 0.f);
  }
  __syncthreads();
  h2_t* sp = (h2_t*)(p.ws + OFF_SPEC) + (size_t)oc * 2 * 8192;
  fft8192_spectrum(lds, tid, sp);
#pragma unroll 2
  for (int i = 0; i < 8; ++i) {
    const int t0 = 4 * (tid + 256 * i);
#pragma unroll
    for (int e = 0; e < 4; ++e) {
      const int t = t0 + e;
      const float2 w = twid_rev((float)t * (1.f / 16384.f));
      const float d = (ldsc1(sa + t) - ldsc1(sb + t)) * inv;
      lds[fphys(t)] = make_float2(d * w.x, d * w.y);
    }
  }
  __syncthreads();
  fft8192_spectrum(lds, tid, sp + 8192);
}

DI float dwc(const u16* s, int t, int len, float w0, float w1, float w2, float bias) {
  const int tm = max(t - 1, 0), tp = min(t + 1, len - 1);
  const float a = bf2f(s[tm]), b = bf2f(s[t]), c = bf2f(s[tp]);
  return b * w1 + bias + (t > 0 ? a * w0 : 0.f) + (t < len - 1 ? c * w2 : 0.f);
}

DI void ld4(const u16* s, int t0, float (&o)[4]) {
  const u32x2 u = *(const u32x2*)(s + t0);
  o[0] = lo_bf(u.x); o[1] = hi_bf(u.x); o[2] = lo_bf(u.y); o[3] = hi_bf(u.y);
}
DI void dwc4(const u16* s, int t0, int len, float w0, float w1, float w2, float bias, float (&o)[4]) {
  float c[4];
  ld4(s, t0, c);
  float l = bf2f(s[max(t0 - 1, 0)]), r = bf2f(s[min(t0 + 4, len - 1)]);
  l = (t0 > 0) ? l : 0.f;
  r = (t0 + 4 < len) ? r : 0.f;
  o[0] = l * w0 + c[0] * w1 + c[1] * w2 + bias;
  o[1] = c[0] * w0 + c[1] * w1 + c[2] * w2 + bias;
  o[2] = c[1] * w0 + c[2] * w1 + c[3] * w2 + bias;
  o[3] = c[2] * w0 + c[3] * w1 + r * w2 + bias;
}

DI void hconv_item(const Params& p, int l, int o, int c, int bp, char* smem) {
  float2* lds = (float2*)smem;
  const int tid = opq(threadIdx.x);
  u16* hyt = (u16*)(p.ws + OFF_HYT);
  const int b0 = bp * 2, b1 = b0 + 1;
  u16* z0p = hyt + (size_t)(b0 * 1536 + c) * TPB + CTX;
  u16* z1p = hyt + (size_t)(b1 * 1536 + c) * TPB + CTX;
  const int gc = (o + 1) * 512 + c;
  const u16* g0p = hyt + (size_t)(b0 * 1536 + gc) * TPB + CTX;
  const u16* g1p = hyt + (size_t)(b1 * 1536 + gc) * TPB + CTX;
  const float* cw = p.hy_conv_w + (size_t)l * 3 * 1536;
  const float* cb = p.hy_conv_b + (size_t)l * 1536;
  const float zw0 = cw[c], zw1 = cw[1536 + c], zw2 = cw[3072 + c], zbias = cb[c];
  const float gw0 = cw[gc], gw1 = cw[1536 + gc], gw2 = cw[3072 + gc], gbias = cb[gc];
  const float skip = p.hy_skip[l * 1024 + o * 512 + c];
  const h2_t* spe = (const h2_t*)(p.ws + OFF_SPEC) + (size_t)(o * 512 + c) * 2 * 8192;
  const h2_t* spo = spe + 8192;
  float2* Eg = (float2*)(p.ws + OFF_ESCR + (size_t)blockIdx.x * 65536);
  __syncthreads();
#pragma unroll 2
  for (int i = 0; i < 8; ++i) {
    const int t0 = 4 * (tid + 256 * i);
    float za[4], zb[4];
    if (o == 0) { dwc4(z0p, t0, SEQ, zw0, zw1, zw2, zbias, za); dwc4(z1p, t0, SEQ, zw0, zw1, zw2, zbias, zb); }
    else { ld4(z0p, t0, za); ld4(z1p, t0, zb); }
#pragma unroll
    for (int e = 0; e < 4; ++e) lds[fphys(t0 + e)] = make_float2(za[e], zb[e]);
  }
  __syncthreads();
  fft8192_conv(lds, tid, spe);
#pragma unroll 2
  for (int i = 0; i < 8; ++i) {
    const int t0 = 4 * (tid + 256 * i);
#pragma unroll
    for (int e = 0; e < 4; ++e) Eg[t0 + e] = lds[fphys(t0 + e)];
  }
  __syncthreads();
#pragma unroll 2
  for (int i = 0; i < 8; ++i) {
    const int t0 = 4 * (tid + 256 * i);
    float za[4], zb[4];
    if (o == 0) { dwc4(z0p, t0, SEQ, zw0, zw1, zw2, zbias, za); dwc4(z1p, t0, SEQ, zw0, zw1, zw2, zbias, zb); }
    else { ld4(z0p, t0, za); ld4(z1p, t0, zb); }
#pragma unroll
    for (int e = 0; e < 4; ++e) lds[fphys(t0 + e)] = cmul(make_float2(za[e], zb[e]), twid_rev((float)(t0 + e) * (1.f / 16384.f)));
  }
  __syncthreads();
  fft8192_conv(lds, tid, spo);
#pragma unroll 2
  for (int i = 0; i < 8; ++i) {
    const int t0 = 4 * (tid + 256 * i);
    float za[4], zb[4], ga[4], gb[4];
    if (o == 0) { dwc4(z0p, t0, SEQ, zw0, zw1, zw2, zbias, za); dwc4(z1p, t0, SEQ, zw0, zw1, zw2, zbias, zb); }
    else { ld4(z0p, t0, za); ld4(z1p, t0, zb); }
    dwc4(g0p, t0, SEQ, gw0, gw1, gw2, gbias, ga);
    dwc4(g1p, t0, SEQ, gw0, gw1, gw2, gbias, gb);
#pragma unroll
    for (int e = 0; e < 4; ++e) {
      const int t = t0 + e;
      const float2 ov = cmulc(lds[fphys(t)], twid_rev((float)t * (1.f / 16384.f)));
      const float2 ev = Eg[t];
      const float y0 = (ev.x + ov.x) * (1.f / 16384.f), y1 = (ev.y + ov.y) * (1.f / 16384.f);
      Eg[t] = make_float2(ga[e] * (y0 + za[e] * skip), gb[e] * (y1 + zb[e] * skip));
    }
  }
  __syncthreads();
  u16* d0 = (o == 0) ? z0p : hyt + (size_t)(b0 * 1536 + 512 + c) * TPB + CTX;
  u16* d1 = (o == 0) ? z1p : hyt + (size_t)(b1 * 1536 + 512 + c) * TPB + CTX;
#pragma unroll 2
  for (int i = 0; i < 8; ++i) {
    const int t0 = 4 * (tid + 256 * i);
    float2 e4[4];
#pragma unroll
    for (int e = 0; e < 4; ++e) e4[e] = Eg[t0 + e];
    *(u32x2*)(d0 + t0) = u32x2{pack2(e4[0].x, e4[1].x), pack2(e4[2].x, e4[3].x)};
    *(u32x2*)(d1 + t0) = u32x2{pack2(e4[0].y, e4[1].y), pack2(e4[2].y, e4[3].y)};
  }
}

DI void hctx_item(const Params& p, int l, int c, char* smem) {
  float* lf = (float*)smem;
  float* kern = lf;
  float* zb = lf + 1024;
  float* z1b = lf + 2048;
  float* red = lf + 3072;
  const int tid = opq(threadIdx.x), lane = tid & 63, wave = tid >> 6;
  const float* hid = (const float*)(p.ws + OFF_HID + l * HID_LAYER) + 64 * 8192;
  const float* w3 = p.hy_w3 + (size_t)l * 64 * 2048;
  const u16* hyt = (const u16*)(p.ws + OFF_HYT);
  const float* cw = p.hy_conv_w + (size_t)l * 3 * 1536;
  const float* cb = p.hy_conv_b + (size_t)l * 1536;
  __syncthreads();
  {
    const int t = tid;
    float d[4] = {0.f, 0.f, 0.f, 0.f};
#pragma unroll 4
    for (int j = 0; j < 64; ++j) {
      const float hv = hid[j * 256 + t];
#pragma unroll
      for (int q = 0; q < 4; ++q) d[q] += hv * w3[j * 2048 + (q >> 1) * 1024 + (q & 1) * 512 + c];
    }
    const float dec = __expf(-((float)t * (1.f / 255.f)) * (HY_D0 + (float)c * HY_DSTEP));
#pragma unroll
    for (int o = 0; o < 2; ++o) {
      const float f0 = d[o] * dec, f1 = d[2 + o] * dec;
      kern[o * 512 + t] = f0;
      if (t >= 1) kern[o * 512 + 512 - t] = f1;
      if (t == 0) kern[o * 512 + 256] = 0.f;
      float s = fabsf(f0) + (t >= 1 ? fabsf(f1) : 0.f);
      s = wave_sum(s);
      if (lane == 0) red[o * 4 + wave] = s;
    }
  }
  const int b = tid >> 6, tq = tid & 63;
  const u16* zs = hyt + (size_t)(b * 1536 + c) * TPB;
  const u16* g1s = hyt + (size_t)(b * 1536 + 512 + c) * TPB;
  const u16* g2s = hyt + (size_t)(b * 1536 + 1024 + c) * TPB;
#pragma unroll
  for (int k = 0; k < 4; ++k) {
    const int tt = tq + 64 * k;
    zb[b * 256 + tt] = dwc(zs, tt, CTX, cw[c], cw[1536 + c], cw[3072 + c], cb[c]);
  }
  __syncthreads();
  const float inv0 = 1.f / (red[0] + red[1] + red[2] + red[3]);
  const float inv1 = 1.f / (red[4] + red[5] + red[6] + red[7]);
  const float sk0 = p.hy_skip[l * 1024 + c], sk1 = p.hy_skip[l * 1024 + 512 + c];
#pragma unroll 1
  for (int k = 0; k < 4; ++k) {
    const int tt = tq + 64 * k;
    float acc = 0.f;
#pragma unroll 8
    for (int s = 0; s < 256; ++s) acc += kern[(tt - s) & 511] * zb[b * 256 + s];
    const float g = dwc(g1s, tt, CTX, cw[512 + c], cw[1536 + 512 + c], cw[3072 + 512 + c], cb[512 + c]);
    z1b[b * 256 + tt] = g * (acc * inv0 + zb[b * 256 + tt] * sk0);
  }
  __syncthreads();
  u16* yc = (u16*)(p.ws + OFF_HYT) + (size_t)(b * 1536 + 512 + c) * TPB;
#pragma unroll 1
  for (int k = 0; k < 4; ++k) {
    const int tt = tq + 64 * k;
    float acc = 0.f;
#pragma unroll 8
    for (int s = 0; s < 256; ++s) acc += kern[512 + ((tt - s) & 511)] * z1b[b * 256 + s];
    const float g = dwc(g2s, tt, CTX, cw[1024 + c], cw[1536 + 1024 + c], cw[3072 + 1024 + c], cb[1024 + c]);
    yc[tt] = DBG_ZERO_HCTX ? (u16)0 : f2bf(g * (acc * inv1 + z1b[b * 256 + tt] * sk1));
  }
  __syncthreads();
}

#define XB_XCNT(j) (256 + 64 * (j))
#define XB_XSUB(j) (1280 + 64 * (j))
#define XB_XGEN(j) (2304 + 64 * (j))
#define XB_TOP 3328
#define XB_TOPGEN 3392
DI unsigned xb_ld(unsigned* p) { return __hip_atomic_load(p, __ATOMIC_RELAXED, __HIP_MEMORY_SCOPE_AGENT); }
DI unsigned xb_add(unsigned* p, unsigned v) { return __hip_atomic_fetch_add(p, v, __ATOMIC_RELAXED, __HIP_MEMORY_SCOPE_AGENT); }
struct XBar { unsigned* bar; unsigned x, nloc, nx; };
DI void gsync_impl(cg::grid_group& g, XBar& b) {
#if DBG_CG_SYNC
  g.sync();
#else
  asm volatile("s_waitcnt vmcnt(0)" ::: "memory");
  __syncthreads();
  if (threadIdx.x == 0) {
    unsigned* bar = b.bar;
    __builtin_amdgcn_s_waitcnt(0);
    if (b.nloc == 0u) {
      unsigned sum, cnt, mine;
      for (;;) {
        sum = 0u; cnt = 0u; mine = 0u;
#pragma unroll
        for (unsigned j = 0; j < 16; ++j) { const unsigned c = xb_ld(&bar[XB_XCNT(j)]); sum += c; cnt += (c > 0u) ? 1u : 0u; mine = (j == b.x) ? c : mine; }
        if (sum == gridDim.x) break;
        __builtin_amdgcn_s_sleep(1);
      }
      b.nloc = mine > 0u ? mine : 1u; b.nx = cnt > 0u ? cnt : 1u;
    }
    const unsigned old = xb_add(&bar[XB_XSUB(b.x)], 1u);
    const unsigned gen = old / b.nloc;
    if (old + 1u == (gen + 1u) * b.nloc) {
      __builtin_amdgcn_fence(__ATOMIC_RELEASE, "agent");
      asm volatile("s_waitcnt vmcnt(0)" ::: "memory");
      const unsigned og = xb_add(&bar[XB_TOP], 1u);
      const unsigned tg = og / b.nx;
      if (og + 1u == (tg + 1u) * b.nx) xb_add(&bar[XB_TOPGEN], 1u);
      else { while (xb_ld(&bar[XB_TOPGEN]) == tg) __builtin_amdgcn_s_sleep(1); }
      __builtin_amdgcn_fence(__ATOMIC_ACQUIRE, "agent");
      xb_add(&bar[XB_XGEN(b.x)], 1u);
      asm volatile("s_waitcnt vmcnt(0)" ::: "memory");
    } else {
      while (xb_ld(&bar[XB_XGEN(b.x)]) == gen) __builtin_amdgcn_s_sleep(1);
      __builtin_amdgcn_fence(__ATOMIC_ACQUIRE, "agent");
      asm volatile("s_waitcnt vmcnt(0)" ::: "memory");
    }
  }
  __syncthreads();
#endif
}

#define gsync(G, E) gsync_impl(G, E)
DI int tile_map(int L, int MT, int NT) {
  const int per = 8 * NT;
  const int P = L / per, u = L - P * per;
  const int h = min(8, MT - P * 8);
  const int nt = u / h, mt = P * 8 + (u - nt * h);
  return mt * NT + nt;
}
__global__ void __launch_bounds__(256, 2) fwd_mega(Params p) {
  cg::grid_group grid = cg::this_grid();
  __shared__ __attribute__((aligned(16))) char smem[65536];
  const int nb = gridDim.x, bid = blockIdx.x;
  const int pb = ((nb & 7) == 0) ? (bid & 7) * (nb >> 3) + (bid >> 3) : bid;
  float* xctx = (float*)(p.ws + OFF_XCTX);
  u16* RH = (u16*)(p.ws + OFF_RH);
  u16* HP = (u16*)(p.ws + OFF_HP);
  XBar epoch;
  epoch.bar = (unsigned*)(p.ws + OFF_BAR);
  epoch.x = (unsigned)__builtin_amdgcn_s_getreg((3 << 11) | 20) & 0xFu;
  epoch.nloc = 0u; epoch.nx = 0u;
  if (threadIdx.x == 0) (void)xb_add(&epoch.bar[XB_XCNT(epoch.x)], 1u);
  {
    constexpr int NC0 = 2336;
    const int total = NC0 + 192 + 1536 + 528;
    for (int it = bid; it < total; it += nb) {
      if (it < NC0) conv_tile(p, 0, it, smem);
      else if (it < NC0 + 192) mod_item(p, it - NC0, smem);
      else if (it < NC0 + 192 + 1536) rope_item(p, it - NC0 - 192);
      else hid_item(p, it - NC0 - 192 - 1536, smem);
    }
  }
  if (p.ws == nullptr) grid.sync();
  gsync(grid, epoch);
  row_pass(p, 0, p.x, p.ctx, nullptr, nullptr, nullptr, nullptr, 0, 0, false, p.norm_g, 0, 0, 1024, RH, false);
  gsync(grid, epoch);
#pragma unroll 1
  for (int l = 0; l < 2; ++l) {
    const float* xl = (l == 0) ? p.x : p.out;
    const float* xc = (l == 0) ? p.ctx : xctx;
    for (int rep = 0; rep < DBG_REP_FFT; ++rep)
    for (int it = pb; it < 1024; it += nb) filt_item(p, l, it, smem);
    gsync(grid, epoch);
    for (int rep = 0; rep < DBG_REP_GEMM; ++rep)
    for (int it = pb; it < 4752; it += nb) inproj_tile(p, tile_map(it, 176, 27), smem);
    gsync(grid, epoch);
#if DBG_DUMP == 5
    { const _Float16* sp = (const _Float16*)(p.ws + OFF_SPEC);
      for (size_t i = (size_t)bid * 256 + threadIdx.x; i < (size_t)NBATCH * SEQ * DM; i += (size_t)nb * 256) p.out[i] = (float)sp[i];
      return; }
#endif
    {
      const int nSW = 2048 + (l == 0 ? 64 : 0);
      for (int rep = 0; rep < DBG_REP_GEMM; ++rep)
      for (int it = pb; it < 1408 + nSW; it += nb) {
        if (it < 1408) kvup_tile(p, tile_map(it, 176, 8), smem);
        else if (it < 1408 + 2048) {
          const int i1 = it - 1408, n = i1 & 63, jlo = (n == 0) ? 2 : 0, jhi = (n == 63) ? 4 : 6;
          attn_item<64, true>(p, l, i1 >> 9, (i1 >> 6) & 7, CTX + n * 128, 4, jhi - jlo, (n - 1) * 128 + 64 * jlo, smem);
        } else { const int i2 = it - 1408 - 2048; attn_item<64, true>(p, l, i2 >> 4, (i2 >> 1) & 7, (i2 & 1) * 128, 4, 0, 0, smem); }
      }
    }
    gsync(grid, epoch);
    {
      const int nF = 2048 + (l == 0 ? 64 : 0);
      for (int rep = 0; rep < DBG_REP_MLA; ++rep)
      for (int it = pb; it < nF; it += nb) {
        if (it < 2048) attn_item<96, false>(p, l, it >> 9, (it >> 6) & 7, CTX + (it & 63) * 128, 132, 0, 0, smem);
        else { const int i2 = it - 2048; attn_item<96, false>(p, l, i2 >> 4, (i2 >> 1) & 7, (i2 & 1) * 128, 4, 0, 0, smem); }
      }
    }
    gsync(grid, epoch);
    {
      const int nF2 = 1024 + (l == 0 ? 512 : 0);
      for (int it = pb; it < nF2; it += nb) {
        if (it < 1024) hconv_item(p, l, 0, it >> 1, it & 1, smem);
        else hctx_item(p, l, it - 1024, smem);
      }
    }
    gsync(grid, epoch);
    for (int rep = 0; rep < DBG_REP_FFT; ++rep)
    for (int it = pb; it < 1024; it += nb) hconv_item(p, l, 1, it >> 1, it & 1, smem);
    gsync(grid, epoch);
    for (int rep = 0; rep < DBG_REP_GEMM; ++rep)
    for (int it = pb; it < 1408; it += nb) merge_tile(p, tile_map(it, 176, 8), smem);
    if (l == 0 && pb >= 384 && nb > 384) for (int ct = 2336 + (pb - 384); ct < NCONV_TILES; ct += nb - 384) conv_tile(p, 0, ct, smem);
    gsync(grid, epoch);
    for (int rep = 0; rep < DBG_REP_GEMM * DBG_REP_PLAIN; ++rep)
    for (int it = pb; it < 1408; it += nb) plain_tile(p, tile_map(it, 176, 8), (const u16*)(p.ws + OFF_MERGED), 1024, 16, (const u16*)(p.ws + OFF_WT_OUT), (u16*)(p.ws + OFF_Y), smem);
    gsync(grid, epoch);
    row_pass(p, 1, xl, xc, p.out, xctx, (const u16*)(p.ws + OFF_Y), p.norm_g + (size_t)(l * 4 + 1) * 1024, 2048, l, true, p.norm_g + (size_t)(l * 4 + 2) * 1024, l, 3072, 4096, RH, false);
    gsync(grid, epoch);
    for (int rep = 0; rep < DBG_REP_GEMM; ++rep)
    for (int it = pb; it < 184 * 44; it += nb) ffnup_tile(p, l, tile_map(it, 184, 44), smem);
    gsync(grid, epoch);
    for (int rep = 0; rep < DBG_REP_GEMM * DBG_REP_PLAIN; ++rep)
    for (int it = pb; it < 1408; it += nb) plain_tile(p, tile_map(it, 176, 8), (const u16*)(p.ws + OFF_A), 2816, 44, (const u16*)(p.ws + OFF_WT_DOWN), HP, smem);
    if (l == 0 && pb >= 384 && nb > 384) for (int ct = pb - 384; ct < 1632; ct += nb - 384) conv_tile(p, 1, ct, smem);
    gsync(grid, epoch);
    row_pass(p, 1, p.out, xctx, p.out, xctx, HP, p.norm_g + (size_t)(l * 4 + 3) * 1024, 5120, l, l == 0, p.norm_g + (size_t)((l + 1) * 4) * 1024, l + 1, 0, 1024, RH, l == 1);
    if (l == 0) {
      for (int it = bid; it < NCONV_TILES - 1632; it += nb) conv_tile(p, 1, 1632 + it, smem);
      gsync(grid, epoch);
    }
  }
  for (int rep = 0; rep < DBG_EXTRA_SYNCS; ++rep) gsync(grid, epoch);
#if DBG_DUMP == 1
  gsync(grid, epoch);
  { const _Float16* sp = (const _Float16*)(p.ws + OFF_SPEC);
    for (size_t i = (size_t)bid * 256 + threadIdx.x; i < (size_t)NBATCH * SEQ * DM; i += (size_t)nb * 256) p.out[i] = (float)sp[i]; }
#elif DBG_DUMP == 3
  gsync(grid, epoch);
  { const float* hd = (const float*)(p.ws + OFF_HID);
    for (size_t i = (size_t)bid * 256 + threadIdx.x; i < (size_t)NBATCH * SEQ * DM; i += (size_t)nb * 256) p.out[i] = i < (size_t)2 * 64 * 8448 ? hd[i] : 0.f; }
#elif DBG_DUMP == 2
  gsync(grid, epoch);
  { const u16* yc = (const u16*)(p.ws + OFF_YCT);
    for (size_t i = (size_t)bid * 256 + threadIdx.x; i < (size_t)NBATCH * SEQ * DM; i += (size_t)nb * 256) p.out[i] = i < (size_t)4 * 512 * TPB ? bf2f(yc[i]) : 0.f; }
#endif
}

extern "C" void kernel_launch(void* const* d_in, const int* in_sizes, int n_in, void* d_out, int out_size, void* d_ws, size_t ws_size,
                              hipStream_t stream) {
  static int grid_blocks = 0;
  if (!grid_blocks) {
    int dev = 0, cus = 0, per_cu = 0;
    (void)hipGetDevice(&dev);
    (void)hipDeviceGetAttribute(&cus, hipDeviceAttributeMultiprocessorCount, dev);
    (void)hipOccupancyMaxActiveBlocksPerMultiprocessor(&per_cu, fwd_mega, 256, 0);
    if (per_cu > 2) per_cu = 2;
    if (per_cu < 1) per_cu = 1;
    grid_blocks = cus * per_cu;
  }
  if (ws_size < WS_NEED) { fprintf(stderr, "workspace too small: %zu < %zu\n", ws_size, (size_t)WS_NEED); return; }
  Params p{};
  const float** pp = (const float**)&p;
  for (int i = 0; i < 26; ++i) pp[i] = (const float*)d_in[i];
  p.out = (float*)d_out;
  p.ws = (char*)d_ws;
  (void)hipMemsetAsync((char*)d_ws + OFF_BAR, 0, BAR_BYTES, stream);
  void* args[] = {&p};
  hipError_t e = hipLaunchCooperativeKernel((void*)fwd_mega, dim3(grid_blocks), dim3(256), args, 0, stream);
  if (e != hipSuccess) fprintf(stderr, "cooperative launch failed: %s (grid %d)\n", hipGetErrorString(e), grid_blocks);
}
```

```cpp
#include <hip/hip_runtime.h>
#include <hip/hip_cooperative_groups.h>
#include <cstdio>
namespace cg = cooperative_groups;
#define DI __device__ __forceinline__
typedef unsigned short u16;
typedef __attribute__((ext_vector_type(8))) short bf16x8;
typedef __attribute__((ext_vector_type(4))) short s16x4;
typedef __attribute__((ext_vector_type(16))) float f32x16;
typedef __attribute__((ext_vector_type(4))) unsigned u32x4;
typedef __attribute__((ext_vector_type(2))) unsigned u32x2;
typedef __attribute__((ext_vector_type(2))) __bf16 bf2_t;
typedef __attribute__((ext_vector_type(2))) float f2_t;
typedef __attribute__((ext_vector_type(2))) _Float16 h2_t;
#define MFMA(a, b, c) __builtin_amdgcn_mfma_f32_32x32x16_bf16((a), (b), (c), 0, 0, 0)

constexpr int DM = 1024, NBATCH = 4, SEQ = 8192, CTX = 256, TPB = 8448, MTOK = 33792;
constexpr int DFF = 2816;
#ifndef DBG_ZERO_HCTX
#define DBG_ZERO_HCTX 0
#endif
#ifndef DBG_DUMP
#define DBG_DUMP 0
#endif
#ifndef DBG_NOFFT
#define DBG_NOFFT 0
#endif
#ifndef DBG_SPLITC
#define DBG_SPLITC 0
#endif
#ifndef DBG_REP_GEMM
#define DBG_REP_GEMM 1
#endif
#ifndef DBG_REP_MLA
#define DBG_REP_MLA 1
#endif
#ifndef DBG_HEAVY_SYNC
#define DBG_HEAVY_SYNC 0
#endif
#ifndef DBG_REP_FFT
#define DBG_REP_FFT 1
#endif
#ifndef DBG_REP_PLAIN
#define DBG_REP_PLAIN 1
#endif
#ifndef DBG_EXTRA_SYNCS
#define DBG_EXTRA_SYNCS 0
#endif
#ifndef DBG_CG_SYNC
#define DBG_CG_SYNC 0
#endif
#ifndef DBG_SKIP_BR
#define DBG_SKIP_BR 0
#endif
#define DBG_FIRST_BR ((DBG_SKIP_BR & 1) ? ((DBG_SKIP_BR & 2) ? 2 : 1) : 0)
constexpr float LOG2E = 1.4426950408889634f;
constexpr float EPS = 1e-6f;

struct Params {
  const float *x, *c, *ctx, *c_ctx, *w_mod, *b_mod, *norm_g, *w_in, *kv_norm_g, *w_kv_up, *swa_sink, *hy_conv_w, *hy_conv_b,
      *hy_w1, *hy_b1, *hy_w2, *hy_b2, *hy_freq, *hy_w3, *hy_skip, *w_branch, *w_out, *w_up, *ffn_conv_w, *ffn_conv_b, *w_down;
  float* out;
  char* ws;
};

constexpr size_t OFF_WT_IN = 0;
constexpr size_t OFF_WT_GATE = OFF_WT_IN + (size_t)3456 * 1024 * 2;
constexpr size_t OFF_WT_KV = OFF_WT_GATE + (size_t)3072 * 1024 * 2;
constexpr size_t OFF_WT_BR = OFF_WT_KV + (size_t)1024 * 256 * 2;
constexpr size_t OFF_WT_OUT = OFF_WT_BR + (size_t)3 * 1024 * 512 * 2;
constexpr size_t OFF_WT_UP = OFF_WT_OUT + (size_t)1024 * 1024 * 2;
constexpr size_t OFF_WT_DOWN = OFF_WT_UP + (size_t)5632 * 1024 * 2;
constexpr size_t OFF_RH = OFF_WT_DOWN + (size_t)1024 * 2816 * 2;
constexpr size_t OFF_KN = OFF_RH + (size_t)MTOK * 1024 * 2;
constexpr size_t OFF_VT = OFF_KN + (size_t)MTOK * 512 * 2;
constexpr size_t OFF_KR = OFF_VT + (size_t)MTOK * 512 * 2;
constexpr size_t OFF_Q = OFF_KR + (size_t)MTOK * 32 * 2;
constexpr size_t OFF_SQ = OFF_Q + (size_t)MTOK * 768 * 2;
constexpr size_t OFF_CKV = OFF_SQ + (size_t)MTOK * 512 * 2;
constexpr size_t OFF_SK = OFF_CKV + (size_t)MTOK * 256 * 2;
constexpr size_t OFF_SVT = OFF_SK + (size_t)MTOK * 128 * 2;
constexpr size_t OFF_HYT = OFF_SVT + (size_t)MTOK * 128 * 2;
constexpr size_t OFF_SPEC = OFF_HYT + (size_t)MTOK * 1536 * 2;
constexpr size_t OFF_XCTX = OFF_SPEC + (size_t)1024 * 2 * 8192 * 4;
constexpr size_t OFF_MOD = OFF_XCTX + (size_t)1024 * 1024 * 4;
constexpr size_t OFF_ROPE = OFF_MOD + (size_t)2 * 5 * 6144 * 4;
constexpr size_t OFF_HID = OFF_ROPE + (size_t)8192 * 96 * 4;
constexpr size_t HID_LAYER = (size_t)64 * (8192 + 256) * 4;
constexpr size_t OFF_ESCR = OFF_HID + 2 * HID_LAYER;
constexpr size_t OFF_BAR = OFF_ESCR + (size_t)512 * 65536;
constexpr size_t BAR_BYTES = 3456 * 4;
constexpr size_t WS_NEED = OFF_BAR + BAR_BYTES;
constexpr size_t OFF_A = OFF_Q;
constexpr size_t OFF_MERGED = OFF_KN;
constexpr size_t OFF_Y = OFF_HYT;
constexpr size_t OFF_HP = OFF_KN;
constexpr size_t OFF_YCT = OFF_RH;
constexpr size_t OFF_YA = OFF_RH + (size_t)MTOK * 512 * 2;
static_assert(OFF_A + (size_t)MTOK * 2816 * 2 <= OFF_SPEC, "A overlay");
static_assert(WS_NEED <= (size_t)512 * 1024 * 1024, "ws");

DI int opq(int x) { asm volatile("" : "+v"(x)); return x; }
DI float ldsc1(const float* p) { return __hip_atomic_load(p, __ATOMIC_RELAXED, __HIP_MEMORY_SCOPE_AGENT); }
DI float bf2f(u16 v) { return __uint_as_float(((unsigned)v) << 16); }
DI unsigned pack2(float a, float b) { f2_t v = {a, b}; return __builtin_bit_cast(unsigned, __builtin_convertvector(v, bf2_t)); }
DI u16 f2bf(float a) { return (u16)(pack2(a, 0.f) & 0xffffu); }
DI float lo_bf(unsigned u) { return __uint_as_float(u << 16); }
DI float hi_bf(unsigned u) { return __uint_as_float(u & 0xffff0000u); }
DI int crow(int i, int h) { return (i & 3) + 8 * (i >> 2) + 4 * h; }
DI float wave_sum(float v) {
#pragma unroll
  for (int o = 32; o > 0; o >>= 1) v += __shfl_xor(v, o);
  return v;
}
DI float sinrev(float r) { return __builtin_amdgcn_sinf(r - floorf(r)); }
DI float cosrev(float r) { return __builtin_amdgcn_cosf(r - floorf(r)); }
#if DBG_TRIVTW
#define COSREV(f) (1.0f)
#define SINREV(f) (0.0f * (f))
#else
#define COSREV(f) cosrev(f)
#define SINREV(f) sinrev(f)
#endif
#define SYNC() __syncthreads()
DI float2 cmul(float2 a, float2 b) { return make_float2(a.x * b.x - a.y * b.y, a.x * b.y + a.y * b.x); }
DI float2 cmulc(float2 a, float2 b) { return make_float2(a.x * b.x + a.y * b.y, a.y * b.x - a.x * b.y); }
#ifndef DBG_NOSWZ
#define DBG_NOSWZ 0
#endif
DI int fphys(int i) { return DBG_NOSWZ ? i : (i ^ ((i >> 4) & 15)); }
DI float2 twid_rev(float fr) { return make_float2(COSREV(fr), -SINREV(fr)); }

DI float2 root16(int e) {
  const float C1 = 0.92387953251128674f, S1 = 0.38268343236508977f, R = 0.70710678118654752f;
  switch (e) {
    case 0: return make_float2(1.f, 0.f);
    case 1: return make_float2(C1, -S1);
    case 2: return make_float2(R, -R);
    case 3: return make_float2(S1, -C1);
    case 4: return make_float2(0.f, -1.f);
    case 5: return make_float2(-S1, -C1);
    case 6: return make_float2(-R, -R);
    default: return make_float2(-C1, -S1);
  }
}
template <int R, int HALF, int S, bool INV, bool HASW>
DI void fft_stage(float2 (&v)[R], const float2 (&wp)[4]) {
#pragma unroll
  for (int idx = 0; idx < R / 2; ++idx) {
    const int blk = idx / HALF, jj = idx % HALF;
    const int j0 = blk * 2 * HALF + jj, j1 = j0 + HALF;
    const int e = jj * (8 / HALF);
    float2 tw = root16(e);
    if (HASW) { if (e == 0) tw = wp[S]; else tw = cmul(wp[S], tw); }
    const bool triv = (!HASW) && (e == 0);
    if (!INV) {
      float2 a = v[j0], b = v[j1];
      v[j0] = make_float2(a.x + b.x, a.y + b.y);
      float2 d = make_float2(a.x - b.x, a.y - b.y);
      v[j1] = triv ? d : cmul(d, tw);
    } else {
      float2 t = triv ? v[j1] : cmulc(v[j1], tw);
      float2 a = v[j0];
      v[j0] = make_float2(a.x + t.x, a.y + t.y);
      v[j1] = make_float2(a.x - t.x, a.y - t.y);
    }
  }
}
template <bool INV> DI void fft_local8(float2 (&v)[8], const float2 (&wp)[4]) {
  if (!INV) { fft_stage<8, 4, 0, false, true>(v, wp); fft_stage<8, 2, 1, false, true>(v, wp); fft_stage<8, 1, 2, false, true>(v, wp); }
  else      { fft_stage<8, 1, 2, true, true>(v, wp); fft_stage<8, 2, 1, true, true>(v, wp); fft_stage<8, 4, 0, true, true>(v, wp); }
}
template <bool INV> DI void fft_local16(float2 (&v)[16], const float2 (&wp)[4]) {
  if (!INV) { fft_stage<16, 8, 0, false, false>(v, wp); fft_stage<16, 4, 1, false, false>(v, wp); fft_stage<16, 2, 2, false, false>(v, wp); fft_stage<16, 1, 3, false, false>(v, wp); }
  else      { fft_stage<16, 1, 3, true, false>(v, wp); fft_stage<16, 2, 2, true, false>(v, wp); fft_stage<16, 4, 1, true, false>(v, wp); fft_stage<16, 8, 0, true, false>(v, wp); }
}

template <int LQ, bool INV> DI void fft_pass8(float2* lds, int tid) {
  constexpr int q = 1 << LQ;
#pragma unroll 1
  for (int it = 0; it < 4; ++it) {
    const int task = tid + 256 * it;
    const int p = task & (q - 1);
    const int g = task >> LQ;
    const int base = g * 8 * q + p;
    float2 v[8];
#pragma unroll
    for (int j = 0; j < 8; ++j) v[j] = lds[fphys(base + j * q)];
    float2 wp[4];
    wp[0] = twid_rev((float)p * (1.0f / (float)(8 * q)));
    wp[1] = cmul(wp[0], wp[0]);
    wp[2] = cmul(wp[1], wp[1]);
    wp[3] = wp[2];
    fft_local8<INV>(v, wp);
#pragma unroll
    for (int j = 0; j < 8; ++j) lds[fphys(base + j * q)] = v[j];
  }
}
template <bool INV> DI void fft_pass16(float2* lds, int tid) {
#pragma unroll 1
  for (int it = 0; it < 2; ++it) {
    const int g = tid + 256 * it;
    float2 v[16];
    const int sw = DBG_NOSWZ ? 0 : (g & 15);
#pragma unroll
    for (int j = 0; j < 16; ++j) v[j] = lds[g * 16 + (j ^ sw)];
    float2 wp[4] = {make_float2(1.f, 0.f), make_float2(1.f, 0.f), make_float2(1.f, 0.f), make_float2(1.f, 0.f)};
    fft_local16<INV>(v, wp);
#pragma unroll
    for (int j = 0; j < 16; ++j) lds[g * 16 + (j ^ sw)] = v[j];
  }
}
#ifndef DBG_FFTPASSES
#define DBG_FFTPASSES 15
#endif
DI void fft8192_fwd(float2* lds, int tid) {
  if (DBG_FFTPASSES & 1) { fft_pass8<10, false>(lds, tid); SYNC(); }
  if (DBG_FFTPASSES & 2) { fft_pass8<7, false>(lds, tid); SYNC(); }
  if (DBG_FFTPASSES & 4) { fft_pass8<4, false>(lds, tid); SYNC(); }
  if (DBG_FFTPASSES & 8) { fft_pass16<false>(lds, tid); SYNC(); }
}
DI void fft8192_inv(float2* lds, int tid) {
  fft_pass16<true>(lds, tid); SYNC();
  fft_pass8<4, true>(lds, tid); SYNC();
  fft_pass8<7, true>(lds, tid); SYNC();
  fft_pass8<10, true>(lds, tid); SYNC();
}

DI void fft_mid16(float2* lds, int tid, const h2_t* H) {
#pragma unroll 1
  for (int it = 0; it < 2; ++it) {
    const int g = tid + 256 * it;
    float2 v[16];
    const int sw = g & 15;
#pragma unroll
    for (int j = 0; j < 16; ++j) v[j] = lds[g * 16 + (j ^ sw)];
    const float2 wp[4] = {make_float2(1.f, 0.f), make_float2(1.f, 0.f), make_float2(1.f, 0.f), make_float2(1.f, 0.f)};
    fft_local16<false>(v, wp);
    const h2_t* hp = H + g * 16;
#pragma unroll
    for (int j = 0; j < 16; ++j) { const h2_t hv = hp[j]; v[j] = cmul(v[j], make_float2((float)hv[0], (float)hv[1])); }
    fft_local16<true>(v, wp);
#pragma unroll
    for (int j = 0; j < 16; ++j) lds[g * 16 + (j ^ sw)] = v[j];
  }
}
DI void fft_last16_store(const float2* lds, int tid, h2_t* H) {
#pragma unroll 1
  for (int it = 0; it < 2; ++it) {
    const int g = tid + 256 * it;
    float2 v[16];
    const int sw = g & 15;
#pragma unroll
    for (int j = 0; j < 16; ++j) v[j] = lds[g * 16 + (j ^ sw)];
    const float2 wp[4] = {make_float2(1.f, 0.f), make_float2(1.f, 0.f), make_float2(1.f, 0.f), make_float2(1.f, 0.f)};
    fft_local16<false>(v, wp);
    h2_t* hp = H + g * 16;
#pragma unroll
    for (int j = 0; j < 16; ++j) { h2_t hv = {(_Float16)v[j].x, (_Float16)v[j].y}; hp[j] = hv; }
  }
}
DI void fft8192_conv(float2* lds, int tid, const h2_t* H) {
  fft_pass8<10, false>(lds, tid); SYNC();
  fft_pass8<7, false>(lds, tid); SYNC();
  fft_pass8<4, false>(lds, tid); SYNC();
  fft_mid16(lds, tid, H); SYNC();
  fft_pass8<4, true>(lds, tid); SYNC();
  fft_pass8<7, true>(lds, tid); SYNC();
  fft_pass8<10, true>(lds, tid); SYNC();
}
DI void fft8192_spectrum(float2* lds, int tid, h2_t* H) {
  fft_pass8<10, false>(lds, tid); SYNC();
  fft_pass8<7, false>(lds, tid); SYNC();
  fft_pass8<4, false>(lds, tid); SYNC();
  fft_last16_store(lds, tid, H); SYNC();
}

template <bool SWAP, bool ATR = false, int MTW = 2>
DI void gemm_main(const u16* __restrict__ A, int lda, int a_row0, int a_lo, int a_hi, int a_kstep,
                  const u16* __restrict__ B, int ldb, int nk, f32x16 (&acc)[MTW][2], char* smem) {
  constexpr int ROWS = MTW * 64, NA = MTW * 2;
  const int tid = opq(threadIdx.x), lane = tid & 63, wave = tid >> 6, wm = wave >> 1, wn = wave & 1, r = lane & 31, h = lane >> 5;
  char* sA = smem;
  char* sB = smem + ROWS * 144;
  const u16* ap[NA];
  const u16* bp[4];
  int loa[NA], lob[4];
#pragma unroll
  for (int i = 0; i < NA; ++i) {
    const int idx = tid + 256 * i, row = idx >> 3, ch = idx & 7;
    if (ATR) {
      ap[i] = A + (size_t)(idx & 63) * lda + a_row0 + (idx >> 6) * 8;
    } else {
      const int gr = min(max(a_row0 + row, a_lo), a_hi);
      ap[i] = A + (size_t)gr * lda + ch * 8;
    }
    loa[i] = row * 144 + ch * 16;
  }
#pragma unroll
  for (int i = 0; i < 4; ++i) {
    const int idx = tid + 256 * i, row = idx >> 3, ch = idx & 7;
    bp[i] = B + (size_t)row * ldb + ch * 8;
    lob[i] = row * 144 + ch * 16;
  }
  u32x4 ra0[NA], rb0[4];
#define GEMM_LOAD(RA, RB, KT)                                                                                         \
  _Pragma("unroll") for (int i = 0; i < NA; ++i)                                                                      \
    RA[i] = *(const u32x4*)(ap[i] + (ATR ? (size_t)(KT) * 64 * lda : (size_t)(KT) * a_kstep));                        \
  _Pragma("unroll") for (int i = 0; i < 4; ++i) RB[i] = *(const u32x4*)(bp[i] + (KT) * 64);
#define GEMM_STASH(RA, RB)                                                                                            \
  _Pragma("unroll") for (int i = 0; i < NA; ++i) {                                                                    \
    if (ATR) {                                                                                                        \
      const int idx = tid + 256 * i, krow = idx & 63, mch = idx >> 6;                                                 \
      _Pragma("unroll") for (int e = 0; e < 4; ++e) {                                                                 \
        *(u16*)(sA + (mch * 8 + 2 * e) * 144 + krow * 2) = (u16)(RA[i][e] & 0xffffu);                                 \
        *(u16*)(sA + (mch * 8 + 2 * e + 1) * 144 + krow * 2) = (u16)(RA[i][e] >> 16);                                 \
      }                                                                                                               \
    } else {                                                                                                          \
      *(u32x4*)(sA + loa[i]) = RA[i];                                                                                 \
    }                                                                                                                 \
  }                                                                                                                   \
  _Pragma("unroll") for (int i = 0; i < 4; ++i) *(u32x4*)(sB + lob[i]) = RB[i];
#define GEMM_COMPUTE()                                                                                                \
  __builtin_amdgcn_s_setprio(1);                                                                                      \
  _Pragma("unroll") for (int ks = 0; ks < 4; ++ks) {                                                                  \
    bf16x8 af[MTW], bfr[2];                                                                                           \
    _Pragma("unroll") for (int t = 0; t < MTW; ++t) af[t] = *(const bf16x8*)(pa + t * 32 * 144 + ks * 32);            \
    _Pragma("unroll") for (int t = 0; t < 2; ++t) bfr[t] = *(const bf16x8*)(pb + t * 32 * 144 + ks * 32);             \
    _Pragma("unroll") for (int mt = 0; mt < MTW; ++mt)                                                                \
      _Pragma("unroll") for (int nt = 0; nt < 2; ++nt)                                                                \
        acc[mt][nt] = SWAP ? MFMA(bfr[nt], af[mt], acc[mt][nt]) : MFMA(af[mt], bfr[nt], acc[mt][nt]);                 \
  }                                                                                                                   \
  __builtin_amdgcn_s_setprio(0);
  GEMM_LOAD(ra0, rb0, 0)
#pragma unroll
  for (int mt = 0; mt < MTW; ++mt)
#pragma unroll
    for (int nt = 0; nt < 2; ++nt)
#pragma unroll
      for (int i = 0; i < 16; ++i) acc[mt][nt][i] = 0.f;
  const char* pa = sA + (wm * (MTW * 32) + r) * 144 + h * 16;
  const char* pb = sB + (wn * 64 + r) * 144 + h * 16;
#pragma unroll 1
  for (int kk = 0; kk < nk; ++kk) {
    __syncthreads();
    GEMM_STASH(ra0, rb0)
    __syncthreads();
    if (kk + 1 < nk) { GEMM_LOAD(ra0, rb0, kk + 1) }
    GEMM_COMPUTE()
  }
#undef GEMM_LOAD
#undef GEMM_STASH
#undef GEMM_COMPUTE
}
template <int MTW>
DI void store_rowmajor(const f32x16 (&acc)[MTW][2], u16* C, int ldc, int m0, int ncol0, float scale) {
  const int tid = opq(threadIdx.x), lane = tid & 63, wave = tid >> 6, wm = wave >> 1, wn = wave & 1, r = lane & 31, h = lane >> 5;
#pragma unroll
  for (int mt = 0; mt < MTW; ++mt)
#pragma unroll
    for (int nt = 0; nt < 2; ++nt)
#pragma unroll
      for (int g = 0; g < 4; ++g) {
        const int m = m0 + wm * (MTW * 32) + mt * 32 + r, n = ncol0 + wn * 64 + nt * 32 + 8 * g + 4 * h;
        u32x2 pk;
        pk.x = pack2(acc[mt][nt][4 * g] * scale, acc[mt][nt][4 * g + 1] * scale);
        pk.y = pack2(acc[mt][nt][4 * g + 2] * scale, acc[mt][nt][4 * g + 3] * scale);
        *(u32x2*)(C + (size_t)m * ldc + n) = pk;
      }
}
template <int MTW>
DI void store_transposed(const f32x16 (&acc)[MTW][2], u16* T, int ldt, int trow0, int j0) {
  const int tid = opq(threadIdx.x), lane = tid & 63, wave = tid >> 6, wm = wave >> 1, wn = wave & 1, r = lane & 31, h = lane >> 5;
#pragma unroll
  for (int mt = 0; mt < MTW; ++mt)
#pragma unroll
    for (int nt = 0; nt < 2; ++nt)
#pragma unroll
      for (int g = 0; g < 4; ++g) {
        const int n = trow0 + wn * 64 + nt * 32 + r, m = j0 + wm * (MTW * 32) + mt * 32 + 8 * g + 4 * h;
        u32x2 pk;
        pk.x = pack2(acc[mt][nt][4 * g], acc[mt][nt][4 * g + 1]);
        pk.y = pack2(acc[mt][nt][4 * g + 2], acc[mt][nt][4 * g + 3]);
        *(u32x2*)(T + (size_t)n * ldt + m) = pk;
      }
}

constexpr int NCONV_TILES = 864 + 768 + 64 + 384 + 256 + 1408 + 704;
DI void conv_tile(const Params& p, int l, int tile, char* smem) {
  float* t = (float*)smem;
  const int tid = opq(threadIdx.x);
  int mat, tn, tk;
  if (tile < 864) { mat = 0; tn = tile / 16; tk = tile % 16; }
  else if (tile < 1632) { tile -= 864; mat = 1; tn = tile / 16; tk = tile % 16; }
  else if (tile < 1696) { tile -= 1632; mat = 2; tn = tile / 4; tk = tile % 4; }
  else if (tile < 2080) { tile -= 1696; mat = 3; tn = tile / 8; tk = tile % 8; }
  else if (tile < 2336) { tile -= 2080; mat = 4; tn = tile / 16; tk = tile % 16; }
  else if (tile < 3744) { tile -= 2336; mat = 5; tn = tile / 16; tk = tile % 16; }
  else { tile -= 3744; mat = 6; tn = tile / 44; tk = tile % 44; }
  const int k0 = tk * 64;
  const int nn = tid & 63;
  int np = tn * 64 + nn;
  const float* src; int ld; int col;
  if (mat == 0) { src = p.w_in + (size_t)l * 1024 * 6432; ld = 6432; col = np < 1024 ? np : (np < 3328 ? np + 32 : (np < 3360 ? np - 3328 + 1024 : -1)); }
  else if (mat == 1) { src = p.w_in + (size_t)l * 1024 * 6432; ld = 6432; col = 3360 + np; }
  else if (mat == 2) { src = p.w_kv_up + (size_t)l * 256 * 1024; ld = 1024; col = np < 512 ? (np >> 6) * 128 + (np & 63) : ((np - 512) >> 6) * 128 + 64 + (np & 63); }
  else if (mat == 3) { const int br = tn / 16; np = (tn % 16) * 64 + nn; src = p.w_branch + (size_t)(l * 3 + br) * 512 * 1024; ld = 1024; col = np; }
  else if (mat == 4) { src = p.w_out + (size_t)l * 1024 * 1024; ld = 1024; col = np; }
  else if (mat == 5) { src = p.w_up + (size_t)l * 1024 * 5632; ld = 5632; const int blk = np >> 7, rr = np & 127; col = rr < 64 ? blk * 64 + rr : 2816 + blk * 64 + rr - 64; }
  else { src = p.w_down + (size_t)l * 2816 * 1024; ld = 1024; col = np; }
#pragma unroll 4
  for (int i = 0; i < 16; ++i) {
    const int kk = (tid >> 6) + 4 * i;
    float v = 0.f;
    if (col >= 0) v = src[(size_t)(k0 + kk) * ld + col];
    if (mat == 2) v *= p.kv_norm_g[l * 256 + k0 + kk];
    t[kk * 65 + nn] = v;
  }
  __syncthreads();
  {
    const int n2 = tid >> 2, kq = (tid & 3) * 16;
    const int drow = tn * 64 + n2;
    u16* dst;
    if (mat == 0) dst = (u16*)(p.ws + OFF_WT_IN) + (size_t)drow * 1024;
    else if (mat == 1) dst = (u16*)(p.ws + OFF_WT_GATE) + (size_t)drow * 1024;
    else if (mat == 2) dst = (u16*)(p.ws + OFF_WT_KV) + (size_t)drow * 256;
    else if (mat == 3) dst = (u16*)(p.ws + OFF_WT_BR) + (size_t)drow * 512;
    else if (mat == 4) dst = (u16*)(p.ws + OFF_WT_OUT) + (size_t)drow * 1024;
    else if (mat == 5) dst = (u16*)(p.ws + OFF_WT_UP) + (size_t)drow * 1024;
    else dst = (u16*)(p.ws + OFF_WT_DOWN) + (size_t)drow * 2816;
    unsigned pk[8];
#pragma unroll
    for (int j = 0; j < 8; ++j) pk[j] = pack2(t[(kq + 2 * j) * 65 + n2], t[(kq + 2 * j + 1) * 65 + n2]);
    u32x4* d4 = (u32x4*)(dst + k0 + kq);
    d4[0] = u32x4{pk[0], pk[1], pk[2], pk[3]};
    d4[1] = u32x4{pk[4], pk[5], pk[6], pk[7]};
  }
  __syncthreads();
}

DI void mod_item(const Params& p, int item, char* smem) {
  float* sv = (float*)smem;
  float* red = sv + 5 * 1024;
  const int tid = opq(threadIdx.x);
  const int l = item / 96, cg0 = (item % 96) * 64;
  for (int i = tid; i < 5 * 1024; i += 256) {
    const int v = i >> 10, k = i & 1023;
    const float c = v < 4 ? p.c[v * 1024 + k] : p.c_ctx[k];
    sv[i] = c / (1.f + __expf(-c));
  }
  __syncthreads();
  const int kq = tid >> 6, cc = tid & 63, col = cg0 + cc;
  float a[5] = {0.f, 0.f, 0.f, 0.f, 0.f};
  const float* w = p.w_mod + (size_t)l * 1024 * 6144 + col;
#pragma unroll 8
  for (int k = kq * 256; k < kq * 256 + 256; ++k) {
    const float wv = w[(size_t)k * 6144];
#pragma unroll
    for (int v = 0; v < 5; ++v) a[v] += sv[v * 1024 + k] * wv;
  }
#pragma unroll
  for (int v = 0; v < 5; ++v) red[(kq * 5 + v) * 64 + cc] = a[v];
  __syncthreads();
  for (int i = tid; i < 5 * 64; i += 256) {
    const int v = i >> 6, c2 = i & 63;
    float s = p.b_mod[l * 6144 + cg0 + c2];
#pragma unroll
    for (int q = 0; q < 4; ++q) s += red[(q * 5 + v) * 64 + c2];
    ((float*)(p.ws + OFF_MOD))[(l * 5 + v) * 6144 + cg0 + c2] = s;
  }
  __syncthreads();
}

DI void rope_item(const Params& p, int item) {
  const int e = item * 256 + opq(threadIdx.x);
  const int pos = e / 48, f = e % 48;
  const int row = pos >> 6, colp = pos & 63;
  float* base = (float*)(p.ws + OFF_ROPE);
  float ang; float *cd, *sd;
  if (f < 16) {
    const int fi = f & 7;
    const float inv = exp2f(-(float)fi * (13.287712379549449f / 8.f));
    ang = (f < 8 ? (float)row : (float)colp) * inv;
    cd = base + pos * 16 + f; sd = base + 8192 * 16 + pos * 16 + f;
  } else {
    const int f2 = f - 16, fi = f2 & 15;
    const float inv = exp2f(-(float)fi * (13.287712379549449f / 16.f));
    ang = (f2 < 16 ? (float)row : (float)colp) * inv;
    cd = base + 2 * 8192 * 16 + pos * 32 + f2; sd = base + 2 * 8192 * 16 + 8192 * 32 + pos * 32 + f2;
  }
  const float rev = ang * 0.15915494309189535f;
  *cd = cosrev(rev);
  *sd = sinrev(rev);
}

DI void hid_item(const Params& p, int item, char* smem) {
  float* feat = (float*)smem;
  float* h1 = feat + 4 * 36;
  const int tid = opq(threadIdx.x);
  const int l = item / 264; const int it = item % 264;
  int L, pos00; float* dst;
  if (it < 256) { L = 8192; pos00 = it * 32; dst = (float*)(p.ws + OFF_HID + l * HID_LAYER); }
  else { L = 256; pos00 = (it - 256) * 32; dst = (float*)(p.ws + OFF_HID + l * HID_LAYER) + 64 * 8192; }
  const int pp = tid >> 6, j = tid & 63;
#pragma unroll 1
  for (int sub = 0; sub < 8; ++sub) {
    const int pos = pos00 + sub * 4 + pp;
    if (j < 33) {
      float fv;
      if (j == 0) fv = (float)pos / (float)(L - 1);
      else {
        const int bi = (j - 1) & 15;
        const float band = 1e-4f + (float)bi * ((15.f - 1e-4f) / 15.f);
        const float rev = (float)pos * band / (float)L;
        fv = (j <= 16) ? cosrev(rev) : -sinrev(rev);
      }
      feat[pp * 36 + j] = fv;
    }
    __syncthreads();
    {
      float s = p.hy_b1[l * 64 + j];
      const float* w1 = p.hy_w1 + (size_t)l * 33 * 64;
#pragma unroll
      for (int f = 0; f < 33; ++f) s += feat[pp * 36 + f] * w1[f * 64 + j];
      s *= p.hy_freq[l * 128 + j];
      h1[pp * 64 + j] = sinrev(s * 0.15915494309189535f);
    }
    __syncthreads();
    {
      float s = p.hy_b2[l * 64 + j];
      const float* w2 = p.hy_w2 + (size_t)l * 64 * 64;
#pragma unroll 8
      for (int i = 0; i < 64; ++i) s += h1[pp * 64 + i] * w2[i * 64 + j];
      s *= p.hy_freq[l * 128 + 64 + j];
      dst[(size_t)j * L + pos] = sinrev(s * 0.15915494309189535f);
    }
    __syncthreads();
  }
}

DI const float* xrow_src(const float* xl, const float* xc, int m) {
  const int b = m / TPB, j = m - b * TPB;
  return j < CTX ? xc + (size_t)(b * CTX + j) * DM : xl + (size_t)(b * SEQ + j - CTX) * DM;
}
DI void row_pass(const Params& p, int mode, const float* xl_src, const float* xc_src, float* xl_dst, float* xc_dst,
                 const u16* ybuf, const float* gy, int gate_off, int modl_gate,
                 bool has_next, const float* gn, int modl_next, int sh_off, int sc_off, u16* hdst, bool skip_ctx_rows) {
  const int tid0 = opq(threadIdx.x);
  const int lane = tid0 & 63;
  const int gw = blockIdx.x * 4 + (tid0 >> 6), nw = gridDim.x * 4;
  const float* modb = (const float*)(p.ws + OFF_MOD);
  const int per = (MTOK + nw - 1) / nw;
  const int m_beg = gw * per, m_end = min(m_beg + per, MTOK);
  int cur_v = -1;
  float4 gg[4], gs[4], shv[4];
#pragma unroll
  for (int i = 0; i < 4; ++i) { gg[i] = make_float4(0.f, 0.f, 0.f, 0.f); gs[i] = gg[i]; shv[i] = gg[i]; }
  const bool do_h = (mode == 0) || has_next;
  float4 xv_n[4];
  u32x2 yr_n[4];
#pragma unroll
  for (int i = 0; i < 4; ++i) { xv_n[i] = make_float4(0.f, 0.f, 0.f, 0.f); yr_n[i] = u32x2{0u, 0u}; }
  if (m_beg < m_end) {
    const float* xs0 = xrow_src(xl_src, xc_src, m_beg);
#pragma unroll
    for (int i = 0; i < 4; ++i) {
      xv_n[i] = *(const float4*)(xs0 + lane * 4 + 256 * i);
      if (mode == 1) yr_n[i] = *(const u32x2*)(ybuf + (size_t)m_beg * DM + lane * 4 + 256 * i);
    }
  }
  for (int m = m_beg; m < m_end; ++m) {
    const int b = m / TPB, j = m - b * TPB;
    float4 xv[4];
    u32x2 yr[4];
#pragma unroll
    for (int i = 0; i < 4; ++i) { xv[i] = xv_n[i]; yr[i] = yr_n[i]; }
    if (m + 1 < m_end) {
      const float* xs1 = xrow_src(xl_src, xc_src, m + 1);
#pragma unroll
      for (int i = 0; i < 4; ++i) {
        xv_n[i] = *(const float4*)(xs1 + lane * 4 + 256 * i);
        if (mode == 1) yr_n[i] = *(const u32x2*)(ybuf + (size_t)(m + 1) * DM + lane * 4 + 256 * i);
      }
    }
    if (skip_ctx_rows && j < CTX) continue;
    const int v = j < CTX ? 4 : b;
    if (v != cur_v) {
      cur_v = v;
#pragma unroll
      for (int i = 0; i < 4; ++i) {
        const int c = lane * 4 + 256 * i;
        if (mode == 1) {
          const float4 g4 = *(const float4*)(gy + c);
          const float4 t4 = *(const float4*)(modb + (size_t)(modl_gate * 5 + v) * 6144 + gate_off + c);
          gg[i] = make_float4(g4.x * t4.x, g4.y * t4.y, g4.z * t4.z, g4.w * t4.w);
        }
        if (do_h) {
          const float* mb = modb + (size_t)(modl_next * 5 + v) * 6144;
          const float4 g4 = *(const float4*)(gn + c);
          const float4 sc = *(const float4*)(mb + sc_off + c);
          shv[i] = *(const float4*)(mb + sh_off + c);
          gs[i] = make_float4(g4.x * (1.f + sc.x), g4.y * (1.f + sc.y), g4.z * (1.f + sc.z), g4.w * (1.f + sc.w));
        }
      }
    }
    if (mode == 1) {
      float yv[4][4];
      float ss = 0.f;
#pragma unroll
      for (int i = 0; i < 4; ++i) {
        const u32x2 u = yr[i];
        yv[i][0] = lo_bf(u.x); yv[i][1] = hi_bf(u.x); yv[i][2] = lo_bf(u.y); yv[i][3] = hi_bf(u.y);
#pragma unroll
        for (int e = 0; e < 4; ++e) ss += yv[i][e] * yv[i][e];
      }
      ss = wave_sum(ss);
      const float rstd = rsqrtf(ss * (1.f / DM) + EPS);
#pragma unroll
      for (int i = 0; i < 4; ++i) {
        xv[i].x += gg[i].x * (yv[i][0] * rstd);
        xv[i].y += gg[i].y * (yv[i][1] * rstd);
        xv[i].z += gg[i].z * (yv[i][2] * rstd);
        xv[i].w += gg[i].w * (yv[i][3] * rstd);
      }
      float* xd = (j < CTX) ? xc_dst + (size_t)(b * CTX + j) * DM : xl_dst + (size_t)(b * SEQ + j - CTX) * DM;
#pragma unroll
      for (int i = 0; i < 4; ++i) *(float4*)(xd + lane * 4 + 256 * i) = xv[i];
    }
    if (do_h) {
      float ss = 0.f;
#pragma unroll
      for (int i = 0; i < 4; ++i) ss += xv[i].x * xv[i].x + xv[i].y * xv[i].y + xv[i].z * xv[i].z + xv[i].w * xv[i].w;
      ss = wave_sum(ss);
      const float rstd = rsqrtf(ss * (1.f / DM) + EPS);
#pragma unroll
      for (int i = 0; i < 4; ++i) {
        const int c = lane * 4 + 256 * i;
        u32x2 pk;
        pk.x = pack2(xv[i].x * rstd * gs[i].x + shv[i].x, xv[i].y * rstd * gs[i].y + shv[i].y);
        pk.y = pack2(xv[i].z * rstd * gs[i].z + shv[i].z, xv[i].w * rstd * gs[i].w + shv[i].w);
        *(u32x2*)(hdst + (size_t)m * DM + c) = pk;
      }
    }
  }
}

constexpr float QS_MLA = 0.10206207261596577f * LOG2E;
constexpr float QS_SWA = 0.125f * LOG2E;

DI void rope32(f32x16& a, const float* cm, const float* sm, int pos, int h) {
#pragma unroll
  for (int i = 0; i < 8; ++i) {
    const int f = crow(i, h);
    const float c = cm[pos * 16 + f], s = sm[pos * 16 + f];
    const float x1 = a[i], x2 = a[i + 8];
    a[i] = x1 * c - x2 * s;
    a[i + 8] = x2 * c + x1 * s;
    if ((i & 3) == 3) __builtin_amdgcn_sched_barrier(0);
  }
}
DI void rope64(f32x16& a0, f32x16& a1, const float* cs, const float* ss, int pos, int h) {
#pragma unroll
  for (int i = 0; i < 16; ++i) {
    const int f = crow(i, h);
    const float c = cs[pos * 32 + f], s = ss[pos * 32 + f];
    const float x1 = a0[i], x2 = a1[i];
    a0[i] = x1 * c - x2 * s;
    a1[i] = x2 * c + x1 * s;
    if ((i & 3) == 3) __builtin_amdgcn_sched_barrier(0);
  }
}

DI void inproj_tile(const Params& p, int tile, char* smem) {
  const int mt_i = tile / 27, nt_i = tile % 27;
  const int m0 = mt_i * 192;
  const int tid = opq(threadIdx.x), lane = tid & 63, wave = tid >> 6, wm = wave >> 1, wn = wave & 1, r = lane & 31, h = lane >> 5;
  const u16* hbuf = (const u16*)(p.ws + OFF_RH);
  const u16* wt = (const u16*)(p.ws + OFF_WT_IN) + (size_t)nt_i * 128 * 1024;
  const int b = m0 / TPB, j0 = m0 - b * TPB;
  const float* cm = (const float*)(p.ws + OFF_ROPE);
  const float* sm = cm + 8192 * 16;
  const float* cs = sm + 8192 * 16;
  const float* ss = cs + 8192 * 32;
  f32x16 acc[3][2];
  if (nt_i >= 13 && nt_i <= 25) {
    gemm_main<false>(hbuf, 1024, m0, 0, MTOK - 1, 64, wt, 1024, 16, acc, smem);
    if (nt_i == 13) store_transposed(acc, (u16*)(p.ws + OFF_SVT), TPB, b * 128, j0);
    else store_transposed(acc, (u16*)(p.ws + OFF_HYT), TPB, b * 1536 + (nt_i - 14) * 128, j0);
    return;
  }
  gemm_main<true>(hbuf, 1024, m0, 0, MTOK - 1, 64, wt, 1024, 16, acc, smem);
  if (nt_i < 6) {
#pragma unroll
    for (int ntl = 0; ntl < 2; ++ntl) {
      const int s32 = nt_i * 4 + wn * 2 + ntl;
      if (s32 % 3 == 2) {
#pragma unroll
        for (int mt = 0; mt < 3; ++mt) {
          const int jr = j0 + wm * 96 + mt * 32 + r;
          if (jr >= CTX) rope32(acc[mt][ntl], cm, sm, jr - CTX, h);
        }
      }
    }
    store_rowmajor(acc, (u16*)(p.ws + OFF_Q), 768, m0, nt_i * 128, QS_MLA);
  } else if (nt_i < 8) {
    store_rowmajor(acc, (u16*)(p.ws + OFF_CKV), 256, m0, (nt_i - 6) * 128, 1.f);
  } else if (nt_i < 12) {
#pragma unroll
    for (int mt = 0; mt < 3; ++mt) {
      const int jr = j0 + wm * 96 + mt * 32 + r;
      if (jr >= CTX) rope64(acc[mt][0], acc[mt][1], cs, ss, jr - CTX, h);
    }
    store_rowmajor(acc, (u16*)(p.ws + OFF_SQ), 512, m0, (nt_i - 8) * 128, QS_SWA);
  } else if (nt_i == 12) {
#pragma unroll
    for (int mt = 0; mt < 3; ++mt) {
      const int jr = j0 + wm * 96 + mt * 32 + r;
      if (jr >= CTX) rope64(acc[mt][0], acc[mt][1], cs, ss, jr - CTX, h);
    }
    store_rowmajor(acc, (u16*)(p.ws + OFF_SK), 128, m0, 0, 1.f);
  } else {
    if (wn == 0) {
      u16* kr = (u16*)(p.ws + OFF_KR);
#pragma unroll
      for (int mt = 0; mt < 3; ++mt) {
        const int ml = wm * 96 + mt * 32 + r;
        if (j0 + ml >= CTX) rope32(acc[mt][0], cm, sm, j0 + ml - CTX, h);
#pragma unroll
        for (int g = 0; g < 4; ++g) {
          u32x2 pk;
          pk.x = pack2(acc[mt][0][4 * g], acc[mt][0][4 * g + 1]);
          pk.y = pack2(acc[mt][0][4 * g + 2], acc[mt][0][4 * g + 3]);
          *(u32x2*)(kr + (size_t)(m0 + ml) * 32 + 8 * g + 4 * h) = pk;
        }
      }
    }
  }
}

DI void kvup_tile(const Params& p, int tile, char* smem) {
  const int mt_i = tile >> 3, nt_i = tile & 7;
  const int m0 = mt_i * 192;
  const int tid = opq(threadIdx.x), lane = tid & 63, wave = tid >> 6, wm = wave >> 1, r = lane & 31, h = lane >> 5;
  const u16* ckv = (const u16*)(p.ws + OFF_CKV);
  float* rs = (float*)(smem + (192 + 128) * 144);
#pragma unroll
  for (int pass = 0; pass < 2; ++pass) {
    const int row = pass * 128 + (tid >> 1), half = tid & 1;
    const int rowc = min(row, 191);
    const u32x4* src = (const u32x4*)(ckv + (size_t)(m0 + rowc) * 256 + half * 128);
    float ss = 0.f;
#pragma unroll
    for (int i = 0; i < 16; ++i) {
      const u32x4 u = src[i];
      const unsigned w[4] = {u.x, u.y, u.z, u.w};
#pragma unroll
      for (int e = 0; e < 4; ++e) { const float a = lo_bf(w[e]), c = hi_bf(w[e]); ss += a * a + c * c; }
    }
    ss += __shfl_xor(ss, 1);
    if (half == 0 && row < 192) rs[row] = rsqrtf(ss * (1.f / 256.f) + EPS);
  }
  const u16* wt = (const u16*)(p.ws + OFF_WT_KV) + (size_t)nt_i * 128 * 256;
  const int b = m0 / TPB, j0 = m0 - b * TPB;
  f32x16 acc[3][2];
  if (nt_i < 4) {
    gemm_main<true>(ckv, 256, m0, 0, MTOK - 1, 64, wt, 256, 4, acc, smem);
#pragma unroll
    for (int mt = 0; mt < 3; ++mt) {
      const float sc = rs[wm * 96 + mt * 32 + r];
#pragma unroll
      for (int nt = 0; nt < 2; ++nt)
#pragma unroll
        for (int i = 0; i < 16; ++i) acc[mt][nt][i] *= sc;
    }
    store_rowmajor(acc, (u16*)(p.ws + OFF_KN), 512, m0, nt_i * 128, 1.f);
  } else {
    gemm_main<false>(ckv, 256, m0, 0, MTOK - 1, 64, wt, 256, 4, acc, smem);
#pragma unroll
    for (int mt = 0; mt < 3; ++mt)
#pragma unroll
      for (int i = 0; i < 16; ++i) {
        const float sc = rs[wm * 96 + mt * 32 + crow(i, h)];
        acc[mt][0][i] *= sc;
        acc[mt][1][i] *= sc;
      }
    store_transposed(acc, (u16*)(p.ws + OFF_VT), TPB, b * 512 + (nt_i - 4) * 128, j0);
  }
  __syncthreads();
}

DI void merge_tile(const Params& p, int tile, char* smem) {
  const int mt_i = tile >> 3, nt_i = tile & 7;
  const int m0 = mt_i * 192;
  const u16* hp = (const u16*)(p.ws + OFF_RH);
  const int tid = opq(threadIdx.x), lane = tid & 63, wave = tid >> 6, wm = wave >> 1, wn = wave & 1, r = lane & 31, h = lane >> 5;
  u16* C = (u16*)(p.ws + OFF_MERGED);
#pragma unroll 1
  for (int br = 0; br < 3; ++br) {
    if ((DBG_SKIP_BR >> br) & 1) continue;
    f32x16 acc[3][2];
    gemm_main<true>(hp, 1024, m0, 0, MTOK - 1, 64, (const u16*)(p.ws + OFF_WT_GATE) + (size_t)(br * 1024 + nt_i * 128) * 1024, 1024, 16, acc, smem);
    u32x2* sgp = (u32x2*)(p.ws + OFF_ESCR + (size_t)blockIdx.x * 65536) + tid * 24;
#pragma unroll
    for (int a = 0; a < 3; ++a)
#pragma unroll
      for (int b2 = 0; b2 < 2; ++b2)
#pragma unroll
        for (int g = 0; g < 4; ++g) {
          u32x2 v;
          v.x = pack2(1.f / (1.f + __expf(-acc[a][b2][4 * g])), 1.f / (1.f + __expf(-acc[a][b2][4 * g + 1])));
          v.y = pack2(1.f / (1.f + __expf(-acc[a][b2][4 * g + 2])), 1.f / (1.f + __expf(-acc[a][b2][4 * g + 3])));
          sgp[(a * 2 + b2) * 4 + g] = v;
        }
    const u16* wbr = (const u16*)(p.ws + OFF_WT_BR) + (size_t)(br * 1024 + nt_i * 128) * 512;
    if (br == 0) gemm_main<true>((const u16*)(p.ws + OFF_Q), 768, m0, 0, MTOK - 1, 96, wbr, 512, 8, acc, smem);
    else if (br == 1) gemm_main<true>((const u16*)(p.ws + OFF_SQ), 512, m0, 0, MTOK - 1, 64, wbr, 512, 8, acc, smem);
    else {
      const int b = m0 / TPB, j0 = m0 - b * TPB;
      gemm_main<true, true>((const u16*)(p.ws + OFF_HYT) + (size_t)(b * 1536 + 512) * TPB, TPB, j0, 0, 0, 64, wbr, 512, 8, acc, smem);
    }
#pragma unroll
    for (int mt = 0; mt < 3; ++mt)
#pragma unroll
      for (int nt = 0; nt < 2; ++nt)
#pragma unroll
        for (int g = 0; g < 4; ++g) {
          const int m = m0 + wm * 96 + mt * 32 + r, n = nt_i * 128 + wn * 64 + nt * 32 + 8 * g + 4 * h;
          u32x2* dst = (u32x2*)(C + (size_t)m * 1024 + n);
          u32x2 prev = {0u, 0u};
          if (br > DBG_FIRST_BR) prev = *dst;
          const u32x2 sv = sgp[(mt * 2 + nt) * 4 + g];
          const unsigned s0 = sv.x, s1 = sv.y;
          u32x2 nv;
          nv.x = pack2(lo_bf(prev.x) + lo_bf(s0) * acc[mt][nt][4 * g], hi_bf(prev.x) + hi_bf(s0) * acc[mt][nt][4 * g + 1]);
          nv.y = pack2(lo_bf(prev.y) + lo_bf(s1) * acc[mt][nt][4 * g + 2], hi_bf(prev.y) + hi_bf(s1) * acc[mt][nt][4 * g + 3]);
          *dst = nv;
          __builtin_amdgcn_sched_barrier(0);
        }
  }
}

DI void plain_tile(const Params& p, int tile, const u16* A, int lda, int nk, const u16* W, u16* C, char* smem) {
  const int mt_i = tile >> 3, nt_i = tile & 7;
  f32x16 acc[3][2];
  gemm_main<true>(A, lda, mt_i * 192, 0, MTOK - 1, 64, W + (size_t)nt_i * 128 * lda, lda, nk, acc, smem);
  store_rowmajor(acc, C, 1024, mt_i * 192, nt_i * 128, 1.f);
}

DI void ffnup_tile(const Params& p, int l, int tile, char* smem) {
  const int mt_i = tile / 44, nt_i = tile % 44;
  const int b = mt_i / 46, ti = mt_i % 46;
  int seq_base, len, r0;
  if (ti < 2) { seq_base = b * TPB; len = CTX; r0 = 190 * ti; }
  else { seq_base = b * TPB + CTX; len = SEQ; r0 = 190 * (ti - 2); }
  const int tid = opq(threadIdx.x), lane = tid & 63, wave = tid >> 6, wm = wave >> 1, wn = wave & 1, r = lane & 31, h = lane >> 5;
  f32x16 acc[3][2];
  gemm_main<true>((const u16*)(p.ws + OFF_RH), 1024, seq_base + r0 - 1, seq_base, seq_base + len - 1, 64,
                  (const u16*)(p.ws + OFF_WT_UP) + (size_t)nt_i * 128 * 1024, 1024, 16, acc, smem);
  __syncthreads();
#pragma unroll
  for (int mt = 0; mt < 3; ++mt) {
    const int ml = wm * 96 + mt * 32 + r;
    const int pos = r0 - 1 + ml;
    const bool valid = pos >= 0 && pos < len;
#pragma unroll
    for (int nt = 0; nt < 2; ++nt)
#pragma unroll
      for (int g = 0; g < 4; ++g) {
        u32x2 pk = u32x2{0u, 0u};
        if (valid) {
          pk.x = pack2(acc[mt][nt][4 * g], acc[mt][nt][4 * g + 1]);
          pk.y = pack2(acc[mt][nt][4 * g + 2], acc[mt][nt][4 * g + 3]);
        }
        *(u32x2*)(smem + ml * 272 + (wn * 64 + nt * 32 + 8 * g + 4 * h) * 2) = pk;
      }
  }
  __syncthreads();
  {
    const int j4 = (tid & 15) * 4, tr = tid >> 4;
    const float* cw = p.ffn_conv_w + (size_t)l * 3 * 5632;
    const float* cb = p.ffn_conv_b + (size_t)l * 5632;
    const int cha = nt_i * 64 + j4, chb = DFF + cha;
    float wa[3][4], wb[3][4], ba[4], bb[4];
#pragma unroll
    for (int e = 0; e < 4; ++e) {
#pragma unroll
      for (int d = 0; d < 3; ++d) { wa[d][e] = cw[d * 5632 + cha + e]; wb[d][e] = cw[d * 5632 + chb + e]; }
      ba[e] = cb[cha + e]; bb[e] = cb[chb + e];
    }
    u16* Aout = (u16*)(p.ws + OFF_A);
#pragma unroll 1
    for (int i = 0; i < 12; ++i) {
      const int t = 1 + tr + 16 * i;
      const int pos = r0 - 1 + t;
      if (t <= 190 && pos < len) {
        float ca[4], cbv[4];
#pragma unroll
        for (int e = 0; e < 4; ++e) { ca[e] = ba[e]; cbv[e] = bb[e]; }
#pragma unroll
        for (int d = 0; d < 3; ++d) {
          const u32x2 ua = *(const u32x2*)(smem + (t - 1 + d) * 272 + j4 * 2);
          const u32x2 ub = *(const u32x2*)(smem + (t - 1 + d) * 272 + (64 + j4) * 2);
          ca[0] += lo_bf(ua.x) * wa[d][0]; ca[1] += hi_bf(ua.x) * wa[d][1]; ca[2] += lo_bf(ua.y) * wa[d][2]; ca[3] += hi_bf(ua.y) * wa[d][3];
          cbv[0] += lo_bf(ub.x) * wb[d][0]; cbv[1] += hi_bf(ub.x) * wb[d][1]; cbv[2] += lo_bf(ub.y) * wb[d][2]; cbv[3] += hi_bf(ub.y) * wb[d][3];
        }
        float o[4];
#pragma unroll
        for (int e = 0; e < 4; ++e) o[e] = ca[e] / (1.f + __expf(-ca[e])) * cbv[e];
        *(u32x2*)(Aout + (size_t)(seq_base + pos) * DFF + cha) = u32x2{pack2(o[0], o[1]), pack2(o[2], o[3])};
      }
    }
  }
}

template <int DQK, bool SWA>
DI void attn_item(const Params& p, int l, int b, int hq, int jq0  , int nct, int nband, int kp_start, char* smem) {
  constexpr int KS = DQK * 2 + 16;
  constexpr int KCH = DQK / 8;
  constexpr int NKC = 64 * KCH / 256;
  constexpr int NKS = DQK / 16;
  constexpr int BUFSZ = 22016;
  const int tid = opq(threadIdx.x), lane = tid & 63, wave = tid >> 6, r = lane & 31, h = lane >> 5;
  const int brow = b * TPB;
  const int ntiles = nct + nband;
  const u16* K1; int ldk1, koff; const u16* KR = (const u16*)(p.ws + OFF_KR);
  const u16* Vb; u16* outp; int ldo, ooff; const u16* Qb; int ldq;
  if (!SWA) {
    K1 = (const u16*)(p.ws + OFF_KN); ldk1 = 512; koff = hq * 64;
    Vb = (const u16*)(p.ws + OFF_VT) + (size_t)((b * 8 + hq) * 64) * TPB;
    Qb = (const u16*)(p.ws + OFF_Q); ldq = 768;
    outp = (u16*)(p.ws + OFF_Q); ldo = 768; ooff = hq * 96;
  } else {
    const int kvh = hq >> 2;
    K1 = (const u16*)(p.ws + OFF_SK); ldk1 = 128; koff = kvh * 64;
    Vb = (const u16*)(p.ws + OFF_SVT) + (size_t)((b * 2 + kvh) * 64) * TPB;
    Qb = (const u16*)(p.ws + OFF_SQ); ldq = 512;
    outp = (u16*)(p.ws + OFF_SQ); ldo = 512; ooff = hq * 64;
  }
  const int qrow = brow + jq0 + wave * 32 + r;
  bf16x8 qf[NKS];
#pragma unroll
  for (int ks = 0; ks < NKS; ++ks) qf[ks] = *(const bf16x8*)(Qb + (size_t)qrow * ldq + hq * DQK + ks * 16 + h * 8);
  f32x16 o[2];
#pragma unroll
  for (int dt = 0; dt < 2; ++dt)
#pragma unroll
    for (int i = 0; i < 16; ++i) o[dt][i] = 0.f;
  float mrun = -INFINITY, lsum = 0.f;
  u32x4 kreg[NKC], vreg[2];
  auto tile_j = [&](int it) { return it < nct ? it * 64 : CTX + kp_start + 64 * (it - nct); };
  auto issue = [&](int it) {
    const int jr = tile_j(it);
#pragma unroll
    for (int i = 0; i < NKC; ++i) {
      const int c = tid + 256 * i, key = c / KCH, part = c % KCH;
      const u16* src = (part < 8) ? K1 + (size_t)(brow + jr + key) * ldk1 + koff + part * 8
                                  : KR + (size_t)(brow + jr + key) * 32 + (part - 8) * 8;
      kreg[i] = *(const u32x4*)src;
    }
#pragma unroll
    for (int i = 0; i < 2; ++i) {
      const int c = tid + 256 * i, d = c >> 3, part = c & 7;
      vreg[i] = *(const u32x4*)(Vb + (size_t)d * TPB + jr + part * 8);
    }
  };
  auto stash = [&](int buf) {
    char* kb = smem + buf * BUFSZ;
    char* vb = kb + 13312;
#pragma unroll
    for (int i = 0; i < NKC; ++i) {
      const int c = tid + 256 * i, key = c / KCH, part = c % KCH;
      *(u32x4*)(kb + key * KS + part * 16) = kreg[i];
    }
#pragma unroll
    for (int i = 0; i < 2; ++i) {
      const int c = tid + 256 * i, d = c >> 3, part = c & 7;
      *(u32x2*)(vb + d * 136 + part * 16) = u32x2{vreg[i].x, vreg[i].y};
      *(u32x2*)(vb + d * 136 + part * 16 + 8) = u32x2{vreg[i].z, vreg[i].w};
    }
  };
  __syncthreads();
  issue(0);
  stash(0);
  __syncthreads();
  const int qpos = jq0 - CTX + wave * 32 + r;
#pragma unroll 1
  for (int it = 0; it < ntiles; ++it) {
    const int buf = it & 1;
    const char* kb = smem + buf * BUFSZ;
    const char* vb = kb + 13312;
    if (it + 1 < ntiles) issue(it + 1);
    f32x16 s[2];
#pragma unroll
    for (int kt = 0; kt < 2; ++kt) {
#pragma unroll
      for (int i = 0; i < 16; ++i) s[kt][i] = 0.f;
#pragma unroll
      for (int ks = 0; ks < NKS; ++ks) {
        const bf16x8 kf = *(const bf16x8*)(kb + (kt * 32 + r) * KS + ks * 32 + h * 16);
        s[kt] = MFMA(kf, qf[ks], s[kt]);
      }
    }
    if (SWA && it >= nct) {
      const int kpos0 = kp_start + 64 * (it - nct);
#pragma unroll
      for (int kt = 0; kt < 2; ++kt)
#pragma unroll
        for (int i = 0; i < 16; ++i) {
          const int diff = qpos - (kpos0 + kt * 32 + crow(i, h));
          if (diff > 128 || diff < -128) s[kt][i] = -1e30f;
        }
    }
    float mx = s[0][0];
#pragma unroll
    for (int kt = 0; kt < 2; ++kt)
#pragma unroll
      for (int i = 0; i < 16; ++i) mx = fmaxf(mx, s[kt][i]);
    mx = fmaxf(mx, __shfl_xor(mx, 32));
    const float mnew = fmaxf(mrun, mx);
    const float alpha = __builtin_amdgcn_exp2f(mrun - mnew);
    float ps = 0.f;
#pragma unroll
    for (int kt = 0; kt < 2; ++kt)
#pragma unroll
      for (int i = 0; i < 16; ++i) { const float e = __builtin_amdgcn_exp2f(s[kt][i] - mnew); s[kt][i] = e; ps += e; }
    if (__builtin_amdgcn_ballot_w64(mnew != mrun) != 0ull) {
      lsum *= alpha;
#pragma unroll
      for (int dt = 0; dt < 2; ++dt)
#pragma unroll
        for (int i = 0; i < 16; ++i) o[dt][i] *= alpha;
    }
    lsum += ps;
    mrun = mnew;
#pragma unroll
    for (int kt = 0; kt < 2; ++kt)
#pragma unroll
      for (int s2 = 0; s2 < 2; ++s2) {
        unsigned pk[4];
#pragma unroll
        for (int j = 0; j < 4; ++j) pk[j] = pack2(s[kt][8 * s2 + 2 * j], s[kt][8 * s2 + 2 * j + 1]);
        const bf16x8 pf = __builtin_bit_cast(bf16x8, u32x4{pk[0], pk[1], pk[2], pk[3]});
#pragma unroll
        for (int dt = 0; dt < 2; ++dt) {
          const char* vp = vb + (dt * 32 + r) * 136 + (kt * 32 + 16 * s2 + 4 * h) * 2;
          const s16x4 lo = *(const s16x4*)vp;
          const s16x4 hi = *(const s16x4*)(vp + 16);
          const bf16x8 vf = __builtin_shufflevector(lo, hi, 0, 1, 2, 3, 4, 5, 6, 7);
          o[dt] = MFMA(vf, pf, o[dt]);
        }
      }
    if (it + 1 < ntiles) stash(buf ^ 1);
    __syncthreads();
  }
  float ltot = lsum + __shfl_xor(lsum, 32);
  if (SWA) ltot += __builtin_amdgcn_exp2f(p.swa_sink[l * 8 + hq] * LOG2E - mrun);
  const float inv = 1.f / ltot;
#pragma unroll
  for (int dt = 0; dt < 2; ++dt)
#pragma unroll
    for (int g = 0; g < 4; ++g) {
      u32x2 pk;
      pk.x = pack2(o[dt][4 * g] * inv, o[dt][4 * g + 1] * inv);
      pk.y = pack2(o[dt][4 * g + 2] * inv, o[dt][4 * g + 3] * inv);
      *(u32x2*)(outp + (size_t)qrow * ldo + ooff + dt * 32 + 8 * g + 4 * h) = pk;
    }
}

constexpr float HY_D0 = 3.0701134573253944f;
constexpr float HY_DSTEP = (15.350567286626972f - 3.0701134573253944f) / 511.f;

DI void filt_item(const Params& p, int l, int oc, char* smem) {
  float2* lds = (float2*)smem;
  float* lf = (float*)smem;
  const int tid = opq(threadIdx.x), lane = tid & 63, wave = tid >> 6;
  const int c = oc & 511;
  const float* hid = (const float*)(p.ws + OFF_HID + l * HID_LAYER);
  const float* w3 = p.hy_w3 + (size_t)l * 64 * 2048;
  float* sa = (float*)(p.ws + OFF_ESCR + (size_t)blockIdx.x * 65536);
  float* sb = sa + 8192;
  __syncthreads();
  if (tid < 128) { const int dir = tid >> 6, j = tid & 63; lf[tid] = w3[j * 2048 + dir * 1024 + oc]; }
  __syncthreads();
  const float delta = HY_D0 + (float)c * HY_DSTEP;
  float asum = 0.f;
#pragma unroll 1
  for (int ib = 0; ib < 4; ++ib) {
    float a[8], bm[8];
#pragma unroll
    for (int i = 0; i < 8; ++i) { a[i] = 0.f; bm[i] = 0.f; }
#pragma unroll 4
    for (int j = 0; j < 64; ++j) {
      const float w0 = lf[j], w1 = lf[64 + j];
      const float* hr = hid + (size_t)j * 8192 + 4 * (tid + 512 * ib);
#pragma unroll
      for (int ii = 0; ii < 2; ++ii) {
        const float4 hv = *(const float4*)(hr + 1024 * ii);
        a[4 * ii + 0] += hv.x * w0; bm[4 * ii + 0] += hv.x * w1;
        a[4 * ii + 1] += hv.y * w0; bm[4 * ii + 1] += hv.y * w1;
        a[4 * ii + 2] += hv.z * w0; bm[4 * ii + 2] += hv.z * w1;
        a[4 * ii + 3] += hv.w * w0; bm[4 * ii + 3] += hv.w * w1;
      }
    }
#pragma unroll
    for (int ii = 0; ii < 2; ++ii) {
      const int t0 = 4 * (tid + 256 * (2 * ib + ii));
      float av[4];
#pragma unroll
      for (int e = 0; e < 4; ++e) {
        const int t = t0 + e;
        const float dec = __expf(-((float)t * (1.f / 8191.f)) * delta);
        av[e] = a[4 * ii + e] * dec;
        const float bv = bm[4 * ii + e] * dec;
        if (t >= 1) { sb[8192 - t] = bv; asum += fabsf(bv); } else sb[0] = 0.f;
        asum += fabsf(av[e]);
      }
      *(float4*)(sa + t0) = make_float4(av[0], av[1], av[2], av[3]);
    }
  }
  asum = wave_sum(asum);
  asm volatile("s_waitcnt vmcnt(0)" ::: "memory");
  __syncthreads();
  if (lane == 0) lf[wave] = asum;
  __syncthreads();
  const float inv = 1.f / (lf[0] + lf[1] + lf[2] + lf[3]);
  __syncthreads();
#pragma unroll 2
  for (int i = 0; i < 8; ++i) {
    const int t0 = 4 * (tid + 256 * i);
#pragma unroll
    for (int e = 0; e < 4; ++e) lds[fphys(t0 + e)] = make_float2((ldsc1(sa + t0 + e) + ldsc1(sb + t0 + e)) * inv, 0.f);
  }
  __syncthreads();
  h2_t* sp = (h2_t*)(p.ws + OFF_SPEC) + (size_t)oc * 2 * 8192;
  fft8192_spectrum(lds, tid, sp);
#pragma unroll 2
  for (int i = 0; i < 8; ++i) {
    const int t0 = 4 * (tid + 256 * i);
#pragma unroll
    for (int e = 0; e < 4; ++e) {
      const int t = t0 + e;
      const float2 w = twid_rev((float)t * (1.f / 16384.f));
      const float d = (ldsc1(sa + t) - ldsc1(sb + t)) * inv;
      lds[fphys(t)] = make_float2(d * w.x, d * w.y);
    }
  }
  __syncthreads();
  fft8192_spectrum(lds, tid, sp + 8192);
}

DI float dwc(const u16* s, int t, int len, float w0, float w1, float w2, float bias) {
  const int tm = max(t - 1, 0), tp = min(t + 1, len - 1);
  const float a = bf2f(s[tm]), b = bf2f(s[t]), c = bf2f(s[tp]);
  return b * w1 + bias + (t > 0 ? a * w0 : 0.f) + (t < len - 1 ? c * w2 : 0.f);
}

DI void ld4(const u16* s, int t0, float (&o)[4]) {
  const u32x2 u = *(const u32x2*)(s + t0);
  o[0] = lo_bf(u.x); o[1] = hi_bf(u.x); o[2] = lo_bf(u.y); o[3] = hi_bf(u.y);
}
DI void dwc4(const u16* s, int t0, int len, float w0, float w1, float w2, float bias, float (&o)[4]) {
  float c[4];
  ld4(s, t0, c);
  float l = bf2f(s[max(t0 - 1, 0)]), r = bf2f(s[min(t0 + 4, len - 1)]);
  l = (t0 > 0) ? l : 0.f;
  r = (t0 + 4 < len) ? r : 0.f;
  o[0] = l * w0 + c[0] * w1 + c[1] * w2 + bias;
  o[1] = c[0] * w0 + c[1] * w1 + c[2] * w2 + bias;
  o[2] = c[1] * w0 + c[2] * w1 + c[3] * w2 + bias;
  o[3] = c[2] * w0 + c[3] * w1 + r * w2 + bias;
}

DI void hconv_item(const Params& p, int l, int o, int c, int bp, char* smem) {
  float2* lds = (float2*)smem;
  const int tid = opq(threadIdx.x);
  u16* hyt = (u16*)(p.ws + OFF_HYT);
  const int b0 = bp * 2, b1 = b0 + 1;
  u16* z0p = hyt + (size_t)(b0 * 1536 + c) * TPB + CTX;
  u16* z1p = hyt + (size_t)(b1 * 1536 + c) * TPB + CTX;
  const int gc = (o + 1) * 512 + c;
  const u16* g0p = hyt + (size_t)(b0 * 1536 + gc) * TPB + CTX;
  const u16* g1p = hyt + (size_t)(b1 * 1536 + gc) * TPB + CTX;
  const float* cw = p.hy_conv_w + (size_t)l * 3 * 1536;
  const float* cb = p.hy_conv_b + (size_t)l * 1536;
  const float zw0 = cw[c], zw1 = cw[1536 + c], zw2 = cw[3072 + c], zbias = cb[c];
  const float gw0 = cw[gc], gw1 = cw[1536 + gc], gw2 = cw[3072 + gc], gbias = cb[gc];
  const float skip = p.hy_skip[l * 1024 + o * 512 + c];
  const h2_t* spe = (const h2_t*)(p.ws + OFF_SPEC) + (size_t)(o * 512 + c) * 2 * 8192;
  const h2_t* spo = spe + 8192;
  float2* Eg = (float2*)(p.ws + OFF_ESCR + (size_t)blockIdx.x * 65536);
  __syncthreads();
#pragma unroll 2
  for (int i = 0; i < 8; ++i) {
    const int t0 = 4 * (tid + 256 * i);
    float za[4], zb[4];
    if (o == 0) { dwc4(z0p, t0, SEQ, zw0, zw1, zw2, zbias, za); dwc4(z1p, t0, SEQ, zw0, zw1, zw2, zbias, zb); }
    else { ld4(z0p, t0, za); ld4(z1p, t0, zb); }
#pragma unroll
    for (int e = 0; e < 4; ++e) lds[fphys(t0 + e)] = make_float2(za[e], zb[e]);
  }
  __syncthreads();
  fft8192_conv(lds, tid, spe);
#pragma unroll 2
  for (int i = 0; i < 8; ++i) {
    const int t0 = 4 * (tid + 256 * i);
    float za[4], zb[4];
    if (o == 0) { dwc4(z0p, t0, SEQ, zw0, zw1, zw2, zbias, za); dwc4(z1p, t0, SEQ, zw0, zw1, zw2, zbias, zb); }
    else { ld4(z0p, t0, za); ld4(z1p, t0, zb); }
#pragma unroll
    for (int e = 0; e < 4; ++e) {
      Eg[t0 + e] = lds[fphys(t0 + e)];
      lds[fphys(t0 + e)] = cmul(make_float2(za[e], zb[e]), twid_rev((float)(t0 + e) * (1.f / 16384.f)));
    }
  }
  __syncthreads();
  fft8192_conv(lds, tid, spo);
#pragma unroll 2
  for (int i = 0; i < 8; ++i) {
    const int t0 = 4 * (tid + 256 * i);
    float za[4], zb[4], ga[4], gb[4];
    if (o == 0) { dwc4(z0p, t0, SEQ, zw0, zw1, zw2, zbias, za); dwc4(z1p, t0, SEQ, zw0, zw1, zw2, zbias, zb); }
    else { ld4(z0p, t0, za); ld4(z1p, t0, zb); }
    dwc4(g0p, t0, SEQ, gw0, gw1, gw2, gbias, ga);
    dwc4(g1p, t0, SEQ, gw0, gw1, gw2, gbias, gb);
#pragma unroll
    for (int e = 0; e < 4; ++e) {
      const int t = t0 + e;
      const float2 ov = cmulc(lds[fphys(t)], twid_rev((float)t * (1.f / 16384.f)));
      const float2 ev = Eg[t];
      const float y0 = (ev.x + ov.x) * (1.f / 16384.f), y1 = (ev.y + ov.y) * (1.f / 16384.f);
      Eg[t] = make_float2(ga[e] * (y0 + za[e] * skip), gb[e] * (y1 + zb[e] * skip));
    }
  }
  __syncthreads();
  u16* d0 = (o == 0) ? z0p : hyt + (size_t)(b0 * 1536 + 512 + c) * TPB + CTX;
  u16* d1 = (o == 0) ? z1p : hyt + (size_t)(b1 * 1536 + 512 + c) * TPB + CTX;
#pragma unroll 2
  for (int i = 0; i < 8; ++i) {
    const int t0 = 4 * (tid + 256 * i);
    float2 e4[4];
#pragma unroll
    for (int e = 0; e < 4; ++e) e4[e] = Eg[t0 + e];
    *(u32x2*)(d0 + t0) = u32x2{pack2(e4[0].x, e4[1].x), pack2(e4[2].x, e4[3].x)};
    *(u32x2*)(d1 + t0) = u32x2{pack2(e4[0].y, e4[1].y), pack2(e4[2].y, e4[3].y)};
  }
}

DI void hctx_item(const Params& p, int l, int c, char* smem) {
  float* lf = (float*)smem;
  float* kern = lf;
  float* zb = lf + 1024;
  float* z1b = lf + 2048;
  float* red = lf + 3072;
  const int tid = opq(threadIdx.x), lane = tid & 63, wave = tid >> 6;
  const float* hid = (const float*)(p.ws + OFF_HID + l * HID_LAYER) + 64 * 8192;
  const float* w3 = p.hy_w3 + (size_t)l * 64 * 2048;
  const u16* hyt = (const u16*)(p.ws + OFF_HYT);
  const float* cw = p.hy_conv_w + (size_t)l * 3 * 1536;
  const float* cb = p.hy_conv_b + (size_t)l * 1536;
  __syncthreads();
  {
    const int t = tid;
    float d[4] = {0.f, 0.f, 0.f, 0.f};
#pragma unroll 4
    for (int j = 0; j < 64; ++j) {
      const float hv = hid[j * 256 + t];
#pragma unroll
      for (int q = 0; q < 4; ++q) d[q] += hv * w3[j * 2048 + (q >> 1) * 1024 + (q & 1) * 512 + c];
    }
    const float dec = __expf(-((float)t * (1.f / 255.f)) * (HY_D0 + (float)c * HY_DSTEP));
#pragma unroll
    for (int o = 0; o < 2; ++o) {
      const float f0 = d[o] * dec, f1 = d[2 + o] * dec;
      kern[o * 512 + t] = f0;
      if (t >= 1) kern[o * 512 + 512 - t] = f1;
      if (t == 0) kern[o * 512 + 256] = 0.f;
      float s = fabsf(f0) + (t >= 1 ? fabsf(f1) : 0.f);
      s = wave_sum(s);
      if (lane == 0) red[o * 4 + wave] = s;
    }
  }
  const int b = tid >> 6, tq = tid & 63;
  const u16* zs = hyt + (size_t)(b * 1536 + c) * TPB;
  const u16* g1s = hyt + (size_t)(b * 1536 + 512 + c) * TPB;
  const u16* g2s = hyt + (size_t)(b * 1536 + 1024 + c) * TPB;
#pragma unroll
  for (int k = 0; k < 4; ++k) {
    const int tt = tq + 64 * k;
    zb[b * 256 + tt] = dwc(zs, tt, CTX, cw[c], cw[1536 + c], cw[3072 + c], cb[c]);
  }
  __syncthreads();
  const float inv0 = 1.f / (red[0] + red[1] + red[2] + red[3]);
  const float inv1 = 1.f / (red[4] + red[5] + red[6] + red[7]);
  const float sk0 = p.hy_skip[l * 1024 + c], sk1 = p.hy_skip[l * 1024 + 512 + c];
#pragma unroll 1
  for (int k = 0; k < 4; ++k) {
    const int tt = tq + 64 * k;
    float acc = 0.f;
#pragma unroll 8
    for (int s = 0; s < 256; ++s) acc += kern[(tt - s) & 511] * zb[b * 256 + s];
    const float g = dwc(g1s, tt, CTX, cw[512 + c], cw[1536 + 512 + c], cw[3072 + 512 + c], cb[512 + c]);
    z1b[b * 256 + tt] = g * (acc * inv0 + zb[b * 256 + tt] * sk0);
  }
  __syncthreads();
  u16* yc = (u16*)(p.ws + OFF_HYT) + (size_t)(b * 1536 + 512 + c) * TPB;
#pragma unroll 1
  for (int k = 0; k < 4; ++k) {
    const int tt = tq + 64 * k;
    float acc = 0.f;
#pragma unroll 8
    for (int s = 0; s < 256; ++s) acc += kern[512 + ((tt - s) & 511)] * z1b[b * 256 + s];
    const float g = dwc(g2s, tt, CTX, cw[1024 + c], cw[1536 + 1024 + c], cw[3072 + 1024 + c], cb[1024 + c]);
    yc[tt] = DBG_ZERO_HCTX ? (u16)0 : f2bf(g * (acc * inv1 + z1b[b * 256 + tt] * sk1));
  }
  __syncthreads();
}

#define XB_XCNT(j) (256 + 64 * (j))
#define XB_XSUB(j) (1280 + 64 * (j))
#define XB_XGEN(j) (2304 + 64 * (j))
#define XB_TOP 3328
#define XB_TOPGEN 3392
DI unsigned xb_ld(unsigned* p) { return __hip_atomic_load(p, __ATOMIC_RELAXED, __HIP_MEMORY_SCOPE_AGENT); }
DI unsigned xb_add(unsigned* p, unsigned v) { return __hip_atomic_fetch_add(p, v, __ATOMIC_RELAXED, __HIP_MEMORY_SCOPE_AGENT); }
struct XBar { unsigned* bar; unsigned x, nloc, nx; };
DI void gsync_impl(cg::grid_group& g, XBar& b) {
#if DBG_CG_SYNC
  g.sync();
#else
  asm volatile("s_waitcnt vmcnt(0)" ::: "memory");
  __syncthreads();
  if (threadIdx.x == 0) {
    unsigned* bar = b.bar;
    __builtin_amdgcn_s_waitcnt(0);
    if (b.nloc == 0u) {
      unsigned sum, cnt, mine;
      for (;;) {
        sum = 0u; cnt = 0u; mine = 0u;
#pragma unroll
        for (unsigned j = 0; j < 16; ++j) { const unsigned c = xb_ld(&bar[XB_XCNT(j)]); sum += c; cnt += (c > 0u) ? 1u : 0u; mine = (j == b.x) ? c : mine; }
        if (sum == gridDim.x) break;
        __builtin_amdgcn_s_sleep(1);
      }
      b.nloc = mine > 0u ? mine : 1u; b.nx = cnt > 0u ? cnt : 1u;
    }
    const unsigned old = xb_add(&bar[XB_XSUB(b.x)], 1u);
    const unsigned gen = old / b.nloc;
    if (old + 1u == (gen + 1u) * b.nloc) {
      __builtin_amdgcn_fence(__ATOMIC_RELEASE, "agent");
      asm volatile("s_waitcnt vmcnt(0)" ::: "memory");
      const unsigned og = xb_add(&bar[XB_TOP], 1u);
      const unsigned tg = og / b.nx;
      if (og + 1u == (tg + 1u) * b.nx) xb_add(&bar[XB_TOPGEN], 1u);
      else { while (xb_ld(&bar[XB_TOPGEN]) == tg) __builtin_amdgcn_s_sleep(1); }
      __builtin_amdgcn_fence(__ATOMIC_ACQUIRE, "agent");
      xb_add(&bar[XB_XGEN(b.x)], 1u);
      asm volatile("s_waitcnt vmcnt(0)" ::: "memory");
    } else {
      while (xb_ld(&bar[XB_XGEN(b.x)]) == gen) __builtin_amdgcn_s_sleep(1);
      __builtin_amdgcn_fence(__ATOMIC_ACQUIRE, "agent");
      asm volatile("s_waitcnt vmcnt(0)" ::: "memory");
    }
  }
  __syncthreads();
#endif
}

#define gsync(G, E) gsync_impl(G, E)
DI int tile_map(int L, int MT, int NT) {
  const int per = 8 * NT;
  const int P = L / per, u = L - P * per;
  const int h = min(8, MT - P * 8);
  const int nt = u / h, mt = P * 8 + (u - nt * h);
  return mt * NT + nt;
}
__global__ void __launch_bounds__(256, 2) fwd_mega(Params p) {
  cg::grid_group grid = cg::this_grid();
  __shared__ __attribute__((aligned(16))) char smem[65536];
  const int nb = gridDim.x, bid = blockIdx.x;
  const int pb = ((nb & 7) == 0) ? (bid & 7) * (nb >> 3) + (bid >> 3) : bid;
  float* xctx = (float*)(p.ws + OFF_XCTX);
  u16* RH = (u16*)(p.ws + OFF_RH);
  u16* HP = (u16*)(p.ws + OFF_HP);
  XBar epoch;
  epoch.bar = (unsigned*)(p.ws + OFF_BAR);
  epoch.x = (unsigned)__builtin_amdgcn_s_getreg((3 << 11) | 20) & 0xFu;
  epoch.nloc = 0u; epoch.nx = 0u;
  if (threadIdx.x == 0) (void)xb_add(&epoch.bar[XB_XCNT(epoch.x)], 1u);
  {
    constexpr int NC0 = 2336;
    const int total = NC0 + 192 + 1536 + 528;
    for (int it = bid; it < total; it += nb) {
      if (it < NC0) conv_tile(p, 0, it, smem);
      else if (it < NC0 + 192) mod_item(p, it - NC0, smem);
      else if (it < NC0 + 192 + 1536) rope_item(p, it - NC0 - 192);
      else hid_item(p, it - NC0 - 192 - 1536, smem);
    }
  }
  if (p.ws == nullptr) grid.sync();
  gsync(grid, epoch);
  row_pass(p, 0, p.x, p.ctx, nullptr, nullptr, nullptr, nullptr, 0, 0, false, p.norm_g, 0, 0, 1024, RH, false);
  gsync(grid, epoch);
#pragma unroll 1
  for (int l = 0; l < 2; ++l) {
    const float* xl = (l == 0) ? p.x : p.out;
    const float* xc = (l == 0) ? p.ctx : xctx;
    for (int rep = 0; rep < DBG_REP_FFT; ++rep)
    for (int it = pb; it < 1024; it += nb) filt_item(p, l, it, smem);
    gsync(grid, epoch);
    for (int rep = 0; rep < DBG_REP_GEMM; ++rep)
    for (int it = pb; it < 4752; it += nb) inproj_tile(p, tile_map(it, 176, 27), smem);
    gsync(grid, epoch);
#if DBG_DUMP == 5
    { const _Float16* sp = (const _Float16*)(p.ws + OFF_SPEC);
      for (size_t i = (size_t)bid * 256 + threadIdx.x; i < (size_t)NBATCH * SEQ * DM; i += (size_t)nb * 256) p.out[i] = (float)sp[i];
      return; }
#endif
    {
      const int nSW = 2048 + (l == 0 ? 64 : 0);
      for (int rep = 0; rep < DBG_REP_GEMM; ++rep)
      for (int it = pb; it < 1408 + nSW; it += nb) {
        if (it < 1408) kvup_tile(p, tile_map(it, 176, 8), smem);
        else if (it < 1408 + 2048) {
          const int i1 = it - 1408, n = i1 & 63, jlo = (n == 0) ? 2 : 0, jhi = (n == 63) ? 4 : 6;
          attn_item<64, true>(p, l, i1 >> 9, (i1 >> 6) & 7, CTX + n * 128, 4, jhi - jlo, (n - 1) * 128 + 64 * jlo, smem);
        } else { const int i2 = it - 1408 - 2048; attn_item<64, true>(p, l, i2 >> 4, (i2 >> 1) & 7, (i2 & 1) * 128, 4, 0, 0, smem); }
      }
    }
    gsync(grid, epoch);
    {
      const int nF = 2048 + (l == 0 ? 64 : 0);
      for (int rep = 0; rep < DBG_REP_MLA; ++rep)
      for (int it = pb; it < nF; it += nb) {
        if (it < 2048) attn_item<96, false>(p, l, it >> 9, (it >> 6) & 7, CTX + (it & 63) * 128, 132, 0, 0, smem);
        else { const int i2 = it - 2048; attn_item<96, false>(p, l, i2 >> 4, (i2 >> 1) & 7, (i2 & 1) * 128, 4, 0, 0, smem); }
      }
    }
    gsync(grid, epoch);
    {
      const int nF2 = 1024 + (l == 0 ? 512 : 0);
      for (int it = pb; it < nF2; it += nb) {
        if (it < 1024) hconv_item(p, l, 0, it >> 1, it & 1, smem);
        else hctx_item(p, l, it - 1024, smem);
      }
    }
    gsync(grid, epoch);
    for (int rep = 0; rep < DBG_REP_FFT; ++rep)
    for (int it = pb; it < 1024; it += nb) hconv_item(p, l, 1, it >> 1, it & 1, smem);
    gsync(grid, epoch);
    for (int rep = 0; rep < DBG_REP_GEMM; ++rep)
    for (int it = pb; it < 1408; it += nb) merge_tile(p, tile_map(it, 176, 8), smem);
    if (l == 0 && pb >= 384 && nb > 384) for (int ct = 2336 + (pb - 384); ct < NCONV_TILES; ct += nb - 384) conv_tile(p, 0, ct, smem);
    gsync(grid, epoch);
    for (int rep = 0; rep < DBG_REP_GEMM * DBG_REP_PLAIN; ++rep)
    for (int it = pb; it < 1408; it += nb) plain_tile(p, tile_map(it, 176, 8), (const u16*)(p.ws + OFF_MERGED), 1024, 16, (const u16*)(p.ws + OFF_WT_OUT), (u16*)(p.ws + OFF_Y), smem);
    gsync(grid, epoch);
    row_pass(p, 1, xl, xc, p.out, xctx, (const u16*)(p.ws + OFF_Y), p.norm_g + (size_t)(l * 4 + 1) * 1024, 2048, l, true, p.norm_g + (size_t)(l * 4 + 2) * 1024, l, 3072, 4096, RH, false);
    gsync(grid, epoch);
    for (int rep = 0; rep < DBG_REP_GEMM; ++rep)
    for (int it = pb; it < 184 * 44; it += nb) ffnup_tile(p, l, tile_map(it, 184, 44), smem);
    gsync(grid, epoch);
    for (int rep = 0; rep < DBG_REP_GEMM * DBG_REP_PLAIN; ++rep)
    for (int it = pb; it < 1408; it += nb) plain_tile(p, tile_map(it, 176, 8), (const u16*)(p.ws + OFF_A), 2816, 44, (const u16*)(p.ws + OFF_WT_DOWN), HP, smem);
    if (l == 0 && pb >= 384 && nb > 384) for (int ct = pb - 384; ct < 1632; ct += nb - 384) conv_tile(p, 1, ct, smem);
    gsync(grid, epoch);
    row_pass(p, 1, p.out, xctx, p.out, xctx, HP, p.norm_g + (size_t)(l * 4 + 3) * 1024, 5120, l, l == 0, p.norm_g + (size_t)((l + 1) * 4) * 1024, l + 1, 0, 1024, RH, l == 1);
    if (l == 0) {
      for (int it = bid; it < NCONV_TILES - 1632; it += nb) conv_tile(p, 1, 1632 + it, smem);
      gsync(grid, epoch);
    }
  }
  for (int rep = 0; rep < DBG_EXTRA_SYNCS; ++rep) gsync(grid, epoch);
#if DBG_DUMP == 1
  gsync(grid, epoch);
  { const _Float16* sp = (const _Float16*)(p.ws + OFF_SPEC);
    for (size_t i = (size_t)bid * 256 + threadIdx.x; i < (size_t)NBATCH * SEQ * DM; i += (size_t)nb * 256) p.out[i] = (float)sp[i]; }
#elif DBG_DUMP == 3
  gsync(grid, epoch);
  { const float* hd = (const float*)(p.ws + OFF_HID);
    for (size_t i = (size_t)bid * 256 + threadIdx.x; i < (size_t)NBATCH * SEQ * DM; i += (size_t)nb * 256) p.out[i] = i < (size_t)2 * 64 * 8448 ? hd[i] : 0.f; }
#elif DBG_DUMP == 2
  gsync(grid, epoch);
  { const u16* yc = (const u16*)(p.ws + OFF_YCT);
    for (size_t i = (size_t)bid * 256 + threadIdx.x; i < (size_t)NBATCH * SEQ * DM; i += (size_t)nb * 256) p.out[i] = i < (size_t)4 * 512 * TPB ? bf2f(yc[i]) : 0.f; }
#endif
}

extern "C" void kernel_launch(void* const* d_in, const int* in_sizes, int n_in, void* d_out, int out_size, void* d_ws, size_t ws_size,
                              hipStream_t stream) {
  static int grid_blocks = 0;
  if (!grid_blocks) {
    int dev = 0, cus = 0, per_cu = 0;
    (void)hipGetDevice(&dev);
    (void)hipDeviceGetAttribute(&cus, hipDeviceAttributeMultiprocessorCount, dev);
    (void)hipOccupancyMaxActiveBlocksPerMultiprocessor(&per_cu, fwd_mega, 256, 0);
    if (per_cu > 2) per_cu = 2;
    if (per_cu < 1) per_cu = 1;
    grid_blocks = cus * per_cu;
  }
  if (ws_size < WS_NEED) { fprintf(stderr, "workspace too small: %zu < %zu\n", ws_size, (size_t)WS_NEED); return; }
  Params p{};
  const float** pp = (const float**)&p;
  for (int i = 0; i < 26; ++i) pp[i] = (const float*)d_in[i];
  p.out = (float*)d_out;
  p.ws = (char*)d_ws;
  (void)hipMemsetAsync((char*)d_ws + OFF_BAR, 0, BAR_BYTES, stream);
  void* args[] = {&p};
  hipError_t e = hipLaunchCooperativeKernel((void*)fwd_mega, dim3(grid_blocks), dim3(256), args, 0, stream);
  if (e != hipSuccess) fprintf(stderr, "cooperative launch failed: %s (grid %d)\n", hipGetErrorString(e), grid_blocks);
}
```

```cpp
#include <hip/hip_runtime.h>
#include <hip/hip_cooperative_groups.h>
#include <cstdio>
namespace cg = cooperative_groups;
#define DI __device__ __forceinline__
typedef unsigned short u16;
typedef __attribute__((ext_vector_type(8))) short bf16x8;
typedef __attribute__((ext_vector_type(4))) short s16x4;
typedef __attribute__((ext_vector_type(16))) float f32x16;
typedef __attribute__((ext_vector_type(4))) unsigned u32x4;
typedef __attribute__((ext_vector_type(2))) unsigned u32x2;
typedef __attribute__((ext_vector_type(2))) __bf16 bf2_t;
typedef __attribute__((ext_vector_type(2))) float f2_t;
typedef __attribute__((ext_vector_type(2))) _Float16 h2_t;
#define MFMA(a, b, c) __builtin_amdgcn_mfma_f32_32x32x16_bf16((a), (b), (c), 0, 0, 0)

constexpr int DM = 1024, NBATCH = 4, SEQ = 8192, CTX = 256, TPB = 8448, MTOK = 33792;
constexpr int DFF = 2816;
#ifndef DBG_ZERO_HCTX
#define DBG_ZERO_HCTX 0
#endif
#ifndef DBG_DUMP
#define DBG_DUMP 0
#endif
#ifndef DBG_NOFFT
#define DBG_NOFFT 0
#endif
#ifndef DBG_SPLITC
#define DBG_SPLITC 0
#endif
#ifndef DBG_REP_GEMM
#define DBG_REP_GEMM 1
#endif
#ifndef DBG_REP_MLA
#define DBG_REP_MLA 1
#endif
#ifndef DBG_HEAVY_SYNC
#define DBG_HEAVY_SYNC 0
#endif
#ifndef DBG_REP_FFT
#define DBG_REP_FFT 1
#endif
#ifndef DBG_REP_PLAIN
#define DBG_REP_PLAIN 1
#endif
#ifndef DBG_EXTRA_SYNCS
#define DBG_EXTRA_SYNCS 0
#endif
#ifndef DBG_CG_SYNC
#define DBG_CG_SYNC 0
#endif
#ifndef DBG_SKIP_BR
#define DBG_SKIP_BR 0
#endif
#define DBG_FIRST_BR ((DBG_SKIP_BR & 1) ? ((DBG_SKIP_BR & 2) ? 2 : 1) : 0)
constexpr float LOG2E = 1.4426950408889634f;
constexpr float EPS = 1e-6f;

struct Params {
  const float *x, *c, *ctx, *c_ctx, *w_mod, *b_mod, *norm_g, *w_in, *kv_norm_g, *w_kv_up, *swa_sink, *hy_conv_w, *hy_conv_b,
      *hy_w1, *hy_b1, *hy_w2, *hy_b2, *hy_freq, *hy_w3, *hy_skip, *w_branch, *w_out, *w_up, *ffn_conv_w, *ffn_conv_b, *w_down;
  float* out;
  char* ws;
};

constexpr size_t OFF_WT_IN = 0;
constexpr size_t OFF_WT_GATE = OFF_WT_IN + (size_t)3456 * 1024 * 2;
constexpr size_t OFF_WT_KV = OFF_WT_GATE + (size_t)3072 * 1024 * 2;
constexpr size_t OFF_WT_BR = OFF_WT_KV + (size_t)1024 * 256 * 2;
constexpr size_t OFF_WT_OUT = OFF_WT_BR + (size_t)3 * 1024 * 512 * 2;
constexpr size_t OFF_WT_UP = OFF_WT_OUT + (size_t)1024 * 1024 * 2;
constexpr size_t OFF_WT_DOWN = OFF_WT_UP + (size_t)5632 * 1024 * 2;
constexpr size_t OFF_RH = OFF_WT_DOWN + (size_t)1024 * 2816 * 2;
constexpr size_t OFF_KN = OFF_RH + (size_t)MTOK * 1024 * 2;
constexpr size_t OFF_VT = OFF_KN + (size_t)MTOK * 512 * 2;
constexpr size_t OFF_KR = OFF_VT + (size_t)MTOK * 512 * 2;
constexpr size_t OFF_Q = OFF_KR + (size_t)MTOK * 32 * 2;
constexpr size_t OFF_SQ = OFF_Q + (size_t)MTOK * 768 * 2;
constexpr size_t OFF_CKV = OFF_SQ + (size_t)MTOK * 512 * 2;
constexpr size_t OFF_SK = OFF_CKV + (size_t)MTOK * 256 * 2;
constexpr size_t OFF_SVT = OFF_SK + (size_t)MTOK * 128 * 2;
constexpr size_t OFF_HYT = OFF_SVT + (size_t)MTOK * 128 * 2;
constexpr size_t OFF_SPEC = OFF_HYT + (size_t)MTOK * 1536 * 2;
constexpr size_t OFF_XCTX = OFF_SPEC + (size_t)1024 * 2 * 8192 * 4;
constexpr size_t OFF_MOD = OFF_XCTX + (size_t)1024 * 1024 * 4;
constexpr size_t OFF_ROPE = OFF_MOD + (size_t)2 * 5 * 6144 * 4;
constexpr size_t OFF_HID = OFF_ROPE + (size_t)8192 * 96 * 4;
constexpr size_t HID_LAYER = (size_t)64 * (8192 + 256) * 4;
constexpr size_t OFF_ESCR = OFF_HID + 2 * HID_LAYER;
constexpr size_t OFF_BAR = OFF_ESCR + (size_t)512 * 65536;
constexpr size_t BAR_BYTES = 3456 * 4;
constexpr size_t WS_NEED = OFF_BAR + BAR_BYTES;
constexpr size_t OFF_A = OFF_Q;
constexpr size_t OFF_MERGED = OFF_KN;
constexpr size_t OFF_Y = OFF_HYT;
constexpr size_t OFF_HP = OFF_KN;
constexpr size_t OFF_YCT = OFF_RH;
constexpr size_t OFF_YA = OFF_RH + (size_t)MTOK * 512 * 2;
static_assert(OFF_A + (size_t)MTOK * 2816 * 2 <= OFF_SPEC, "A overlay");
static_assert(WS_NEED <= (size_t)512 * 1024 * 1024, "ws");

DI int opq(int x) { asm volatile("" : "+v"(x)); return x; }
DI float ldsc1(const float* p) { return __hip_atomic_load(p, __ATOMIC_RELAXED, __HIP_MEMORY_SCOPE_AGENT); }
DI float bf2f(u16 v) { return __uint_as_float(((unsigned)v) << 16); }
DI unsigned pack2(float a, float b) { f2_t v = {a, b}; return __builtin_bit_cast(unsigned, __builtin_convertvector(v, bf2_t)); }
DI u16 f2bf(float a) { return (u16)(pack2(a, 0.f) & 0xffffu); }
DI float lo_bf(unsigned u) { return __uint_as_float(u << 16); }
DI float hi_bf(unsigned u) { return __uint_as_float(u & 0xffff0000u); }
DI int crow(int i, int h) { return (i & 3) + 8 * (i >> 2) + 4 * h; }
DI float wave_sum(float v) {
#pragma unroll
  for (int o = 32; o > 0; o >>= 1) v += __shfl_xor(v, o);
  return v;
}
DI float sinrev(float r) { return __builtin_amdgcn_sinf(r - floorf(r)); }
DI float cosrev(float r) { return __builtin_amdgcn_cosf(r - floorf(r)); }
#if DBG_TRIVTW
#define COSREV(f) (1.0f)
#define SINREV(f) (0.0f * (f))
#else
#define COSREV(f) cosrev(f)
#define SINREV(f) sinrev(f)
#endif
#define SYNC() __syncthreads()
DI float2 cmul(float2 a, float2 b) { return make_float2(a.x * b.x - a.y * b.y, a.x * b.y + a.y * b.x); }
DI float2 cmulc(float2 a, float2 b) { return make_float2(a.x * b.x + a.y * b.y, a.y * b.x - a.x * b.y); }
#ifndef DBG_NOSWZ
#define DBG_NOSWZ 0
#endif
DI int fphys(int i) { return DBG_NOSWZ ? i : (i ^ ((i >> 4) & 15)); }
DI float2 twid_rev(float fr) { return make_float2(COSREV(fr), -SINREV(fr)); }

DI float2 root16(int e) {
  const float C1 = 0.92387953251128674f, S1 = 0.38268343236508977f, R = 0.70710678118654752f;
  switch (e) {
    case 0: return make_float2(1.f, 0.f);
    case 1: return make_float2(C1, -S1);
    case 2: return make_float2(R, -R);
    case 3: return make_float2(S1, -C1);
    case 4: return make_float2(0.f, -1.f);
    case 5: return make_float2(-S1, -C1);
    case 6: return make_float2(-R, -R);
    default: return make_float2(-C1, -S1);
  }
}
template <int R, int HALF, int S, bool INV, bool HASW>
DI void fft_stage(float2 (&v)[R], const float2 (&wp)[4]) {
#pragma unroll
  for (int idx = 0; idx < R / 2; ++idx) {
    const int blk = idx / HALF, jj = idx % HALF;
    const int j0 = blk * 2 * HALF + jj, j1 = j0 + HALF;
    const int e = jj * (8 / HALF);
    float2 tw = root16(e);
    if (HASW) { if (e == 0) tw = wp[S]; else tw = cmul(wp[S], tw); }
    const bool triv = (!HASW) && (e == 0);
    if (!INV) {
      float2 a = v[j0], b = v[j1];
      v[j0] = make_float2(a.x + b.x, a.y + b.y);
      float2 d = make_float2(a.x - b.x, a.y - b.y);
      v[j1] = triv ? d : cmul(d, tw);
    } else {
      float2 t = triv ? v[j1] : cmulc(v[j1], tw);
      float2 a = v[j0];
      v[j0] = make_float2(a.x + t.x, a.y + t.y);
      v[j1] = make_float2(a.x - t.x, a.y - t.y);
    }
  }
}
template <bool INV> DI void fft_local8(float2 (&v)[8], const float2 (&wp)[4]) {
  if (!INV) { fft_stage<8, 4, 0, false, true>(v, wp); fft_stage<8, 2, 1, false, true>(v, wp); fft_stage<8, 1, 2, false, true>(v, wp); }
  else      { fft_stage<8, 1, 2, true, true>(v, wp); fft_stage<8, 2, 1, true, true>(v, wp); fft_stage<8, 4, 0, true, true>(v, wp); }
}
template <bool INV> DI void fft_local16(float2 (&v)[16], const float2 (&wp)[4]) {
  if (!INV) { fft_stage<16, 8, 0, false, false>(v, wp); fft_stage<16, 4, 1, false, false>(v, wp); fft_stage<16, 2, 2, false, false>(v, wp); fft_stage<16, 1, 3, false, false>(v, wp); }
  else      { fft_stage<16, 1, 3, true, false>(v, wp); fft_stage<16, 2, 2, true, false>(v, wp); fft_stage<16, 4, 1, true, false>(v, wp); fft_stage<16, 8, 0, true, false>(v, wp); }
}

template <int LQ, bool INV> DI void fft_pass8(float2* lds, int tid) {
  constexpr int q = 1 << LQ;
#pragma unroll 1
  for (int it = 0; it < 4; ++it) {
    const int task = tid + 256 * it;
    const int p = task & (q - 1);
    const int g = task >> LQ;
    const int base = g * 8 * q + p;
    float2 v[8];
#pragma unroll
    for (int j = 0; j < 8; ++j) v[j] = lds[fphys(base + j * q)];
    float2 wp[4];
    wp[0] = twid_rev((float)p * (1.0f / (float)(8 * q)));
    wp[1] = cmul(wp[0], wp[0]);
    wp[2] = cmul(wp[1], wp[1]);
    wp[3] = wp[2];
    fft_local8<INV>(v, wp);
#pragma unroll
    for (int j = 0; j < 8; ++j) lds[fphys(base + j * q)] = v[j];
  }
}
template <bool INV> DI void fft_pass16(float2* lds, int tid) {
#pragma unroll 1
  for (int it = 0; it < 2; ++it) {
    const int g = tid + 256 * it;
    float2 v[16];
    const int sw = DBG_NOSWZ ? 0 : (g & 15);
#pragma unroll
    for (int j = 0; j < 16; ++j) v[j] = lds[g * 16 + (j ^ sw)];
    float2 wp[4] = {make_float2(1.f, 0.f), make_float2(1.f, 0.f), make_float2(1.f, 0.f), make_float2(1.f, 0.f)};
    fft_local16<INV>(v, wp);
#pragma unroll
    for (int j = 0; j < 16; ++j) lds[g * 16 + (j ^ sw)] = v[j];
  }
}
#ifndef DBG_FFTPASSES
#define DBG_FFTPASSES 15
#endif
DI void fft8192_fwd(float2* lds, int tid) {
  if (DBG_FFTPASSES & 1) { fft_pass8<10, false>(lds, tid); SYNC(); }
  if (DBG_FFTPASSES & 2) { fft_pass8<7, false>(lds, tid); SYNC(); }
  if (DBG_FFTPASSES & 4) { fft_pass8<4, false>(lds, tid); SYNC(); }
  if (DBG_FFTPASSES & 8) { fft_pass16<false>(lds, tid); SYNC(); }
}
DI void fft8192_inv(float2* lds, int tid) {
  fft_pass16<true>(lds, tid); SYNC();
  fft_pass8<4, true>(lds, tid); SYNC();
  fft_pass8<7, true>(lds, tid); SYNC();
  fft_pass8<10, true>(lds, tid); SYNC();
}

DI void fft_mid16(float2* lds, int tid, const h2_t* H) {
#pragma unroll 1
  for (int it = 0; it < 2; ++it) {
    const int g = tid + 256 * it;
    float2 v[16];
    const int sw = g & 15;
#pragma unroll
    for (int j = 0; j < 16; ++j) v[j] = lds[g * 16 + (j ^ sw)];
    const float2 wp[4] = {make_float2(1.f, 0.f), make_float2(1.f, 0.f), make_float2(1.f, 0.f), make_float2(1.f, 0.f)};
    const h2_t* hp = H + g * 16;
    h2_t hv[16];
#pragma unroll
    for (int j = 0; j < 16; ++j) hv[j] = hp[j];
    fft_local16<false>(v, wp);
#pragma unroll
    for (int j = 0; j < 16; ++j) v[j] = cmul(v[j], make_float2((float)hv[j][0], (float)hv[j][1]));
    fft_local16<true>(v, wp);
#pragma unroll
    for (int j = 0; j < 16; ++j) lds[g * 16 + (j ^ sw)] = v[j];
  }
}
DI void fft_last16_store(const float2* lds, int tid, h2_t* H) {
#pragma unroll 1
  for (int it = 0; it < 2; ++it) {
    const int g = tid + 256 * it;
    float2 v[16];
    const int sw = g & 15;
#pragma unroll
    for (int j = 0; j < 16; ++j) v[j] = lds[g * 16 + (j ^ sw)];
    const float2 wp[4] = {make_float2(1.f, 0.f), make_float2(1.f, 0.f), make_float2(1.f, 0.f), make_float2(1.f, 0.f)};
    fft_local16<false>(v, wp);
    h2_t* hp = H + g * 16;
#pragma unroll
    for (int j = 0; j < 16; ++j) { h2_t hv = {(_Float16)v[j].x, (_Float16)v[j].y}; hp[j] = hv; }
  }
}
DI void fft8192_conv(float2* lds, int tid, const h2_t* H) {
  fft_pass8<10, false>(lds, tid); SYNC();
  fft_pass8<7, false>(lds, tid); SYNC();
  fft_pass8<4, false>(lds, tid); SYNC();
  fft_mid16(lds, tid, H); SYNC();
  fft_pass8<4, true>(lds, tid); SYNC();
  fft_pass8<7, true>(lds, tid); SYNC();
  fft_pass8<10, true>(lds, tid); SYNC();
}
DI void fft8192_spectrum(float2* lds, int tid, h2_t* H) {
  fft_pass8<10, false>(lds, tid); SYNC();
  fft_pass8<7, false>(lds, tid); SYNC();
  fft_pass8<4, false>(lds, tid); SYNC();
  fft_last16_store(lds, tid, H); SYNC();
}

template <bool SWAP, bool ATR = false, int MTW = 2>
DI void gemm_main(const u16* __restrict__ A, int lda, int a_row0, int a_lo, int a_hi, int a_kstep,
                  const u16* __restrict__ B, int ldb, int nk, f32x16 (&acc)[MTW][2], char* smem) {
  constexpr int ROWS = MTW * 64, NA = MTW * 2;
  const int tid = opq(threadIdx.x), lane = tid & 63, wave = tid >> 6, wm = wave >> 1, wn = wave & 1, r = lane & 31, h = lane >> 5;
  char* sA = smem;
  char* sB = smem + ROWS * 144;
  const u16* ap[NA];
  const u16* bp[4];
  int loa[NA], lob[4];
#pragma unroll
  for (int i = 0; i < NA; ++i) {
    const int idx = tid + 256 * i, row = idx >> 3, ch = idx & 7;
    if (ATR) {
      ap[i] = A + (size_t)(idx & 63) * lda + a_row0 + (idx >> 6) * 8;
    } else {
      const int gr = min(max(a_row0 + row, a_lo), a_hi);
      ap[i] = A + (size_t)gr * lda + ch * 8;
    }
    loa[i] = row * 144 + ch * 16;
  }
#pragma unroll
  for (int i = 0; i < 4; ++i) {
    const int idx = tid + 256 * i, row = idx >> 3, ch = idx & 7;
    bp[i] = B + (size_t)row * ldb + ch * 8;
    lob[i] = row * 144 + ch * 16;
  }
  u32x4 ra0[NA], rb0[4];
#define GEMM_LOAD(RA, RB, KT)                                                                                         \
  _Pragma("unroll") for (int i = 0; i < NA; ++i)                                                                      \
    RA[i] = *(const u32x4*)(ap[i] + (ATR ? (size_t)(KT) * 64 * lda : (size_t)(KT) * a_kstep));                        \
  _Pragma("unroll") for (int i = 0; i < 4; ++i) RB[i] = *(const u32x4*)(bp[i] + (KT) * 64);
#define GEMM_STASH(RA, RB)                                                                                            \
  _Pragma("unroll") for (int i = 0; i < NA; ++i) {                                                                    \
    if (ATR) {                                                                                                        \
      const int idx = tid + 256 * i, krow = idx & 63, mch = idx >> 6;                                                 \
      _Pragma("unroll") for (int e = 0; e < 4; ++e) {                                                                 \
        *(u16*)(sA + (mch * 8 + 2 * e) * 144 + krow * 2) = (u16)(RA[i][e] & 0xffffu);                                 \
        *(u16*)(sA + (mch * 8 + 2 * e + 1) * 144 + krow * 2) = (u16)(RA[i][e] >> 16);                                 \
      }                                                                                                               \
    } else {                                                                                                          \
      *(u32x4*)(sA + loa[i]) = RA[i];                                                                                 \
    }                                                                                                                 \
  }                                                                                                                   \
  _Pragma("unroll") for (int i = 0; i < 4; ++i) *(u32x4*)(sB + lob[i]) = RB[i];
#define GEMM_COMPUTE()                                                                                                \
  __builtin_amdgcn_s_setprio(1);                                                                                      \
  _Pragma("unroll") for (int ks = 0; ks < 4; ++ks) {                                                                  \
    bf16x8 af[MTW], bfr[2];                                                                                           \
    _Pragma("unroll") for (int t = 0; t < MTW; ++t) af[t] = *(const bf16x8*)(pa + t * 32 * 144 + ks * 32);            \
    _Pragma("unroll") for (int t = 0; t < 2; ++t) bfr[t] = *(const bf16x8*)(pb + t * 32 * 144 + ks * 32);             \
    _Pragma("unroll") for (int mt = 0; mt < MTW; ++mt)                                                                \
      _Pragma("unroll") for (int nt = 0; nt < 2; ++nt)                                                                \
        acc[mt][nt] = SWAP ? MFMA(bfr[nt], af[mt], acc[mt][nt]) : MFMA(af[mt], bfr[nt], acc[mt][nt]);                 \
  }                                                                                                                   \
  __builtin_amdgcn_s_setprio(0);
  GEMM_LOAD(ra0, rb0, 0)
#pragma unroll
  for (int mt = 0; mt < MTW; ++mt)
#pragma unroll
    for (int nt = 0; nt < 2; ++nt)
#pragma unroll
      for (int i = 0; i < 16; ++i) acc[mt][nt][i] = 0.f;
  const char* pa = sA + (wm * (MTW * 32) + r) * 144 + h * 16;
  const char* pb = sB + (wn * 64 + r) * 144 + h * 16;
#pragma unroll 1
  for (int kk = 0; kk < nk; ++kk) {
    __syncthreads();
    GEMM_STASH(ra0, rb0)
    __syncthreads();
    if (kk + 1 < nk) { GEMM_LOAD(ra0, rb0, kk + 1) }
    GEMM_COMPUTE()
  }
#undef GEMM_LOAD
#undef GEMM_STASH
#undef GEMM_COMPUTE
}
template <int MTW>
DI void store_rowmajor(const f32x16 (&acc)[MTW][2], u16* C, int ldc, int m0, int ncol0, float scale) {
  const int tid = opq(threadIdx.x), lane = tid & 63, wave = tid >> 6, wm = wave >> 1, wn = wave & 1, r = lane & 31, h = lane >> 5;
#pragma unroll
  for (int mt = 0; mt < MTW; ++mt)
#pragma unroll
    for (int nt = 0; nt < 2; ++nt)
#pragma unroll
      for (int g = 0; g < 4; ++g) {
        const int m = m0 + wm * (MTW * 32) + mt * 32 + r, n = ncol0 + wn * 64 + nt * 32 + 8 * g + 4 * h;
        u32x2 pk;
        pk.x = pack2(acc[mt][nt][4 * g] * scale, acc[mt][nt][4 * g + 1] * scale);
        pk.y = pack2(acc[mt][nt][4 * g + 2] * scale, acc[mt][nt][4 * g + 3] * scale);
        *(u32x2*)(C + (size_t)m * ldc + n) = pk;
      }
}
template <int MTW>
DI void store_transposed(const f32x16 (&acc)[MTW][2], u16* T, int ldt, int trow0, int j0) {
  const int tid = opq(threadIdx.x), lane = tid & 63, wave = tid >> 6, wm = wave >> 1, wn = wave & 1, r = lane & 31, h = lane >> 5;
#pragma unroll
  for (int mt = 0; mt < MTW; ++mt)
#pragma unroll
    for (int nt = 0; nt < 2; ++nt)
#pragma unroll
      for (int g = 0; g < 4; ++g) {
        const int n = trow0 + wn * 64 + nt * 32 + r, m = j0 + wm * (MTW * 32) + mt * 32 + 8 * g + 4 * h;
        u32x2 pk;
        pk.x = pack2(acc[mt][nt][4 * g], acc[mt][nt][4 * g + 1]);
        pk.y = pack2(acc[mt][nt][4 * g + 2], acc[mt][nt][4 * g + 3]);
        *(u32x2*)(T + (size_t)n * ldt + m) = pk;
      }
}

constexpr int NCONV_TILES = 864 + 768 + 64 + 384 + 256 + 1408 + 704;
DI void conv_tile(const Params& p, int l, int tile, char* smem) {
  float* t = (float*)smem;
  const int tid = opq(threadIdx.x);
  int mat, tn, tk;
  if (tile < 864) { mat = 0; tn = tile / 16; tk = tile % 16; }
  else if (tile < 1632) { tile -= 864; mat = 1; tn = tile / 16; tk = tile % 16; }
  else if (tile < 1696) { tile -= 1632; mat = 2; tn = tile / 4; tk = tile % 4; }
  else if (tile < 2080) { tile -= 1696; mat = 3; tn = tile / 8; tk = tile % 8; }
  else if (tile < 2336) { tile -= 2080; mat = 4; tn = tile / 16; tk = tile % 16; }
  else if (tile < 3744) { tile -= 2336; mat = 5; tn = tile / 16; tk = tile % 16; }
  else { tile -= 3744; mat = 6; tn = tile / 44; tk = tile % 44; }
  const int k0 = tk * 64;
  const int nn = tid & 63;
  int np = tn * 64 + nn;
  const float* src; int ld; int col;
  if (mat == 0) { src = p.w_in + (size_t)l * 1024 * 6432; ld = 6432; col = np < 1024 ? np : (np < 3328 ? np + 32 : (np < 3360 ? np - 3328 + 1024 : -1)); }
  else if (mat == 1) { src = p.w_in + (size_t)l * 1024 * 6432; ld = 6432; col = 3360 + np; }
  else if (mat == 2) { src = p.w_kv_up + (size_t)l * 256 * 1024; ld = 1024; col = np < 512 ? (np >> 6) * 128 + (np & 63) : ((np - 512) >> 6) * 128 + 64 + (np & 63); }
  else if (mat == 3) { const int br = tn / 16; np = (tn % 16) * 64 + nn; src = p.w_branch + (size_t)(l * 3 + br) * 512 * 1024; ld = 1024; col = np; }
  else if (mat == 4) { src = p.w_out + (size_t)l * 1024 * 1024; ld = 1024; col = np; }
  else if (mat == 5) { src = p.w_up + (size_t)l * 1024 * 5632; ld = 5632; const int blk = np >> 7, rr = np & 127; col = rr < 64 ? blk * 64 + rr : 2816 + blk * 64 + rr - 64; }
  else { src = p.w_down + (size_t)l * 2816 * 1024; ld = 1024; col = np; }
#pragma unroll 4
  for (int i = 0; i < 16; ++i) {
    const int kk = (tid >> 6) + 4 * i;
    float v = 0.f;
    if (col >= 0) v = src[(size_t)(k0 + kk) * ld + col];
    if (mat == 2) v *= p.kv_norm_g[l * 256 + k0 + kk];
    t[kk * 65 + nn] = v;
  }
  __syncthreads();
  {
    const int n2 = tid >> 2, kq = (tid & 3) * 16;
    const int drow = tn * 64 + n2;
    u16* dst;
    if (mat == 0) dst = (u16*)(p.ws + OFF_WT_IN) + (size_t)drow * 1024;
    else if (mat == 1) dst = (u16*)(p.ws + OFF_WT_GATE) + (size_t)drow * 1024;
    else if (mat == 2) dst = (u16*)(p.ws + OFF_WT_KV) + (size_t)drow * 256;
    else if (mat == 3) dst = (u16*)(p.ws + OFF_WT_BR) + (size_t)drow * 512;
    else if (mat == 4) dst = (u16*)(p.ws + OFF_WT_OUT) + (size_t)drow * 1024;
    else if (mat == 5) dst = (u16*)(p.ws + OFF_WT_UP) + (size_t)drow * 1024;
    else dst = (u16*)(p.ws + OFF_WT_DOWN) + (size_t)drow * 2816;
    unsigned pk[8];
#pragma unroll
    for (int j = 0; j < 8; ++j) pk[j] = pack2(t[(kq + 2 * j) * 65 + n2], t[(kq + 2 * j + 1) * 65 + n2]);
    u32x4* d4 = (u32x4*)(dst + k0 + kq);
    d4[0] = u32x4{pk[0], pk[1], pk[2], pk[3]};
    d4[1] = u32x4{pk[4], pk[5], pk[6], pk[7]};
  }
  __syncthreads();
}

DI void mod_item(const Params& p, int item, char* smem) {
  float* sv = (float*)smem;
  float* red = sv + 5 * 1024;
  const int tid = opq(threadIdx.x);
  const int l = item / 96, cg0 = (item % 96) * 64;
  for (int i = tid; i < 5 * 1024; i += 256) {
    const int v = i >> 10, k = i & 1023;
    const float c = v < 4 ? p.c[v * 1024 + k] : p.c_ctx[k];
    sv[i] = c / (1.f + __expf(-c));
  }
  __syncthreads();
  const int kq = tid >> 6, cc = tid & 63, col = cg0 + cc;
  float a[5] = {0.f, 0.f, 0.f, 0.f, 0.f};
  const float* w = p.w_mod + (size_t)l * 1024 * 6144 + col;
#pragma unroll 8
  for (int k = kq * 256; k < kq * 256 + 256; ++k) {
    const float wv = w[(size_t)k * 6144];
#pragma unroll
    for (int v = 0; v < 5; ++v) a[v] += sv[v * 1024 + k] * wv;
  }
#pragma unroll
  for (int v = 0; v < 5; ++v) red[(kq * 5 + v) * 64 + cc] = a[v];
  __syncthreads();
  for (int i = tid; i < 5 * 64; i += 256) {
    const int v = i >> 6, c2 = i & 63;
    float s = p.b_mod[l * 6144 + cg0 + c2];
#pragma unroll
    for (int q = 0; q < 4; ++q) s += red[(q * 5 + v) * 64 + c2];
    ((float*)(p.ws + OFF_MOD))[(l * 5 + v) * 6144 + cg0 + c2] = s;
  }
  __syncthreads();
}

DI void rope_item(const Params& p, int item) {
  const int e = item * 256 + opq(threadIdx.x);
  const int pos = e / 48, f = e % 48;
  const int row = pos >> 6, colp = pos & 63;
  float* base = (float*)(p.ws + OFF_ROPE);
  float ang; float *cd, *sd;
  if (f < 16) {
    const int fi = f & 7;
    const float inv = exp2f(-(float)fi * (13.287712379549449f / 8.f));
    ang = (f < 8 ? (float)row : (float)colp) * inv;
    cd = base + pos * 16 + f; sd = base + 8192 * 16 + pos * 16 + f;
  } else {
    const int f2 = f - 16, fi = f2 & 15;
    const float inv = exp2f(-(float)fi * (13.287712379549449f / 16.f));
    ang = (f2 < 16 ? (float)row : (float)colp) * inv;
    cd = base + 2 * 8192 * 16 + pos * 32 + f2; sd = base + 2 * 8192 * 16 + 8192 * 32 + pos * 32 + f2;
  }
  const float rev = ang * 0.15915494309189535f;
  *cd = cosrev(rev);
  *sd = sinrev(rev);
}

DI void hid_item(const Params& p, int item, char* smem) {
  float* feat = (float*)smem;
  float* h1 = feat + 4 * 36;
  const int tid = opq(threadIdx.x);
  const int l = item / 264; const int it = item % 264;
  int L, pos00; float* dst;
  if (it < 256) { L = 8192; pos00 = it * 32; dst = (float*)(p.ws + OFF_HID + l * HID_LAYER); }
  else { L = 256; pos00 = (it - 256) * 32; dst = (float*)(p.ws + OFF_HID + l * HID_LAYER) + 64 * 8192; }
  const int pp = tid >> 6, j = tid & 63;
#pragma unroll 1
  for (int sub = 0; sub < 8; ++sub) {
    const int pos = pos00 + sub * 4 + pp;
    if (j < 33) {
      float fv;
      if (j == 0) fv = (float)pos / (float)(L - 1);
      else {
        const int bi = (j - 1) & 15;
        const float band = 1e-4f + (float)bi * ((15.f - 1e-4f) / 15.f);
        const float rev = (float)pos * band / (float)L;
        fv = (j <= 16) ? cosrev(rev) : -sinrev(rev);
      }
      feat[pp * 36 + j] = fv;
    }
    __syncthreads();
    {
      float s = p.hy_b1[l * 64 + j];
      const float* w1 = p.hy_w1 + (size_t)l * 33 * 64;
#pragma unroll
      for (int f = 0; f < 33; ++f) s += feat[pp * 36 + f] * w1[f * 64 + j];
      s *= p.hy_freq[l * 128 + j];
      h1[pp * 64 + j] = sinrev(s * 0.15915494309189535f);
    }
    __syncthreads();
    {
      float s = p.hy_b2[l * 64 + j];
      const float* w2 = p.hy_w2 + (size_t)l * 64 * 64;
#pragma unroll 8
      for (int i = 0; i < 64; ++i) s += h1[pp * 64 + i] * w2[i * 64 + j];
      s *= p.hy_freq[l * 128 + 64 + j];
      dst[(size_t)j * L + pos] = sinrev(s * 0.15915494309189535f);
    }
    __syncthreads();
  }
}

DI const float* xrow_src(const float* xl, const float* xc, int m) {
  const int b = m / TPB, j = m - b * TPB;
  return j < CTX ? xc + (size_t)(b * CTX + j) * DM : xl + (size_t)(b * SEQ + j - CTX) * DM;
}
DI void row_pass(const Params& p, int mode, const float* xl_src, const float* xc_src, float* xl_dst, float* xc_dst,
                 const u16* ybuf, const float* gy, int gate_off, int modl_gate,
                 bool has_next, const float* gn, int modl_next, int sh_off, int sc_off, u16* hdst, bool skip_ctx_rows) {
  const int tid0 = opq(threadIdx.x);
  const int lane = tid0 & 63;
  const int gw = blockIdx.x * 4 + (tid0 >> 6), nw = gridDim.x * 4;
  const float* modb = (const float*)(p.ws + OFF_MOD);
  const int per = (MTOK + nw - 1) / nw;
  const int m_beg = gw * per, m_end = min(m_beg + per, MTOK);
  int cur_v = -1;
  float4 gg[4], gs[4], shv[4];
#pragma unroll
  for (int i = 0; i < 4; ++i) { gg[i] = make_float4(0.f, 0.f, 0.f, 0.f); gs[i] = gg[i]; shv[i] = gg[i]; }
  const bool do_h = (mode == 0) || has_next;
  float4 xv_n[4];
  u32x2 yr_n[4];
#pragma unroll
  for (int i = 0; i < 4; ++i) { xv_n[i] = make_float4(0.f, 0.f, 0.f, 0.f); yr_n[i] = u32x2{0u, 0u}; }
  if (m_beg < m_end) {
    const float* xs0 = xrow_src(xl_src, xc_src, m_beg);
#pragma unroll
    for (int i = 0; i < 4; ++i) {
      xv_n[i] = *(const float4*)(xs0 + lane * 4 + 256 * i);
      if (mode == 1) yr_n[i] = *(const u32x2*)(ybuf + (size_t)m_beg * DM + lane * 4 + 256 * i);
    }
  }
  for (int m = m_beg; m < m_end; ++m) {
    const int b = m / TPB, j = m - b * TPB;
    float4 xv[4];
    u32x2 yr[4];
#pragma unroll
    for (int i = 0; i < 4; ++i) { xv[i] = xv_n[i]; yr[i] = yr_n[i]; }
    if (m + 1 < m_end) {
      const float* xs1 = xrow_src(xl_src, xc_src, m + 1);
#pragma unroll
      for (int i = 0; i < 4; ++i) {
        xv_n[i] = *(const float4*)(xs1 + lane * 4 + 256 * i);
        if (mode == 1) yr_n[i] = *(const u32x2*)(ybuf + (size_t)(m + 1) * DM + lane * 4 + 256 * i);
      }
    }
    if (skip_ctx_rows && j < CTX) continue;
    const int v = j < CTX ? 4 : b;
    if (v != cur_v) {
      cur_v = v;
#pragma unroll
      for (int i = 0; i < 4; ++i) {
        const int c = lane * 4 + 256 * i;
        if (mode == 1) {
          const float4 g4 = *(const float4*)(gy + c);
          const float4 t4 = *(const float4*)(modb + (size_t)(modl_gate * 5 + v) * 6144 + gate_off + c);
          gg[i] = make_float4(g4.x * t4.x, g4.y * t4.y, g4.z * t4.z, g4.w * t4.w);
        }
        if (do_h) {
          const float* mb = modb + (size_t)(modl_next * 5 + v) * 6144;
          const float4 g4 = *(const float4*)(gn + c);
          const float4 sc = *(const float4*)(mb + sc_off + c);
          shv[i] = *(const float4*)(mb + sh_off + c);
          gs[i] = make_float4(g4.x * (1.f + sc.x), g4.y * (1.f + sc.y), g4.z * (1.f + sc.z), g4.w * (1.f + sc.w));
        }
      }
    }
    if (mode == 1) {
      float yv[4][4];
      float ss = 0.f;
#pragma unroll
      for (int i = 0; i < 4; ++i) {
        const u32x2 u = yr[i];
        yv[i][0] = lo_bf(u.x); yv[i][1] = hi_bf(u.x); yv[i][2] = lo_bf(u.y); yv[i][3] = hi_bf(u.y);
#pragma unroll
        for (int e = 0; e < 4; ++e) ss += yv[i][e] * yv[i][e];
      }
      ss = wave_sum(ss);
      const float rstd = rsqrtf(ss * (1.f / DM) + EPS);
#pragma unroll
      for (int i = 0; i < 4; ++i) {
        xv[i].x += gg[i].x * (yv[i][0] * rstd);
        xv[i].y += gg[i].y * (yv[i][1] * rstd);
        xv[i].z += gg[i].z * (yv[i][2] * rstd);
        xv[i].w += gg[i].w * (yv[i][3] * rstd);
      }
      float* xd = (j < CTX) ? xc_dst + (size_t)(b * CTX + j) * DM : xl_dst + (size_t)(b * SEQ + j - CTX) * DM;
#pragma unroll
      for (int i = 0; i < 4; ++i) *(float4*)(xd + lane * 4 + 256 * i) = xv[i];
    }
    if (do_h) {
      float ss = 0.f;
#pragma unroll
      for (int i = 0; i < 4; ++i) ss += xv[i].x * xv[i].x + xv[i].y * xv[i].y + xv[i].z * xv[i].z + xv[i].w * xv[i].w;
      ss = wave_sum(ss);
      const float rstd = rsqrtf(ss * (1.f / DM) + EPS);
#pragma unroll
      for (int i = 0; i < 4; ++i) {
        const int c = lane * 4 + 256 * i;
        u32x2 pk;
        pk.x = pack2(xv[i].x * rstd * gs[i].x + shv[i].x, xv[i].y * rstd * gs[i].y + shv[i].y);
        pk.y = pack2(xv[i].z * rstd * gs[i].z + shv[i].z, xv[i].w * rstd * gs[i].w + shv[i].w);
        *(u32x2*)(hdst + (size_t)m * DM + c) = pk;
      }
    }
  }
}

constexpr float QS_MLA = 0.10206207261596577f * LOG2E;
constexpr float QS_SWA = 0.125f * LOG2E;

DI void rope32(f32x16& a, const float* cm, const float* sm, int pos, int h) {
#pragma unroll
  for (int i = 0; i < 8; ++i) {
    const int f = crow(i, h);
    const float c = cm[pos * 16 + f], s = sm[pos * 16 + f];
    const float x1 = a[i], x2 = a[i + 8];
    a[i] = x1 * c - x2 * s;
    a[i + 8] = x2 * c + x1 * s;
    if ((i & 3) == 3) __builtin_amdgcn_sched_barrier(0);
  }
}
DI void rope64(f32x16& a0, f32x16& a1, const float* cs, const float* ss, int pos, int h) {
#pragma unroll
  for (int i = 0; i < 16; ++i) {
    const int f = crow(i, h);
    const float c = cs[pos * 32 + f], s = ss[pos * 32 + f];
    const float x1 = a0[i], x2 = a1[i];
    a0[i] = x1 * c - x2 * s;
    a1[i] = x2 * c + x1 * s;
    if ((i & 3) == 3) __builtin_amdgcn_sched_barrier(0);
  }
}

DI void inproj_tile(const Params& p, int tile, char* smem) {
  const int mt_i = tile / 27, nt_i = tile % 27;
  const int m0 = mt_i * 192;
  const int tid = opq(threadIdx.x), lane = tid & 63, wave = tid >> 6, wm = wave >> 1, wn = wave & 1, r = lane & 31, h = lane >> 5;
  const u16* hbuf = (const u16*)(p.ws + OFF_RH);
  const u16* wt = (const u16*)(p.ws + OFF_WT_IN) + (size_t)nt_i * 128 * 1024;
  const int b = m0 / TPB, j0 = m0 - b * TPB;
  const float* cm = (const float*)(p.ws + OFF_ROPE);
  const float* sm = cm + 8192 * 16;
  const float* cs = sm + 8192 * 16;
  const float* ss = cs + 8192 * 32;
  f32x16 acc[3][2];
  if (nt_i >= 13 && nt_i <= 25) {
    gemm_main<false>(hbuf, 1024, m0, 0, MTOK - 1, 64, wt, 1024, 16, acc, smem);
    if (nt_i == 13) store_transposed(acc, (u16*)(p.ws + OFF_SVT), TPB, b * 128, j0);
    else store_transposed(acc, (u16*)(p.ws + OFF_HYT), TPB, b * 1536 + (nt_i - 14) * 128, j0);
    return;
  }
  gemm_main<true>(hbuf, 1024, m0, 0, MTOK - 1, 64, wt, 1024, 16, acc, smem);
  if (nt_i < 6) {
#pragma unroll
    for (int ntl = 0; ntl < 2; ++ntl) {
      const int s32 = nt_i * 4 + wn * 2 + ntl;
      if (s32 % 3 == 2) {
#pragma unroll
        for (int mt = 0; mt < 3; ++mt) {
          const int jr = j0 + wm * 96 + mt * 32 + r;
          if (jr >= CTX) rope32(acc[mt][ntl], cm, sm, jr - CTX, h);
        }
      }
    }
    store_rowmajor(acc, (u16*)(p.ws + OFF_Q), 768, m0, nt_i * 128, QS_MLA);
  } else if (nt_i < 8) {
    store_rowmajor(acc, (u16*)(p.ws + OFF_CKV), 256, m0, (nt_i - 6) * 128, 1.f);
  } else if (nt_i < 12) {
#pragma unroll
    for (int mt = 0; mt < 3; ++mt) {
      const int jr = j0 + wm * 96 + mt * 32 + r;
      if (jr >= CTX) rope64(acc[mt][0], acc[mt][1], cs, ss, jr - CTX, h);
    }
    store_rowmajor(acc, (u16*)(p.ws + OFF_SQ), 512, m0, (nt_i - 8) * 128, QS_SWA);
  } else if (nt_i == 12) {
#pragma unroll
    for (int mt = 0; mt < 3; ++mt) {
      const int jr = j0 + wm * 96 + mt * 32 + r;
      if (jr >= CTX) rope64(acc[mt][0], acc[mt][1], cs, ss, jr - CTX, h);
    }
    store_rowmajor(acc, (u16*)(p.ws + OFF_SK), 128, m0, 0, 1.f);
  } else {
    if (wn == 0) {
      u16* kr = (u16*)(p.ws + OFF_KR);
#pragma unroll
      for (int mt = 0; mt < 3; ++mt) {
        const int ml = wm * 96 + mt * 32 + r;
        if (j0 + ml >= CTX) rope32(acc[mt][0], cm, sm, j0 + ml - CTX, h);
#pragma unroll
        for (int g = 0; g < 4; ++g) {
          u32x2 pk;
          pk.x = pack2(acc[mt][0][4 * g], acc[mt][0][4 * g + 1]);
          pk.y = pack2(acc[mt][0][4 * g + 2], acc[mt][0][4 * g + 3]);
          *(u32x2*)(kr + (size_t)(m0 + ml) * 32 + 8 * g + 4 * h) = pk;
        }
      }
    }
  }
}

DI void kvup_tile(const Params& p, int tile, char* smem) {
  const int mt_i = tile >> 3, nt_i = tile & 7;
  const int m0 = mt_i * 192;
  const int tid = opq(threadIdx.x), lane = tid & 63, wave = tid >> 6, wm = wave >> 1, r = lane & 31, h = lane >> 5;
  const u16* ckv = (const u16*)(p.ws + OFF_CKV);
  float* rs = (float*)(smem + (192 + 128) * 144);
#pragma unroll
  for (int pass = 0; pass < 2; ++pass) {
    const int row = pass * 128 + (tid >> 1), half = tid & 1;
    const int rowc = min(row, 191);
    const u32x4* src = (const u32x4*)(ckv + (size_t)(m0 + rowc) * 256 + half * 128);
    float ss = 0.f;
#pragma unroll
    for (int i = 0; i < 16; ++i) {
      const u32x4 u = src[i];
      const unsigned w[4] = {u.x, u.y, u.z, u.w};
#pragma unroll
      for (int e = 0; e < 4; ++e) { const float a = lo_bf(w[e]), c = hi_bf(w[e]); ss += a * a + c * c; }
    }
    ss += __shfl_xor(ss, 1);
    if (half == 0 && row < 192) rs[row] = rsqrtf(ss * (1.f / 256.f) + EPS);
  }
  const u16* wt = (const u16*)(p.ws + OFF_WT_KV) + (size_t)nt_i * 128 * 256;
  const int b = m0 / TPB, j0 = m0 - b * TPB;
  f32x16 acc[3][2];
  if (nt_i < 4) {
    gemm_main<true>(ckv, 256, m0, 0, MTOK - 1, 64, wt, 256, 4, acc, smem);
#pragma unroll
    for (int mt = 0; mt < 3; ++mt) {
      const float sc = rs[wm * 96 + mt * 32 + r];
#pragma unroll
      for (int nt = 0; nt < 2; ++nt)
#pragma unroll
        for (int i = 0; i < 16; ++i) acc[mt][nt][i] *= sc;
    }
    store_rowmajor(acc, (u16*)(p.ws + OFF_KN), 512, m0, nt_i * 128, 1.f);
  } else {
    gemm_main<false>(ckv, 256, m0, 0, MTOK - 1, 64, wt, 256, 4, acc, smem);
#pragma unroll
    for (int mt = 0; mt < 3; ++mt)
#pragma unroll
      for (int i = 0; i < 16; ++i) {
        const float sc = rs[wm * 96 + mt * 32 + crow(i, h)];
        acc[mt][0][i] *= sc;
        acc[mt][1][i] *= sc;
      }
    store_transposed(acc, (u16*)(p.ws + OFF_VT), TPB, b * 512 + (nt_i - 4) * 128, j0);
  }
  __syncthreads();
}

DI void merge_tile(const Params& p, int tile, char* smem) {
  const int mt_i = tile >> 3, nt_i = tile & 7;
  const int m0 = mt_i * 192;
  const u16* hp = (const u16*)(p.ws + OFF_RH);
  const int tid = opq(threadIdx.x), lane = tid & 63, wave = tid >> 6, wm = wave >> 1, wn = wave & 1, r = lane & 31, h = lane >> 5;
  u16* C = (u16*)(p.ws + OFF_MERGED);
#pragma unroll 1
  for (int br = 0; br < 3; ++br) {
    if ((DBG_SKIP_BR >> br) & 1) continue;
    f32x16 acc[3][2];
    gemm_main<true>(hp, 1024, m0, 0, MTOK - 1, 64, (const u16*)(p.ws + OFF_WT_GATE) + (size_t)(br * 1024 + nt_i * 128) * 1024, 1024, 16, acc, smem);
    u32x2* sgp = (u32x2*)(p.ws + OFF_ESCR + (size_t)blockIdx.x * 65536) + tid * 24;
#pragma unroll
    for (int a = 0; a < 3; ++a)
#pragma unroll
      for (int b2 = 0; b2 < 2; ++b2)
#pragma unroll
        for (int g = 0; g < 4; ++g) {
          u32x2 v;
          v.x = pack2(1.f / (1.f + __expf(-acc[a][b2][4 * g])), 1.f / (1.f + __expf(-acc[a][b2][4 * g + 1])));
          v.y = pack2(1.f / (1.f + __expf(-acc[a][b2][4 * g + 2])), 1.f / (1.f + __expf(-acc[a][b2][4 * g + 3])));
          sgp[(a * 2 + b2) * 4 + g] = v;
        }
    const u16* wbr = (const u16*)(p.ws + OFF_WT_BR) + (size_t)(br * 1024 + nt_i * 128) * 512;
    if (br == 0) gemm_main<true>((const u16*)(p.ws + OFF_Q), 768, m0, 0, MTOK - 1, 96, wbr, 512, 8, acc, smem);
    else if (br == 1) gemm_main<true>((const u16*)(p.ws + OFF_SQ), 512, m0, 0, MTOK - 1, 64, wbr, 512, 8, acc, smem);
    else {
      const int b = m0 / TPB, j0 = m0 - b * TPB;
      gemm_main<true, true>((const u16*)(p.ws + OFF_HYT) + (size_t)(b * 1536 + 512) * TPB, TPB, j0, 0, 0, 64, wbr, 512, 8, acc, smem);
    }
#pragma unroll
    for (int mt = 0; mt < 3; ++mt)
#pragma unroll
      for (int nt = 0; nt < 2; ++nt)
#pragma unroll
        for (int g = 0; g < 4; ++g) {
          const int m = m0 + wm * 96 + mt * 32 + r, n = nt_i * 128 + wn * 64 + nt * 32 + 8 * g + 4 * h;
          u32x2* dst = (u32x2*)(C + (size_t)m * 1024 + n);
          u32x2 prev = {0u, 0u};
          if (br > DBG_FIRST_BR) prev = *dst;
          const u32x2 sv = sgp[(mt * 2 + nt) * 4 + g];
          const unsigned s0 = sv.x, s1 = sv.y;
          u32x2 nv;
          nv.x = pack2(lo_bf(prev.x) + lo_bf(s0) * acc[mt][nt][4 * g], hi_bf(prev.x) + hi_bf(s0) * acc[mt][nt][4 * g + 1]);
          nv.y = pack2(lo_bf(prev.y) + lo_bf(s1) * acc[mt][nt][4 * g + 2], hi_bf(prev.y) + hi_bf(s1) * acc[mt][nt][4 * g + 3]);
          *dst = nv;
          __builtin_amdgcn_sched_barrier(0);
        }
  }
}

DI void plain_tile(const Params& p, int tile, const u16* A, int lda, int nk, const u16* W, u16* C, char* smem) {
  const int mt_i = tile >> 3, nt_i = tile & 7;
  f32x16 acc[3][2];
  gemm_main<true>(A, lda, mt_i * 192, 0, MTOK - 1, 64, W + (size_t)nt_i * 128 * lda, lda, nk, acc, smem);
  store_rowmajor(acc, C, 1024, mt_i * 192, nt_i * 128, 1.f);
}

DI void ffnup_tile(const Params& p, int l, int tile, char* smem) {
  const int mt_i = tile / 44, nt_i = tile % 44;
  const int b = mt_i / 46, ti = mt_i % 46;
  int seq_base, len, r0;
  if (ti < 2) { seq_base = b * TPB; len = CTX; r0 = 190 * ti; }
  else { seq_base = b * TPB + CTX; len = SEQ; r0 = 190 * (ti - 2); }
  const int tid = opq(threadIdx.x), lane = tid & 63, wave = tid >> 6, wm = wave >> 1, wn = wave & 1, r = lane & 31, h = lane >> 5;
  f32x16 acc[3][2];
  gemm_main<true>((const u16*)(p.ws + OFF_RH), 1024, seq_base + r0 - 1, seq_base, seq_base + len - 1, 64,
                  (const u16*)(p.ws + OFF_WT_UP) + (size_t)nt_i * 128 * 1024, 1024, 16, acc, smem);
  __syncthreads();
#pragma unroll
  for (int mt = 0; mt < 3; ++mt) {
    const int ml = wm * 96 + mt * 32 + r;
    const int pos = r0 - 1 + ml;
    const bool valid = pos >= 0 && pos < len;
#pragma unroll
    for (int nt = 0; nt < 2; ++nt)
#pragma unroll
      for (int g = 0; g < 4; ++g) {
        u32x2 pk = u32x2{0u, 0u};
        if (valid) {
          pk.x = pack2(acc[mt][nt][4 * g], acc[mt][nt][4 * g + 1]);
          pk.y = pack2(acc[mt][nt][4 * g + 2], acc[mt][nt][4 * g + 3]);
        }
        *(u32x2*)(smem + ml * 272 + (wn * 64 + nt * 32 + 8 * g + 4 * h) * 2) = pk;
      }
  }
  __syncthreads();
  {
    const int j4 = (tid & 15) * 4, tr = tid >> 4;
    const float* cw = p.ffn_conv_w + (size_t)l * 3 * 5632;
    const float* cb = p.ffn_conv_b + (size_t)l * 5632;
    const int cha = nt_i * 64 + j4, chb = DFF + cha;
    float wa[3][4], wb[3][4], ba[4], bb[4];
#pragma unroll
    for (int e = 0; e < 4; ++e) {
#pragma unroll
      for (int d = 0; d < 3; ++d) { wa[d][e] = cw[d * 5632 + cha + e]; wb[d][e] = cw[d * 5632 + chb + e]; }
      ba[e] = cb[cha + e]; bb[e] = cb[chb + e];
    }
    u16* Aout = (u16*)(p.ws + OFF_A);
#pragma unroll 1
    for (int i = 0; i < 12; ++i) {
      const int t = 1 + tr + 16 * i;
      const int pos = r0 - 1 + t;
      if (t <= 190 && pos < len) {
        float ca[4], cbv[4];
#pragma unroll
        for (int e = 0; e < 4; ++e) { ca[e] = ba[e]; cbv[e] = bb[e]; }
#pragma unroll
        for (int d = 0; d < 3; ++d) {
          const u32x2 ua = *(const u32x2*)(smem + (t - 1 + d) * 272 + j4 * 2);
          const u32x2 ub = *(const u32x2*)(smem + (t - 1 + d) * 272 + (64 + j4) * 2);
          ca[0] += lo_bf(ua.x) * wa[d][0]; ca[1] += hi_bf(ua.x) * wa[d][1]; ca[2] += lo_bf(ua.y) * wa[d][2]; ca[3] += hi_bf(ua.y) * wa[d][3];
          cbv[0] += lo_bf(ub.x) * wb[d][0]; cbv[1] += hi_bf(ub.x) * wb[d][1]; cbv[2] += lo_bf(ub.y) * wb[d][2]; cbv[3] += hi_bf(ub.y) * wb[d][3];
        }
        float o[4];
#pragma unroll
        for (int e = 0; e < 4; ++e) o[e] = ca[e] / (1.f + __expf(-ca[e])) * cbv[e];
        *(u32x2*)(Aout + (size_t)(seq_base + pos) * DFF + cha) = u32x2{pack2(o[0], o[1]), pack2(o[2], o[3])};
      }
    }
  }
}

template <int DQK, bool SWA>
DI void attn_item(const Params& p, int l, int b, int hq, int jq0  , int nct, int nband, int kp_start, char* smem) {
  constexpr int KS = DQK * 2 + 16;
  constexpr int KCH = DQK / 8;
  constexpr int NKC = 64 * KCH / 256;
  constexpr int NKS = DQK / 16;
  constexpr int BUFSZ = 22016;
  const int tid = opq(threadIdx.x), lane = tid & 63, wave = tid >> 6, r = lane & 31, h = lane >> 5;
  const int brow = b * TPB;
  const int ntiles = nct + nband;
  const u16* K1; int ldk1, koff; const u16* KR = (const u16*)(p.ws + OFF_KR);
  const u16* Vb; u16* outp; int ldo, ooff; const u16* Qb; int ldq;
  if (!SWA) {
    K1 = (const u16*)(p.ws + OFF_KN); ldk1 = 512; koff = hq * 64;
    Vb = (const u16*)(p.ws + OFF_VT) + (size_t)((b * 8 + hq) * 64) * TPB;
    Qb = (const u16*)(p.ws + OFF_Q); ldq = 768;
    outp = (u16*)(p.ws + OFF_Q); ldo = 768; ooff = hq * 96;
  } else {
    const int kvh = hq >> 2;
    K1 = (const u16*)(p.ws + OFF_SK); ldk1 = 128; koff = kvh * 64;
    Vb = (const u16*)(p.ws + OFF_SVT) + (size_t)((b * 2 + kvh) * 64) * TPB;
    Qb = (const u16*)(p.ws + OFF_SQ); ldq = 512;
    outp = (u16*)(p.ws + OFF_SQ); ldo = 512; ooff = hq * 64;
  }
  const int qrow = brow + jq0 + wave * 32 + r;
  bf16x8 qf[NKS];
#pragma unroll
  for (int ks = 0; ks < NKS; ++ks) qf[ks] = *(const bf16x8*)(Qb + (size_t)qrow * ldq + hq * DQK + ks * 16 + h * 8);
  f32x16 o[2];
#pragma unroll
  for (int dt = 0; dt < 2; ++dt)
#pragma unroll
    for (int i = 0; i < 16; ++i) o[dt][i] = 0.f;
  float mrun = -INFINITY, lsum = 0.f;
  u32x4 kreg[NKC], vreg[2];
  auto tile_j = [&](int it) { return it < nct ? it * 64 : CTX + kp_start + 64 * (it - nct); };
  auto issue = [&](int it) {
    const int jr = tile_j(it);
#pragma unroll
    for (int i = 0; i < NKC; ++i) {
      const int c = tid + 256 * i, key = c / KCH, part = c % KCH;
      const u16* src = (part < 8) ? K1 + (size_t)(brow + jr + key) * ldk1 + koff + part * 8
                                  : KR + (size_t)(brow + jr + key) * 32 + (part - 8) * 8;
      kreg[i] = *(const u32x4*)src;
    }
#pragma unroll
    for (int i = 0; i < 2; ++i) {
      const int c = tid + 256 * i, d = c >> 3, part = c & 7;
      vreg[i] = *(const u32x4*)(Vb + (size_t)d * TPB + jr + part * 8);
    }
  };
  auto stash = [&](int buf) {
    char* kb = smem + buf * BUFSZ;
    char* vb = kb + 13312;
#pragma unroll
    for (int i = 0; i < NKC; ++i) {
      const int c = tid + 256 * i, key = c / KCH, part = c % KCH;
      *(u32x4*)(kb + key * KS + part * 16) = kreg[i];
    }
#pragma unroll
    for (int i = 0; i < 2; ++i) {
      const int c = tid + 256 * i, d = c >> 3, part = c & 7;
      *(u32x2*)(vb + d * 136 + part * 16) = u32x2{vreg[i].x, vreg[i].y};
      *(u32x2*)(vb + d * 136 + part * 16 + 8) = u32x2{vreg[i].z, vreg[i].w};
    }
  };
  __syncthreads();
  issue(0);
  stash(0);
  __syncthreads();
  const int qpos = jq0 - CTX + wave * 32 + r;
#pragma unroll 1
  for (int it = 0; it < ntiles; ++it) {
    const int buf = it & 1;
    const char* kb = smem + buf * BUFSZ;
    const char* vb = kb + 13312;
    if (it + 1 < ntiles) issue(it + 1);
    f32x16 s[2];
#pragma unroll
    for (int kt = 0; kt < 2; ++kt) {
#pragma unroll
      for (int i = 0; i < 16; ++i) s[kt][i] = 0.f;
#pragma unroll
      for (int ks = 0; ks < NKS; ++ks) {
        const bf16x8 kf = *(const bf16x8*)(kb + (kt * 32 + r) * KS + ks * 32 + h * 16);
        s[kt] = MFMA(kf, qf[ks], s[kt]);
      }
    }
    if (SWA && it >= nct) {
      const int kpos0 = kp_start + 64 * (it - nct);
#pragma unroll
      for (int kt = 0; kt < 2; ++kt)
#pragma unroll
        for (int i = 0; i < 16; ++i) {
          const int diff = qpos - (kpos0 + kt * 32 + crow(i, h));
          if (diff > 128 || diff < -128) s[kt][i] = -1e30f;
        }
    }
    float mx = s[0][0];
#pragma unroll
    for (int kt = 0; kt < 2; ++kt)
#pragma unroll
      for (int i = 0; i < 16; ++i) mx = fmaxf(mx, s[kt][i]);
    mx = fmaxf(mx, __shfl_xor(mx, 32));
    const float mnew = fmaxf(mrun, mx);
    const float alpha = __builtin_amdgcn_exp2f(mrun - mnew);
    float ps = 0.f;
#pragma unroll
    for (int kt = 0; kt < 2; ++kt)
#pragma unroll
      for (int i = 0; i < 16; ++i) { const float e = __builtin_amdgcn_exp2f(s[kt][i] - mnew); s[kt][i] = e; ps += e; }
    if (__builtin_amdgcn_ballot_w64(mnew != mrun) != 0ull) {
      lsum *= alpha;
#pragma unroll
      for (int dt = 0; dt < 2; ++dt)
#pragma unroll
        for (int i = 0; i < 16; ++i) o[dt][i] *= alpha;
    }
    lsum += ps;
    mrun = mnew;
#pragma unroll
    for (int kt = 0; kt < 2; ++kt)
#pragma unroll
      for (int s2 = 0; s2 < 2; ++s2) {
        unsigned pk[4];
#pragma unroll
        for (int j = 0; j < 4; ++j) pk[j] = pack2(s[kt][8 * s2 + 2 * j], s[kt][8 * s2 + 2 * j + 1]);
        const bf16x8 pf = __builtin_bit_cast(bf16x8, u32x4{pk[0], pk[1], pk[2], pk[3]});
#pragma unroll
        for (int dt = 0; dt < 2; ++dt) {
          const char* vp = vb + (dt * 32 + r) * 136 + (kt * 32 + 16 * s2 + 4 * h) * 2;
          const s16x4 lo = *(const s16x4*)vp;
          const s16x4 hi = *(const s16x4*)(vp + 16);
          const bf16x8 vf = __builtin_shufflevector(lo, hi, 0, 1, 2, 3, 4, 5, 6, 7);
          o[dt] = MFMA(vf, pf, o[dt]);
        }
      }
    if (it + 1 < ntiles) stash(buf ^ 1);
    __syncthreads();
  }
  float ltot = lsum + __shfl_xor(lsum, 32);
  if (SWA) ltot += __builtin_amdgcn_exp2f(p.swa_sink[l * 8 + hq] * LOG2E - mrun);
  const float inv = 1.f / ltot;
#pragma unroll
  for (int dt = 0; dt < 2; ++dt)
#pragma unroll
    for (int g = 0; g < 4; ++g) {
      u32x2 pk;
      pk.x = pack2(o[dt][4 * g] * inv, o[dt][4 * g + 1] * inv);
      pk.y = pack2(o[dt][4 * g + 2] * inv, o[dt][4 * g + 3] * inv);
      *(u32x2*)(outp + (size_t)qrow * ldo + ooff + dt * 32 + 8 * g + 4 * h) = pk;
    }
}

constexpr float HY_D0 = 3.0701134573253944f;
constexpr float HY_DSTEP = (15.350567286626972f - 3.0701134573253944f) / 511.f;

DI void filt_item(const Params& p, int l, int oc, char* smem) {
  float2* lds = (float2*)smem;
  float* lf = (float*)smem;
  const int tid = opq(threadIdx.x), lane = tid & 63, wave = tid >> 6;
  const int c = oc & 511;
  const float* hid = (const float*)(p.ws + OFF_HID + l * HID_LAYER);
  const float* w3 = p.hy_w3 + (size_t)l * 64 * 2048;
  float* sa = (float*)(p.ws + OFF_ESCR + (size_t)blockIdx.x * 65536);
  float* sb = sa + 8192;
  __syncthreads();
  if (tid < 128) { const int dir = tid >> 6, j = tid & 63; lf[tid] = w3[j * 2048 + dir * 1024 + oc]; }
  __syncthreads();
  const float delta = HY_D0 + (float)c * HY_DSTEP;
  float asum = 0.f;
#pragma unroll 1
  for (int ib = 0; ib < 4; ++ib) {
    float a[8], bm[8];
#pragma unroll
    for (int i = 0; i < 8; ++i) { a[i] = 0.f; bm[i] = 0.f; }
#pragma unroll 4
    for (int j = 0; j < 64; ++j) {
      const float w0 = lf[j], w1 = lf[64 + j];
      const float* hr = hid + (size_t)j * 8192 + 4 * (tid + 512 * ib);
#pragma unroll
      for (int ii = 0; ii < 2; ++ii) {
        const float4 hv = *(const float4*)(hr + 1024 * ii);
        a[4 * ii + 0] += hv.x * w0; bm[4 * ii + 0] += hv.x * w1;
        a[4 * ii + 1] += hv.y * w0; bm[4 * ii + 1] += hv.y * w1;
        a[4 * ii + 2] += hv.z * w0; bm[4 * ii + 2] += hv.z * w1;
        a[4 * ii + 3] += hv.w * w0; bm[4 * ii + 3] += hv.w * w1;
      }
    }
#pragma unroll
    for (int ii = 0; ii < 2; ++ii) {
      const int t0 = 4 * (tid + 256 * (2 * ib + ii));
      float av[4];
#pragma unroll
      for (int e = 0; e < 4; ++e) {
        const int t = t0 + e;
        const float dec = __expf(-((float)t * (1.f / 8191.f)) * delta);
        av[e] = a[4 * ii + e] * dec;
        const float bv = bm[4 * ii + e] * dec;
        if (t >= 1) { sb[8192 - t] = bv; asum += fabsf(bv); } else sb[0] = 0.f;
        asum += fabsf(av[e]);
      }
      *(float4*)(sa + t0) = make_float4(av[0], av[1], av[2], av[3]);
    }
  }
  asum = wave_sum(asum);
  asm volatile("s_waitcnt vmcnt(0)" ::: "memory");
  __syncthreads();
  if (lane == 0) lf[wave] = asum;
  __syncthreads();
  const float inv = 1.f / (lf[0] + lf[1] + lf[2] + lf[3]);
  __syncthreads();
#pragma unroll 2
  for (int i = 0; i < 8; ++i) {
    const int t0 = 4 * (tid + 256 * i);
#pragma unroll
    for (int e = 0; e < 4; ++e) lds[fphys(t0 + e)] = make_float2((ldsc1(sa + t0 + e) + ldsc1(sb + t0 + e)) * inv, 0.f);
  }
  __syncthreads();
  h2_t* sp = (h2_t*)(p.ws + OFF_SPEC) + (size_t)oc * 2 * 8192;
  fft8192_spectrum(lds, tid, sp);
#pragma unroll 2
  for (int i = 0; i < 8; ++i) {
    const int t0 = 4 * (tid + 256 * i);
#pragma unroll
    for (int e = 0; e < 4; ++e) {
      const int t = t0 + e;
      const float2 w = twid_rev((float)t * (1.f / 16384.f));
      const float d = (ldsc1(sa + t) - ldsc1(sb + t)) * inv;
      lds[fphys(t)] = make_float2(d * w.x, d * w.y);
    }
  }
  __syncthreads();
  fft8192_spectrum(lds, tid, sp + 8192);
}

DI float dwc(const u16* s, int t, int len, float w0, float w1, float w2, float bias) {
  const int tm = max(t - 1, 0), tp = min(t + 1, len - 1);
  const float a = bf2f(s[tm]), b = bf2f(s[t]), c = bf2f(s[tp]);
  return b * w1 + bias + (t > 0 ? a * w0 : 0.f) + (t < len - 1 ? c * w2 : 0.f);
}

DI void ld4(const u16* s, int t0, float (&o)[4]) {
  const u32x2 u = *(const u32x2*)(s + t0);
  o[0] = lo_bf(u.x); o[1] = hi_bf(u.x); o[2] = lo_bf(u.y); o[3] = hi_bf(u.y);
}
DI void dwc4(const u16* s, int t0, int len, float w0, float w1, float w2, float bias, float (&o)[4]) {
  float c[4];
  ld4(s, t0, c);
  float l = bf2f(s[max(t0 - 1, 0)]), r = bf2f(s[min(t0 + 4, len - 1)]);
  l = (t0 > 0) ? l : 0.f;
  r = (t0 + 4 < len) ? r : 0.f;
  o[0] = l * w0 + c[0] * w1 + c[1] * w2 + bias;
  o[1] = c[0] * w0 + c[1] * w1 + c[2] * w2 + bias;
  o[2] = c[1] * w0 + c[2] * w1 + c[3] * w2 + bias;
  o[3] = c[2] * w0 + c[3] * w1 + r * w2 + bias;
}

DI void hconv_item(const Params& p, int l, int o, int c, int bp, char* smem) {
  float2* lds = (float2*)smem;
  const int tid = opq(threadIdx.x);
  u16* hyt = (u16*)(p.ws + OFF_HYT);
  const int b0 = bp * 2, b1 = b0 + 1;
  u16* z0p = hyt + (size_t)(b0 * 1536 + c) * TPB + CTX;
  u16* z1p = hyt + (size_t)(b1 * 1536 + c) * TPB + CTX;
  const int gc = (o + 1) * 512 + c;
  const u16* g0p = hyt + (size_t)(b0 * 1536 + gc) * TPB + CTX;
  const u16* g1p = hyt + (size_t)(b1 * 1536 + gc) * TPB + CTX;
  const float* cw = p.hy_conv_w + (size_t)l * 3 * 1536;
  const float* cb = p.hy_conv_b + (size_t)l * 1536;
  const float zw0 = cw[c], zw1 = cw[1536 + c], zw2 = cw[3072 + c], zbias = cb[c];
  const float gw0 = cw[gc], gw1 = cw[1536 + gc], gw2 = cw[3072 + gc], gbias = cb[gc];
  const float skip = p.hy_skip[l * 1024 + o * 512 + c];
  const h2_t* spe = (const h2_t*)(p.ws + OFF_SPEC) + (size_t)(o * 512 + c) * 2 * 8192;
  const h2_t* spo = spe + 8192;
  float2* Eg = (float2*)(p.ws + OFF_ESCR + (size_t)blockIdx.x * 65536);
  __syncthreads();
#pragma unroll 2
  for (int i = 0; i < 8; ++i) {
    const int t0 = 4 * (tid + 256 * i);
    float za[4], zb[4];
    if (o == 0) { dwc4(z0p, t0, SEQ, zw0, zw1, zw2, zbias, za); dwc4(z1p, t0, SEQ, zw0, zw1, zw2, zbias, zb); }
    else { ld4(z0p, t0, za); ld4(z1p, t0, zb); }
#pragma unroll
    for (int e = 0; e < 4; ++e) lds[fphys(t0 + e)] = make_float2(za[e], zb[e]);
  }
  __syncthreads();
  fft8192_conv(lds, tid, spe);
#pragma unroll 2
  for (int i = 0; i < 8; ++i) {
    const int t0 = 4 * (tid + 256 * i);
    float za[4], zb[4];
    if (o == 0) { dwc4(z0p, t0, SEQ, zw0, zw1, zw2, zbias, za); dwc4(z1p, t0, SEQ, zw0, zw1, zw2, zbias, zb); }
    else { ld4(z0p, t0, za); ld4(z1p, t0, zb); }
#pragma unroll
    for (int e = 0; e < 4; ++e) {
      Eg[t0 + e] = lds[fphys(t0 + e)];
      lds[fphys(t0 + e)] = cmul(make_float2(za[e], zb[e]), twid_rev((float)(t0 + e) * (1.f / 16384.f)));
    }
  }
  __syncthreads();
  fft8192_conv(lds, tid, spo);
#pragma unroll 2
  for (int i = 0; i < 8; ++i) {
    const int t0 = 4 * (tid + 256 * i);
    float za[4], zb[4], ga[4], gb[4];
    if (o == 0) { dwc4(z0p, t0, SEQ, zw0, zw1, zw2, zbias, za); dwc4(z1p, t0, SEQ, zw0, zw1, zw2, zbias, zb); }
    else { ld4(z0p, t0, za); ld4(z1p, t0, zb); }
    dwc4(g0p, t0, SEQ, gw0, gw1, gw2, gbias, ga);
    dwc4(g1p, t0, SEQ, gw0, gw1, gw2, gbias, gb);
#pragma unroll
    for (int e = 0; e < 4; ++e) {
      const int t = t0 + e;
      const float2 ov = cmulc(lds[fphys(t)], twid_rev((float)t * (1.f / 16384.f)));
      const float2 ev = Eg[t];
      const float y0 = (ev.x + ov.x) * (1.f / 16384.f), y1 = (ev.y + ov.y) * (1.f / 16384.f);
      Eg[t] = make_float2(ga[e] * (y0 + za[e] * skip), gb[e] * (y1 + zb[e] * skip));
    }
  }
  __syncthreads();
  u16* d0 = (o == 0) ? z0p : hyt + (size_t)(b0 * 1536 + 512 + c) * TPB + CTX;
  u16* d1 = (o == 0) ? z1p : hyt + (size_t)(b1 * 1536 + 512 + c) * TPB + CTX;
#pragma unroll 2
  for (int i = 0; i < 8; ++i) {
    const int t0 = 4 * (tid + 256 * i);
    float2 e4[4];
#pragma unroll
    for (int e = 0; e < 4; ++e) e4[e] = Eg[t0 + e];
    *(u32x2*)(d0 + t0) = u32x2{pack2(e4[0].x, e4[1].x), pack2(e4[2].x, e4[3].x)};
    *(u32x2*)(d1 + t0) = u32x2{pack2(e4[0].y, e4[1].y), pack2(e4[2].y, e4[3].y)};
  }
}

DI void hctx_item(const Params& p, int l, int c, char* smem) {
  float* lf = (float*)smem;
  float* kern = lf;
  float* zb = lf + 1024;
  float* z1b = lf + 2048;
  float* red = lf + 3072;
  const int tid = opq(threadIdx.x), lane = tid & 63, wave = tid >> 6;
  const float* hid = (const float*)(p.ws + OFF_HID + l * HID_LAYER) + 64 * 8192;
  const float* w3 = p.hy_w3 + (size_t)l * 64 * 2048;
  const u16* hyt = (const u16*)(p.ws + OFF_HYT);
  const float* cw = p.hy_conv_w + (size_t)l * 3 * 1536;
  const float* cb = p.hy_conv_b + (size_t)l * 1536;
  __syncthreads();
  {
    const int t = tid;
    float d[4] = {0.f, 0.f, 0.f, 0.f};
#pragma unroll 4
    for (int j = 0; j < 64; ++j) {
      const float hv = hid[j * 256 + t];
#pragma unroll
      for (int q = 0; q < 4; ++q) d[q] += hv * w3[j * 2048 + (q >> 1) * 1024 + (q & 1) * 512 + c];
    }
    const float dec = __expf(-((float)t * (1.f / 255.f)) * (HY_D0 + (float)c * HY_DSTEP));
#pragma unroll
    for (int o = 0; o < 2; ++o) {
      const float f0 = d[o] * dec, f1 = d[2 + o] * dec;
      kern[o * 512 + t] = f0;
      if (t >= 1) kern[o * 512 + 512 - t] = f1;
      if (t == 0) kern[o * 512 + 256] = 0.f;
      float s = fabsf(f0) + (t >= 1 ? fabsf(f1) : 0.f);
      s = wave_sum(s);
      if (lane == 0) red[o * 4 + wave] = s;
    }
  }
  const int b = tid >> 6, tq = tid & 63;
  const u16* zs = hyt + (size_t)(b * 1536 + c) * TPB;
  const u16* g1s = hyt + (size_t)(b * 1536 + 512 + c) * TPB;
  const u16* g2s = hyt + (size_t)(b * 1536 + 1024 + c) * TPB;
#pragma unroll
  for (int k = 0; k < 4; ++k) {
    const int tt = tq + 64 * k;
    zb[b * 256 + tt] = dwc(zs, tt, CTX, cw[c], cw[1536 + c], cw[3072 + c], cb[c]);
  }
  __syncthreads();
  const float inv0 = 1.f / (red[0] + red[1] + red[2] + red[3]);
  const float inv1 = 1.f / (red[4] + red[5] + red[6] + red[7]);
  const float sk0 = p.hy_skip[l * 1024 + c], sk1 = p.hy_skip[l * 1024 + 512 + c];
#pragma unroll 1
  for (int k = 0; k < 4; ++k) {
    const int tt = tq + 64 * k;
    float acc = 0.f;
#pragma unroll 8
    for (int s = 0; s < 256; ++s) acc += kern[(tt - s) & 511] * zb[b * 256 + s];
    const float g = dwc(g1s, tt, CTX, cw[512 + c], cw[1536 + 512 + c], cw[3072 + 512 + c], cb[512 + c]);
    z1b[b * 256 + tt] = g * (acc * inv0 + zb[b * 256 + tt] * sk0);
  }
  __syncthreads();
  u16* yc = (u16*)(p.ws + OFF_HYT) + (size_t)(b * 1536 + 512 + c) * TPB;
#pragma unroll 1
  for (int k = 0; k < 4; ++k) {
    const int tt = tq + 64 * k;
    float acc = 0.f;
#pragma unroll 8
    for (int s = 0; s < 256; ++s) acc += kern[512 + ((tt - s) & 511)] * z1b[b * 256 + s];
    const float g = dwc(g2s, tt, CTX, cw[1024 + c], cw[1536 + 1024 + c], cw[3072 + 1024 + c], cb[1024 + c]);
    yc[tt] = DBG_ZERO_HCTX ? (u16)0 : f2bf(g * (acc * inv1 + z1b[b * 256 + tt] * sk1));
  }
  __syncthreads();
}

#define XB_XCNT(j) (256 + 64 * (j))
#define XB_XSUB(j) (1280 + 64 * (j))
#define XB_XGEN(j) (2304 + 64 * (j))
#define XB_TOP 3328
#define XB_TOPGEN 3392
DI unsigned xb_ld(unsigned* p) { return __hip_atomic_load(p, __ATOMIC_RELAXED, __HIP_MEMORY_SCOPE_AGENT); }
DI unsigned xb_add(unsigned* p, unsigned v) { return __hip_atomic_fetch_add(p, v, __ATOMIC_RELAXED, __HIP_MEMORY_SCOPE_AGENT); }
struct XBar { unsigned* bar; unsigned x, nloc, nx; };
DI void gsync_impl(cg::grid_group& g, XBar& b) {
#if DBG_CG_SYNC
  g.sync();
#else
  asm volatile("s_waitcnt vmcnt(0)" ::: "memory");
  __syncthreads();
  if (threadIdx.x == 0) {
    unsigned* bar = b.bar;
    __builtin_amdgcn_s_waitcnt(0);
    if (b.nloc == 0u) {
      unsigned sum, cnt, mine;
      for (;;) {
        sum = 0u; cnt = 0u; mine = 0u;
#pragma unroll
        for (unsigned j = 0; j < 16; ++j) { const unsigned c = xb_ld(&bar[XB_XCNT(j)]); sum += c; cnt += (c > 0u) ? 1u : 0u; mine = (j == b.x) ? c : mine; }
        if (sum == gridDim.x) break;
        __builtin_amdgcn_s_sleep(1);
      }
      b.nloc = mine > 0u ? mine : 1u; b.nx = cnt > 0u ? cnt : 1u;
    }
    const unsigned old = xb_add(&bar[XB_XSUB(b.x)], 1u);
    const unsigned gen = old / b.nloc;
    if (old + 1u == (gen + 1u) * b.nloc) {
      __builtin_amdgcn_fence(__ATOMIC_RELEASE, "agent");
      asm volatile("s_waitcnt vmcnt(0)" ::: "memory");
      const unsigned og = xb_add(&bar[XB_TOP], 1u);
      const unsigned tg = og / b.nx;
      if (og + 1u == (tg + 1u) * b.nx) xb_add(&bar[XB_TOPGEN], 1u);
      else { while (xb_ld(&bar[XB_TOPGEN]) == tg) __builtin_amdgcn_s_sleep(1); }
      __builtin_amdgcn_fence(__ATOMIC_ACQUIRE, "agent");
      xb_add(&bar[XB_XGEN(b.x)], 1u);
      asm volatile("s_waitcnt vmcnt(0)" ::: "memory");
    } else {
      while (xb_ld(&bar[XB_XGEN(b.x)]) == gen) __builtin_amdgcn_s_sleep(1);
      __builtin_amdgcn_fence(__ATOMIC_ACQUIRE, "agent");
      asm volatile("s_waitcnt vmcnt(0)" ::: "memory");
    }
  }
  __syncthreads();
#endif
}

#define gsync(G, E) gsync_impl(G, E)
DI int tile_map(int L, int MT, int NT) {
  const int per = 8 * NT;
  const int P = L / per, u = L - P * per;
  const int h = min(8, MT - P * 8);
  const int nt = u / h, mt = P * 8 + (u - nt * h);
  return mt * NT + nt;
}
__global__ void __launch_bounds__(256, 2) fwd_mega(Params p) {
  cg::grid_group grid = cg::this_grid();
  __shared__ __attribute__((aligned(16))) char smem[65536];
  const int nb = gridDim.x, bid = blockIdx.x;
  const int pb = ((nb & 7) == 0) ? (bid & 7) * (nb >> 3) + (bid >> 3) : bid;
  float* xctx = (float*)(p.ws + OFF_XCTX);
  u16* RH = (u16*)(p.ws + OFF_RH);
  u16* HP = (u16*)(p.ws + OFF_HP);
  XBar epoch;
  epoch.bar = (unsigned*)(p.ws + OFF_BAR);
  epoch.x = (unsigned)__builtin_amdgcn_s_getreg((3 << 11) | 20) & 0xFu;
  epoch.nloc = 0u; epoch.nx = 0u;
  if (threadIdx.x == 0) (void)xb_add(&epoch.bar[XB_XCNT(epoch.x)], 1u);
  {
    constexpr int NC0 = 2336;
    const int total = NC0 + 192 + 1536 + 528;
    for (int it = bid; it < total; it += nb) {
      if (it < NC0) conv_tile(p, 0, it, smem);
      else if (it < NC0 + 192) mod_item(p, it - NC0, smem);
      else if (it < NC0 + 192 + 1536) rope_item(p, it - NC0 - 192);
      else hid_item(p, it - NC0 - 192 - 1536, smem);
    }
  }
  if (p.ws == nullptr) grid.sync();
  gsync(grid, epoch);
  row_pass(p, 0, p.x, p.ctx, nullptr, nullptr, nullptr, nullptr, 0, 0, false, p.norm_g, 0, 0, 1024, RH, false);
  gsync(grid, epoch);
#pragma unroll 1
  for (int l = 0; l < 2; ++l) {
    const float* xl = (l == 0) ? p.x : p.out;
    const float* xc = (l == 0) ? p.ctx : xctx;
    for (int rep = 0; rep < DBG_REP_FFT; ++rep)
    for (int it = pb; it < 1024; it += nb) filt_item(p, l, it, smem);
    gsync(grid, epoch);
    for (int rep = 0; rep < DBG_REP_GEMM; ++rep)
    for (int it = pb; it < 4752; it += nb) inproj_tile(p, tile_map(it, 176, 27), smem);
    gsync(grid, epoch);
#if DBG_DUMP == 5
    { const _Float16* sp = (const _Float16*)(p.ws + OFF_SPEC);
      for (size_t i = (size_t)bid * 256 + threadIdx.x; i < (size_t)NBATCH * SEQ * DM; i += (size_t)nb * 256) p.out[i] = (float)sp[i];
      return; }
#endif
    {
      const int nSW = 2048 + (l == 0 ? 64 : 0);
      for (int rep = 0; rep < DBG_REP_GEMM; ++rep)
      for (int it = pb; it < 1408 + nSW; it += nb) {
        if (it < 1408) kvup_tile(p, tile_map(it, 176, 8), smem);
        else if (it < 1408 + 2048) {
          const int i1 = it - 1408, n = i1 & 63, jlo = (n == 0) ? 2 : 0, jhi = (n == 63) ? 4 : 6;
          attn_item<64, true>(p, l, i1 >> 9, (i1 >> 6) & 7, CTX + n * 128, 4, jhi - jlo, (n - 1) * 128 + 64 * jlo, smem);
        } else { const int i2 = it - 1408 - 2048; attn_item<64, true>(p, l, i2 >> 4, (i2 >> 1) & 7, (i2 & 1) * 128, 4, 0, 0, smem); }
      }
    }
    gsync(grid, epoch);
    {
      const int nF = 2048 + (l == 0 ? 64 : 0);
      for (int rep = 0; rep < DBG_REP_MLA; ++rep)
      for (int it = pb; it < nF; it += nb) {
        if (it < 2048) attn_item<96, false>(p, l, it >> 9, (it >> 6) & 7, CTX + (it & 63) * 128, 132, 0, 0, smem);
        else { const int i2 = it - 2048; attn_item<96, false>(p, l, i2 >> 4, (i2 >> 1) & 7, (i2 & 1) * 128, 4, 0, 0, smem); }
      }
    }
    gsync(grid, epoch);
    {
      const int nF2 = 1024 + (l == 0 ? 512 : 0);
      for (int it = pb; it < nF2; it += nb) {
        if (it < 1024) hconv_item(p, l, 0, it >> 1, it & 1, smem);
        else hctx_item(p, l, it - 1024, smem);
      }
    }
    gsync(grid, epoch);
    for (int rep = 0; rep < DBG_REP_FFT; ++rep)
    for (int it = pb; it < 1024; it += nb) hconv_item(p, l, 1, it >> 1, it & 1, smem);
    gsync(grid, epoch);
    for (int rep = 0; rep < DBG_REP_GEMM; ++rep)
    for (int it = pb; it < 1408; it += nb) merge_tile(p, tile_map(it, 176, 8), smem);
    if (l == 0 && pb >= 384 && nb > 384) for (int ct = 2336 + (pb - 384); ct < NCONV_TILES; ct += nb - 384) conv_tile(p, 0, ct, smem);
    gsync(grid, epoch);
    for (int rep = 0; rep < DBG_REP_GEMM * DBG_REP_PLAIN; ++rep)
    for (int it = pb; it < 1408; it += nb) plain_tile(p, tile_map(it, 176, 8), (const u16*)(p.ws + OFF_MERGED), 1024, 16, (const u16*)(p.ws + OFF_WT_OUT), (u16*)(p.ws + OFF_Y), smem);
    gsync(grid, epoch);
    row_pass(p, 1, xl, xc, p.out, xctx, (const u16*)(p.ws + OFF_Y), p.norm_g + (size_t)(l * 4 + 1) * 1024, 2048, l, true, p.norm_g + (size_t)(l * 4 + 2) * 1024, l, 3072, 4096, RH, false);
    gsync(grid, epoch);
    for (int rep = 0; rep < DBG_REP_GEMM; ++rep)
    for (int it = pb; it < 184 * 44; it += nb) ffnup_tile(p, l, tile_map(it, 184, 44), smem);
    gsync(grid, epoch);
    for (int rep = 0; rep < DBG_REP_GEMM * DBG_REP_PLAIN; ++rep)
    for (int it = pb; it < 1408; it += nb) plain_tile(p, tile_map(it, 176, 8), (const u16*)(p.ws + OFF_A), 2816, 44, (const u16*)(p.ws + OFF_WT_DOWN), HP, smem);
    if (l == 0 && pb >= 384 && nb > 384) for (int ct = pb - 384; ct < 1632; ct += nb - 384) conv_tile(p, 1, ct, smem);
    gsync(grid, epoch);
    row_pass(p, 1, p.out, xctx, p.out, xctx, HP, p.norm_g + (size_t)(l * 4 + 3) * 1024, 5120, l, l == 0, p.norm_g + (size_t)((l + 1) * 4) * 1024, l + 1, 0, 1024, RH, l == 1);
    if (l == 0) {
      for (int it = bid; it < NCONV_TILES - 1632; it += nb) conv_tile(p, 1, 1632 + it, smem);
      gsync(grid, epoch);
    }
  }
  for (int rep = 0; rep < DBG_EXTRA_SYNCS; ++rep) gsync(grid, epoch);
#if DBG_DUMP == 1
  gsync(grid, epoch);
  { const _Float16* sp = (const _Float16*)(p.ws + OFF_SPEC);
    for (size_t i = (size_t)bid * 256 + threadIdx.x; i < (size_t)NBATCH * SEQ * DM; i += (size_t)nb * 256) p.out[i] = (float)sp[i]; }
#elif DBG_DUMP == 3
  gsync(grid, epoch);
  { const float* hd = (const float*)(p.ws + OFF_HID);
    for (size_t i = (size_t)bid * 256 + threadIdx.x; i < (size_t)NBATCH * SEQ * DM; i += (size_t)nb * 256) p.out[i] = i < (size_t)2 * 64 * 8448 ? hd[i] : 0.f; }
#elif DBG_DUMP == 2
  gsync(grid, epoch);
  { const u16* yc = (const u16*)(p.ws + OFF_YCT);
    for (size_t i = (size_t)bid * 256 + threadIdx.x; i < (size_t)NBATCH * SEQ * DM; i += (size_t)nb * 256) p.out[i] = i < (size_t)4 * 512 * TPB ? bf2f(yc[i]) : 0.f; }
#endif
}

extern "C" void kernel_launch(void* const* d_in, const int* in_sizes, int n_in, void* d_out, int out_size, void* d_ws, size_t ws_size,
                              hipStream_t stream) {
  static int grid_blocks = 0;
  if (!grid_blocks) {
    int dev = 0, cus = 0, per_cu = 0;
    (void)hipGetDevice(&dev);
    (void)hipDeviceGetAttribute(&cus, hipDeviceAttributeMultiprocessorCount, dev);
    (void)hipOccupancyMaxActiveBlocksPerMultiprocessor(&per_cu, fwd_mega, 256, 0);
    if (per_cu > 2) per_cu = 2;
    if (per_cu < 1) per_cu = 1;
    grid_blocks = cus * per_cu;
  }
  if (ws_size < WS_NEED) { fprintf(stderr, "workspace too small: %zu < %zu\n", ws_size, (size_t)WS_NEED); return; }
  Params p{};
  const float** pp = (const float**)&p;
  for (int i = 0; i < 26; ++i) pp[i] = (const float*)d_in[i];
  p.out = (float*)d_out;
  p.ws = (char*)d_ws;
  (void)hipMemsetAsync((char*)d_ws + OFF_BAR, 0, BAR_BYTES, stream);
  void* args[] = {&p};
  hipError_t e = hipLaunchCooperativeKernel((void*)fwd_mega, dim3(grid_blocks), dim3(256), args, 0, stream);
  if (e != hipSuccess) fprintf(stderr, "cooperative launch failed: %s (grid %d)\n", hipGetErrorString(e), grid_blocks);
}
```

```cpp
#include <hip/hip_runtime.h>
#include <hip/hip_cooperative_groups.h>
#include <cstdio>
namespace cg = cooperative_groups;
#define DI __device__ __forceinline__
typedef unsigned short u16;
typedef __attribute__((ext_vector_type(8))) short bf16x8;
typedef __attribute__((ext_vector_type(4))) short s16x4;
typedef __attribute__((ext_vector_type(16))) float f32x16;
typedef __attribute__((ext_vector_type(4))) unsigned u32x4;
typedef __attribute__((ext_vector_type(2))) unsigned u32x2;
typedef __attribute__((ext_vector_type(2))) __bf16 bf2_t;
typedef __attribute__((ext_vector_type(2))) float f2_t;
typedef __attribute__((ext_vector_type(2))) _Float16 h2_t;
#define MFMA(a, b, c) __builtin_amdgcn_mfma_f32_32x32x16_bf16((a), (b), (c), 0, 0, 0)

constexpr int DM = 1024, NBATCH = 4, SEQ = 8192, CTX = 256, TPB = 8448, MTOK = 33792;
constexpr int DFF = 2816;
#ifndef DBG_ZERO_HCTX
#define DBG_ZERO_HCTX 0
#endif
#ifndef DBG_DUMP
#define DBG_DUMP 0
#endif
#ifndef DBG_NOFFT
#define DBG_NOFFT 0
#endif
#ifndef DBG_SPLITC
#define DBG_SPLITC 0
#endif
#ifndef DBG_REP_GEMM
#define DBG_REP_GEMM 1
#endif
#ifndef DBG_REP_MLA
#define DBG_REP_MLA 1
#endif
#ifndef DBG_HEAVY_SYNC
#define DBG_HEAVY_SYNC 0
#endif
#ifndef DBG_REP_FFT
#define DBG_REP_FFT 1
#endif
#ifndef DBG_REP_PLAIN
#define DBG_REP_PLAIN 1
#endif
#ifndef DBG_EXTRA_SYNCS
#define DBG_EXTRA_SYNCS 0
#endif
#ifndef DBG_CG_SYNC
#define DBG_CG_SYNC 0
#endif
#ifndef DBG_SKIP_BR
#define DBG_SKIP_BR 0
#endif
#define DBG_FIRST_BR ((DBG_SKIP_BR & 1) ? ((DBG_SKIP_BR & 2) ? 2 : 1) : 0)
constexpr float LOG2E = 1.4426950408889634f;
constexpr float EPS = 1e-6f;

struct Params {
  const float *x, *c, *ctx, *c_ctx, *w_mod, *b_mod, *norm_g, *w_in, *kv_norm_g, *w_kv_up, *swa_sink, *hy_conv_w, *hy_conv_b,
      *hy_w1, *hy_b1, *hy_w2, *hy_b2, *hy_freq, *hy_w3, *hy_skip, *w_branch, *w_out, *w_up, *ffn_conv_w, *ffn_conv_b, *w_down;
  float* out;
  char* ws;
};

constexpr size_t OFF_WT_IN = 0;
constexpr size_t OFF_WT_GATE = OFF_WT_IN + (size_t)3456 * 1024 * 2;
constexpr size_t OFF_WT_KV = OFF_WT_GATE + (size_t)3072 * 1024 * 2;
constexpr size_t OFF_WT_BR = OFF_WT_KV + (size_t)1024 * 256 * 2;
constexpr size_t OFF_WT_OUT = OFF_WT_BR + (size_t)3 * 1024 * 512 * 2;
constexpr size_t OFF_WT_UP = OFF_WT_OUT + (size_t)1024 * 1024 * 2;
constexpr size_t OFF_WT_DOWN = OFF_WT_UP + (size_t)5632 * 1024 * 2;
constexpr size_t OFF_RH = OFF_WT_DOWN + (size_t)1024 * 2816 * 2;
constexpr size_t OFF_KN = OFF_RH + (size_t)MTOK * 1024 * 2;
constexpr size_t OFF_VT = OFF_KN + (size_t)MTOK * 512 * 2;
constexpr size_t OFF_KR = OFF_VT + (size_t)MTOK * 512 * 2;
constexpr size_t OFF_Q = OFF_KR + (size_t)MTOK * 32 * 2;
constexpr size_t OFF_SQ = OFF_Q + (size_t)MTOK * 768 * 2;
constexpr size_t OFF_CKV = OFF_SQ + (size_t)MTOK * 512 * 2;
constexpr size_t OFF_SK = OFF_CKV + (size_t)MTOK * 256 * 2;
constexpr size_t OFF_SVT = OFF_SK + (size_t)MTOK * 128 * 2;
constexpr size_t OFF_HYT = OFF_SVT + (size_t)MTOK * 128 * 2;
constexpr size_t OFF_SPEC = OFF_HYT + (size_t)MTOK * 1536 * 2;
constexpr size_t OFF_XCTX = OFF_SPEC + (size_t)1024 * 2 * 8192 * 4;
constexpr size_t OFF_MOD = OFF_XCTX + (size_t)1024 * 1024 * 4;
constexpr size_t OFF_ROPE = OFF_MOD + (size_t)2 * 5 * 6144 * 4;
constexpr size_t OFF_HID = OFF_ROPE + (size_t)8192 * 96 * 4;
constexpr size_t HID_LAYER = (size_t)64 * (8192 + 256) * 4;
constexpr size_t OFF_ESCR = OFF_HID + 2 * HID_LAYER;
constexpr size_t OFF_BAR = OFF_ESCR + (size_t)512 * 65536;
constexpr size_t BAR_BYTES = 3456 * 4;
constexpr size_t WS_NEED = OFF_BAR + BAR_BYTES;
constexpr size_t OFF_A = OFF_Q;
constexpr size_t OFF_MERGED = OFF_KN;
constexpr size_t OFF_Y = OFF_HYT;
constexpr size_t OFF_HP = OFF_KN;
constexpr size_t OFF_YCT = OFF_RH;
constexpr size_t OFF_YA = OFF_RH + (size_t)MTOK * 512 * 2;
static_assert(OFF_A + (size_t)MTOK * 2816 * 2 <= OFF_SPEC, "A overlay");
static_assert(WS_NEED <= (size_t)512 * 1024 * 1024, "ws");

DI int opq(int x) { asm volatile("" : "+v"(x)); return x; }
DI float ldsc1(const float* p) { return __hip_atomic_load(p, __ATOMIC_RELAXED, __HIP_MEMORY_SCOPE_AGENT); }
DI float bf2f(u16 v) { return __uint_as_float(((unsigned)v) << 16); }
DI unsigned pack2(float a, float b) { f2_t v = {a, b}; return __builtin_bit_cast(unsigned, __builtin_convertvector(v, bf2_t)); }
DI u16 f2bf(float a) { return (u16)(pack2(a, 0.f) & 0xffffu); }
DI float lo_bf(unsigned u) { return __uint_as_float(u << 16); }
DI float hi_bf(unsigned u) { return __uint_as_float(u & 0xffff0000u); }
DI int crow(int i, int h) { return (i & 3) + 8 * (i >> 2) + 4 * h; }
DI float wave_sum(float v) {
#pragma unroll
  for (int o = 32; o > 0; o >>= 1) v += __shfl_xor(v, o);
  return v;
}
DI float sinrev(float r) { return __builtin_amdgcn_sinf(r - floorf(r)); }
DI float cosrev(float r) { return __builtin_amdgcn_cosf(r - floorf(r)); }
#if DBG_TRIVTW
#define COSREV(f) (1.0f)
#define SINREV(f) (0.0f * (f))
#else
#define COSREV(f) cosrev(f)
#define SINREV(f) sinrev(f)
#endif
#define SYNC() __syncthreads()
DI float2 cmul(float2 a, float2 b) { return make_float2(a.x * b.x - a.y * b.y, a.x * b.y + a.y * b.x); }
DI float2 cmulc(float2 a, float2 b) { return make_float2(a.x * b.x + a.y * b.y, a.y * b.x - a.x * b.y); }
#ifndef DBG_NOSWZ
#define DBG_NOSWZ 0
#endif
DI int fphys(int i) { return DBG_NOSWZ ? i : (i ^ ((i >> 4) & 15)); }
DI float2 twid_rev(float fr) { return make_float2(COSREV(fr), -SINREV(fr)); }

DI float2 root16(int e) {
  const float C1 = 0.92387953251128674f, S1 = 0.38268343236508977f, R = 0.70710678118654752f;
  switch (e) {
    case 0: return make_float2(1.f, 0.f);
    case 1: return make_float2(C1, -S1);
    case 2: return make_float2(R, -R);
    case 3: return make_float2(S1, -C1);
    case 4: return make_float2(0.f, -1.f);
    case 5: return make_float2(-S1, -C1);
    case 6: return make_float2(-R, -R);
    default: return make_float2(-C1, -S1);
  }
}
template <int R, int HALF, int S, bool INV, bool HASW>
DI void fft_stage(float2 (&v)[R], const float2 (&wp)[4]) {
#pragma unroll
  for (int idx = 0; idx < R / 2; ++idx) {
    const int blk = idx / HALF, jj = idx % HALF;
    const int j0 = blk * 2 * HALF + jj, j1 = j0 + HALF;
    const int e = jj * (8 / HALF);
    float2 tw = root16(e);
    if (HASW) { if (e == 0) tw = wp[S]; else tw = cmul(wp[S], tw); }
    const bool triv = (!HASW) && (e == 0);
    if (!INV) {
      float2 a = v[j0], b = v[j1];
      v[j0] = make_float2(a.x + b.x, a.y + b.y);
      float2 d = make_float2(a.x - b.x, a.y - b.y);
      v[j1] = triv ? d : cmul(d, tw);
    } else {
      float2 t = triv ? v[j1] : cmulc(v[j1], tw);
      float2 a = v[j0];
      v[j0] = make_float2(a.x + t.x, a.y + t.y);
      v[j1] = make_float2(a.x - t.x, a.y - t.y);
    }
  }
}
template <bool INV> DI void fft_local8(float2 (&v)[8], const float2 (&wp)[4]) {
  if (!INV) { fft_stage<8, 4, 0, false, true>(v, wp); fft_stage<8, 2, 1, false, true>(v, wp); fft_stage<8, 1, 2, false, true>(v, wp); }
  else      { fft_stage<8, 1, 2, true, true>(v, wp); fft_stage<8, 2, 1, true, true>(v, wp); fft_stage<8, 4, 0, true, true>(v, wp); }
}
template <bool INV> DI void fft_local16(float2 (&v)[16], const float2 (&wp)[4]) {
  if (!INV) { fft_stage<16, 8, 0, false, false>(v, wp); fft_stage<16, 4, 1, false, false>(v, wp); fft_stage<16, 2, 2, false, false>(v, wp); fft_stage<16, 1, 3, false, false>(v, wp); }
  else      { fft_stage<16, 1, 3, true, false>(v, wp); fft_stage<16, 2, 2, true, false>(v, wp); fft_stage<16, 4, 1, true, false>(v, wp); fft_stage<16, 8, 0, true, false>(v, wp); }
}

template <int LQ, bool INV> DI void fft_pass8(float2* lds, int tid) {
  constexpr int q = 1 << LQ;
#pragma unroll 1
  for (int it = 0; it < 4; ++it) {
    const int task = tid + 256 * it;
    const int p = task & (q - 1);
    const int g = task >> LQ;
    const int base = g * 8 * q + p;
    float2 v[8];
#pragma unroll
    for (int j = 0; j < 8; ++j) v[j] = lds[fphys(base + j * q)];
    float2 wp[4];
    wp[0] = twid_rev((float)p * (1.0f / (float)(8 * q)));
    wp[1] = cmul(wp[0], wp[0]);
    wp[2] = cmul(wp[1], wp[1]);
    wp[3] = wp[2];
    fft_local8<INV>(v, wp);
#pragma unroll
    for (int j = 0; j < 8; ++j) lds[fphys(base + j * q)] = v[j];
  }
}
template <bool INV> DI void fft_pass16(float2* lds, int tid) {
#pragma unroll 1
  for (int it = 0; it < 2; ++it) {
    const int g = tid + 256 * it;
    float2 v[16];
    const int sw = DBG_NOSWZ ? 0 : (g & 15);
#pragma unroll
    for (int j = 0; j < 16; ++j) v[j] = lds[g * 16 + (j ^ sw)];
    float2 wp[4] = {make_float2(1.f, 0.f), make_float2(1.f, 0.f), make_float2(1.f, 0.f), make_float2(1.f, 0.f)};
    fft_local16<INV>(v, wp);
#pragma unroll
    for (int j = 0; j < 16; ++j) lds[g * 16 + (j ^ sw)] = v[j];
  }
}
#ifndef DBG_FFTPASSES
#define DBG_FFTPASSES 15
#endif
DI void fft8192_fwd(float2* lds, int tid) {
  if (DBG_FFTPASSES & 1) { fft_pass8<10, false>(lds, tid); SYNC(); }
  if (DBG_FFTPASSES & 2) { fft_pass8<7, false>(lds, tid); SYNC(); }
  if (DBG_FFTPASSES & 4) { fft_pass8<4, false>(lds, tid); SYNC(); }
  if (DBG_FFTPASSES & 8) { fft_pass16<false>(lds, tid); SYNC(); }
}
DI void fft8192_inv(float2* lds, int tid) {
  fft_pass16<true>(lds, tid); SYNC();
  fft_pass8<4, true>(lds, tid); SYNC();
  fft_pass8<7, true>(lds, tid); SYNC();
  fft_pass8<10, true>(lds, tid); SYNC();
}

DI void fft_mid16(float2* lds, int tid, const h2_t* H) {
#pragma unroll 1
  for (int it = 0; it < 2; ++it) {
    const int g = tid + 256 * it;
    float2 v[16];
    const int sw = g & 15;
#pragma unroll
    for (int j = 0; j < 16; ++j) v[j] = lds[g * 16 + (j ^ sw)];
    const float2 wp[4] = {make_float2(1.f, 0.f), make_float2(1.f, 0.f), make_float2(1.f, 0.f), make_float2(1.f, 0.f)};
    const h2_t* hp = H + g * 16;
    h2_t hv[16];
#pragma unroll
    for (int j = 0; j < 16; ++j) hv[j] = hp[j];
    fft_local16<false>(v, wp);
#pragma unroll
    for (int j = 0; j < 16; ++j) v[j] = cmul(v[j], make_float2((float)hv[j][0], (float)hv[j][1]));
    fft_local16<true>(v, wp);
#pragma unroll
    for (int j = 0; j < 16; ++j) lds[g * 16 + (j ^ sw)] = v[j];
  }
}
DI void fft_last16_store(const float2* lds, int tid, h2_t* H) {
#pragma unroll 1
  for (int it = 0; it < 2; ++it) {
    const int g = tid + 256 * it;
    float2 v[16];
    const int sw = g & 15;
#pragma unroll
    for (int j = 0; j < 16; ++j) v[j] = lds[g * 16 + (j ^ sw)];
    const float2 wp[4] = {make_float2(1.f, 0.f), make_float2(1.f, 0.f), make_float2(1.f, 0.f), make_float2(1.f, 0.f)};
    fft_local16<false>(v, wp);
    h2_t* hp = H + g * 16;
#pragma unroll
    for (int j = 0; j < 16; ++j) { h2_t hv = {(_Float16)v[j].x, (_Float16)v[j].y}; hp[j] = hv; }
  }
}
DI void fft8192_conv(float2* lds, int tid, const h2_t* H) {
  fft_pass8<10, false>(lds, tid); SYNC();
  fft_pass8<7, false>(lds, tid); SYNC();
  fft_pass8<4, false>(lds, tid); SYNC();
  fft_mid16(lds, tid, H); SYNC();
  fft_pass8<4, true>(lds, tid); SYNC();
  fft_pass8<7, true>(lds, tid); SYNC();
  fft_pass8<10, true>(lds, tid); SYNC();
}
DI void fft8192_spectrum(float2* lds, int tid, h2_t* H) {
  fft_pass8<10, false>(lds, tid); SYNC();
  fft_pass8<7, false>(lds, tid); SYNC();
  fft_pass8<4, false>(lds, tid); SYNC();
  fft_last16_store(lds, tid, H); SYNC();
}

template <bool SWAP, bool ATR = false, int MTW = 2>
DI void gemm_main(const u16* __restrict__ A, int lda, int a_row0, int a_lo, int a_hi, int a_kstep,
                  const u16* __restrict__ B, int ldb, int nk, f32x16 (&acc)[MTW][2], char* smem) {
  constexpr int ROWS = MTW * 64, NA = MTW * 2;
  const int tid = opq(threadIdx.x), lane = tid & 63, wave = tid >> 6, wm = wave >> 1, wn = wave & 1, r = lane & 31, h = lane >> 5;
  char* sA = smem;
  char* sB = smem + ROWS * 144;
  const u16* ap[NA];
  const u16* bp[4];
  int loa[NA], lob[4];
#pragma unroll
  for (int i = 0; i < NA; ++i) {
    const int idx = tid + 256 * i, row = idx >> 3, ch = idx & 7;
    if (ATR) {
      ap[i] = A + (size_t)(idx & 63) * lda + a_row0 + (idx >> 6) * 8;
    } else {
      const int gr = min(max(a_row0 + row, a_lo), a_hi);
      ap[i] = A + (size_t)gr * lda + ch * 8;
    }
    loa[i] = row * 144 + ch * 16;
  }
#pragma unroll
  for (int i = 0; i < 4; ++i) {
    const int idx = tid + 256 * i, row = idx >> 3, ch = idx & 7;
    bp[i] = B + (size_t)row * ldb + ch * 8;
    lob[i] = row * 144 + ch * 16;
  }
  u32x4 ra0[NA], rb0[4];
#define GEMM_LOAD(RA, RB, KT)                                                                                         \
  _Pragma("unroll") for (int i = 0; i < NA; ++i)                                                                      \
    RA[i] = *(const u32x4*)(ap[i] + (ATR ? (size_t)(KT) * 64 * lda : (size_t)(KT) * a_kstep));                        \
  _Pragma("unroll") for (int i = 0; i < 4; ++i) RB[i] = *(const u32x4*)(bp[i] + (KT) * 64);
#define GEMM_STASH(RA, RB)                                                                                            \
  _Pragma("unroll") for (int i = 0; i < NA; ++i) {                                                                    \
    if (ATR) {                                                                                                        \
      const int idx = tid + 256 * i, krow = idx & 63, mch = idx >> 6;                                                 \
      _Pragma("unroll") for (int e = 0; e < 4; ++e) {                                                                 \
        *(u16*)(sA + (mch * 8 + 2 * e) * 144 + krow * 2) = (u16)(RA[i][e] & 0xffffu);                                 \
        *(u16*)(sA + (mch * 8 + 2 * e + 1) * 144 + krow * 2) = (u16)(RA[i][e] >> 16);                                 \
      }                                                                                                               \
    } else {                                                                                                          \
      *(u32x4*)(sA + loa[i]) = RA[i];                                                                                 \
    }                                                                                                                 \
  }                                                                                                                   \
  _Pragma("unroll") for (int i = 0; i < 4; ++i) *(u32x4*)(sB + lob[i]) = RB[i];
#define GEMM_COMPUTE()                                                                                                \
  __builtin_amdgcn_s_setprio(1);                                                                                      \
  _Pragma("unroll") for (int ks = 0; ks < 4; ++ks) {                                                                  \
    bf16x8 af[MTW], bfr[2];                                                                                           \
    _Pragma("unroll") for (int t = 0; t < MTW; ++t) af[t] = *(const bf16x8*)(pa + t * 32 * 144 + ks * 32);            \
    _Pragma("unroll") for (int t = 0; t < 2; ++t) bfr[t] = *(const bf16x8*)(pb + t * 32 * 144 + ks * 32);             \
    _Pragma("unroll") for (int mt = 0; mt < MTW; ++mt)                                                                \
      _Pragma("unroll") for (int nt = 0; nt < 2; ++nt)                                                                \
        acc[mt][nt] = SWAP ? MFMA(bfr[nt], af[mt], acc[mt][nt]) : MFMA(af[mt], bfr[nt], acc[mt][nt]);                 \
  }                                                                                                                   \
  __builtin_amdgcn_s_setprio(0);
  GEMM_LOAD(ra0, rb0, 0)
#pragma unroll
  for (int mt = 0; mt < MTW; ++mt)
#pragma unroll
    for (int nt = 0; nt < 2; ++nt)
#pragma unroll
      for (int i = 0; i < 16; ++i) acc[mt][nt][i] = 0.f;
  const char* pa = sA + (wm * (MTW * 32) + r) * 144 + h * 16;
  const char* pb = sB + (wn * 64 + r) * 144 + h * 16;
#pragma unroll 1
  for (int kk = 0; kk < nk; ++kk) {
    __syncthreads();
    GEMM_STASH(ra0, rb0)
    __syncthreads();
    if (kk + 1 < nk) { GEMM_LOAD(ra0, rb0, kk + 1) }
    GEMM_COMPUTE()
  }
#undef GEMM_LOAD
#undef GEMM_STASH
#undef GEMM_COMPUTE
}
template <int MTW>
DI void store_rowmajor(const f32x16 (&acc)[MTW][2], u16* C, int ldc, int m0, int ncol0, float scale) {
  const int tid = opq(threadIdx.x), lane = tid & 63, wave = tid >> 6, wm = wave >> 1, wn = wave & 1, r = lane & 31, h = lane >> 5;
#pragma unroll
  for (int mt = 0; mt < MTW; ++mt)
#pragma unroll
    for (int nt = 0; nt < 2; ++nt)
#pragma unroll
      for (int g = 0; g < 4; ++g) {
        const int m = m0 + wm * (MTW * 32) + mt * 32 + r, n = ncol0 + wn * 64 + nt * 32 + 8 * g + 4 * h;
        u32x2 pk;
        pk.x = pack2(acc[mt][nt][4 * g] * scale, acc[mt][nt][4 * g + 1] * scale);
        pk.y = pack2(acc[mt][nt][4 * g + 2] * scale, acc[mt][nt][4 * g + 3] * scale);
        *(u32x2*)(C + (size_t)m * ldc + n) = pk;
      }
}
template <int MTW>
DI void store_transposed(const f32x16 (&acc)[MTW][2], u16* T, int ldt, int trow0, int j0) {
  const int tid = opq(threadIdx.x), lane = tid & 63, wave = tid >> 6, wm = wave >> 1, wn = wave & 1, r = lane & 31, h = lane >> 5;
#pragma unroll
  for (int mt = 0; mt < MTW; ++mt)
#pragma unroll
    for (int nt = 0; nt < 2; ++nt)
#pragma unroll
      for (int g = 0; g < 4; ++g) {
        const int n = trow0 + wn * 64 + nt * 32 + r, m = j0 + wm * (MTW * 32) + mt * 32 + 8 * g + 4 * h;
        u32x2 pk;
        pk.x = pack2(acc[mt][nt][4 * g], acc[mt][nt][4 * g + 1]);
        pk.y = pack2(acc[mt][nt][4 * g + 2], acc[mt][nt][4 * g + 3]);
        *(u32x2*)(T + (size_t)n * ldt + m) = pk;
      }
}

constexpr int NCONV_TILES = 864 + 768 + 64 + 384 + 256 + 1408 + 704;
DI void conv_tile(const Params& p, int l, int tile, char* smem) {
  float* t = (float*)smem;
  const int tid = opq(threadIdx.x);
  int mat, tn, tk;
  if (tile < 864) { mat = 0; tn = tile / 16; tk = tile % 16; }
  else if (tile < 1632) { tile -= 864; mat = 1; tn = tile / 16; tk = tile % 16; }
  else if (tile < 1696) { tile -= 1632; mat = 2; tn = tile / 4; tk = tile % 4; }
  else if (tile < 2080) { tile -= 1696; mat = 3; tn = tile / 8; tk = tile % 8; }
  else if (tile < 2336) { tile -= 2080; mat = 4; tn = tile / 16; tk = tile % 16; }
  else if (tile < 3744) { tile -= 2336; mat = 5; tn = tile / 16; tk = tile % 16; }
  else { tile -= 3744; mat = 6; tn = tile / 44; tk = tile % 44; }
  const int k0 = tk * 64;
  const int nn = tid & 63;
  int np = tn * 64 + nn;
  const float* src; int ld; int col;
  if (mat == 0) { src = p.w_in + (size_t)l * 1024 * 6432; ld = 6432; col = np < 1024 ? np : (np < 3328 ? np + 32 : (np < 3360 ? np - 3328 + 1024 : -1)); }
  else if (mat == 1) { src = p.w_in + (size_t)l * 1024 * 6432; ld = 6432; col = 3360 + np; }
  else if (mat == 2) { src = p.w_kv_up + (size_t)l * 256 * 1024; ld = 1024; col = np < 512 ? (np >> 6) * 128 + (np & 63) : ((np - 512) >> 6) * 128 + 64 + (np & 63); }
  else if (mat == 3) { const int br = tn / 16; np = (tn % 16) * 64 + nn; src = p.w_branch + (size_t)(l * 3 + br) * 512 * 1024; ld = 1024; col = np; }
  else if (mat == 4) { src = p.w_out + (size_t)l * 1024 * 1024; ld = 1024; col = np; }
  else if (mat == 5) { src = p.w_up + (size_t)l * 1024 * 5632; ld = 5632; const int blk = np >> 7, rr = np & 127; col = rr < 64 ? blk * 64 + rr : 2816 + blk * 64 + rr - 64; }
  else { src = p.w_down + (size_t)l * 2816 * 1024; ld = 1024; col = np; }
#pragma unroll 4
  for (int i = 0; i < 16; ++i) {
    const int kk = (tid >> 6) + 4 * i;
    float v = 0.f;
    if (col >= 0) v = src[(size_t)(k0 + kk) * ld + col];
    if (mat == 2) v *= p.kv_norm_g[l * 256 + k0 + kk];
    t[kk * 65 + nn] = v;
  }
  __syncthreads();
  {
    const int n2 = tid >> 2, kq = (tid & 3) * 16;
    const int drow = tn * 64 + n2;
    u16* dst;
    if (mat == 0) dst = (u16*)(p.ws + OFF_WT_IN) + (size_t)drow * 1024;
    else if (mat == 1) dst = (u16*)(p.ws + OFF_WT_GATE) + (size_t)drow * 1024;
    else if (mat == 2) dst = (u16*)(p.ws + OFF_WT_KV) + (size_t)drow * 256;
    else if (mat == 3) dst = (u16*)(p.ws + OFF_WT_BR) + (size_t)drow * 512;
    else if (mat == 4) dst = (u16*)(p.ws + OFF_WT_OUT) + (size_t)drow * 1024;
    else if (mat == 5) dst = (u16*)(p.ws + OFF_WT_UP) + (size_t)drow * 1024;
    else dst = (u16*)(p.ws + OFF_WT_DOWN) + (size_t)drow * 2816;
    unsigned pk[8];
#pragma unroll
    for (int j = 0; j < 8; ++j) pk[j] = pack2(t[(kq + 2 * j) * 65 + n2], t[(kq + 2 * j + 1) * 65 + n2]);
    u32x4* d4 = (u32x4*)(dst + k0 + kq);
    d4[0] = u32x4{pk[0], pk[1], pk[2], pk[3]};
    d4[1] = u32x4{pk[4], pk[5], pk[6], pk[7]};
  }
  __syncthreads();
}

DI void mod_item(const Params& p, int item, char* smem) {
  float* sv = (float*)smem;
  float* red = sv + 5 * 1024;
  const int tid = opq(threadIdx.x);
  const int l = item / 96, cg0 = (item % 96) * 64;
  for (int i = tid; i < 5 * 1024; i += 256) {
    const int v = i >> 10, k = i & 1023;
    const float c = v < 4 ? p.c[v * 1024 + k] : p.c_ctx[k];
    sv[i] = c / (1.f + __expf(-c));
  }
  __syncthreads();
  const int kq = tid >> 6, cc = tid & 63, col = cg0 + cc;
  float a[5] = {0.f, 0.f, 0.f, 0.f, 0.f};
  const float* w = p.w_mod + (size_t)l * 1024 * 6144 + col;
#pragma unroll 8
  for (int k = kq * 256; k < kq * 256 + 256; ++k) {
    const float wv = w[(size_t)k * 6144];
#pragma unroll
    for (int v = 0; v < 5; ++v) a[v] += sv[v * 1024 + k] * wv;
  }
#pragma unroll
  for (int v = 0; v < 5; ++v) red[(kq * 5 + v) * 64 + cc] = a[v];
  __syncthreads();
  for (int i = tid; i < 5 * 64; i += 256) {
    const int v = i >> 6, c2 = i & 63;
    float s = p.b_mod[l * 6144 + cg0 + c2];
#pragma unroll
    for (int q = 0; q < 4; ++q) s += red[(q * 5 + v) * 64 + c2];
    ((float*)(p.ws + OFF_MOD))[(l * 5 + v) * 6144 + cg0 + c2] = s;
  }
  __syncthreads();
}

DI void rope_item(const Params& p, int item) {
  const int e = item * 256 + opq(threadIdx.x);
  const int pos = e / 48, f = e % 48;
  const int row = pos >> 6, colp = pos & 63;
  float* base = (float*)(p.ws + OFF_ROPE);
  float ang; float *cd, *sd;
  if (f < 16) {
    const int fi = f & 7;
    const float inv = exp2f(-(float)fi * (13.287712379549449f / 8.f));
    ang = (f < 8 ? (float)row : (float)colp) * inv;
    cd = base + pos * 16 + f; sd = base + 8192 * 16 + pos * 16 + f;
  } else {
    const int f2 = f - 16, fi = f2 & 15;
    const float inv = exp2f(-(float)fi * (13.287712379549449f / 16.f));
    ang = (f2 < 16 ? (float)row : (float)colp) * inv;
    cd = base + 2 * 8192 * 16 + pos * 32 + f2; sd = base + 2 * 8192 * 16 + 8192 * 32 + pos * 32 + f2;
  }
  const float rev = ang * 0.15915494309189535f;
  *cd = cosrev(rev);
  *sd = sinrev(rev);
}

DI void hid_item(const Params& p, int item, char* smem) {
  float* feat = (float*)smem;
  float* h1 = feat + 4 * 36;
  const int tid = opq(threadIdx.x);
  const int l = item / 264; const int it = item % 264;
  int L, pos00; float* dst;
  if (it < 256) { L = 8192; pos00 = it * 32; dst = (float*)(p.ws + OFF_HID + l * HID_LAYER); }
  else { L = 256; pos00 = (it - 256) * 32; dst = (float*)(p.ws + OFF_HID + l * HID_LAYER) + 64 * 8192; }
  const int pp = tid >> 6, j = tid & 63;
#pragma unroll 1
  for (int sub = 0; sub < 8; ++sub) {
    const int pos = pos00 + sub * 4 + pp;
    if (j < 33) {
      float fv;
      if (j == 0) fv = (float)pos / (float)(L - 1);
      else {
        const int bi = (j - 1) & 15;
        const float band = 1e-4f + (float)bi * ((15.f - 1e-4f) / 15.f);
        const float rev = (float)pos * band / (float)L;
        fv = (j <= 16) ? cosrev(rev) : -sinrev(rev);
      }
      feat[pp * 36 + j] = fv;
    }
    __syncthreads();
    {
      float s = p.hy_b1[l * 64 + j];
      const float* w1 = p.hy_w1 + (size_t)l * 33 * 64;
#pragma unroll
      for (int f = 0; f < 33; ++f) s += feat[pp * 36 + f] * w1[f * 64 + j];
      s *= p.hy_freq[l * 128 + j];
      h1[pp * 64 + j] = sinrev(s * 0.15915494309189535f);
    }
    __syncthreads();
    {
      float s = p.hy_b2[l * 64 + j];
      const float* w2 = p.hy_w2 + (size_t)l * 64 * 64;
#pragma unroll 8
      for (int i = 0; i < 64; ++i) s += h1[pp * 64 + i] * w2[i * 64 + j];
      s *= p.hy_freq[l * 128 + 64 + j];
      dst[(size_t)j * L + pos] = sinrev(s * 0.15915494309189535f);
    }
    __syncthreads();
  }
}

DI const float* xrow_src(const float* xl, const float* xc, int m) {
  const int b = m / TPB, j = m - b * TPB;
  return j < CTX ? xc + (size_t)(b * CTX + j) * DM : xl + (size_t)(b * SEQ + j - CTX) * DM;
}
DI void row_pass(const Params& p, int mode, const float* xl_src, const float* xc_src, float* xl_dst, float* xc_dst,
                 const u16* ybuf, const float* gy, int gate_off, int modl_gate,
                 bool has_next, const float* gn, int modl_next, int sh_off, int sc_off, u16* hdst, bool skip_ctx_rows) {
  const int tid0 = opq(threadIdx.x);
  const int lane = tid0 & 63;
  const int gw = blockIdx.x * 4 + (tid0 >> 6), nw = gridDim.x * 4;
  const float* modb = (const float*)(p.ws + OFF_MOD);
  const int per = (MTOK + nw - 1) / nw;
  const int m_beg = gw * per, m_end = min(m_beg + per, MTOK);
  int cur_v = -1;
  float4 gg[4], gs[4], shv[4];
#pragma unroll
  for (int i = 0; i < 4; ++i) { gg[i] = make_float4(0.f, 0.f, 0.f, 0.f); gs[i] = gg[i]; shv[i] = gg[i]; }
  const bool do_h = (mode == 0) || has_next;
  float4 xv_n[4];
  u32x2 yr_n[4];
#pragma unroll
  for (int i = 0; i < 4; ++i) { xv_n[i] = make_float4(0.f, 0.f, 0.f, 0.f); yr_n[i] = u32x2{0u, 0u}; }
  if (m_beg < m_end) {
    const float* xs0 = xrow_src(xl_src, xc_src, m_beg);
#pragma unroll
    for (int i = 0; i < 4; ++i) {
      xv_n[i] = *(const float4*)(xs0 + lane * 4 + 256 * i);
      if (mode == 1) yr_n[i] = *(const u32x2*)(ybuf + (size_t)m_beg * DM + lane * 4 + 256 * i);
    }
  }
  for (int m = m_beg; m < m_end; ++m) {
    const int b = m / TPB, j = m - b * TPB;
    float4 xv[4];
    u32x2 yr[4];
#pragma unroll
    for (int i = 0; i < 4; ++i) { xv[i] = xv_n[i]; yr[i] = yr_n[i]; }
    if (m + 1 < m_end) {
      const float* xs1 = xrow_src(xl_src, xc_src, m + 1);
#pragma unroll
      for (int i = 0; i < 4; ++i) {
        xv_n[i] = *(const float4*)(xs1 + lane * 4 + 256 * i);
        if (mode == 1) yr_n[i] = *(const u32x2*)(ybuf + (size_t)(m + 1) * DM + lane * 4 + 256 * i);
      }
    }
    if (skip_ctx_rows && j < CTX) continue;
    const int v = j < CTX ? 4 : b;
    if (v != cur_v) {
      cur_v = v;
#pragma unroll
      for (int i = 0; i < 4; ++i) {
        const int c = lane * 4 + 256 * i;
        if (mode == 1) {
          const float4 g4 = *(const float4*)(gy + c);
          const float4 t4 = *(const float4*)(modb + (size_t)(modl_gate * 5 + v) * 6144 + gate_off + c);
          gg[i] = make_float4(g4.x * t4.x, g4.y * t4.y, g4.z * t4.z, g4.w * t4.w);
        }
        if (do_h) {
          const float* mb = modb + (size_t)(modl_next * 5 + v) * 6144;
          const float4 g4 = *(const float4*)(gn + c);
          const float4 sc = *(const float4*)(mb + sc_off + c);
          shv[i] = *(const float4*)(mb + sh_off + c);
          gs[i] = make_float4(g4.x * (1.f + sc.x), g4.y * (1.f + sc.y), g4.z * (1.f + sc.z), g4.w * (1.f + sc.w));
        }
      }
    }
    if (mode == 1) {
      float yv[4][4];
      float ss = 0.f;
#pragma unroll
      for (int i = 0; i < 4; ++i) {
        const u32x2 u = yr[i];
        yv[i][0] = lo_bf(u.x); yv[i][1] = hi_bf(u.x); yv[i][2] = lo_bf(u.y); yv[i][3] = hi_bf(u.y);
#pragma unroll
        for (int e = 0; e < 4; ++e) ss += yv[i][e] * yv[i][e];
      }
      ss = wave_sum(ss);
      const float rstd = rsqrtf(ss * (1.f / DM) + EPS);
#pragma unroll
      for (int i = 0; i < 4; ++i) {
        xv[i].x += gg[i].x * (yv[i][0] * rstd);
        xv[i].y += gg[i].y * (yv[i][1] * rstd);
        xv[i].z += gg[i].z * (yv[i][2] * rstd);
        xv[i].w += gg[i].w * (yv[i][3] * rstd);
      }
      float* xd = (j < CTX) ? xc_dst + (size_t)(b * CTX + j) * DM : xl_dst + (size_t)(b * SEQ + j - CTX) * DM;
#pragma unroll
      for (int i = 0; i < 4; ++i) *(float4*)(xd + lane * 4 + 256 * i) = xv[i];
    }
    if (do_h) {
      float ss = 0.f;
#pragma unroll
      for (int i = 0; i < 4; ++i) ss += xv[i].x * xv[i].x + xv[i].y * xv[i].y + xv[i].z * xv[i].z + xv[i].w * xv[i].w;
      ss = wave_sum(ss);
      const float rstd = rsqrtf(ss * (1.f / DM) + EPS);
#pragma unroll
      for (int i = 0; i < 4; ++i) {
        const int c = lane * 4 + 256 * i;
        u32x2 pk;
        pk.x = pack2(xv[i].x * rstd * gs[i].x + shv[i].x, xv[i].y * rstd * gs[i].y + shv[i].y);
        pk.y = pack2(xv[i].z * rstd * gs[i].z + shv[i].z, xv[i].w * rstd * gs[i].w + shv[i].w);
        *(u32x2*)(hdst + (size_t)m * DM + c) = pk;
      }
    }
  }
}

constexpr float QS_MLA = 0.10206207261596577f * LOG2E;
constexpr float QS_SWA = 0.125f * LOG2E;

DI void rope32(f32x16& a, const float* cm, const float* sm, int pos, int h) {
#pragma unroll
  for (int i = 0; i < 8; ++i) {
    const int f = crow(i, h);
    const float c = cm[pos * 16 + f], s = sm[pos * 16 + f];
    const float x1 = a[i], x2 = a[i + 8];
    a[i] = x1 * c - x2 * s;
    a[i + 8] = x2 * c + x1 * s;
    if ((i & 3) == 3) __builtin_amdgcn_sched_barrier(0);
  }
}
DI void rope64(f32x16& a0, f32x16& a1, const float* cs, const float* ss, int pos, int h) {
#pragma unroll
  for (int i = 0; i < 16; ++i) {
    const int f = crow(i, h);
    const float c = cs[pos * 32 + f], s = ss[pos * 32 + f];
    const float x1 = a0[i], x2 = a1[i];
    a0[i] = x1 * c - x2 * s;
    a1[i] = x2 * c + x1 * s;
    if ((i & 3) == 3) __builtin_amdgcn_sched_barrier(0);
  }
}

DI void inproj_tile(const Params& p, int tile, char* smem) {
  const int mt_i = tile / 27, nt_i = tile % 27;
  const int m0 = mt_i * 192;
  const int tid = opq(threadIdx.x), lane = tid & 63, wave = tid >> 6, wm = wave >> 1, wn = wave & 1, r = lane & 31, h = lane >> 5;
  const u16* hbuf = (const u16*)(p.ws + OFF_RH);
  const u16* wt = (const u16*)(p.ws + OFF_WT_IN) + (size_t)nt_i * 128 * 1024;
  const int b = m0 / TPB, j0 = m0 - b * TPB;
  const float* cm = (const float*)(p.ws + OFF_ROPE);
  const float* sm = cm + 8192 * 16;
  const float* cs = sm + 8192 * 16;
  const float* ss = cs + 8192 * 32;
  f32x16 acc[3][2];
  if (nt_i >= 13 && nt_i <= 25) {
    gemm_main<false>(hbuf, 1024, m0, 0, MTOK - 1, 64, wt, 1024, 16, acc, smem);
    if (nt_i == 13) store_transposed(acc, (u16*)(p.ws + OFF_SVT), TPB, b * 128, j0);
    else store_transposed(acc, (u16*)(p.ws + OFF_HYT), TPB, b * 1536 + (nt_i - 14) * 128, j0);
    return;
  }
  gemm_main<true>(hbuf, 1024, m0, 0, MTOK - 1, 64, wt, 1024, 16, acc, smem);
  if (nt_i < 6) {
#pragma unroll
    for (int ntl = 0; ntl < 2; ++ntl) {
      const int s32 = nt_i * 4 + wn * 2 + ntl;
      if (s32 % 3 == 2) {
#pragma unroll
        for (int mt = 0; mt < 3; ++mt) {
          const int jr = j0 + wm * 96 + mt * 32 + r;
          if (jr >= CTX) rope32(acc[mt][ntl], cm, sm, jr - CTX, h);
        }
      }
    }
    store_rowmajor(acc, (u16*)(p.ws + OFF_Q), 768, m0, nt_i * 128, QS_MLA);
  } else if (nt_i < 8) {
    store_rowmajor(acc, (u16*)(p.ws + OFF_CKV), 256, m0, (nt_i - 6) * 128, 1.f);
  } else if (nt_i < 12) {
#pragma unroll
    for (int mt = 0; mt < 3; ++mt) {
      const int jr = j0 + wm * 96 + mt * 32 + r;
      if (jr >= CTX) rope64(acc[mt][0], acc[mt][1], cs, ss, jr - CTX, h);
    }
    store_rowmajor(acc, (u16*)(p.ws + OFF_SQ), 512, m0, (nt_i - 8) * 128, QS_SWA);
  } else if (nt_i == 12) {
#pragma unroll
    for (int mt = 0; mt < 3; ++mt) {
      const int jr = j0 + wm * 96 + mt * 32 + r;
      if (jr >= CTX) rope64(acc[mt][0], acc[mt][1], cs, ss, jr - CTX, h);
    }
    store_rowmajor(acc, (u16*)(p.ws + OFF_SK), 128, m0, 0, 1.f);
  } else {
    if (wn == 0) {
      u16* kr = (u16*)(p.ws + OFF_KR);
#pragma unroll
      for (int mt = 0; mt < 3; ++mt) {
        const int ml = wm * 96 + mt * 32 + r;
        if (j0 + ml >= CTX) rope32(acc[mt][0], cm, sm, j0 + ml - CTX, h);
#pragma unroll
        for (int g = 0; g < 4; ++g) {
          u32x2 pk;
          pk.x = pack2(acc[mt][0][4 * g], acc[mt][0][4 * g + 1]);
          pk.y = pack2(acc[mt][0][4 * g + 2], acc[mt][0][4 * g + 3]);
          *(u32x2*)(kr + (size_t)(m0 + ml) * 32 + 8 * g + 4 * h) = pk;
        }
      }
    }
  }
}

DI void kvup_tile(const Params& p, int tile, char* smem) {
  const int mt_i = tile >> 3, nt_i = tile & 7;
  const int m0 = mt_i * 192;
  const int tid = opq(threadIdx.x), lane = tid & 63, wave = tid >> 6, wm = wave >> 1, r = lane & 31, h = lane >> 5;
  const u16* ckv = (const u16*)(p.ws + OFF_CKV);
  float* rs = (float*)(smem + (192 + 128) * 144);
#pragma unroll
  for (int pass = 0; pass < 2; ++pass) {
    const int row = pass * 128 + (tid >> 1), half = tid & 1;
    const int rowc = min(row, 191);
    const u32x4* src = (const u32x4*)(ckv + (size_t)(m0 + rowc) * 256 + half * 128);
    float ss = 0.f;
#pragma unroll
    for (int i = 0; i < 16; ++i) {
      const u32x4 u = src[i];
      const unsigned w[4] = {u.x, u.y, u.z, u.w};
#pragma unroll
      for (int e = 0; e < 4; ++e) { const float a = lo_bf(w[e]), c = hi_bf(w[e]); ss += a * a + c * c; }
    }
    ss += __shfl_xor(ss, 1);
    if (half == 0 && row < 192) rs[row] = rsqrtf(ss * (1.f / 256.f) + EPS);
  }
  const u16* wt = (const u16*)(p.ws + OFF_WT_KV) + (size_t)nt_i * 128 * 256;
  const int b = m0 / TPB, j0 = m0 - b * TPB;
  f32x16 acc[3][2];
  if (nt_i < 4) {
    gemm_main<true>(ckv, 256, m0, 0, MTOK - 1, 64, wt, 256, 4, acc, smem);
#pragma unroll
    for (int mt = 0; mt < 3; ++mt) {
      const float sc = rs[wm * 96 + mt * 32 + r];
#pragma unroll
      for (int nt = 0; nt < 2; ++nt)
#pragma unroll
        for (int i = 0; i < 16; ++i) acc[mt][nt][i] *= sc;
    }
    store_rowmajor(acc, (u16*)(p.ws + OFF_KN), 512, m0, nt_i * 128, 1.f);
  } else {
    gemm_main<false>(ckv, 256, m0, 0, MTOK - 1, 64, wt, 256, 4, acc, smem);
#pragma unroll
    for (int mt = 0; mt < 3; ++mt)
#pragma unroll
      for (int i = 0; i < 16; ++i) {
        const float sc = rs[wm * 96 + mt * 32 + crow(i, h)];
        acc[mt][0][i] *= sc;
        acc[mt][1][i] *= sc;
      }
    store_transposed(acc, (u16*)(p.ws + OFF_VT), TPB, b * 512 + (nt_i - 4) * 128, j0);
  }
  __syncthreads();
}

DI void merge_tile(const Params& p, int tile, char* smem) {
  const int mt_i = tile >> 3, nt_i = tile & 7;
  const int m0 = mt_i * 192;
  const u16* hp = (const u16*)(p.ws + OFF_RH);
  const int tid = opq(threadIdx.x), lane = tid & 63, wave = tid >> 6, wm = wave >> 1, wn = wave & 1, r = lane & 31, h = lane >> 5;
  u16* C = (u16*)(p.ws + OFF_MERGED);
#pragma unroll 1
  for (int br = 0; br < 3; ++br) {
    if ((DBG_SKIP_BR >> br) & 1) continue;
    f32x16 acc[3][2];
    gemm_main<true>(hp, 1024, m0, 0, MTOK - 1, 64, (const u16*)(p.ws + OFF_WT_GATE) + (size_t)(br * 1024 + nt_i * 128) * 1024, 1024, 16, acc, smem);
    u32x2* sgp = (u32x2*)(p.ws + OFF_ESCR + (size_t)blockIdx.x * 65536) + tid * 24;
#pragma unroll
    for (int a = 0; a < 3; ++a)
#pragma unroll
      for (int b2 = 0; b2 < 2; ++b2)
#pragma unroll
        for (int g = 0; g < 4; ++g) {
          u32x2 v;
          v.x = pack2(1.f / (1.f + __expf(-acc[a][b2][4 * g])), 1.f / (1.f + __expf(-acc[a][b2][4 * g + 1])));
          v.y = pack2(1.f / (1.f + __expf(-acc[a][b2][4 * g + 2])), 1.f / (1.f + __expf(-acc[a][b2][4 * g + 3])));
          sgp[(a * 2 + b2) * 4 + g] = v;
        }
    const u16* wbr = (const u16*)(p.ws + OFF_WT_BR) + (size_t)(br * 1024 + nt_i * 128) * 512;
    if (br == 0) gemm_main<true>((const u16*)(p.ws + OFF_Q), 768, m0, 0, MTOK - 1, 96, wbr, 512, 8, acc, smem);
    else if (br == 1) gemm_main<true>((const u16*)(p.ws + OFF_SQ), 512, m0, 0, MTOK - 1, 64, wbr, 512, 8, acc, smem);
    else {
      const int b = m0 / TPB, j0 = m0 - b * TPB;
      gemm_main<true, true>((const u16*)(p.ws + OFF_HYT) + (size_t)(b * 1536 + 512) * TPB, TPB, j0, 0, 0, 64, wbr, 512, 8, acc, smem);
    }
#pragma unroll
    for (int mt = 0; mt < 3; ++mt)
#pragma unroll
      for (int nt = 0; nt < 2; ++nt)
#pragma unroll
        for (int g = 0; g < 4; ++g) {
          const int m = m0 + wm * 96 + mt * 32 + r, n = nt_i * 128 + wn * 64 + nt * 32 + 8 * g + 4 * h;
          u32x2* dst = (u32x2*)(C + (size_t)m * 1024 + n);
          u32x2 prev = {0u, 0u};
          if (br > DBG_FIRST_BR) prev = *dst;
          const u32x2 sv = sgp[(mt * 2 + nt) * 4 + g];
          const unsigned s0 = sv.x, s1 = sv.y;
          u32x2 nv;
          nv.x = pack2(lo_bf(prev.x) + lo_bf(s0) * acc[mt][nt][4 * g], hi_bf(prev.x) + hi_bf(s0) * acc[mt][nt][4 * g + 1]);
          nv.y = pack2(lo_bf(prev.y) + lo_bf(s1) * acc[mt][nt][4 * g + 2], hi_bf(prev.y) + hi_bf(s1) * acc[mt][nt][4 * g + 3]);
          *dst = nv;
          __builtin_amdgcn_sched_barrier(0);
        }
  }
}

DI void plain_tile(const Params& p, int tile, const u16* A, int lda, int nk, const u16* W, u16* C, char* smem) {
  const int mt_i = tile >> 3, nt_i = tile & 7;
  f32x16 acc[3][2];
  gemm_main<true>(A, lda, mt_i * 192, 0, MTOK - 1, 64, W + (size_t)nt_i * 128 * lda, lda, nk, acc, smem);
  store_rowmajor(acc, C, 1024, mt_i * 192, nt_i * 128, 1.f);
}

DI void ffnup_tile(const Params& p, int l, int tile, char* smem) {
  const int mt_i = tile / 44, nt_i = tile % 44;
  const int b = mt_i / 46, ti = mt_i % 46;
  int seq_base, len, r0;
  if (ti < 2) { seq_base = b * TPB; len = CTX; r0 = 190 * ti; }
  else { seq_base = b * TPB + CTX; len = SEQ; r0 = 190 * (ti - 2); }
  const int tid = opq(threadIdx.x), lane = tid & 63, wave = tid >> 6, wm = wave >> 1, wn = wave & 1, r = lane & 31, h = lane >> 5;
  f32x16 acc[3][2];
  gemm_main<true>((const u16*)(p.ws + OFF_RH), 1024, seq_base + r0 - 1, seq_base, seq_base + len - 1, 64,
                  (const u16*)(p.ws + OFF_WT_UP) + (size_t)nt_i * 128 * 1024, 1024, 16, acc, smem);
  __syncthreads();
#pragma unroll
  for (int mt = 0; mt < 3; ++mt) {
    const int ml = wm * 96 + mt * 32 + r;
    const int pos = r0 - 1 + ml;
    const bool valid = pos >= 0 && pos < len;
#pragma unroll
    for (int nt = 0; nt < 2; ++nt)
#pragma unroll
      for (int g = 0; g < 4; ++g) {
        u32x2 pk = u32x2{0u, 0u};
        if (valid) {
          pk.x = pack2(acc[mt][nt][4 * g], acc[mt][nt][4 * g + 1]);
          pk.y = pack2(acc[mt][nt][4 * g + 2], acc[mt][nt][4 * g + 3]);
        }
        *(u32x2*)(smem + ml * 272 + (wn * 64 + nt * 32 + 8 * g + 4 * h) * 2) = pk;
      }
  }
  __syncthreads();
  {
    const int j4 = (tid & 15) * 4, tr = tid >> 4;
    const float* cw = p.ffn_conv_w + (size_t)l * 3 * 5632;
    const float* cb = p.ffn_conv_b + (size_t)l * 5632;
    const int cha = nt_i * 64 + j4, chb = DFF + cha;
    float wa[3][4], wb[3][4], ba[4], bb[4];
#pragma unroll
    for (int e = 0; e < 4; ++e) {
#pragma unroll
      for (int d = 0; d < 3; ++d) { wa[d][e] = cw[d * 5632 + cha + e]; wb[d][e] = cw[d * 5632 + chb + e]; }
      ba[e] = cb[cha + e]; bb[e] = cb[chb + e];
    }
    u16* Aout = (u16*)(p.ws + OFF_A);
#pragma unroll 1
    for (int i = 0; i < 12; ++i) {
      const int t = 1 + tr + 16 * i;
      const int pos = r0 - 1 + t;
      if (t <= 190 && pos < len) {
        float ca[4], cbv[4];
#pragma unroll
        for (int e = 0; e < 4; ++e) { ca[e] = ba[e]; cbv[e] = bb[e]; }
#pragma unroll
        for (int d = 0; d < 3; ++d) {
          const u32x2 ua = *(const u32x2*)(smem + (t - 1 + d) * 272 + j4 * 2);
          const u32x2 ub = *(const u32x2*)(smem + (t - 1 + d) * 272 + (64 + j4) * 2);
          ca[0] += lo_bf(ua.x) * wa[d][0]; ca[1] += hi_bf(ua.x) * wa[d][1]; ca[2] += lo_bf(ua.y) * wa[d][2]; ca[3] += hi_bf(ua.y) * wa[d][3];
          cbv[0] += lo_bf(ub.x) * wb[d][0]; cbv[1] += hi_bf(ub.x) * wb[d][1]; cbv[2] += lo_bf(ub.y) * wb[d][2]; cbv[3] += hi_bf(ub.y) * wb[d][3];
        }
        float o[4];
#pragma unroll
        for (int e = 0; e < 4; ++e) o[e] = ca[e] / (1.f + __expf(-ca[e])) * cbv[e];
        *(u32x2*)(Aout + (size_t)(seq_base + pos) * DFF + cha) = u32x2{pack2(o[0], o[1]), pack2(o[2], o[3])};
      }
    }
  }
}

template <int DQK, bool SWA>
DI void attn_item(const Params& p, int l, int b, int hq, int jq0  , int nct, int nband, int kp_start, char* smem) {
  constexpr int KS = DQK * 2 + 16;
  constexpr int KCH = DQK / 8;
  constexpr int NKC = 64 * KCH / 256;
  constexpr int NKS = DQK / 16;
  constexpr int BUFSZ = 22016;
  const int tid = opq(threadIdx.x), lane = tid & 63, wave = tid >> 6, r = lane & 31, h = lane >> 5;
  const int brow = b * TPB;
  const int ntiles = nct + nband;
  const u16* K1; int ldk1, koff; const u16* KR = (const u16*)(p.ws + OFF_KR);
  const u16* Vb; u16* outp; int ldo, ooff; const u16* Qb; int ldq;
  if (!SWA) {
    K1 = (const u16*)(p.ws + OFF_KN); ldk1 = 512; koff = hq * 64;
    Vb = (const u16*)(p.ws + OFF_VT) + (size_t)((b * 8 + hq) * 64) * TPB;
    Qb = (const u16*)(p.ws + OFF_Q); ldq = 768;
    outp = (u16*)(p.ws + OFF_Q); ldo = 768; ooff = hq * 96;
  } else {
    const int kvh = hq >> 2;
    K1 = (const u16*)(p.ws + OFF_SK); ldk1 = 128; koff = kvh * 64;
    Vb = (const u16*)(p.ws + OFF_SVT) + (size_t)((b * 2 + kvh) * 64) * TPB;
    Qb = (const u16*)(p.ws + OFF_SQ); ldq = 512;
    outp = (u16*)(p.ws + OFF_SQ); ldo = 512; ooff = hq * 64;
  }
  const int qrow = brow + jq0 + wave * 32 + r;
  bf16x8 qf[NKS];
#pragma unroll
  for (int ks = 0; ks < NKS; ++ks) qf[ks] = *(const bf16x8*)(Qb + (size_t)qrow * ldq + hq * DQK + ks * 16 + h * 8);
  f32x16 o[2];
#pragma unroll
  for (int dt = 0; dt < 2; ++dt)
#pragma unroll
    for (int i = 0; i < 16; ++i) o[dt][i] = 0.f;
  float mrun = -INFINITY, lsum = 0.f;
  u32x4 kreg[NKC], vreg[2];
  auto tile_j = [&](int it) { return it < nct ? it * 64 : CTX + kp_start + 64 * (it - nct); };
  auto issue = [&](int it) {
    const int jr = tile_j(it);
#pragma unroll
    for (int i = 0; i < NKC; ++i) {
      const int c = tid + 256 * i, key = c / KCH, part = c % KCH;
      const u16* src = (part < 8) ? K1 + (size_t)(brow + jr + key) * ldk1 + koff + part * 8
                                  : KR + (size_t)(brow + jr + key) * 32 + (part - 8) * 8;
      kreg[i] = *(const u32x4*)src;
    }
#pragma unroll
    for (int i = 0; i < 2; ++i) {
      const int c = tid + 256 * i, d = c >> 3, part = c & 7;
      vreg[i] = *(const u32x4*)(Vb + (size_t)d * TPB + jr + part * 8);
    }
  };
  auto stash = [&](int buf) {
    char* kb = smem + buf * BUFSZ;
    char* vb = kb + 13312;
#pragma unroll
    for (int i = 0; i < NKC; ++i) {
      const int c = tid + 256 * i, key = c / KCH, part = c % KCH;
      *(u32x4*)(kb + key * KS + part * 16) = kreg[i];
    }
#pragma unroll
    for (int i = 0; i < 2; ++i) {
      const int c = tid + 256 * i, d = c >> 3, part = c & 7;
      *(u32x2*)(vb + d * 136 + part * 16) = u32x2{vreg[i].x, vreg[i].y};
      *(u32x2*)(vb + d * 136 + part * 16 + 8) = u32x2{vreg[i].z, vreg[i].w};
    }
  };
  __syncthreads();
  issue(0);
  stash(0);
  __syncthreads();
  const int qpos = jq0 - CTX + wave * 32 + r;
#pragma unroll 1
  for (int it = 0; it < ntiles; ++it) {
    const int buf = it & 1;
    const char* kb = smem + buf * BUFSZ;
    const char* vb = kb + 13312;
    if (it + 1 < ntiles) issue(it + 1);
    f32x16 s[2];
#pragma unroll
    for (int kt = 0; kt < 2; ++kt) {
#pragma unroll
      for (int i = 0; i < 16; ++i) s[kt][i] = 0.f;
#pragma unroll
      for (int ks = 0; ks < NKS; ++ks) {
        const bf16x8 kf = *(const bf16x8*)(kb + (kt * 32 + r) * KS + ks * 32 + h * 16);
        s[kt] = MFMA(kf, qf[ks], s[kt]);
      }
    }
    if (SWA && it >= nct) {
      const int kpos0 = kp_start + 64 * (it - nct);
#pragma unroll
      for (int kt = 0; kt < 2; ++kt)
#pragma unroll
        for (int i = 0; i < 16; ++i) {
          const int diff = qpos - (kpos0 + kt * 32 + crow(i, h));
          if (diff > 128 || diff < -128) s[kt][i] = -1e30f;
        }
    }
    float mx = s[0][0];
#pragma unroll
    for (int kt = 0; kt < 2; ++kt)
#pragma unroll
      for (int i = 0; i < 16; ++i) mx = fmaxf(mx, s[kt][i]);
    mx = fmaxf(mx, __shfl_xor(mx, 32));
    const float mnew = fmaxf(mrun, mx);
    const float alpha = __builtin_amdgcn_exp2f(mrun - mnew);
    float ps = 0.f;
#pragma unroll
    for (int kt = 0; kt < 2; ++kt)
#pragma unroll
      for (int i = 0; i < 16; ++i) { const float e = __builtin_amdgcn_exp2f(s[kt][i] - mnew); s[kt][i] = e; ps += e; }
    if (__builtin_amdgcn_ballot_w64(mnew != mrun) != 0ull) {
      lsum *= alpha;
#pragma unroll
      for (int dt = 0; dt < 2; ++dt)
#pragma unroll
        for (int i = 0; i < 16; ++i) o[dt][i] *= alpha;
    }
    lsum += ps;
    mrun = mnew;
#pragma unroll
    for (int kt = 0; kt < 2; ++kt)
#pragma unroll
      for (int s2 = 0; s2 < 2; ++s2) {
        unsigned pk[4];
#pragma unroll
        for (int j = 0; j < 4; ++j) pk[j] = pack2(s[kt][8 * s2 + 2 * j], s[kt][8 * s2 + 2 * j + 1]);
        const bf16x8 pf = __builtin_bit_cast(bf16x8, u32x4{pk[0], pk[1], pk[2], pk[3]});
#pragma unroll
        for (int dt = 0; dt < 2; ++dt) {
          const char* vp = vb + (dt * 32 + r) * 136 + (kt * 32 + 16 * s2 + 4 * h) * 2;
          const s16x4 lo = *(const s16x4*)vp;
          const s16x4 hi = *(const s16x4*)(vp + 16);
          const bf16x8 vf = __builtin_shufflevector(lo, hi, 0, 1, 2, 3, 4, 5, 6, 7);
          o[dt] = MFMA(vf, pf, o[dt]);
        }
      }
    if (it + 1 < ntiles) stash(buf ^ 1);
    __syncthreads();
  }
  float ltot = lsum + __shfl_xor(lsum, 32);
  if (SWA) ltot += __builtin_amdgcn_exp2f(p.swa_sink[l * 8 + hq] * LOG2E - mrun);
  const float inv = 1.f / ltot;
#pragma unroll
  for (int dt = 0; dt < 2; ++dt)
#pragma unroll
    for (int g = 0; g < 4; ++g) {
      u32x2 pk;
      pk.x = pack2(o[dt][4 * g] * inv, o[dt][4 * g + 1] * inv);
      pk.y = pack2(o[dt][4 * g + 2] * inv, o[dt][4 * g + 3] * inv);
      *(u32x2*)(outp + (size_t)qrow * ldo + ooff + dt * 32 + 8 * g + 4 * h) = pk;
    }
}

constexpr float HY_D0 = 3.0701134573253944f;
constexpr float HY_DSTEP = (15.350567286626972f - 3.0701134573253944f) / 511.f;

DI void filt_item(const Params& p, int l, int oc, char* smem) {
  float2* lds = (float2*)smem;
  float* lf = (float*)smem;
  const int tid = opq(threadIdx.x), lane = tid & 63, wave = tid >> 6;
  const int c = oc & 511;
  const float* hid = (const float*)(p.ws + OFF_HID + l * HID_LAYER);
  const float* w3 = p.hy_w3 + (size_t)l * 64 * 2048;
  float* sa = (float*)(p.ws + OFF_ESCR + (size_t)blockIdx.x * 65536);
  float* sb = sa + 8192;
  __syncthreads();
  if (tid < 128) { const int dir = tid >> 6, j = tid & 63; lf[tid] = w3[j * 2048 + dir * 1024 + oc]; }
  __syncthreads();
  const float delta = HY_D0 + (float)c * HY_DSTEP;
  float asum = 0.f;
#pragma unroll 1
  for (int ib = 0; ib < 4; ++ib) {
    float a[8], bm[8];
#pragma unroll
    for (int i = 0; i < 8; ++i) { a[i] = 0.f; bm[i] = 0.f; }
#pragma unroll 4
    for (int j = 0; j < 64; ++j) {
      const float w0 = lf[j], w1 = lf[64 + j];
      const float* hr = hid + (size_t)j * 8192 + 4 * (tid + 512 * ib);
#pragma unroll
      for (int ii = 0; ii < 2; ++ii) {
        const float4 hv = *(const float4*)(hr + 1024 * ii);
        a[4 * ii + 0] += hv.x * w0; bm[4 * ii + 0] += hv.x * w1;
        a[4 * ii + 1] += hv.y * w0; bm[4 * ii + 1] += hv.y * w1;
        a[4 * ii + 2] += hv.z * w0; bm[4 * ii + 2] += hv.z * w1;
        a[4 * ii + 3] += hv.w * w0; bm[4 * ii + 3] += hv.w * w1;
      }
    }
#pragma unroll
    for (int ii = 0; ii < 2; ++ii) {
      const int t0 = 4 * (tid + 256 * (2 * ib + ii));
      float av[4];
#pragma unroll
      for (int e = 0; e < 4; ++e) {
        const int t = t0 + e;
        const float dec = __expf(-((float)t * (1.f / 8191.f)) * delta);
        av[e] = a[4 * ii + e] * dec;
        const float bv = bm[4 * ii + e] * dec;
        if (t >= 1) { sb[8192 - t] = bv; asum += fabsf(bv); } else sb[0] = 0.f;
        asum += fabsf(av[e]);
      }
      *(float4*)(sa + t0) = make_float4(av[0], av[1], av[2], av[3]);
    }
  }
  asum = wave_sum(asum);
  asm volatile("s_waitcnt vmcnt(0)" ::: "memory");
  __syncthreads();
  if (lane == 0) lf[wave] = asum;
  __syncthreads();
  const float inv = 1.f / (lf[0] + lf[1] + lf[2] + lf[3]);
  __syncthreads();
#pragma unroll 2
  for (int i = 0; i < 8; ++i) {
    const int t0 = 4 * (tid + 256 * i);
#pragma unroll
    for (int e = 0; e < 4; ++e) lds[fphys(t0 + e)] = make_float2((ldsc1(sa + t0 + e) + ldsc1(sb + t0 + e)) * inv, 0.f);
  }
  __syncthreads();
  h2_t* sp = (h2_t*)(p.ws + OFF_SPEC) + (size_t)oc * 2 * 8192;
  fft8192_spectrum(lds, tid, sp);
#pragma unroll 2
  for (int i = 0; i < 8; ++i) {
    const int t0 = 4 * (tid + 256 * i);
#pragma unroll
    for (int e = 0; e < 4; ++e) {
      const int t = t0 + e;
      const float2 w = twid_rev((float)t * (1.f / 16384.f));
      const float d = (ldsc1(sa + t) - ldsc1(sb + t)) * inv;
      lds[fphys(t)] = make_float2(d * w.x, d * w.y);
    }
  }
  __syncthreads();
  fft8192_spectrum(lds, tid, sp + 8192);
}

DI float dwc(const u16* s, int t, int len, float w0, float w1, float w2, float bias) {
  const int tm = max(t - 1, 0), tp = min(t + 1, len - 1);
  const float a = bf2f(s[tm]), b = bf2f(s[t]), c = bf2f(s[tp]);
  return b * w1 + bias + (t > 0 ? a * w0 : 0.f) + (t < len - 1 ? c * w2 : 0.f);
}

DI void ld4(const u16* s, int t0, float (&o)[4]) {
  const u32x2 u = *(const u32x2*)(s + t0);
  o[0] = lo_bf(u.x); o[1] = hi_bf(u.x); o[2] = lo_bf(u.y); o[3] = hi_bf(u.y);
}
DI void dwc4(const u16* s, int t0, int len, float w0, float w1, float w2, float bias, float (&o)[4]) {
  float c[4];
  ld4(s, t0, c);
  float l = bf2f(s[max(t0 - 1, 0)]), r = bf2f(s[min(t0 + 4, len - 1)]);
  l = (t0 > 0) ? l : 0.f;
  r = (t0 + 4 < len) ? r : 0.f;
  o[0] = l * w0 + c[0] * w1 + c[1] * w2 + bias;
  o[1] = c[0] * w0 + c[1] * w1 + c[2] * w2 + bias;
  o[2] = c[1] * w0 + c[2] * w1 + c[3] * w2 + bias;
  o[3] = c[2] * w0 + c[3] * w1 + r * w2 + bias;
}

DI void hconv_item(const Params& p, int l, int o, int c, int bp, char* smem) {
  float2* lds = (float2*)smem;
  const int tid = opq(threadIdx.x);
  u16* hyt = (u16*)(p.ws + OFF_HYT);
  const int b0 = bp * 2, b1 = b0 + 1;
  u16* z0p = hyt + (size_t)(b0 * 1536 + c) * TPB + CTX;
  u16* z1p = hyt + (size_t)(b1 * 1536 + c) * TPB + CTX;
  const int gc = (o + 1) * 512 + c;
  const u16* g0p = hyt + (size_t)(b0 * 1536 + gc) * TPB + CTX;
  const u16* g1p = hyt + (size_t)(b1 * 1536 + gc) * TPB + CTX;
  const float* cw = p.hy_conv_w + (size_t)l * 3 * 1536;
  const float* cb = p.hy_conv_b + (size_t)l * 1536;
  const float zw0 = cw[c], zw1 = cw[1536 + c], zw2 = cw[3072 + c], zbias = cb[c];
  const float gw0 = cw[gc], gw1 = cw[1536 + gc], gw2 = cw[3072 + gc], gbias = cb[gc];
  const float skip = p.hy_skip[l * 1024 + o * 512 + c];
  const h2_t* spe = (const h2_t*)(p.ws + OFF_SPEC) + (size_t)(o * 512 + c) * 2 * 8192;
  const h2_t* spo = spe + 8192;
  float2* Eg = (float2*)(p.ws + OFF_ESCR + (size_t)blockIdx.x * 65536);
  __syncthreads();
#pragma unroll 4
  for (int i = 0; i < 8; ++i) {
    const int t0 = 4 * (tid + 256 * i);
    float za[4], zb[4];
    if (o == 0) { dwc4(z0p, t0, SEQ, zw0, zw1, zw2, zbias, za); dwc4(z1p, t0, SEQ, zw0, zw1, zw2, zbias, zb); }
    else { ld4(z0p, t0, za); ld4(z1p, t0, zb); }
#pragma unroll
    for (int e = 0; e < 4; ++e) lds[fphys(t0 + e)] = make_float2(za[e], zb[e]);
  }
  __syncthreads();
  fft8192_conv(lds, tid, spe);
#pragma unroll 4
  for (int i = 0; i < 8; ++i) {
    const int t0 = 4 * (tid + 256 * i);
    float za[4], zb[4];
    if (o == 0) { dwc4(z0p, t0, SEQ, zw0, zw1, zw2, zbias, za); dwc4(z1p, t0, SEQ, zw0, zw1, zw2, zbias, zb); }
    else { ld4(z0p, t0, za); ld4(z1p, t0, zb); }
#pragma unroll
    for (int e = 0; e < 4; ++e) {
      Eg[t0 + e] = lds[fphys(t0 + e)];
      lds[fphys(t0 + e)] = cmul(make_float2(za[e], zb[e]), twid_rev((float)(t0 + e) * (1.f / 16384.f)));
    }
  }
  __syncthreads();
  fft8192_conv(lds, tid, spo);
#pragma unroll 4
  for (int i = 0; i < 8; ++i) {
    const int t0 = 4 * (tid + 256 * i);
    float za[4], zb[4], ga[4], gb[4];
    if (o == 0) { dwc4(z0p, t0, SEQ, zw0, zw1, zw2, zbias, za); dwc4(z1p, t0, SEQ, zw0, zw1, zw2, zbias, zb); }
    else { ld4(z0p, t0, za); ld4(z1p, t0, zb); }
    dwc4(g0p, t0, SEQ, gw0, gw1, gw2, gbias, ga);
    dwc4(g1p, t0, SEQ, gw0, gw1, gw2, gbias, gb);
#pragma unroll
    for (int e = 0; e < 4; ++e) {
      const int t = t0 + e;
      const float2 ov = cmulc(lds[fphys(t)], twid_rev((float)t * (1.f / 16384.f)));
      const float2 ev = Eg[t];
      const float y0 = (ev.x + ov.x) * (1.f / 16384.f), y1 = (ev.y + ov.y) * (1.f / 16384.f);
      Eg[t] = make_float2(ga[e] * (y0 + za[e] * skip), gb[e] * (y1 + zb[e] * skip));
    }
  }
  __syncthreads();
  u16* d0 = (o == 0) ? z0p : hyt + (size_t)(b0 * 1536 + 512 + c) * TPB + CTX;
  u16* d1 = (o == 0) ? z1p : hyt + (size_t)(b1 * 1536 + 512 + c) * TPB + CTX;
#pragma unroll 4
  for (int i = 0; i < 8; ++i) {
    const int t0 = 4 * (tid + 256 * i);
    float2 e4[4];
#pragma unroll
    for (int e = 0; e < 4; ++e) e4[e] = Eg[t0 + e];
    *(u32x2*)(d0 + t0) = u32x2{pack2(e4[0].x, e4[1].x), pack2(e4[2].x, e4[3].x)};
    *(u32x2*)(d1 + t0) = u32x2{pack2(e4[0].y, e4[1].y), pack2(e4[2].y, e4[3].y)};
  }
}

DI void hctx_item(const Params& p, int l, int c, char* smem) {
  float* lf = (float*)smem;
  float* kern = lf;
  float* zb = lf + 1024;
  float* z1b = lf + 2048;
  float* red = lf + 3072;
  const int tid = opq(threadIdx.x), lane = tid & 63, wave = tid >> 6;
  const float* hid = (const float*)(p.ws + OFF_HID + l * HID_LAYER) + 64 * 8192;
  const float* w3 = p.hy_w3 + (size_t)l * 64 * 2048;
  const u16* hyt = (const u16*)(p.ws + OFF_HYT);
  const float* cw = p.hy_conv_w + (size_t)l * 3 * 1536;
  const float* cb = p.hy_conv_b + (size_t)l * 1536;
  __syncthreads();
  {
    const int t = tid;
    float d[4] = {0.f, 0.f, 0.f, 0.f};
#pragma unroll 4
    for (int j = 0; j < 64; ++j) {
      const float hv = hid[j * 256 + t];
#pragma unroll
      for (int q = 0; q < 4; ++q) d[q] += hv * w3[j * 2048 + (q >> 1) * 1024 + (q & 1) * 512 + c];
    }
    const float dec = __expf(-((float)t * (1.f / 255.f)) * (HY_D0 + (float)c * HY_DSTEP));
#pragma unroll
    for (int o = 0; o < 2; ++o) {
      const float f0 = d[o] * dec, f1 = d[2 + o] * dec;
      kern[o * 512 + t] = f0;
      if (t >= 1) kern[o * 512 + 512 - t] = f1;
      if (t == 0) kern[o * 512 + 256] = 0.f;
      float s = fabsf(f0) + (t >= 1 ? fabsf(f1) : 0.f);
      s = wave_sum(s);
      if (lane == 0) red[o * 4 + wave] = s;
    }
  }
  const int b = tid >> 6, tq = tid & 63;
  const u16* zs = hyt + (size_t)(b * 1536 + c) * TPB;
  const u16* g1s = hyt + (size_t)(b * 1536 + 512 + c) * TPB;
  const u16* g2s = hyt + (size_t)(b * 1536 + 1024 + c) * TPB;
#pragma unroll
  for (int k = 0; k < 4; ++k) {
    const int tt = tq + 64 * k;
    zb[b * 256 + tt] = dwc(zs, tt, CTX, cw[c], cw[1536 + c], cw[3072 + c], cb[c]);
  }
  __syncthreads();
  const float inv0 = 1.f / (red[0] + red[1] + red[2] + red[3]);
  const float inv1 = 1.f / (red[4] + red[5] + red[6] + red[7]);
  const float sk0 = p.hy_skip[l * 1024 + c], sk1 = p.hy_skip[l * 1024 + 512 + c];
#pragma unroll 1
  for (int k = 0; k < 4; ++k) {
    const int tt = tq + 64 * k;
    float acc = 0.f;
#pragma unroll 8
    for (int s = 0; s < 256; ++s) acc += kern[(tt - s) & 511] * zb[b * 256 + s];
    const float g = dwc(g1s, tt, CTX, cw[512 + c], cw[1536 + 512 + c], cw[3072 + 512 + c], cb[512 + c]);
    z1b[b * 256 + tt] = g * (acc * inv0 + zb[b * 256 + tt] * sk0);
  }
  __syncthreads();
  u16* yc = (u16*)(p.ws + OFF_HYT) + (size_t)(b * 1536 + 512 + c) * TPB;
#pragma unroll 1
  for (int k = 0; k < 4; ++k) {
    const int tt = tq + 64 * k;
    float acc = 0.f;
#pragma unroll 8
    for (int s = 0; s < 256; ++s) acc += kern[512 + ((tt - s) & 511)] * z1b[b * 256 + s];
    const float g = dwc(g2s, tt, CTX, cw[1024 + c], cw[1536 + 1024 + c], cw[3072 + 1024 + c], cb[1024 + c]);
    yc[tt] = DBG_ZERO_HCTX ? (u16)0 : f2bf(g * (acc * inv1 + z1b[b * 256 + tt] * sk1));
  }
  __syncthreads();
}

#define XB_XCNT(j) (256 + 64 * (j))
#define XB_XSUB(j) (1280 + 64 * (j))
#define XB_XGEN(j) (2304 + 64 * (j))
#define XB_TOP 3328
#define XB_TOPGEN 3392
DI unsigned xb_ld(unsigned* p) { return __hip_atomic_load(p, __ATOMIC_RELAXED, __HIP_MEMORY_SCOPE_AGENT); }
DI unsigned xb_add(unsigned* p, unsigned v) { return __hip_atomic_fetch_add(p, v, __ATOMIC_RELAXED, __HIP_MEMORY_SCOPE_AGENT); }
struct XBar { unsigned* bar; unsigned x, nloc, nx; };
DI void gsync_impl(cg::grid_group& g, XBar& b) {
#if DBG_CG_SYNC
  g.sync();
#else
  asm volatile("s_waitcnt vmcnt(0)" ::: "memory");
  __syncthreads();
  if (threadIdx.x == 0) {
    unsigned* bar = b.bar;
    __builtin_amdgcn_s_waitcnt(0);
    if (b.nloc == 0u) {
      unsigned sum, cnt, mine;
      for (;;) {
        sum = 0u; cnt = 0u; mine = 0u;
#pragma unroll
        for (unsigned j = 0; j < 16; ++j) { const unsigned c = xb_ld(&bar[XB_XCNT(j)]); sum += c; cnt += (c > 0u) ? 1u : 0u; mine = (j == b.x) ? c : mine; }
        if (sum == gridDim.x) break;
        __builtin_amdgcn_s_sleep(1);
      }
      b.nloc = mine > 0u ? mine : 1u; b.nx = cnt > 0u ? cnt : 1u;
    }
    const unsigned old = xb_add(&bar[XB_XSUB(b.x)], 1u);
    const unsigned gen = old / b.nloc;
    if (old + 1u == (gen + 1u) * b.nloc) {
      __builtin_amdgcn_fence(__ATOMIC_RELEASE, "agent");
      asm volatile("s_waitcnt vmcnt(0)" ::: "memory");
      const unsigned og = xb_add(&bar[XB_TOP], 1u);
      const unsigned tg = og / b.nx;
      if (og + 1u == (tg + 1u) * b.nx) xb_add(&bar[XB_TOPGEN], 1u);
      else { while (xb_ld(&bar[XB_TOPGEN]) == tg) __builtin_amdgcn_s_sleep(1); }
      __builtin_amdgcn_fence(__ATOMIC_ACQUIRE, "agent");
      xb_add(&bar[XB_XGEN(b.x)], 1u);
      asm volatile("s_waitcnt vmcnt(0)" ::: "memory");
    } else {
      while (xb_ld(&bar[XB_XGEN(b.x)]) == gen) __builtin_amdgcn_s_sleep(1);
      __builtin_amdgcn_fence(__ATOMIC_ACQUIRE, "agent");
      asm volatile("s_waitcnt vmcnt(0)" ::: "memory");
    }
  }
  __syncthreads();
#endif
}

#define gsync(G, E) gsync_impl(G, E)
DI int tile_map(int L, int MT, int NT) {
  const int per = 8 * NT;
  const int P = L / per, u = L - P * per;
  const int h = min(8, MT - P * 8);
  const int nt = u / h, mt = P * 8 + (u - nt * h);
  return mt * NT + nt;
}
__global__ void __launch_bounds__(256, 2) fwd_mega(Params p) {
  cg::grid_group grid = cg::this_grid();
  __shared__ __attribute__((aligned(16))) char smem[65536];
  const int nb = gridDim.x, bid = blockIdx.x;
  const int pb = ((nb & 7) == 0) ? (bid & 7) * (nb >> 3) + (bid >> 3) : bid;
  float* xctx = (float*)(p.ws + OFF_XCTX);
  u16* RH = (u16*)(p.ws + OFF_RH);
  u16* HP = (u16*)(p.ws + OFF_HP);
  XBar epoch;
  epoch.bar = (unsigned*)(p.ws + OFF_BAR);
  epoch.x = (unsigned)__builtin_amdgcn_s_getreg((3 << 11) | 20) & 0xFu;
  epoch.nloc = 0u; epoch.nx = 0u;
  if (threadIdx.x == 0) (void)xb_add(&epoch.bar[XB_XCNT(epoch.x)], 1u);
  {
    constexpr int NC0 = 2336;
    const int total = NC0 + 192 + 1536 + 528;
    for (int it = bid; it < total; it += nb) {
      if (it < NC0) conv_tile(p, 0, it, smem);
      else if (it < NC0 + 192) mod_item(p, it - NC0, smem);
      else if (it < NC0 + 192 + 1536) rope_item(p, it - NC0 - 192);
      else hid_item(p, it - NC0 - 192 - 1536, smem);
    }
  }
  if (p.ws == nullptr) grid.sync();
  gsync(grid, epoch);
  row_pass(p, 0, p.x, p.ctx, nullptr, nullptr, nullptr, nullptr, 0, 0, false, p.norm_g, 0, 0, 1024, RH, false);
  gsync(grid, epoch);
#pragma unroll 1
  for (int l = 0; l < 2; ++l) {
    const float* xl = (l == 0) ? p.x : p.out;
    const float* xc = (l == 0) ? p.ctx : xctx;
    for (int rep = 0; rep < DBG_REP_FFT; ++rep)
    for (int it = pb; it < 1024; it += nb) filt_item(p, l, it, smem);
    gsync(grid, epoch);
    for (int rep = 0; rep < DBG_REP_GEMM; ++rep)
    for (int it = pb; it < 4752; it += nb) inproj_tile(p, tile_map(it, 176, 27), smem);
    gsync(grid, epoch);
#if DBG_DUMP == 5
    { const _Float16* sp = (const _Float16*)(p.ws + OFF_SPEC);
      for (size_t i = (size_t)bid * 256 + threadIdx.x; i < (size_t)NBATCH * SEQ * DM; i += (size_t)nb * 256) p.out[i] = (float)sp[i];
      return; }
#endif
    {
      const int nSW = 2048 + (l == 0 ? 64 : 0);
      for (int rep = 0; rep < DBG_REP_GEMM; ++rep)
      for (int it = pb; it < 1408 + nSW; it += nb) {
        if (it < 1408) kvup_tile(p, tile_map(it, 176, 8), smem);
        else if (it < 1408 + 2048) {
          const int i1 = it - 1408, n = i1 & 63, jlo = (n == 0) ? 2 : 0, jhi = (n == 63) ? 4 : 6;
          attn_item<64, true>(p, l, i1 >> 9, (i1 >> 6) & 7, CTX + n * 128, 4, jhi - jlo, (n - 1) * 128 + 64 * jlo, smem);
        } else { const int i2 = it - 1408 - 2048; attn_item<64, true>(p, l, i2 >> 4, (i2 >> 1) & 7, (i2 & 1) * 128, 4, 0, 0, smem); }
      }
    }
    gsync(grid, epoch);
    {
      const int nF = 2048 + (l == 0 ? 64 : 0);
      for (int rep = 0; rep < DBG_REP_MLA; ++rep)
      for (int it = pb; it < nF; it += nb) {
        if (it < 2048) attn_item<96, false>(p, l, it >> 9, (it >> 6) & 7, CTX + (it & 63) * 128, 132, 0, 0, smem);
        else { const int i2 = it - 2048; attn_item<96, false>(p, l, i2 >> 4, (i2 >> 1) & 7, (i2 & 1) * 128, 4, 0, 0, smem); }
      }
    }
    gsync(grid, epoch);
    {
      const int nF2 = 1024 + (l == 0 ? 512 : 0);
      for (int it = pb; it < nF2; it += nb) {
        if (it < 1024) hconv_item(p, l, 0, it >> 1, it & 1, smem);
        else hctx_item(p, l, it - 1024, smem);
      }
    }
    gsync(grid, epoch);
    for (int rep = 0; rep < DBG_REP_FFT; ++rep)
    for (int it = pb; it < 1024; it += nb) hconv_item(p, l, 1, it >> 1, it & 1, smem);
    gsync(grid, epoch);
    for (int rep = 0; rep < DBG_REP_GEMM; ++rep)
    for (int it = pb; it < 1408; it += nb) merge_tile(p, tile_map(it, 176, 8), smem);
    if (l == 0 && pb >= 384 && nb > 384) for (int ct = 2336 + (pb - 384); ct < NCONV_TILES; ct += nb - 384) conv_tile(p, 0, ct, smem);
    gsync(grid, epoch);
    for (int rep = 0; rep < DBG_REP_GEMM * DBG_REP_PLAIN; ++rep)
    for (int it = pb; it < 1408; it += nb) plain_tile(p, tile_map(it, 176, 8), (const u16*)(p.ws + OFF_MERGED), 1024, 16, (const u16*)(p.ws + OFF_WT_OUT), (u16*)(p.ws + OFF_Y), smem);
    gsync(grid, epoch);
    row_pass(p, 1, xl, xc, p.out, xctx, (const u16*)(p.ws + OFF_Y), p.norm_g + (size_t)(l * 4 + 1) * 1024, 2048, l, true, p.norm_g + (size_t)(l * 4 + 2) * 1024, l, 3072, 4096, RH, false);
    gsync(grid, epoch);
    for (int rep = 0; rep < DBG_REP_GEMM; ++rep)
    for (int it = pb; it < 184 * 44; it += nb) ffnup_tile(p, l, tile_map(it, 184, 44), smem);
    gsync(grid, epoch);
    for (int rep = 0; rep < DBG_REP_GEMM * DBG_REP_PLAIN; ++rep)
    for (int it = pb; it < 1408; it += nb) plain_tile(p, tile_map(it, 176, 8), (const u16*)(p.ws + OFF_A), 2816, 44, (const u16*)(p.ws + OFF_WT_DOWN), HP, smem);
    if (l == 0 && pb >= 384 && nb > 384) for (int ct = pb - 384; ct < 1632; ct += nb - 384) conv_tile(p, 1, ct, smem);
    gsync(grid, epoch);
    row_pass(p, 1, p.out, xctx, p.out, xctx, HP, p.norm_g + (size_t)(l * 4 + 3) * 1024, 5120, l, l == 0, p.norm_g + (size_t)((l + 1) * 4) * 1024, l + 1, 0, 1024, RH, l == 1);
    if (l == 0) {
      for (int it = bid; it < NCONV_TILES - 1632; it += nb) conv_tile(p, 1, 1632 + it, smem);
      gsync(grid, epoch);
    }
  }
  for (int rep = 0; rep < DBG_EXTRA_SYNCS; ++rep) gsync(grid, epoch);
#if DBG_DUMP == 1
  gsync(grid, epoch);
  { const _Float16* sp = (const _Float16*)(p.ws + OFF_SPEC);
    for (size_t i = (size_t)bid * 256 + threadIdx.x; i < (size_t)NBATCH * SEQ * DM; i += (size_t)nb * 256) p.out[i] = (float)sp[i]; }
#elif DBG_DUMP == 3
  gsync(grid, epoch);
  { const float* hd = (const float*)(p.ws + OFF_HID);
    for (size_t i = (size_t)bid * 256 + threadIdx.x; i < (size_t)NBATCH * SEQ * DM; i += (size_t)nb * 256) p.out[i] = i < (size_t)2 * 64 * 8448 ? hd[i] : 0.f; }
#elif DBG_DUMP == 2
  gsync(grid, epoch);
  { const u16* yc = (const u16*)(p.ws + OFF_YCT);
    for (size_t i = (size_t)bid * 256 + threadIdx.x; i < (size_t)NBATCH * SEQ * DM; i += (size_t)nb * 256) p.out[i] = i < (size_t)4 * 512 * TPB ? bf2f(yc[i]) : 0.f; }
#endif
}

extern "C" void kernel_launch(void* const* d_in, const int* in_sizes, int n_in, void* d_out, int out_size, void* d_ws, size_t ws_size,
                              hipStream_t stream) {
  static int grid_blocks = 0;
  if (!grid_blocks) {
    int dev = 0, cus = 0, per_cu = 0;
    (void)hipGetDevice(&dev);
    (void)hipDeviceGetAttribute(&cus, hipDeviceAttributeMultiprocessorCount, dev);
    (void)hipOccupancyMaxActiveBlocksPerMultiprocessor(&per_cu, fwd_mega, 256, 0);
    if (per_cu > 2) per_cu = 2;
    if (per_cu < 1) per_cu = 1;
    grid_blocks = cus * per_cu;
  }
  if (ws_size < WS_NEED) { fprintf(stderr, "workspace too small: %zu < %zu\n", ws_size, (size_t)WS_NEED); return; }
  Params p{};
  const float** pp = (const float**)&p;
  for (int i = 0; i < 26; ++i) pp[i] = (const float*)d_in[i];
  p.out = (float*)d_out;
  p.ws = (char*)d_ws;
  (void)hipMemsetAsync((char*)d_ws + OFF_BAR, 0, BAR_BYTES, stream);
  void* args[] = {&p};
  hipError_t e = hipLaunchCooperativeKernel((void*)fwd_mega, dim3(grid_blocks), dim3(256), args, 0, stream);
  if (e != hipSuccess) fprintf(stderr, "cooperative launch failed: %s (grid %d)\n", hipGetErrorString(e), grid_blocks);
}
```
